# Optimizing an MI355X kernel written in HIP

```python
import math
import jax, jax.numpy as jnp
from jax import lax
import numpy as np

D_MODEL = 2048
BATCH = 4
SEQ = 2048
DEPTH = 1
DEC_BATCH = 128
DEC_SEQ = 8
PAST_LEN = 16384
PAGE_SIZE = 128

N_META = 16
SSD_HEADS = 32
SSD_HEAD_DIM = 64
SSD_D_INNER = SSD_HEADS * SSD_HEAD_DIM
SSD_GROUPS = 2
SSD_STATE = 128
SSD_CONV = 4
SSD_CONV_DIM = SSD_D_INNER + 2 * SSD_GROUPS * SSD_STATE
ML_HEADS = 8
ML_QK_DIM = 128
ML_V_DIM = 256
ML_D_INNER = ML_HEADS * ML_V_DIM
MIX_WIDTH = SSD_D_INNER + ML_D_INNER
D_FF = 5632
FFN_CONV = 3
CHUNK = 128
EPS = 1e-6

IN_SIZES = [SSD_D_INNER,
            SSD_CONV_DIM,
            SSD_HEADS,
            ML_HEADS * ML_QK_DIM,
            ML_HEADS * ML_QK_DIM,
            ML_D_INNER,
            ML_HEADS,
            ML_HEADS,
            ML_D_INNER]
IN_COLS = int(sum(IN_SIZES))
IN_SPLITS = [int(s) for s in np.cumsum(IN_SIZES)[:-1]]

kernel_name = "hymba_ssd_mlstm_convffn_step"


def rmsnorm(x, w):
    xf = x.astype(jnp.float32)
    r = lax.rsqrt(jnp.mean(xf * xf, axis=-1, keepdims=True) + EPS)
    return (xf * r).astype(x.dtype) * w


def causal_dwconv(x, buf, w, b):
    K = w.shape[0]
    T = x.shape[1]
    xp = jnp.concatenate([buf.astype(x.dtype), x], axis=1)
    y = b
    for j in range(K):
        y = y + xp[:, j:j + T] * w[j]
    return y, xp[:, xp.shape[1] - (K - 1):]


def to_chunks(a, L):
    Bsz, T = a.shape[0], a.shape[1]
    return jnp.moveaxis(a.reshape(Bsz, T // L, L, *a.shape[2:]), 1, 0)


def from_chunks(a):
    a = jnp.moveaxis(a, 0, 1)
    return a.reshape(a.shape[0], a.shape[1] * a.shape[2], *a.shape[3:])


def ssd_scan(x, dt, A, Bm, Cm, S0, L):
    Bsz, T, H, P = x.shape
    G, N = Bm.shape[2], Bm.shape[3]
    E = H // G
    f32 = jnp.float32
    xs = to_chunks(x.astype(f32).reshape(Bsz, T, G, E, P), L)
    dts = to_chunks(dt.astype(f32).reshape(Bsz, T, G, E), L)
    Bs = to_chunks(Bm.astype(f32), L)
    Cs = to_chunks(Cm.astype(f32), L)
    Ag = A.astype(f32).reshape(G, E)
    causal = jnp.tril(jnp.ones((L, L), dtype=bool))

    def step(S, inp):
        xc, dtc, Bc, Cc = inp
        cum = jnp.cumsum(dtc * Ag, axis=1)
        seg = cum[:, :, None] - cum[:, None, :]
        decay = jnp.exp(jnp.where(causal[None, :, :, None, None], seg, -jnp.inf))
        CB = jnp.einsum('btgn,bsgn->btsg', Cc, Bc)
        y = jnp.einsum('btsg,btsge,bsge,bsgep->btgep', CB, decay, dtc, xc)
        y = y + jnp.einsum('btgn,bgepn,btge->btgep', Cc, S, jnp.exp(cum))
        tail = jnp.exp(cum[:, -1:] - cum) * dtc
        S = S * jnp.exp(cum[:, -1])[..., None, None] + jnp.einsum('bsgn,bsge,bsgep->bgepn', Bc, tail, xc)
        return S, y

    S, ys = lax.scan(step, S0.astype(f32).reshape(Bsz, G, E, P, N), (xs, dts, Bs, Cs))
    return from_chunks(ys).reshape(Bsz, T, H, P), S.reshape(Bsz, H, P, N)


def mlstm_scan(q, k, v, ig, lf, C0, n0, m0, L):
    f32 = jnp.float32
    qs, ks, vs = (to_chunks(a.astype(f32), L) for a in (q, k, v))
    is_, fs = to_chunks(ig, L), to_chunks(lf, L)
    causal = jnp.tril(jnp.ones((L, L), dtype=bool))

    def step(carry, inp):
        Cp, npv, mp = carry
        qc, kc, vc, ic, fc = inp
        F = jnp.cumsum(fc, axis=1)
        Dm = F[:, :, None] - F[:, None, :] + ic[:, None, :]
        Dm = jnp.where(causal[None, :, :, None], Dm, -jnp.inf)
        inter = F + mp[:, None]
        m_t = jnp.maximum(jnp.max(Dm, axis=2), inter)
        W = jnp.exp(Dm - m_t[:, :, None]) * jnp.einsum('bthd,bshd->btsh', qc, kc)
        wi = jnp.exp(inter - m_t)
        num = jnp.einsum('btsh,bshv->bthv', W, vc) + wi[..., None] * jnp.einsum('bthd,bhdv->bthv', qc, Cp)
        den = jnp.sum(W, axis=2) + wi * jnp.einsum('bthd,bhd->bth', qc, npv)
        h = num / jnp.maximum(jnp.abs(den), jnp.exp(-m_t))[..., None]
        FL = F[:, -1]
        lw = FL[:, None] - F + ic
        m_new = jnp.maximum(FL + mp, jnp.max(lw, axis=1))
        sc = jnp.exp(lw - m_new[:, None])
        dec = jnp.exp(FL + mp - m_new)
        C_new = dec[..., None, None] * Cp + jnp.einsum('bsh,bshd,bshv->bhdv', sc, kc, vc)
        n_new = dec[..., None] * npv + jnp.einsum('bsh,bshd->bhd', sc, kc)
        return (C_new, n_new, m_new), h

    (C, n, m), hs = lax.scan(step, (C0.astype(f32), n0.astype(f32), m0.astype(f32)), (qs, ks, vs, is_, fs))
    return from_chunks(hs), C, n, m


def hybrid_layer(h, seg_lens, states, params):
    conv_buf, S, Cst, nst, mst, ffn_buf = states
    (norm1_w, w_in, ssd_conv_w, ssd_conv_b, ssd_dt_bias, ssd_A_log, ssd_D, ssd_norm_w,
     ml_i_bias, ml_f_bias, ml_norm_w, w_out, norm2_w, w_up, ffn_conv_w, ffn_conv_b, w_down) = params
    Bsz, T, _ = h.shape
    f32 = jnp.float32
    u = rmsnorm(h, norm1_w) @ w_in
    z, xBC, dt_raw, q, k, v, i_raw, f_raw, o_raw = jnp.split(u, IN_SPLITS, axis=-1)
    xBC, conv_new = causal_dwconv(xBC, conv_buf, ssd_conv_w, ssd_conv_b)
    xBC = jax.nn.silu(xBC)
    xs, Bm, Cm = jnp.split(xBC, [SSD_D_INNER, SSD_D_INNER + SSD_GROUPS * SSD_STATE], axis=-1)
    xs = xs.reshape(Bsz, T, SSD_HEADS, SSD_HEAD_DIM)
    Bm = Bm.reshape(Bsz, T, SSD_GROUPS, SSD_STATE)
    Cm = Cm.reshape(Bsz, T, SSD_GROUPS, SSD_STATE)
    dt = jax.nn.softplus(dt_raw.astype(f32) + ssd_dt_bias.astype(f32))
    A = -jnp.exp(ssd_A_log.astype(f32))
    q = q.reshape(Bsz, T, ML_HEADS, ML_QK_DIM)
    k = k.reshape(Bsz, T, ML_HEADS, ML_QK_DIM) * (ML_QK_DIM ** -0.5)
    v = v.reshape(Bsz, T, ML_HEADS, ML_V_DIM)
    ig = i_raw.astype(f32) + ml_i_bias.astype(f32)
    lf = jax.nn.log_sigmoid(f_raw.astype(f32) + ml_f_bias.astype(f32))
    y_ssd_parts, h_ml_parts = [], []
    start = 0
    for Lseg in seg_lens:
        sl = slice(start, start + Lseg)
        L = math.gcd(Lseg, CHUNK)
        y_seg, S = ssd_scan(xs[:, sl], dt[:, sl], A, Bm[:, sl], Cm[:, sl], S, L)
        h_seg, Cst, nst, mst = mlstm_scan(q[:, sl], k[:, sl], v[:, sl], ig[:, sl], lf[:, sl], Cst, nst, mst, L)
        y_ssd_parts.append(y_seg)
        h_ml_parts.append(h_seg)
        start += Lseg
    y_ssd = jnp.concatenate(y_ssd_parts, axis=1)
    y_ssd = (y_ssd + ssd_D.astype(f32)[:, None] * xs.astype(f32)).astype(h.dtype)
    y_ssd = rmsnorm(y_ssd.reshape(Bsz, T, SSD_D_INNER) * jax.nn.silu(z), ssd_norm_w)
    h_ml = jnp.concatenate(h_ml_parts, axis=1).astype(h.dtype)
    h_ml = rmsnorm(h_ml, ml_norm_w.reshape(ML_HEADS, ML_V_DIM)).reshape(Bsz, T, ML_D_INNER)
    y_ml = jax.nn.sigmoid(o_raw) * h_ml
    h = h + jnp.concatenate([y_ssd, y_ml], axis=-1) @ w_out
    up = rmsnorm(h, norm2_w) @ w_up
    up, ffn_new = causal_dwconv(up, ffn_buf, ffn_conv_w, ffn_conv_b)
    gate, val = jnp.split(up, 2, axis=-1)
    h = h + (jax.nn.silu(gate) * val) @ w_down
    new_states = (conv_new, S.astype(conv_new.dtype), Cst, nst, mst, ffn_new)
    return h, new_states


def setup_inputs(seed: int = 0) -> dict:
    key = jax.random.key(seed)
    ks = jax.random.split(key, 32)
    f32 = jnp.float32
    nrm = lambda kk, shape, s: jax.random.normal(kk, shape, f32) * s
    dt0 = jnp.exp(jax.random.uniform(ks[16], (DEPTH, SSD_HEADS), f32, math.log(1e-3), math.log(1e-1)))
    return {
        "x_prompt": nrm(ks[0], (BATCH, SEQ, D_MODEL), 1.0),
        "x_sample": nrm(ks[1], (DEC_BATCH, DEC_SEQ, D_MODEL), 1.0),
        "state_ssd_conv": nrm(ks[2], (DEPTH, DEC_BATCH, SSD_CONV - 1, SSD_CONV_DIM), 1.0),
        "state_ssd": nrm(ks[3], (DEPTH, DEC_BATCH, SSD_HEADS, SSD_HEAD_DIM, SSD_STATE), 0.1),
        "state_mlstm_C": nrm(ks[4], (DEPTH, DEC_BATCH, ML_HEADS, ML_QK_DIM, ML_V_DIM), 0.1),
        "state_mlstm_n": jnp.abs(nrm(ks[5], (DEPTH, DEC_BATCH, ML_HEADS, ML_QK_DIM), 0.5)),
        "state_mlstm_m": nrm(ks[6], (DEPTH, DEC_BATCH, ML_HEADS), 0.5),
        "state_ffn_conv": nrm(ks[7], (DEPTH, DEC_BATCH, FFN_CONV - 1, 2 * D_FF), 1.0),
        "meta_tokens": nrm(ks[8], (N_META, D_MODEL), 1.0),
        "norm1_w": 1.0 + nrm(ks[9], (DEPTH, D_MODEL), 0.02),
        "w_in": nrm(ks[10], (DEPTH, D_MODEL, IN_COLS), D_MODEL ** -0.5),
        "ssd_conv_w": nrm(ks[11], (DEPTH, SSD_CONV, SSD_CONV_DIM), SSD_CONV ** -0.5),
        "ssd_conv_b": nrm(ks[12], (DEPTH, SSD_CONV_DIM), 0.02),
        "ssd_dt_bias": dt0 + jnp.log(-jnp.expm1(-dt0)),
        "ssd_A_log": jnp.log(jax.random.uniform(ks[13], (DEPTH, SSD_HEADS), f32, 1.0, 16.0)),
        "ssd_D": 1.0 + nrm(ks[14], (DEPTH, SSD_HEADS), 0.02),
        "ssd_norm_w": 1.0 + nrm(ks[15], (DEPTH, SSD_D_INNER), 0.02),
        "ml_i_bias": nrm(ks[17], (DEPTH, ML_HEADS), 0.1) - 1.0,
        "ml_f_bias": jax.random.uniform(ks[18], (DEPTH, ML_HEADS), f32, 3.0, 6.0),
        "ml_norm_w": 1.0 + nrm(ks[19], (DEPTH, ML_D_INNER), 0.02),
        "w_out": nrm(ks[20], (DEPTH, MIX_WIDTH, D_MODEL), MIX_WIDTH ** -0.5),
        "norm2_w": 1.0 + nrm(ks[21], (DEPTH, D_MODEL), 0.02),
        "w_up": nrm(ks[22], (DEPTH, D_MODEL, 2 * D_FF), D_MODEL ** -0.5),
        "ffn_conv_w": nrm(ks[23], (DEPTH, FFN_CONV, 2 * D_FF), FFN_CONV ** -0.5),
        "ffn_conv_b": nrm(ks[24], (DEPTH, 2 * D_FF), 0.02),
        "w_down": nrm(ks[25], (DEPTH, D_FF, D_MODEL), D_FF ** -0.5),
        "final_norm_w": 1.0 + nrm(ks[26], (D_MODEL,), 0.02),
    }


def reference(x_prompt, x_sample, state_ssd_conv, state_ssd, state_mlstm_C, state_mlstm_n,
              state_mlstm_m, state_ffn_conv, meta_tokens, norm1_w, w_in, ssd_conv_w, ssd_conv_b,
              ssd_dt_bias, ssd_A_log, ssd_D, ssd_norm_w, ml_i_bias, ml_f_bias, ml_norm_w, w_out,
              norm2_w, w_up, ffn_conv_w, ffn_conv_b, w_down, final_norm_w):
    Bp = x_prompt.shape[0]
    f32 = jnp.float32
    meta = jnp.broadcast_to(meta_tokens[None].astype(x_prompt.dtype), (Bp, N_META, D_MODEL))
    hp = jnp.concatenate([meta, x_prompt], axis=1)
    hs = x_sample
    p_lists = [[] for _ in range(6)]
    s_lists = [[] for _ in range(6)]
    for l in range(DEPTH):
        params = (norm1_w[l], w_in[l], ssd_conv_w[l], ssd_conv_b[l], ssd_dt_bias[l], ssd_A_log[l],
                  ssd_D[l], ssd_norm_w[l], ml_i_bias[l], ml_f_bias[l], ml_norm_w[l], w_out[l],
                  norm2_w[l], w_up[l], ffn_conv_w[l], ffn_conv_b[l], w_down[l])
        p_init = (jnp.zeros((Bp, SSD_CONV - 1, SSD_CONV_DIM), hp.dtype),
                  jnp.zeros((Bp, SSD_HEADS, SSD_HEAD_DIM, SSD_STATE), f32),
                  jnp.zeros((Bp, ML_HEADS, ML_QK_DIM, ML_V_DIM), f32),
                  jnp.zeros((Bp, ML_HEADS, ML_QK_DIM), f32),
                  jnp.zeros((Bp, ML_HEADS), f32),
                  jnp.zeros((Bp, FFN_CONV - 1, 2 * D_FF), hp.dtype))
        s_init = (state_ssd_conv[l], state_ssd[l], state_mlstm_C[l], state_mlstm_n[l],
                  state_mlstm_m[l], state_ffn_conv[l])
        hp, p_new = hybrid_layer(hp, (N_META, hp.shape[1] - N_META), p_init, params)
        hs, s_new = hybrid_layer(hs, (hs.shape[1],), s_init, params)
        for j in range(6):
            p_lists[j].append(p_new[j])
            s_lists[j].append(s_new[j])
    y_prompt = rmsnorm(hp, final_norm_w)[:, N_META:]
    y_sample = rmsnorm(hs, final_norm_w)
    p_st = [jnp.stack(a, axis=0) for a in p_lists]
    s_st = [jnp.stack(a, axis=0) for a in s_lists]
    return (y_prompt, y_sample,
            p_st[0], p_st[1], p_st[2], p_st[3], p_st[4], p_st[5],
            s_st[0], s_st[1], s_st[2], s_st[3], s_st[4], s_st[5])
```

```cpp
#include <hip/hip_runtime.h>
#include <hip/hip_cooperative_groups.h>
#include <cstdio>
namespace cg = cooperative_groups;

#define LAS __attribute__((address_space(3)))
typedef unsigned short bf16_t;
typedef short bf16x8 __attribute__((ext_vector_type(8)));
typedef float f32x4 __attribute__((ext_vector_type(4)));
typedef unsigned u32x4 __attribute__((ext_vector_type(4)));
typedef unsigned u32x2 __attribute__((ext_vector_type(2)));

constexpr int DM = 2048, MP = 9472, NVALID = 9280, NOUTROWS = 9216;
constexpr int N1P = 11008, N3 = 11264, DFF = 5632, MIXW = 4096;
constexpr int ROW_SAMPLE = 8192, ROW_META = 9216;
constexpr float EPS = 1e-6f;
constexpr int UC_Z = 0, UC_XBC = 2048, UC_Q = 4640, UC_K = 5664, UC_V = 6688, UC_O = 8752;
constexpr size_t WS_WIN = 0;
constexpr size_t WS_WOUT = WS_WIN + (size_t)N1P * 2048 * 2;
constexpr size_t WS_WUP = WS_WOUT + (size_t)2048 * 4096 * 2;
constexpr size_t WS_WDOWN = WS_WUP + (size_t)N3 * 2048 * 2;
constexpr size_t WS_XN = WS_WDOWN + (size_t)2048 * DFF * 2;
constexpr size_t WS_MIX = WS_XN + (size_t)MP * 2048 * 2;
constexpr size_t WS_ACT = WS_XN;
constexpr size_t WS_U = WS_MIX + (size_t)MP * MIXW * 2;
constexpr size_t WS_UP = WS_U;
constexpr size_t WS_H1 = WS_U + (size_t)MP * N3 * 2;
constexpr size_t WS_A2 = WS_H1 + (size_t)MP * 2048 * 4;
constexpr size_t WS_SF = WS_A2 + (size_t)MP * 2048 * 2;
constexpr size_t WS_SSQ = WS_SF + (size_t)MP * 64 * 4;
constexpr size_t WS_SSQM = WS_SSQ + (size_t)MP * 32 * 4;
constexpr size_t WS_SS2 = WS_SSQM + (size_t)MP * 32 * 4;
constexpr size_t WS_SS3 = WS_SS2 + (size_t)MP * 4;
constexpr size_t WS_END = WS_SS3 + (size_t)MP * 4;
constexpr size_t O_Y = 0;
constexpr size_t O_P_SSDCONV = 18874368, O_P_SSD = 18905088, O_P_MLC = 19953664, O_P_MLN = 21002240, O_P_MLM = 21006336, O_P_FFN = 21006368;
constexpr size_t O_S_SSDCONV = 21096480, O_S_SSD = 22079520, O_S_MLC = 55633952, O_S_MLN = 89188384, O_S_MLM = 89319456, O_S_FFN = 89320480;
constexpr size_t O_END = 92204064;
constexpr int LDS_BYTES = 147456;
constexpr int NPHASE = 9;
#ifndef CHL
#define CHL 64
#endif
constexpr int NCH = 1 + 2048 / CHL;
#ifndef PH_MASK
#define PH_MASK 0x1ff
#endif

struct Params {
    const float* in[27];
    float* out;
    unsigned char* ws;
    int ph_lo, ph_hi;
};

__device__ __forceinline__ unsigned pack2(float lo, float hi) { unsigned r; asm("v_cvt_pk_bf16_f32 %0, %1, %2" : "=v"(r) : "v"(lo), "v"(hi)); return r; }
__device__ __forceinline__ float bf_lo(unsigned u) { return __uint_as_float(u << 16); }
__device__ __forceinline__ float bf_hi(unsigned u) { return __uint_as_float(u & 0xffff0000u); }
__device__ __forceinline__ float bf2f(bf16_t h) { return __uint_as_float((unsigned)h << 16); }
__device__ __forceinline__ float silu_f(float x) { return x / (1.f + __expf(-x)); }
__device__ __forceinline__ float sigm_f(float x) { return 1.f / (1.f + __expf(-x)); }
__device__ __forceinline__ float softplus_f(float x) { return x > 20.f ? x : log1pf(__expf(x)); }
__device__ __forceinline__ float logsig_f(float x) { return fminf(x, 0.f) - log1pf(__expf(-fabsf(x))); }
__device__ __forceinline__ int opaque_tid() { int t = threadIdx.x; asm volatile("" : "+v"(t)); return t; }
__device__ __forceinline__ int opaque_bid() { int t = blockIdx.x; asm volatile("" : "+s"(t)); return t; }
__device__ __forceinline__ int row_of(int b, int pos) { return pos < 16 ? ROW_META + b * 16 + pos : b * 2048 + pos - 16; }
__device__ __forceinline__ float wave_sum(float v) {
    v += __shfl_xor(v, 32); v += __shfl_xor(v, 16); v += __shfl_xor(v, 8); v += __shfl_xor(v, 4); v += __shfl_xor(v, 2); v += __shfl_xor(v, 1); return v;
}
__device__ __forceinline__ const float* resid_row(const Params& p, int row) {
    if (row < ROW_SAMPLE) return p.in[0] + (size_t)row * DM;
    if (row < ROW_META) return p.in[1] + (size_t)(row - ROW_SAMPLE) * DM;
    if (row < NVALID) return p.in[8] + (size_t)((row - ROW_META) & 15) * DM;
    return nullptr;
}

namespace pg8 {
constexpr int BM = 256, BK = 64, HALF = 128, HTB = HALF * BK * 2, STAGE_BYTES = 8 * HTB, NXCD = 8, WGM = 8;
__device__ __forceinline__ int lds_byte(int r, int c) { const int st = (r >> 4) * 2 + (c >> 5), rr = r & 15, cc = c & 31, ob = rr * 64 + cc * 2; return st * 1024 + (ob ^ (((ob >> 9) & 1) << 5)); }
__device__ __forceinline__ void stage_rc(int b, int& R, int& C) { const int st = b / 1024, sb = b % 1024, swz = sb ^ (((sb >> 9) & 1) << 5); R = (st >> 1) * 16 + swz / 64; C = (st & 1) * 32 + (swz % 64) / 2; }
__device__ __forceinline__ int perm32(int rho) { const int n = rho >> 4, i = rho & 15; return 8 * (i >> 2) + 4 * n + (i & 3); }
struct Unit { int pm, pn; };
struct Gemm { const bf16_t* A; const bf16_t* Bt; int M, N, K; };
struct StaticOrder {
    int nM, nN, nwg, G, c;
    __device__ void init(int M, int N, int G_, int c_) { nM = M / BM; nN = N / BM; nwg = nM * nN; G = G_; c = c_; }
    __device__ bool next(int i, Unit& u) const {
        const long L = (long)i * G + c; if (L >= nwg) return false;
        int wgid = (int)L; { const int q = nwg / NXCD, r = nwg % NXCD, xcd = wgid % NXCD, off = wgid / NXCD; wgid = (xcd < r ? xcd * (q + 1) : r * (q + 1) + (xcd - r) * q) + off; }
        const int nig = WGM * nN, gid = wgid / nig, fm = gid * WGM, gsz = (nM - fm) < WGM ? (nM - fm) : WGM;
        u.pm = fm + ((wgid % nig) % gsz); u.pn = (wgid % nig) / gsz; return true;
    }
};

template <class Epi>
__device__ __forceinline__ void gemm_phase(LAS unsigned char* lds, const Gemm g, const StaticOrder& S, const Epi& E) {
    const int tid = opaque_tid(), wid = __builtin_amdgcn_readfirstlane(tid >> 6), lane = tid & 63, wr = wid >> 2, wc = wid & 3, fr = lane & 15, fq = lane >> 4;
    const int K = g.K, nt = K / BK;
    unsigned voffA[2], voffB[2];
#pragma unroll
    for (int i = 0; i < 2; ++i) { int R, C; stage_rc(tid * 16 + i * 8192, R, C); const int Rb = ((R & ~31) + perm32(R & 31));
        voffA[i] = (unsigned)(R * K + C) * 2u; voffB[i] = (unsigned)(Rb * K + C) * 2u; }
    const size_t kstep = (size_t)(BK * 2);
    const size_t hstep = (size_t)HALF * K * 2;
    const size_t tstep = 2 * hstep;
    const unsigned ldsw = (unsigned)wid * 1024u;
    const int aoff = lds_byte(wr * 64 + fr, fq * 8), boff = lds_byte(wc * 32 + fr, fq * 8);
#define PG8_SA(b, h) (((b) * 2 + (h)) * HTB)
#define PG8_SB(b, h) ((4 + (b) * 2 + (h)) * HTB)
#define PG8_STAGE(bufoff, gbase, voff) do { _Pragma("unroll") for (int _i = 0; _i < 2; ++_i) \
        __builtin_amdgcn_global_load_lds((const unsigned*)((const char*)(gbase) + (voff)[_i]), (LAS unsigned*)(lds + (bufoff) + ldsw + _i * 8192), 16, 0, 0); } while (0)
#define PG8_LDA(dst, b, h) do { _Pragma("unroll") for (int m = 0; m < 4; ++m) _Pragma("unroll") for (int k = 0; k < 2; ++k) dst[m][k] = *(const LAS bf16x8*)(lds + PG8_SA(b, h) + aoff + m * 2048 + k * 1024); } while (0)
#define PG8_LDB(dst, b, h) do { _Pragma("unroll") for (int n = 0; n < 2; ++n) _Pragma("unroll") for (int k = 0; k < 2; ++k) dst[n][k] = *(const LAS bf16x8*)(lds + PG8_SB(b, h) + boff + n * 2048 + k * 1024); } while (0)
#define PG8_MMA(ai, bj, At, Bt) do { __builtin_amdgcn_s_setprio(1); _Pragma("unroll") for (int m = 0; m < 4; ++m) _Pragma("unroll") for (int n = 0; n < 2; ++n) _Pragma("unroll") for (int k = 0; k < 2; ++k) \
        acc[ai][bj][m][n] = __builtin_amdgcn_mfma_f32_16x16x32_bf16(Bt[n][k], At[m][k], acc[ai][bj][m][n], 0, 0, 0); __builtin_amdgcn_s_setprio(0); } while (0)
#define PG8_WAIT_V(n) asm volatile("s_waitcnt vmcnt(" #n ")" ::: "memory")
#define PG8_WAIT_L(n) asm volatile("s_waitcnt lgkmcnt(" #n ")" ::: "memory")
#define PG8_BAR __builtin_amdgcn_s_barrier()
#define PG8_SCHED __builtin_amdgcn_sched_barrier(0)
    Unit cur, nxt; int ui = 0;
    if (!S.next(0, cur)) return;
    f32x4 acc[2][2][4][2];
#pragma unroll
    for (int a = 0; a < 2; ++a)
#pragma unroll
        for (int b = 0; b < 2; ++b)
#pragma unroll
            for (int m = 0; m < 4; ++m)
#pragma unroll
                for (int n = 0; n < 2; ++n) acc[a][b][m][n] = (f32x4){0.f, 0.f, 0.f, 0.f};
    bf16x8 At[4][2], B0[2][2], B1[2][2];
    const char* cA = (const char*)g.A + (size_t)cur.pm * tstep; const char* cB = (const char*)g.Bt + (size_t)cur.pn * tstep;
    PG8_STAGE(PG8_SB(0, 0), cB, voffB); PG8_STAGE(PG8_SA(0, 0), cA, voffA); PG8_STAGE(PG8_SB(0, 1), cB + hstep, voffB); PG8_STAGE(PG8_SA(0, 1), cA + hstep, voffA);
    if (wr == 1) PG8_BAR;
    PG8_WAIT_V(4); PG8_BAR;
    PG8_STAGE(PG8_SB(1, 0), cB + kstep, voffB); PG8_STAGE(PG8_SA(1, 0), cA + kstep, voffA); PG8_STAGE(PG8_SB(1, 1), cB + hstep + kstep, voffB);
    PG8_WAIT_V(6); PG8_BAR;
    for (;;) {
        const bool has_next = S.next(ui + 1, nxt);
        const char* nA = has_next ? (const char*)g.A + (size_t)nxt.pm * tstep : cA; const char* nB = has_next ? (const char*)g.Bt + (size_t)nxt.pn * tstep : cB;
        for (int t = 0; t < nt; t += 2) {
            const bool last = (t == nt - 2);
            const char* a1 = cA + (size_t)(t + 1) * kstep;
            const char* a2 = last ? nA : cA + (size_t)(t + 2) * kstep; const char* b2 = last ? nB : cB + (size_t)(t + 2) * kstep;
            const char* a3 = a2 + kstep; const char* b3 = b2 + kstep;
            PG8_LDB(B0, 0, 0); PG8_SCHED; PG8_LDA(At, 0, 0); PG8_STAGE(PG8_SA(1, 1), a1 + hstep, voffA);
            PG8_WAIT_L(8); PG8_BAR; PG8_WAIT_L(0); PG8_MMA(0, 0, At, B0); PG8_BAR; PG8_SCHED;
            PG8_LDB(B1, 0, 1); PG8_STAGE(PG8_SB(0, 0), b2, voffB);
            PG8_BAR; PG8_WAIT_L(0); PG8_MMA(0, 1, At, B1); PG8_BAR;
            PG8_LDA(At, 0, 1); PG8_STAGE(PG8_SA(0, 0), a2, voffA);
            PG8_BAR; PG8_WAIT_L(0); PG8_MMA(1, 0, At, B0); PG8_BAR; PG8_SCHED;
            PG8_STAGE(PG8_SB(0, 1), b2 + hstep, voffB);
            PG8_WAIT_V(6); PG8_BAR; PG8_MMA(1, 1, At, B1); PG8_BAR;
            PG8_LDB(B0, 1, 0); PG8_SCHED; PG8_LDA(At, 1, 0); PG8_STAGE(PG8_SA(0, 1), a2 + hstep, voffA);
            PG8_WAIT_L(8); PG8_BAR; PG8_WAIT_L(0); PG8_MMA(0, 0, At, B0); PG8_BAR; PG8_SCHED;
            PG8_LDB(B1, 1, 1); PG8_STAGE(PG8_SB(1, 0), b3, voffB);
            PG8_BAR; PG8_WAIT_L(0); PG8_MMA(0, 1, At, B1); PG8_BAR;
            PG8_LDA(At, 1, 1); PG8_STAGE(PG8_SA(1, 0), a3, voffA);
            PG8_BAR; PG8_WAIT_L(0); PG8_MMA(1, 0, At, B0); PG8_BAR; PG8_SCHED;
            PG8_STAGE(PG8_SB(1, 1), b3 + hstep, voffB);
            PG8_WAIT_V(6); PG8_BAR; PG8_MMA(1, 1, At, B1); PG8_BAR;
        }
        { Unit eu = cur; asm volatile("" : "+s"(eu.pm), "+s"(eu.pn)); E(acc, eu, wr, wc, fr, fq); }
        if (!has_next) break;
#pragma unroll
        for (int a = 0; a < 2; ++a)
#pragma unroll
            for (int b = 0; b < 2; ++b)
#pragma unroll
                for (int m = 0; m < 4; ++m)
#pragma unroll
                    for (int n = 0; n < 2; ++n) acc[a][b][m][n] = (f32x4){0.f, 0.f, 0.f, 0.f};
        cur = nxt; cA = nA; cB = nB; ++ui;
    }
    PG8_WAIT_V(0);
    if (wr == 0) PG8_BAR;
    PG8_BAR;
#undef PG8_SA
#undef PG8_SB
#undef PG8_STAGE
#undef PG8_LDA
#undef PG8_LDB
#undef PG8_MMA
#undef PG8_WAIT_V
#undef PG8_WAIT_L
#undef PG8_BAR
#undef PG8_SCHED
}
}

typedef f32x4 AccT[2][2][4][2];
struct Epi1 {
    bf16_t* U; float* sf;
    __device__ __forceinline__ void operator()(const AccT& acc, const pg8::Unit& u, int wr, int wc, int fr, int fq) const {
        const int row0 = u.pm * 256 + wr * 64 + fr, col0 = u.pn * 256 + wc * 32 + 8 * fq;
        const bool side_dt = (u.pn == 18 && wc == 0), side_if = (u.pn == 34 && wc == 1);
#pragma unroll
        for (int ai = 0; ai < 2; ++ai)
#pragma unroll
            for (int m = 0; m < 4; ++m) {
                const int row = row0 + ai * 128 + m * 16;
                bf16_t* rowp = U + (size_t)row * N1P + col0;
#pragma unroll
                for (int bj = 0; bj < 2; ++bj) {
                    const f32x4 v0 = acc[ai][bj][m][0], v1 = acc[ai][bj][m][1];
                    u32x4 o; o[0] = pack2(v0[0], v0[1]); o[1] = pack2(v0[2], v0[3]); o[2] = pack2(v1[0], v1[1]); o[3] = pack2(v1[2], v1[3]);
                    *(u32x4*)(rowp + bj * 128) = o;
                }
                if (side_dt || side_if) {
                    float* sp = sf + (size_t)row * 64 + (side_if ? 32 : 0) + 8 * fq;
                    *(f32x4*)sp = acc[ai][0][m][0]; *(f32x4*)(sp + 4) = acc[ai][0][m][1];
                }
            }
    }
};
struct Epi2 {
    Params p;
    __device__ __forceinline__ void operator()(const AccT& acc, const pg8::Unit& u, int wr, int wc, int fr, int fq) const {
        float* H1 = (float*)(p.ws + WS_H1); bf16_t* A2 = (bf16_t*)(p.ws + WS_A2); float* SS2 = (float*)(p.ws + WS_SS2);
        const float* nw = p.in[21];
        const int row0 = u.pm * 256 + wr * 64 + fr, col0 = u.pn * 256 + wc * 32 + 8 * fq;
        f32x4 w[2][2];
#pragma unroll
        for (int bj = 0; bj < 2; ++bj) { w[bj][0] = *(const f32x4*)(nw + col0 + bj * 128); w[bj][1] = *(const f32x4*)(nw + col0 + bj * 128 + 4); }
#pragma unroll
        for (int ai = 0; ai < 2; ++ai)
#pragma unroll
            for (int m = 0; m < 4; ++m) {
                const int row = row0 + ai * 128 + m * 16;
                const float* rp = resid_row(p, row);
                float ss = 0.f;
#pragma unroll
                for (int bj = 0; bj < 2; ++bj) {
                    f32x4 v0 = acc[ai][bj][m][0], v1 = acc[ai][bj][m][1];
                    if (rp) { v0 += *(const f32x4*)(rp + col0 + bj * 128); v1 += *(const f32x4*)(rp + col0 + bj * 128 + 4); }
                    *(f32x4*)(H1 + (size_t)row * DM + col0 + bj * 128) = v0; *(f32x4*)(H1 + (size_t)row * DM + col0 + bj * 128 + 4) = v1;
                    ss += v0[0] * v0[0] + v0[1] * v0[1] + v0[2] * v0[2] + v0[3] * v0[3] + v1[0] * v1[0] + v1[1] * v1[1] + v1[2] * v1[2] + v1[3] * v1[3];
                    const f32x4 a0 = v0 * w[bj][0], a1 = v1 * w[bj][1];
                    u32x4 o; o[0] = pack2(a0[0], a0[1]); o[1] = pack2(a0[2], a0[3]); o[2] = pack2(a1[0], a1[1]); o[3] = pack2(a1[2], a1[3]);
                    *(u32x4*)(A2 + (size_t)row * DM + col0 + bj * 128) = o;
                }
                ss += __shfl_xor(ss, 16); ss += __shfl_xor(ss, 32);
                if (fq == 0) atomicAdd(SS2 + row, ss);
            }
    }
};
struct Epi3 {
    bf16_t* UP; const float* SS2;
    __device__ __forceinline__ void operator()(const AccT& acc, const pg8::Unit& u, int wr, int wc, int fr, int fq) const {
        const int row0 = u.pm * 256 + wr * 64 + fr, col0 = u.pn * 256 + wc * 32 + 8 * fq;
#pragma unroll
        for (int ai = 0; ai < 2; ++ai)
#pragma unroll
            for (int m = 0; m < 4; ++m) {
                const int row = row0 + ai * 128 + m * 16;
                const float r2 = rsqrtf(SS2[row] * (1.f / 2048.f) + EPS);
                bf16_t* rowp = UP + (size_t)row * N3 + col0;
#pragma unroll
                for (int bj = 0; bj < 2; ++bj) {
                    const f32x4 v0 = acc[ai][bj][m][0] * r2, v1 = acc[ai][bj][m][1] * r2;
                    u32x4 o; o[0] = pack2(v0[0], v0[1]); o[1] = pack2(v0[2], v0[3]); o[2] = pack2(v1[0], v1[1]); o[3] = pack2(v1[2], v1[3]);
                    *(u32x4*)(rowp + bj * 128) = o;
                }
            }
    }
};
struct Epi4 {
    const float* H1; float* out; float* SS3;
    __device__ __forceinline__ void operator()(const AccT& acc, const pg8::Unit& u, int wr, int wc, int fr, int fq) const {
        const int row0 = u.pm * 256 + wr * 64 + fr, col0 = u.pn * 256 + wc * 32 + 8 * fq;
#pragma unroll
        for (int ai = 0; ai < 2; ++ai)
#pragma unroll
            for (int m = 0; m < 4; ++m) {
                const int row = row0 + ai * 128 + m * 16;
                if (row < NOUTROWS) {
                    float ss = 0.f;
#pragma unroll
                    for (int bj = 0; bj < 2; ++bj) {
                        const f32x4 v0 = acc[ai][bj][m][0] + *(const f32x4*)(H1 + (size_t)row * DM + col0 + bj * 128);
                        const f32x4 v1 = acc[ai][bj][m][1] + *(const f32x4*)(H1 + (size_t)row * DM + col0 + bj * 128 + 4);
                        *(f32x4*)(out + (size_t)row * DM + col0 + bj * 128) = v0; *(f32x4*)(out + (size_t)row * DM + col0 + bj * 128 + 4) = v1;
                        ss += v0[0] * v0[0] + v0[1] * v0[1] + v0[2] * v0[2] + v0[3] * v0[3] + v1[0] * v1[0] + v1[1] * v1[1] + v1[2] * v1[2] + v1[3] * v1[3];
                    }
                    ss += __shfl_xor(ss, 16); ss += __shfl_xor(ss, 32);
                    if (fq == 0) atomicAdd(SS3 + row, ss);
                }
            }
    }
};

__device__ __forceinline__ void transpose_tile(const float* W, bf16_t* WT, int K, int N, int kt, int nt_, unsigned char* smem) {
    float* tile = (float*)smem;
    const int tid = opaque_tid(), k0 = kt * 64, n0 = nt_ * 64;
#pragma unroll
    for (int i = 0; i < 2; ++i) {
        const int kr = (tid >> 4) + 32 * i, nc = (tid & 15) * 4, n = n0 + nc;
        f32x4 v = {0.f, 0.f, 0.f, 0.f};
        if (n < N) v = *(const f32x4*)(W + (size_t)(k0 + kr) * N + n);
        tile[kr * 65 + nc] = v[0]; tile[kr * 65 + nc + 1] = v[1]; tile[kr * 65 + nc + 2] = v[2]; tile[kr * 65 + nc + 3] = v[3];
    }
    __syncthreads();
    {
        const int nr = tid >> 3, kc = (tid & 7) * 8;
        u32x4 o;
        o[0] = pack2(tile[(kc + 0) * 65 + nr], tile[(kc + 1) * 65 + nr]); o[1] = pack2(tile[(kc + 2) * 65 + nr], tile[(kc + 3) * 65 + nr]);
        o[2] = pack2(tile[(kc + 4) * 65 + nr], tile[(kc + 5) * 65 + nr]); o[3] = pack2(tile[(kc + 6) * 65 + nr], tile[(kc + 7) * 65 + nr]);
        *(u32x4*)(WT + (size_t)(n0 + nr) * K + k0 + kc) = o;
    }
    __syncthreads();
}
__device__ __forceinline__ void phase_prep(const Params& p, unsigned char* smem) {
    const int tid = opaque_tid(), wid = tid >> 6, lane = tid & 63;
    { float* SS2 = (float*)(p.ws + WS_SS2); for (int i = opaque_bid() * 512 + tid; i < 2 * MP; i += gridDim.x * 512) SS2[i] = 0.f; }
    {
        bf16_t* XN = (bf16_t*)(p.ws + WS_XN); const float* nw = p.in[9];
        for (int row = opaque_bid() * 8 + wid; row < MP; row += gridDim.x * 8) {
            const float* src = resid_row(p, row);
            f32x4 v[8];
            float ss = 0.f;
#pragma unroll
            for (int it = 0; it < 4; ++it) {
                const int col = it * 512 + lane * 8;
                if (src) { v[2 * it] = *(const f32x4*)(src + col); v[2 * it + 1] = *(const f32x4*)(src + col + 4); }
                else { v[2 * it] = (f32x4){0.f, 0.f, 0.f, 0.f}; v[2 * it + 1] = (f32x4){0.f, 0.f, 0.f, 0.f}; }
#pragma unroll
                for (int j = 0; j < 4; ++j) ss += v[2 * it][j] * v[2 * it][j] + v[2 * it + 1][j] * v[2 * it + 1][j];
            }
            ss = wave_sum(ss);
            const float r = rsqrtf(ss * (1.f / 2048.f) + EPS);
#pragma unroll
            for (int it = 0; it < 4; ++it) {
                const int col = it * 512 + lane * 8;
                const f32x4 w0 = *(const f32x4*)(nw + col), w1 = *(const f32x4*)(nw + col + 4);
                const f32x4 a = v[2 * it] * r * w0, c = v[2 * it + 1] * r * w1;
                u32x4 o; o[0] = pack2(a[0], a[1]); o[1] = pack2(a[2], a[3]); o[2] = pack2(c[0], c[1]); o[3] = pack2(c[2], c[3]);
                *(u32x4*)(XN + (size_t)row * DM + col) = o;
            }
        }
    }
    constexpr int T_IN = 32 * 172, T_OUT = 64 * 32, T_UP = 32 * 176, T_DOWN = 88 * 32, T_ALL = T_IN + T_OUT + T_UP + T_DOWN;
    for (int t = opaque_bid(); t < T_ALL; t += gridDim.x) {
        if (t < T_IN) transpose_tile(p.in[10], (bf16_t*)(p.ws + WS_WIN), 2048, 10800, t % 32, t / 32, smem);
        else if (t < T_IN + T_OUT) { const int q = t - T_IN; transpose_tile(p.in[20], (bf16_t*)(p.ws + WS_WOUT), 4096, 2048, q % 64, q / 64, smem); }
        else if (t < T_IN + T_OUT + T_UP) { const int q = t - T_IN - T_OUT; transpose_tile(p.in[22], (bf16_t*)(p.ws + WS_WUP), 2048, N3, q % 32, q / 32, smem); }
        else { const int q = t - T_IN - T_OUT - T_UP; transpose_tile(p.in[25], (bf16_t*)(p.ws + WS_WDOWN), DFF, 2048, q % 88, q / 88, smem); }
    }
}

constexpr int RS = 272;
constexpr int L_QS = 0, L_KS = 34816, L_KT = 69632, L_VT = 104448, L_ST = 121856, L_SC = 139264;

template <bool ML>
__device__ __forceinline__ void load_block(const Params& p, float (&val)[8][4], int b, int p0, int Lv, int rb, int cg, int colbase, int chbase, float mlscale) {
    const bf16_t* U = (const bf16_t*)(p.ws + WS_U);
    const int t0 = rb * 8;
    if (t0 >= Lv) {
#pragma unroll
        for (int r = 0; r < 8; ++r)
#pragma unroll
            for (int i = 0; i < 4; ++i) val[r][i] = 0.f;
        return;
    }
    if (ML) {
#pragma unroll
        for (int r = 0; r < 8; ++r) {
            const int row = row_of(b, p0 + t0 + r);
            const u32x2 raw = *(const u32x2*)(U + (size_t)row * N1P + colbase + cg * 4);
            val[r][0] = bf_lo(raw[0]) * mlscale; val[r][1] = bf_hi(raw[0]) * mlscale; val[r][2] = bf_lo(raw[1]) * mlscale; val[r][3] = bf_hi(raw[1]) * mlscale;
        }
    } else {
        u32x2 raw[11];
#pragma unroll
        for (int rr = 0; rr < 11; ++rr) {
            const int pos = p0 + t0 - 3 + rr;
            if (pos >= 0) raw[rr] = *(const u32x2*)(U + (size_t)row_of(b, pos) * N1P + colbase + cg * 4);
            else raw[rr] = (u32x2){0u, 0u};
        }
        const float* cw = p.in[11]; const float* cb = p.in[12];
        const int ch = chbase + cg * 4;
        f32x4 w[4];
#pragma unroll
        for (int j = 0; j < 4; ++j) w[j] = *(const f32x4*)(cw + j * 2560 + ch);
        const f32x4 bi = *(const f32x4*)(cb + ch);
#pragma unroll
        for (int i = 0; i < 4; ++i) {
            float x[11];
#pragma unroll
            for (int rr = 0; rr < 11; ++rr) x[rr] = (i & 1) ? bf_hi(raw[rr][i >> 1]) : bf_lo(raw[rr][i >> 1]);
#pragma unroll
            for (int r = 0; r < 8; ++r) val[r][i] = silu_f(bi[i] + w[0][i] * x[r] + w[1][i] * x[r + 1] + w[2][i] * x[r + 2] + w[3][i] * x[r + 3]);
        }
    }
}
__device__ __forceinline__ void store_rows(unsigned char* base, const float (&val)[8][4], int rb, int cg) {
#pragma unroll
    for (int r = 0; r < 8; ++r) *(u32x2*)(base + (rb * 8 + r) * RS + cg * 8) = (u32x2){pack2(val[r][0], val[r][1]), pack2(val[r][2], val[r][3])};
}
__device__ __forceinline__ void store_cols(unsigned char* base, const float (&val)[8][4], int rb, int cg, const float* scale) {
    float s[8];
#pragma unroll
    for (int r = 0; r < 8; ++r) s[r] = scale ? scale[rb * 8 + r] : 1.f;
#pragma unroll
    for (int i = 0; i < 4; ++i) {
        const int row = cg * 4 + i;
        u32x4 o; o[0] = pack2(val[0][i] * s[0], val[1][i] * s[1]); o[1] = pack2(val[2][i] * s[2], val[3][i] * s[3]);
        o[2] = pack2(val[4][i] * s[4], val[5][i] * s[5]); o[3] = pack2(val[6][i] * s[6], val[7][i] * s[7]);
        *(u32x4*)(base + row * RS + ((rb ^ ((row >> 3) & 7)) << 4)) = o;
    }
}

template <bool ML>
__device__ __forceinline__ void prompt_scan(const Params& p, unsigned char* smem, int job) {
    const int tid = opaque_tid(), wid = __builtin_amdgcn_readfirstlane(tid >> 6), lane = tid & 63, fr = lane & 15, fq = lane >> 4;
    int b, h, vq = 0;
    if (ML) { b = job >> 5; h = (job >> 2) & 7; vq = job & 3; } else { b = job >> 5; h = job & 31; }
    const int g = h >> 4;
    const bf16_t* U = (const bf16_t*)(p.ws + WS_U);
    const float* SF = (const float*)(p.ws + WS_SF);
    bf16_t* MIX = (bf16_t*)(p.ws + WS_MIX);
    float* scb = (float*)(smem + L_SC);
    float *qn = scb + 1600, *nvec = scb + 1728, *mpp = scb + 1856;
    const int qcol = ML ? UC_Q + h * 128 : UC_XBC + 2304 + g * 128;
    const int kcol = ML ? UC_K + h * 128 : UC_XBC + 2048 + g * 128;
    const int vcol = ML ? UC_V + h * 256 + vq * 64 : UC_XBC + h * 64;
    const int gcol = ML ? UC_O + h * 256 + vq * 64 : UC_Z + h * 64;
    const int mixcol = ML ? 2048 + h * 256 + vq * 64 : h * 64;
    float A_h = 0.f, D_h = 0.f, dtb = 0.f, ib = 0.f, fb = 0.f;
    if (ML) { ib = p.in[17][h]; fb = p.in[18][h]; } else { A_h = -__expf(p.in[14][h]); D_h = p.in[15][h]; dtb = p.in[13][h]; }
    f32x4 st[4];
#pragma unroll
    for (int i = 0; i < 4; ++i) st[i] = (f32x4){0.f, 0.f, 0.f, 0.f};
    for (int i = tid; i < 64 * RS / 16; i += 512) *(u32x4*)(smem + L_ST + i * 16) = (u32x4){0u, 0u, 0u, 0u};
    if (tid < 128) nvec[tid] = 0.f;
    if (tid == 0) mpp[0] = 0.f;
    auto scalars = [&](int cc) {
        const int p0 = cc == 0 ? 0 : 16 + (cc - 1) * CHL, Lv = cc == 0 ? 16 : CHL;
        float* sc = scb + (cc & 1) * 800;
        float *rowv = sc, *colv = sc + 128, *colm = sc + 256, *ev = sc + 384, *scv = sc + 512, *dden = sc + 640, *misc = sc + 768;
        const int t0 = 2 * lane, t1 = t0 + 1;
        if (!ML) {
            float d0 = 0.f, d1 = 0.f;
            if (t0 < Lv) d0 = softplus_f(SF[(size_t)row_of(b, p0 + t0) * 64 + h] + dtb);
            if (t1 < Lv) d1 = softplus_f(SF[(size_t)row_of(b, p0 + t1) * 64 + h] + dtb);
            const float a0 = d0 * A_h, a1 = d1 * A_h;
            float inc = a0 + a1;
#pragma unroll
            for (int o = 1; o < 64; o <<= 1) { const float y = __shfl_up(inc, o); if (lane >= o) inc += y; }
            const float c1 = inc, c0 = inc - a1, cl = __shfl(inc, 63);
            rowv[t0] = c0; rowv[t1] = c1; colv[t0] = -c0; colv[t1] = -c1; colm[t0] = d0; colm[t1] = d1;
            ev[t0] = __expf(c0); ev[t1] = __expf(c1); scv[t0] = __expf(cl - c0) * d0; scv[t1] = __expf(cl - c1) * d1;
            if (lane == 0) misc[0] = __expf(cl);
        } else {
            float i0 = -INFINITY, i1 = -INFINITY, f0 = 0.f, f1 = 0.f;
            if (t0 < Lv) { const size_t r = (size_t)row_of(b, p0 + t0) * 64; i0 = SF[r + 32 + h] + ib; f0 = logsig_f(SF[r + 40 + h] + fb); }
            if (t1 < Lv) { const size_t r = (size_t)row_of(b, p0 + t1) * 64; i1 = SF[r + 32 + h] + ib; f1 = logsig_f(SF[r + 40 + h] + fb); }
            float inc = f0 + f1;
#pragma unroll
            for (int o = 1; o < 64; o <<= 1) { const float y = __shfl_up(inc, o); if (lane >= o) inc += y; }
            const float F1 = inc, F0 = inc - f1;
            const float g0 = i0 - F0, g1 = i1 - F1;
            float mx = fmaxf(g0, g1);
#pragma unroll
            for (int o = 1; o < 64; o <<= 1) { const float y = __shfl_up(mx, o); if (lane >= o) mx = fmaxf(mx, y); }
            float ex = __shfl_up(mx, 1); if (lane == 0) ex = -INFINITY;
            const float mp = mpp[0];
            const float M0 = fmaxf(fmaxf(ex, g0), mp), M1 = fmaxf(mx, mp);
            const float Ml = __shfl(M1, 63), Fl = __shfl(F1, 63);
            rowv[t0] = -M0; rowv[t1] = -M1; colv[t0] = g0; colv[t1] = g1; colm[t0] = 1.f; colm[t1] = 1.f;
            ev[t0] = __expf(mp - M0); ev[t1] = __expf(mp - M1); dden[t0] = __expf(-(F0 + M0)); dden[t1] = __expf(-(F1 + M1));
            scv[t0] = __expf(g0 - Ml); scv[t1] = __expf(g1 - Ml);
            if (lane == 0) { misc[0] = __expf(mp - Ml); mpp[0] = Fl + Ml; }
        }
    };
    __syncthreads();
    if (wid == 0) scalars(0);
    __syncthreads();
    const int tid_outer = tid;
    for (int c = 0; c < NCH; ++c) {
        int tid = tid_outer; asm volatile("" : "+v"(tid));
        const int lane = tid & 63, fr = lane & 15, fq = lane >> 4;
        const int p0 = c == 0 ? 0 : 16 + (c - 1) * CHL, Lv = c == 0 ? 16 : CHL;
        float* sc = scb + (c & 1) * 800;
        float *rowv = sc, *colv = sc + 128, *colm = sc + 256, *ev = sc + 384, *scv = sc + 512, *dden = sc + 640, *misc = sc + 768;
        if (wid == 0 && c + 1 < NCH) scalars(c + 1);
        {
            float val[8][4];
            load_block<ML>(p, val, b, p0, Lv, tid >> 5, tid & 31, qcol, 2304 + g * 128, 1.f);
            store_rows(smem + L_QS, val, tid >> 5, tid & 31);
            __builtin_amdgcn_sched_barrier(0);
            load_block<ML>(p, val, b, p0, Lv, tid >> 5, tid & 31, kcol, 2048 + g * 128, 0.08838834764831845f);
            store_rows(smem + L_KS, val, tid >> 5, tid & 31);
            store_cols(smem + L_KT, val, tid >> 5, tid & 31, scv);
            __builtin_amdgcn_sched_barrier(0);
            if (tid < 256) {
                load_block<ML>(p, val, b, p0, Lv, tid >> 4, tid & 15, vcol, h * 64, 1.f);
                store_cols(smem + L_VT, val, tid >> 4, tid & 15, nullptr);
            }
        }
        __syncthreads();
        const int t = 16 * wid + fr;
        const bool valid = t < Lv;
        const int row = row_of(b, p0 + (valid ? t : 0));
        u32x2 gate[4];
#pragma unroll
        for (int vb = 0; vb < 4; ++vb) gate[vb] = *(const u32x2*)(U + (size_t)row * N1P + gcol + 16 * vb + 4 * fq);
        if (ML) {
            const int tt = tid >> 2, part = tid & 3;
            float s = 0.f;
#pragma unroll
            for (int cc = 0; cc < 4; ++cc) {
                const u32x4 raw = *(const u32x4*)(smem + L_QS + tt * RS + (part * 4 + cc) * 16);
                const f32x4 n0 = *(const f32x4*)(nvec + (part * 4 + cc) * 8), n1 = *(const f32x4*)(nvec + (part * 4 + cc) * 8 + 4);
                s += bf_lo(raw[0]) * n0[0] + bf_hi(raw[0]) * n0[1] + bf_lo(raw[1]) * n0[2] + bf_hi(raw[1]) * n0[3]
                   + bf_lo(raw[2]) * n1[0] + bf_hi(raw[2]) * n1[1] + bf_lo(raw[3]) * n1[2] + bf_hi(raw[3]) * n1[3];
            }
            s += __shfl_xor(s, 1); s += __shfl_xor(s, 2);
            if (part == 0) qn[tt] = s;
        }
        bf16x8 qf[4];
#pragma unroll
        for (int kk = 0; kk < 4; ++kk) qf[kk] = *(const bf16x8*)(smem + L_QS + t * RS + (kk * 32 + fq * 8) * 2);
        const float rv = rowv[t];
        float rowsum = 0.f;
        u32x2 pk[8];
#pragma unroll
        for (int sb = 0; sb < 8; ++sb) {
            pk[sb] = (u32x2){0u, 0u};
            if (sb <= wid) {
                f32x4 acc = {0.f, 0.f, 0.f, 0.f};
#pragma unroll
                for (int kk = 0; kk < 4; ++kk) {
                    const bf16x8 kf = *(const bf16x8*)(smem + L_KS + (16 * sb + fr) * RS + (kk * 32 + fq * 8) * 2);
                    acc = __builtin_amdgcn_mfma_f32_16x16x32_bf16(kf, qf[kk], acc, 0, 0, 0);
                }
                const f32x4 cv = *(const f32x4*)(colv + 16 * sb + 4 * fq), cm = *(const f32x4*)(colm + 16 * sb + 4 * fq);
                float pv[4];
#pragma unroll
                for (int j = 0; j < 4; ++j) {
                    const int s = 16 * sb + 4 * fq + j;
                    const float w = (s <= t) ? __expf(rv + cv[j]) * cm[j] : 0.f;
                    pv[j] = acc[j] * w; rowsum += pv[j];
                }
                pk[sb] = (u32x2){pack2(pv[0], pv[1]), pack2(pv[2], pv[3])};
            }
        }
        __syncthreads();
#pragma unroll
        for (int sb = 0; sb < 8; ++sb) *(u32x2*)(smem + L_KS + t * RS + (16 * sb + 4 * fq) * 2) = pk[sb];
        rowsum += __shfl_xor(rowsum, 16); rowsum += __shfl_xor(rowsum, 32);
        if (ML) {
            const int d = tid >> 2, part = tid & 3;
            float s = 0.f;
#pragma unroll
            for (int cc = 0; cc < 4; ++cc) {
                const u32x4 raw = *(const u32x4*)(smem + L_KT + d * RS + (part * 4 + cc) * 16);
                s += bf_lo(raw[0]) + bf_hi(raw[0]) + bf_lo(raw[1]) + bf_hi(raw[1]) + bf_lo(raw[2]) + bf_hi(raw[2]) + bf_lo(raw[3]) + bf_hi(raw[3]);
            }
            s += __shfl_xor(s, 1); s += __shfl_xor(s, 2);
            if (part == 0) nvec[d] = misc[0] * nvec[d] + s;
        }
        __syncthreads();
        bf16x8 pf[4];
#pragma unroll
        for (int kk = 0; kk < 4; ++kk) pf[kk] = *(const bf16x8*)(smem + L_KS + t * RS + (kk * 32 + fq * 8) * 2);
        const float et = ev[t];
        float inv = 1.f;
        if (ML) inv = 1.f / fmaxf(fabsf(rowsum + et * qn[t]), dden[t]);
        float ss = 0.f;
#pragma unroll
        for (int vb = 0; vb < 4; ++vb) {
            f32x4 acc = {0.f, 0.f, 0.f, 0.f};
            const int vrow = 16 * vb + fr;
#pragma unroll
            for (int kk = 0; kk < 4; ++kk) {
                const bf16x8 sf = *(const bf16x8*)(smem + L_ST + vrow * RS + (kk * 32 + fq * 8) * 2);
                acc = __builtin_amdgcn_mfma_f32_16x16x32_bf16(sf, qf[kk], acc, 0, 0, 0);
            }
            acc *= et;
#pragma unroll
            for (int kk = 0; kk < 4; ++kk) {
                const bf16x8 vf = *(const bf16x8*)(smem + L_VT + vrow * RS + (((kk * 4 + fq) ^ ((vrow >> 3) & 7)) << 4));
                acc = __builtin_amdgcn_mfma_f32_16x16x32_bf16(vf, pf[kk], acc, 0, 0, 0);
            }
            const float gz[4] = {bf_lo(gate[vb][0]), bf_hi(gate[vb][0]), bf_lo(gate[vb][1]), bf_hi(gate[vb][1])};
            float o[4];
#pragma unroll
            for (int j = 0; j < 4; ++j) {
                if (ML) { const float hv = acc[j] * inv; ss += hv * hv; o[j] = hv * sigm_f(gz[j]); }
                else {
                    const int v = 16 * vb + 4 * fq + j;
                    const float xv = bf2f(*(const bf16_t*)(smem + L_VT + v * RS + (((t >> 3) ^ ((v >> 3) & 7)) << 4) + (t & 7) * 2));
                    const float y = (acc[j] + D_h * xv) * silu_f(gz[j]); ss += y * y; o[j] = y;
                }
            }
            if (valid) *(u32x2*)(MIX + (size_t)row * MIXW + mixcol + 16 * vb + 4 * fq) = (u32x2){pack2(o[0], o[1]), pack2(o[2], o[3])};
        }
        ss += __shfl_xor(ss, 16); ss += __shfl_xor(ss, 32);
        if (valid && fq == 0) {
            if (ML) ((float*)(p.ws + WS_SSQM))[(size_t)row * 32 + h * 4 + vq] = ss;
            else ((float*)(p.ws + WS_SSQ))[(size_t)row * 32 + h] = ss;
        }
        const float dec = misc[0];
#pragma unroll
        for (int vb = 0; vb < 4; ++vb) st[vb] *= dec;
#pragma unroll
        for (int kk = 0; kk < 4; ++kk) {
            const int drow = 16 * wid + fr;
            const bf16x8 kf = *(const bf16x8*)(smem + L_KT + drow * RS + (((kk * 4 + fq) ^ ((drow >> 3) & 7)) << 4));
#pragma unroll
            for (int vb = 0; vb < 4; ++vb) {
                const int vrow = 16 * vb + fr;
                const bf16x8 vf = *(const bf16x8*)(smem + L_VT + vrow * RS + (((kk * 4 + fq) ^ ((vrow >> 3) & 7)) << 4));
                st[vb] = __builtin_amdgcn_mfma_f32_16x16x32_bf16(kf, vf, st[vb], 0, 0, 0);
            }
        }
        __syncthreads();
#pragma unroll
        for (int vb = 0; vb < 4; ++vb)
            *(u32x2*)(smem + L_ST + (16 * vb + fr) * RS + (16 * wid + 4 * fq) * 2) = (u32x2){pack2(st[vb][0], st[vb][1]), pack2(st[vb][2], st[vb][3])};
    }
#pragma unroll
    for (int vb = 0; vb < 4; ++vb) {
        const int v = 16 * vb + fr, d0 = 16 * wid + 4 * fq;
        if (!ML) *(f32x4*)(p.out + O_P_SSD + ((size_t)(b * 32 + h) * 64 + v) * 128 + d0) = st[vb];
        else {
#pragma unroll
            for (int j = 0; j < 4; ++j) p.out[O_P_MLC + ((size_t)(b * 8 + h) * 128 + d0 + j) * 256 + vq * 64 + v] = st[vb][j];
        }
    }
    if (ML && vq == 0) {
        if (tid < 128) p.out[O_P_MLN + (size_t)(b * 8 + h) * 128 + tid] = nvec[tid];
        if (tid == 0) p.out[O_P_MLM + b * 8 + h] = mpp[0];
    }
    __syncthreads();
}

__device__ __forceinline__ void sample_ssd(const Params& p, unsigned char* smem, int job) {
    const int tid = opaque_tid(), wid = tid >> 6, lane = tid & 63;
    const int b = job >> 1, g = job & 1, rowb = ROW_SAMPLE + b * 8;
    const bf16_t* U = (const bf16_t*)(p.ws + WS_U);
    const float* SF = (const float*)(p.ws + WS_SF);
    bf16_t* MIX = (bf16_t*)(p.ws + WS_MIX);
    float* Bc = (float*)smem; float* Cc = Bc + 1024; float* xall = Cc + 1024; float* G = xall + 8192; float* dts = G + 64; float* ssqp = dts + 128;
    const float* sconv = p.in[2]; const float* cw = p.in[11]; const float* cb = p.in[12];
#pragma unroll
    for (int q = 0; q < 3; ++q) {
        int ch; float* dst; int dstride = 0;
        if (q < 2) { ch = g * 1024 + tid + q * 512; dst = xall + tid + q * 512; dstride = 1024; }
        else { if (tid >= 256) break; const int which = tid >> 7, n = tid & 127; ch = 2048 + which * 256 + g * 128 + n; dst = (which ? Cc : Bc) + n; dstride = 128; }
        float xm3 = sconv[(size_t)(b * 3 + 0) * 2560 + ch], xm2 = sconv[(size_t)(b * 3 + 1) * 2560 + ch], xm1 = sconv[(size_t)(b * 3 + 2) * 2560 + ch];
        const float w0 = cw[ch], w1 = cw[2560 + ch], w2 = cw[5120 + ch], w3 = cw[7680 + ch], bb = cb[ch];
#pragma unroll
        for (int t = 0; t < 8; ++t) {
            const float x = bf2f(U[(size_t)(rowb + t) * N1P + UC_XBC + ch]);
            dst[t * dstride] = silu_f(bb + w0 * xm3 + w1 * xm2 + w2 * xm1 + w3 * x);
            xm3 = xm2; xm2 = xm1; xm1 = x;
        }
    }
    if (tid < 128) { const int hh = tid >> 3, t = tid & 7; dts[tid] = softplus_f(SF[(size_t)(rowb + t) * 64 + g * 16 + hh] + p.in[13][g * 16 + hh]); }
    __syncthreads();
    {
        const int pair = tid >> 3, part = tid & 7, t = pair >> 3, s = pair & 7;
        float sum = 0.f;
#pragma unroll
        for (int i = 0; i < 4; ++i) {
            const f32x4 c4 = *(const f32x4*)(Cc + t * 128 + part * 16 + i * 4), b4 = *(const f32x4*)(Bc + s * 128 + part * 16 + i * 4);
            sum += c4[0] * b4[0] + c4[1] * b4[1] + c4[2] * b4[2] + c4[3] * b4[3];
        }
        sum += __shfl_xor(sum, 1); sum += __shfl_xor(sum, 2); sum += __shfl_xor(sum, 4);
        if (part == 0) G[pair] = sum;
    }
    __syncthreads();
    const int pp = tid >> 3, nq = tid & 7;
    for (int hh = 0; hh < 16; ++hh) {
        const int h = g * 16 + hh;
        const float A_h = -__expf(p.in[14][h]), D_h = p.in[15][h];
        float dtv[8], cum[8];
        { float run = 0.f;
#pragma unroll
          for (int t = 0; t < 8; ++t) { dtv[t] = dts[hh * 8 + t]; run += dtv[t] * A_h; cum[t] = run; } }
        const size_t soff = ((size_t)(b * 32 + h) * 64 + pp) * 128 + nq * 4;
        f32x4 s0[4];
#pragma unroll
        for (int i = 0; i < 4; ++i) s0[i] = *(const f32x4*)(p.in[3] + soff + 32 * i);
        float cs[8];
#pragma unroll
        for (int t = 0; t < 8; ++t) {
            float sum = 0.f;
#pragma unroll
            for (int i = 0; i < 4; ++i) { const f32x4 c4 = *(const f32x4*)(Cc + t * 128 + nq * 4 + 32 * i); sum += c4[0] * s0[i][0] + c4[1] * s0[i][1] + c4[2] * s0[i][2] + c4[3] * s0[i][3]; }
            sum += __shfl_xor(sum, 1); sum += __shfl_xor(sum, 2); sum += __shfl_xor(sum, 4);
            cs[t] = sum;
        }
        float ycs = 0.f, ct = 0.f;
#pragma unroll
        for (int t = 0; t < 8; ++t) { ycs = (nq == t) ? cs[t] : ycs; ct = (nq == t) ? cum[t] : ct; }
        float y = __expf(ct) * ycs, xt = 0.f;
#pragma unroll
        for (int s = 0; s < 8; ++s) {
            const float xs = xall[s * 1024 + hh * 64 + pp];
            const float term = (s <= nq) ? G[nq * 8 + s] * __expf(ct - cum[s]) * dtv[s] * xs : 0.f;
            y += term; xt = (s == nq) ? xs : xt;
        }
        y += D_h * xt;
        const float z = bf2f(U[(size_t)(rowb + nq) * N1P + UC_Z + h * 64 + pp]);
        y *= silu_f(z);
        { const unsigned pk = pack2(y, 0.f); MIX[(size_t)(rowb + nq) * MIXW + h * 64 + pp] = (bf16_t)(pk & 0xffffu); }
        float sq = y * y; sq += __shfl_xor(sq, 8); sq += __shfl_xor(sq, 16); sq += __shfl_xor(sq, 32);
        if (lane < 8) ssqp[(hh * 8 + wid) * 8 + lane] = sq;
        const float cl = cum[7], dec = __expf(cl);
        float xw[8];
#pragma unroll
        for (int s = 0; s < 8; ++s) xw[s] = __expf(cl - cum[s]) * dtv[s] * xall[s * 1024 + hh * 64 + pp];
#pragma unroll
        for (int i = 0; i < 4; ++i) {
            f32x4 acc = s0[i] * dec;
#pragma unroll
            for (int s = 0; s < 8; ++s) acc += xw[s] * *(const f32x4*)(Bc + s * 128 + nq * 4 + 32 * i);
            *(f32x4*)(p.out + O_S_SSD + soff + 32 * i) = acc;
        }
    }
    __syncthreads();
    if (tid < 128) {
        const int hh = tid >> 3, t = tid & 7; float tot = 0.f;
#pragma unroll
        for (int w = 0; w < 8; ++w) tot += ssqp[(hh * 8 + w) * 8 + t];
        ((float*)(p.ws + WS_SSQ))[(size_t)(rowb + t) * 32 + g * 16 + hh] = tot;
    }
    __syncthreads();
}

__device__ __forceinline__ void sample_ml(const Params& p, unsigned char* smem, int job) {
    const int tid = opaque_tid(), wid = __builtin_amdgcn_readfirstlane(tid >> 6), lane = tid & 63;
    const int b = job >> 3, h = job & 7, rowb = ROW_SAMPLE + b * 8;
    const bf16_t* U = (const bf16_t*)(p.ws + WS_U);
    const float* SF = (const float*)(p.ws + WS_SF);
    bf16_t* MIX = (bf16_t*)(p.ws + WS_MIX);
    float* qs = (float*)smem; float* ks = qs + 1024; float* vs = qs + 2048; float* QK = qs + 4096; float* sig = qs + 4160; float* slf = qs + 4168;
    float* qnv = qs + 4176; float* n0v = qs + 4192; float* red = qs + 4352;
    {
        const int t = tid >> 6, c = tid & 63;
        const size_t r = (size_t)(rowb + t) * N1P;
        const unsigned qq = *(const unsigned*)(U + r + UC_Q + h * 128 + 2 * c), kk = *(const unsigned*)(U + r + UC_K + h * 128 + 2 * c);
        const u32x2 vv = *(const u32x2*)(U + r + UC_V + h * 256 + 4 * c);
        qs[t * 128 + 2 * c] = bf_lo(qq); qs[t * 128 + 2 * c + 1] = bf_hi(qq);
        ks[t * 128 + 2 * c] = bf_lo(kk) * 0.08838834764831845f; ks[t * 128 + 2 * c + 1] = bf_hi(kk) * 0.08838834764831845f;
        *(f32x4*)(vs + t * 256 + 4 * c) = (f32x4){bf_lo(vv[0]), bf_hi(vv[0]), bf_lo(vv[1]), bf_hi(vv[1])};
        if (tid < 8) { sig[tid] = SF[(size_t)(rowb + tid) * 64 + 32 + h] + p.in[17][h]; slf[tid] = logsig_f(SF[(size_t)(rowb + tid) * 64 + 40 + h] + p.in[18][h]); }
        if (tid >= 128 && tid < 256) n0v[tid - 128] = p.in[5][(size_t)(b * 8 + h) * 128 + tid - 128];
    }
    const int v4 = lane, dg = wid;
    const size_t coff = ((size_t)(b * 8 + h) * 128 + dg * 16) * 256 + v4 * 4;
    f32x4 c0[16];
#pragma unroll
    for (int i = 0; i < 16; ++i) c0[i] = *(const f32x4*)(p.in[4] + coff + (size_t)i * 256);
    const float mp = p.in[6][b * 8 + h];
    __syncthreads();
    float F[8], gg[8], M[8];
    { float run = 0.f, pm = -INFINITY;
#pragma unroll
      for (int t = 0; t < 8; ++t) { run += slf[t]; F[t] = run; gg[t] = sig[t] - run; pm = fmaxf(pm, gg[t]); M[t] = fmaxf(pm, mp); } }
    const float Ml = M[7], dec = __expf(mp - Ml), m_new = F[7] + Ml;
    {
        const int pair = tid >> 3, part = tid & 7, t = pair >> 3, s = pair & 7;
        float sum = 0.f;
#pragma unroll
        for (int i = 0; i < 4; ++i) {
            const f32x4 a4 = *(const f32x4*)(qs + t * 128 + part * 16 + i * 4), b4 = *(const f32x4*)(ks + s * 128 + part * 16 + i * 4);
            sum += a4[0] * b4[0] + a4[1] * b4[1] + a4[2] * b4[2] + a4[3] * b4[3];
        }
        sum += __shfl_xor(sum, 1); sum += __shfl_xor(sum, 2); sum += __shfl_xor(sum, 4);
        if (part == 0) QK[pair] = sum;
        float qd = qs[wid * 128 + 2 * lane] * n0v[2 * lane] + qs[wid * 128 + 2 * lane + 1] * n0v[2 * lane + 1];
        qd = wave_sum(qd);
        if (lane == 0) qnv[wid] = qd;
    }
#pragma unroll
    for (int t = 0; t < 8; ++t) {
        f32x4 acc = {0.f, 0.f, 0.f, 0.f};
#pragma unroll
        for (int i4 = 0; i4 < 4; ++i4) {
            const f32x4 q4 = *(const f32x4*)(qs + t * 128 + dg * 16 + i4 * 4);
            acc += q4[0] * c0[i4 * 4] + q4[1] * c0[i4 * 4 + 1] + q4[2] * c0[i4 * 4 + 2] + q4[3] * c0[i4 * 4 + 3];
        }
        *(f32x4*)(red + (dg * 8 + t) * 256 + v4 * 4) = acc;
    }
    __syncthreads();
    f32x4 vv[8];
    float scs[8];
#pragma unroll
    for (int s = 0; s < 8; ++s) { vv[s] = *(const f32x4*)(vs + s * 256 + v4 * 4); scs[s] = __expf(gg[s] - Ml); }
#pragma unroll
    for (int i = 0; i < 16; ++i) {
        const int d = dg * 16 + i;
        f32x4 cn = c0[i] * dec;
#pragma unroll
        for (int s = 0; s < 8; ++s) cn += (scs[s] * ks[s * 128 + d]) * vv[s];
        *(f32x4*)(p.out + O_S_MLC + coff + (size_t)i * 256) = cn;
    }
    if (tid < 128) {
        float nn = dec * n0v[tid];
#pragma unroll
        for (int s = 0; s < 8; ++s) nn += scs[s] * ks[s * 128 + tid];
        p.out[O_S_MLN + (size_t)(b * 8 + h) * 128 + tid] = nn;
    }
    if (tid == 0) p.out[O_S_MLM + b * 8 + h] = m_new;
    {
        const int t = wid;
        float Mt = 0.f, Ft = 0.f;
#pragma unroll
        for (int q = 0; q < 8; ++q) { Mt = (t == q) ? M[q] : Mt; Ft = (t == q) ? F[q] : Ft; }
        f32x4 numc = {0.f, 0.f, 0.f, 0.f};
#pragma unroll
        for (int q = 0; q < 8; ++q) numc += *(const f32x4*)(red + (q * 8 + t) * 256 + lane * 4);
        const float et = __expf(mp - Mt);
        float den = et * qnv[t];
        f32x4 intra = {0.f, 0.f, 0.f, 0.f};
#pragma unroll
        for (int s = 0; s < 8; ++s) {
            if (s <= t) { const float w = __expf(gg[s] - Mt) * QK[t * 8 + s]; den += w; intra += w * vv[s]; }
        }
        const float dd = fmaxf(fabsf(den), __expf(-(Ft + Mt)));
        const f32x4 hv = (et * numc + intra) * (1.f / dd);
        float ss = hv[0] * hv[0] + hv[1] * hv[1] + hv[2] * hv[2] + hv[3] * hv[3];
        ss = wave_sum(ss);
        const u32x2 og = *(const u32x2*)(U + (size_t)(rowb + t) * N1P + UC_O + h * 256 + lane * 4);
        *(u32x2*)(MIX + (size_t)(rowb + t) * MIXW + 2048 + h * 256 + lane * 4) =
            (u32x2){pack2(hv[0] * sigm_f(bf_lo(og[0])), hv[1] * sigm_f(bf_hi(og[0]))), pack2(hv[2] * sigm_f(bf_lo(og[1])), hv[3] * sigm_f(bf_hi(og[1])))};
        if (lane < 4) ((float*)(p.ws + WS_SSQM))[(size_t)(rowb + t) * 32 + h * 4 + lane] = lane == 0 ? ss : 0.f;
    }
    __syncthreads();
}

__device__ __forceinline__ void phase_scan(const Params& p, unsigned char* smem) {
#ifndef SC_MASK
#define SC_MASK 15
#endif
    for (int j = opaque_bid(); j < 256; j += gridDim.x) { if (j < 128) { if (SC_MASK & 1) prompt_scan<false>(p, smem, j); } else { if (SC_MASK & 2) prompt_scan<true>(p, smem, j - 128); } }
    if (SC_MASK & 4) for (int j = opaque_bid(); j < 256; j += gridDim.x) sample_ssd(p, smem, j);
    if (SC_MASK & 8) for (int j = opaque_bid(); j < 1024; j += gridDim.x) sample_ml(p, smem, j);
}

__device__ __forceinline__ void phase_mixnorm(const Params& p) {
    const int tid = opaque_tid(), wid = tid >> 6, lane = tid & 63;
    bf16_t* MIX = (bf16_t*)(p.ws + WS_MIX);
    const float* SSQ = (const float*)(p.ws + WS_SSQ); const float* SSQM = (const float*)(p.ws + WS_SSQM);
    const float* w1 = p.in[16]; const float* w2 = p.in[19];
    for (int row = opaque_bid() * 8 + wid; row < NVALID; row += gridDim.x * 8) {
        float s = lane < 32 ? SSQ[(size_t)row * 32 + lane] : 0.f;
        s = wave_sum(s);
        const float r1 = rsqrtf(s * (1.f / 2048.f) + EPS);
        float m = lane < 32 ? SSQM[(size_t)row * 32 + lane] : 0.f;
        m += __shfl_xor(m, 1); m += __shfl_xor(m, 2);
        const float rh = rsqrtf(m * (1.f / 256.f) + EPS);
#pragma unroll
        for (int it = 0; it < 8; ++it) {
            const int col = it * 512 + lane * 8;
            const u32x4 raw = *(const u32x4*)(MIX + (size_t)row * MIXW + col);
            float scale; const float* wp;
            if (it < 4) { scale = r1; wp = w1 + col; }
            else { const int head = (it - 4) * 2 + (lane >> 5); scale = __shfl(rh, head * 4); wp = w2 + col - 2048; }
            const f32x4 wa = *(const f32x4*)wp, wb = *(const f32x4*)(wp + 4);
            u32x4 o;
            o[0] = pack2(bf_lo(raw[0]) * scale * wa[0], bf_hi(raw[0]) * scale * wa[1]); o[1] = pack2(bf_lo(raw[1]) * scale * wa[2], bf_hi(raw[1]) * scale * wa[3]);
            o[2] = pack2(bf_lo(raw[2]) * scale * wb[0], bf_hi(raw[2]) * scale * wb[1]); o[3] = pack2(bf_lo(raw[3]) * scale * wb[2], bf_hi(raw[3]) * scale * wb[3]);
            *(u32x4*)(MIX + (size_t)row * MIXW + col) = o;
        }
    }
    const bf16_t* U = (const bf16_t*)(p.ws + WS_U);
    for (int i = opaque_bid() * 512 + tid; i < 132 * 3 * 320; i += gridDim.x * 512) {
        const int cgp = i % 320, j = (i / 320) % 3, q = i / 960;
        int row; float* dst;
        if (q < 4) { row = q * 2048 + 2045 + j; dst = p.out + O_P_SSDCONV + (size_t)(q * 3 + j) * 2560 + cgp * 8; }
        else { row = ROW_SAMPLE + (q - 4) * 8 + 5 + j; dst = p.out + O_S_SSDCONV + (size_t)((q - 4) * 3 + j) * 2560 + cgp * 8; }
        const u32x4 raw = *(const u32x4*)(U + (size_t)row * N1P + UC_XBC + cgp * 8);
        *(f32x4*)dst = (f32x4){bf_lo(raw[0]), bf_hi(raw[0]), bf_lo(raw[1]), bf_hi(raw[1])};
        *(f32x4*)(dst + 4) = (f32x4){bf_lo(raw[2]), bf_hi(raw[2]), bf_lo(raw[3]), bf_hi(raw[3])};
    }
}

__device__ __forceinline__ void unpack8(const u32x4 raw, float (&x)[8]) {
#pragma unroll
    for (int i = 0; i < 4; ++i) { x[2 * i] = bf_lo(raw[i]); x[2 * i + 1] = bf_hi(raw[i]); }
}
__device__ __forceinline__ void phase_act(const Params& p) {
    const bf16_t* UP = (const bf16_t*)(p.ws + WS_UP); bf16_t* ACT = (bf16_t*)(p.ws + WS_ACT);
    const float* cw = p.in[23]; const float* cb = p.in[24]; const float* fst = p.in[7];
    constexpr int CGN = DFF / 8, TOTAL = (NVALID / 8) * CGN;
    const int tid = opaque_tid();
    for (int idx = opaque_bid() * 512 + tid; idx < TOTAL; idx += gridDim.x * 512) {
        const int rb = idx / CGN, cgp = idx % CGN, row0 = rb * 8, c0 = cgp * 8;
        float g2[8], g1[8], v2[8], v1[8];
        int prow = -1; bool from_state = false; int sb = 0, pb = -1;
        if (row0 < ROW_SAMPLE) { const int b = row0 >> 11, t0 = row0 & 2047; prow = t0 > 0 ? row0 - 2 : ROW_META + b * 16 + 14; if (t0 == 2040) pb = b; }
        else if (row0 < ROW_META) { from_state = true; sb = (row0 - ROW_SAMPLE) >> 3; }
        else { if ((row0 - ROW_META) & 15) prow = row0 - 2; }
        if (from_state) {
            const float* s0 = fst + (size_t)(sb * 2) * N3;
#pragma unroll
            for (int i = 0; i < 8; ++i) { g2[i] = s0[c0 + i]; g1[i] = s0[N3 + c0 + i]; v2[i] = s0[DFF + c0 + i]; v1[i] = s0[N3 + DFF + c0 + i]; }
        } else if (prow >= 0) {
            unpack8(*(const u32x4*)(UP + (size_t)prow * N3 + c0), g2); unpack8(*(const u32x4*)(UP + (size_t)(prow + 1) * N3 + c0), g1);
            unpack8(*(const u32x4*)(UP + (size_t)prow * N3 + DFF + c0), v2); unpack8(*(const u32x4*)(UP + (size_t)(prow + 1) * N3 + DFF + c0), v1);
        } else {
#pragma unroll
            for (int i = 0; i < 8; ++i) { g2[i] = 0.f; g1[i] = 0.f; v2[i] = 0.f; v1[i] = 0.f; }
        }
        float wg[3][8], wv[3][8], bg[8], bv[8];
#pragma unroll
        for (int j = 0; j < 3; ++j)
#pragma unroll
            for (int i = 0; i < 8; ++i) { wg[j][i] = cw[j * N3 + c0 + i]; wv[j][i] = cw[j * N3 + DFF + c0 + i]; }
#pragma unroll
        for (int i = 0; i < 8; ++i) { bg[i] = cb[c0 + i]; bv[i] = cb[DFF + c0 + i]; }
#pragma unroll
        for (int r = 0; r < 8; ++r) {
            float gx[8], vx[8];
            unpack8(*(const u32x4*)(UP + (size_t)(row0 + r) * N3 + c0), gx); unpack8(*(const u32x4*)(UP + (size_t)(row0 + r) * N3 + DFF + c0), vx);
            float o[8];
#pragma unroll
            for (int i = 0; i < 8; ++i) {
                const float yg = bg[i] + wg[0][i] * g2[i] + wg[1][i] * g1[i] + wg[2][i] * gx[i];
                const float yv = bv[i] + wv[0][i] * v2[i] + wv[1][i] * v1[i] + wv[2][i] * vx[i];
                o[i] = silu_f(yg) * yv;
                g2[i] = g1[i]; g1[i] = gx[i]; v2[i] = v1[i]; v1[i] = vx[i];
            }
            u32x4 ov; ov[0] = pack2(o[0], o[1]); ov[1] = pack2(o[2], o[3]); ov[2] = pack2(o[4], o[5]); ov[3] = pack2(o[6], o[7]);
            *(u32x4*)(ACT + (size_t)(row0 + r) * DFF + c0) = ov;
        }
        if (from_state || pb >= 0) {
            float* dst = from_state ? p.out + O_S_FFN + (size_t)(sb * 2) * N3 : p.out + O_P_FFN + (size_t)(pb * 2) * N3;
            *(f32x4*)(dst + c0) = (f32x4){g2[0], g2[1], g2[2], g2[3]}; *(f32x4*)(dst + c0 + 4) = (f32x4){g2[4], g2[5], g2[6], g2[7]};
            *(f32x4*)(dst + N3 + c0) = (f32x4){g1[0], g1[1], g1[2], g1[3]}; *(f32x4*)(dst + N3 + c0 + 4) = (f32x4){g1[4], g1[5], g1[6], g1[7]};
            *(f32x4*)(dst + DFF + c0) = (f32x4){v2[0], v2[1], v2[2], v2[3]}; *(f32x4*)(dst + DFF + c0 + 4) = (f32x4){v2[4], v2[5], v2[6], v2[7]};
            *(f32x4*)(dst + N3 + DFF + c0) = (f32x4){v1[0], v1[1], v1[2], v1[3]}; *(f32x4*)(dst + N3 + DFF + c0 + 4) = (f32x4){v1[4], v1[5], v1[6], v1[7]};
        }
    }
}

__device__ __forceinline__ void phase_final(const Params& p) {
    const int tid = opaque_tid(), wid = tid >> 6, lane = tid & 63;
    const float* SS3 = (const float*)(p.ws + WS_SS3); const float* nw = p.in[26];
    for (int row = opaque_bid() * 8 + wid; row < NOUTROWS; row += gridDim.x * 8) {
        const float r = rsqrtf(SS3[row] * (1.f / 2048.f) + EPS);
        float* rp = p.out + (size_t)row * DM;
#pragma unroll
        for (int it = 0; it < 8; ++it) {
            const int col = it * 256 + lane * 4;
            const f32x4 v = *(const f32x4*)(rp + col), w = *(const f32x4*)(nw + col);
            *(f32x4*)(rp + col) = v * r * w;
        }
    }
}

__global__ void __launch_bounds__(512, 2) hymba_fwd(Params p0) {
    extern __shared__ __attribute__((aligned(16))) unsigned char smem[];
    cg::grid_group grid = cg::this_grid();
    for (int ph = p0.ph_lo; ph < p0.ph_hi; ++ph) {
        Params p = p0;
        asm volatile("" : "+s"(p.ws), "+s"(p.out));
        switch (ph) {
        case 0: if (PH_MASK & 1) phase_prep(p, smem); break;
        case 1: if (PH_MASK & 2) { pg8::Gemm g{(const bf16_t*)(p.ws + WS_XN), (const bf16_t*)(p.ws + WS_WIN), MP, N1P, 2048}; pg8::StaticOrder S; S.init(MP, N1P, gridDim.x, opaque_bid());
                  Epi1 E{(bf16_t*)(p.ws + WS_U), (float*)(p.ws + WS_SF)}; pg8::gemm_phase((LAS unsigned char*)smem, g, S, E); } break;
        case 2: if (PH_MASK & 4) phase_scan(p, smem); break;
        case 3: if (PH_MASK & 8) phase_mixnorm(p); break;
        case 4: if (PH_MASK & 16) { pg8::Gemm g{(const bf16_t*)(p.ws + WS_MIX), (const bf16_t*)(p.ws + WS_WOUT), MP, 2048, 4096}; pg8::StaticOrder S; S.init(MP, 2048, gridDim.x, opaque_bid());
                  Epi2 E{p}; pg8::gemm_phase((LAS unsigned char*)smem, g, S, E); } break;
        case 5: if (PH_MASK & 32) { pg8::Gemm g{(const bf16_t*)(p.ws + WS_A2), (const bf16_t*)(p.ws + WS_WUP), MP, N3, 2048}; pg8::StaticOrder S; S.init(MP, N3, gridDim.x, opaque_bid());
                  Epi3 E{(bf16_t*)(p.ws + WS_UP), (const float*)(p.ws + WS_SS2)}; pg8::gemm_phase((LAS unsigned char*)smem, g, S, E); } break;
        case 6: if (PH_MASK & 64) phase_act(p); break;
        case 7: if (PH_MASK & 128) { pg8::Gemm g{(const bf16_t*)(p.ws + WS_ACT), (const bf16_t*)(p.ws + WS_WDOWN), MP, 2048, DFF}; pg8::StaticOrder S; S.init(MP, 2048, gridDim.x, opaque_bid());
                  Epi4 E{(const float*)(p.ws + WS_H1), p.out, (float*)(p.ws + WS_SS3)}; pg8::gemm_phase((LAS unsigned char*)smem, g, S, E); } break;
        default: if (PH_MASK & 256) phase_final(p); break;
        }
        if (ph + 1 < p0.ph_hi) grid.sync();
    }
}

extern "C" void kernel_launch(void* const* d_in, const int* in_sizes, int n_in, void* d_out, int out_size, void* d_ws, size_t ws_size, hipStream_t stream) {
    static int grid_blocks = 0;
    if (grid_blocks == 0) {
        if (n_in != 27 || (size_t)out_size != O_END || ws_size < WS_END) {
            fprintf(stderr, "kernel_launch: unexpected shapes: n_in %d out %d ws %zu (need %zu)\n", n_in, out_size, ws_size, (size_t)WS_END); grid_blocks = -1; return; }
        int dev = 0, cus = 0, per_cu = 0;
        (void)hipGetDevice(&dev);
        (void)hipDeviceGetAttribute(&cus, hipDeviceAttributeMultiprocessorCount, dev);
        (void)hipFuncSetAttribute((const void*)hymba_fwd, hipFuncAttributeMaxDynamicSharedMemorySize, LDS_BYTES);
        (void)hipOccupancyMaxActiveBlocksPerMultiprocessor(&per_cu, (const void*)hymba_fwd, 512, LDS_BYTES);
        if (per_cu < 1) { fprintf(stderr, "kernel_launch: occupancy query says %d blocks per CU\n", per_cu); per_cu = 1; }
        grid_blocks = cus;
    }
    if (grid_blocks < 0) return;
    Params p{};
    for (int i = 0; i < 27; ++i) p.in[i] = (const float*)d_in[i];
    p.out = (float*)d_out; p.ws = (unsigned char*)d_ws; p.ph_lo = 0; p.ph_hi = NPHASE;
    void* args[] = {&p};
    hipError_t e = hipLaunchCooperativeKernel((const void*)hymba_fwd, dim3(grid_blocks), dim3(512), args, LDS_BYTES, stream);
    if (e != hipSuccess) fprintf(stderr, "cooperative launch failed: %s (grid %d)\n", hipGetErrorString(e), grid_blocks);
}
```

```cpp
#include <hip/hip_runtime.h>
#include <hip/hip_cooperative_groups.h>
#include <cstdio>
namespace cg = cooperative_groups;

#define LAS __attribute__((address_space(3)))
typedef unsigned short bf16_t;
typedef short bf16x8 __attribute__((ext_vector_type(8)));
typedef float f32x4 __attribute__((ext_vector_type(4)));
typedef unsigned u32x4 __attribute__((ext_vector_type(4)));
typedef unsigned u32x2 __attribute__((ext_vector_type(2)));

constexpr int DM = 2048, MP = 9472, NVALID = 9280, NOUTROWS = 9216;
constexpr int N1P = 11008, N3 = 11264, DFF = 5632, MIXW = 4096;
constexpr int ROW_SAMPLE = 8192, ROW_META = 9216;
constexpr float EPS = 1e-6f;
constexpr int UC_Z = 0, UC_XBC = 2048, UC_Q = 4640, UC_K = 5664, UC_V = 6688, UC_O = 8752;
constexpr size_t WS_WIN = 0;
constexpr size_t WS_WOUT = WS_WIN + (size_t)N1P * 2048 * 2;
constexpr size_t WS_WUP = WS_WOUT + (size_t)2048 * 4096 * 2;
constexpr size_t WS_WDOWN = WS_WUP + (size_t)N3 * 2048 * 2;
constexpr size_t WS_XN = WS_WDOWN + (size_t)2048 * DFF * 2;
constexpr size_t WS_MIX = WS_XN + (size_t)MP * 2048 * 2;
constexpr size_t WS_ACT = WS_XN;
constexpr size_t WS_U = WS_MIX + (size_t)MP * MIXW * 2;
constexpr size_t WS_UP = WS_U;
constexpr size_t WS_H1 = WS_U + (size_t)MP * N3 * 2;
constexpr size_t WS_A2 = WS_H1 + (size_t)MP * 2048 * 4;
constexpr size_t WS_SF = WS_A2 + (size_t)MP * 2048 * 2;
constexpr size_t WS_SSQ = WS_SF + (size_t)MP * 64 * 4;
constexpr size_t WS_SSQM = WS_SSQ + (size_t)MP * 32 * 4;
constexpr size_t WS_SS2 = WS_SSQM + (size_t)MP * 32 * 4;
constexpr size_t WS_SS3 = WS_SS2 + (size_t)MP * 4;
constexpr size_t WS_DD = WS_SS3 + (size_t)MP * 4;
constexpr size_t WS_END = WS_DD + (size_t)MP * 8 * 4;
constexpr size_t O_Y = 0;
constexpr size_t O_P_SSDCONV = 18874368, O_P_SSD = 18905088, O_P_MLC = 19953664, O_P_MLN = 21002240, O_P_MLM = 21006336, O_P_FFN = 21006368;
constexpr size_t O_S_SSDCONV = 21096480, O_S_SSD = 22079520, O_S_MLC = 55633952, O_S_MLN = 89188384, O_S_MLM = 89319456, O_S_FFN = 89320480;
constexpr size_t O_END = 92204064;
constexpr int LDS_BYTES = 147456;
constexpr int NPHASE = 9;
#ifndef CHL_SSD
#define CHL_SSD 128
#endif
#ifndef CHL_ML
#define CHL_ML 128
#endif
#ifndef PH_MASK
#define PH_MASK 0x1ff
#endif

struct Params {
    const float* in[27];
    float* out;
    unsigned char* ws;
    int ph_lo, ph_hi;
};

__device__ __forceinline__ unsigned pack2(float lo, float hi) { unsigned r; asm("v_cvt_pk_bf16_f32 %0, %1, %2" : "=v"(r) : "v"(lo), "v"(hi)); return r; }
__device__ __forceinline__ float bf_lo(unsigned u) { return __uint_as_float(u << 16); }
__device__ __forceinline__ float bf_hi(unsigned u) { return __uint_as_float(u & 0xffff0000u); }
__device__ __forceinline__ float bf2f(bf16_t h) { return __uint_as_float((unsigned)h << 16); }
__device__ __forceinline__ float silu_f(float x) { return x / (1.f + __expf(-x)); }
__device__ __forceinline__ float sigm_f(float x) { return 1.f / (1.f + __expf(-x)); }
__device__ __forceinline__ float softplus_f(float x) { return x > 20.f ? x : log1pf(__expf(x)); }
__device__ __forceinline__ float logsig_f(float x) { return fminf(x, 0.f) - log1pf(__expf(-fabsf(x))); }
__device__ __forceinline__ int opaque_tid() { int t = threadIdx.x; asm volatile("" : "+v"(t)); return t; }
__device__ __forceinline__ int opaque_bid() { int t = blockIdx.x; asm volatile("" : "+s"(t)); return t; }
__device__ __forceinline__ int row_of(int b, int pos) { return pos < 16 ? ROW_META + b * 16 + pos : b * 2048 + pos - 16; }
__device__ __forceinline__ float wave_sum(float v) {
    v += __shfl_xor(v, 32); v += __shfl_xor(v, 16); v += __shfl_xor(v, 8); v += __shfl_xor(v, 4); v += __shfl_xor(v, 2); v += __shfl_xor(v, 1); return v;
}
__device__ __forceinline__ const float* resid_row(const Params& p, int row) {
    if (row < ROW_SAMPLE) return p.in[0] + (size_t)row * DM;
    if (row < ROW_META) return p.in[1] + (size_t)(row - ROW_SAMPLE) * DM;
    if (row < NVALID) return p.in[8] + (size_t)((row - ROW_META) & 15) * DM;
    return nullptr;
}

namespace pg8 {
constexpr int BM = 256, BK = 64, HALF = 128, HTB = HALF * BK * 2, STAGE_BYTES = 8 * HTB, NXCD = 8, WGM = 8;
__device__ __forceinline__ int lds_byte(int r, int c) { const int st = (r >> 4) * 2 + (c >> 5), rr = r & 15, cc = c & 31, ob = rr * 64 + cc * 2; return st * 1024 + (ob ^ (((ob >> 9) & 1) << 5)); }
__device__ __forceinline__ void stage_rc(int b, int& R, int& C) { const int st = b / 1024, sb = b % 1024, swz = sb ^ (((sb >> 9) & 1) << 5); R = (st >> 1) * 16 + swz / 64; C = (st & 1) * 32 + (swz % 64) / 2; }
__device__ __forceinline__ int perm32(int rho) { const int n = rho >> 4, i = rho & 15; return 8 * (i >> 2) + 4 * n + (i & 3); }
struct Unit { int pm, pn; };
struct Gemm { const bf16_t* A; const bf16_t* Bt; int M, N, K; };
struct StaticOrder {
    int nM, nN, nwg, G, c;
    __device__ void init(int M, int N, int G_, int c_) { nM = M / BM; nN = N / BM; nwg = nM * nN; G = G_; c = c_; }
    __device__ bool next(int i, Unit& u) const {
        const long L = (long)i * G + c; if (L >= nwg) return false;
        int wgid = (int)L; { const int q = nwg / NXCD, r = nwg % NXCD, xcd = wgid % NXCD, off = wgid / NXCD; wgid = (xcd < r ? xcd * (q + 1) : r * (q + 1) + (xcd - r) * q) + off; }
        const int nig = WGM * nN, gid = wgid / nig, fm = gid * WGM, gsz = (nM - fm) < WGM ? (nM - fm) : WGM;
        u.pm = fm + ((wgid % nig) % gsz); u.pn = (wgid % nig) / gsz; return true;
    }
};

template <class Epi>
__device__ __forceinline__ void gemm_phase(LAS unsigned char* lds, const Gemm g, const StaticOrder& S, const Epi& E) {
    const int tid = opaque_tid(), wid = __builtin_amdgcn_readfirstlane(tid >> 6), lane = tid & 63, wr = wid >> 2, wc = wid & 3, fr = lane & 15, fq = lane >> 4;
    const int K = g.K, nt = K / BK;
    unsigned voffA[2], voffB[2];
#pragma unroll
    for (int i = 0; i < 2; ++i) { int R, C; stage_rc(tid * 16 + i * 8192, R, C); const int Rb = ((R & ~31) + perm32(R & 31));
        voffA[i] = (unsigned)(R * K + C) * 2u; voffB[i] = (unsigned)(Rb * K + C) * 2u; }
    const size_t kstep = (size_t)(BK * 2);
    const size_t hstep = (size_t)HALF * K * 2;
    const size_t tstep = 2 * hstep;
    const unsigned ldsw = (unsigned)wid * 1024u;
    const int aoff = lds_byte(wr * 64 + fr, fq * 8), boff = lds_byte(wc * 32 + fr, fq * 8);
#define PG8_SA(b, h) (((b) * 2 + (h)) * HTB)
#define PG8_SB(b, h) ((4 + (b) * 2 + (h)) * HTB)
#define PG8_STAGE(bufoff, gbase, voff) do { _Pragma("unroll") for (int _i = 0; _i < 2; ++_i) \
        __builtin_amdgcn_global_load_lds((const unsigned*)((const char*)(gbase) + (voff)[_i]), (LAS unsigned*)(lds + (bufoff) + ldsw + _i * 8192), 16, 0, 0); } while (0)
#define PG8_LDA(dst, b, h) do { _Pragma("unroll") for (int m = 0; m < 4; ++m) _Pragma("unroll") for (int k = 0; k < 2; ++k) dst[m][k] = *(const LAS bf16x8*)(lds + PG8_SA(b, h) + aoff + m * 2048 + k * 1024); } while (0)
#define PG8_LDB(dst, b, h) do { _Pragma("unroll") for (int n = 0; n < 2; ++n) _Pragma("unroll") for (int k = 0; k < 2; ++k) dst[n][k] = *(const LAS bf16x8*)(lds + PG8_SB(b, h) + boff + n * 2048 + k * 1024); } while (0)
#define PG8_MMA(ai, bj, At, Bt) do { __builtin_amdgcn_s_setprio(1); _Pragma("unroll") for (int m = 0; m < 4; ++m) _Pragma("unroll") for (int n = 0; n < 2; ++n) _Pragma("unroll") for (int k = 0; k < 2; ++k) \
        acc[ai][bj][m][n] = __builtin_amdgcn_mfma_f32_16x16x32_bf16(Bt[n][k], At[m][k], acc[ai][bj][m][n], 0, 0, 0); __builtin_amdgcn_s_setprio(0); } while (0)
#define PG8_WAIT_V(n) asm volatile("s_waitcnt vmcnt(" #n ")" ::: "memory")
#define PG8_WAIT_L(n) asm volatile("s_waitcnt lgkmcnt(" #n ")" ::: "memory")
#define PG8_BAR __builtin_amdgcn_s_barrier()
#define PG8_SCHED __builtin_amdgcn_sched_barrier(0)
    Unit cur, nxt; int ui = 0;
    if (!S.next(0, cur)) return;
    f32x4 acc[2][2][4][2];
#pragma unroll
    for (int a = 0; a < 2; ++a)
#pragma unroll
        for (int b = 0; b < 2; ++b)
#pragma unroll
            for (int m = 0; m < 4; ++m)
#pragma unroll
                for (int n = 0; n < 2; ++n) acc[a][b][m][n] = (f32x4){0.f, 0.f, 0.f, 0.f};
    bf16x8 At[4][2], B0[2][2], B1[2][2];
    const char* cA = (const char*)g.A + (size_t)cur.pm * tstep; const char* cB = (const char*)g.Bt + (size_t)cur.pn * tstep;
    PG8_STAGE(PG8_SB(0, 0), cB, voffB); PG8_STAGE(PG8_SA(0, 0), cA, voffA); PG8_STAGE(PG8_SB(0, 1), cB + hstep, voffB); PG8_STAGE(PG8_SA(0, 1), cA + hstep, voffA);
    if (wr == 1) PG8_BAR;
    PG8_WAIT_V(4); PG8_BAR;
    PG8_STAGE(PG8_SB(1, 0), cB + kstep, voffB); PG8_STAGE(PG8_SA(1, 0), cA + kstep, voffA); PG8_STAGE(PG8_SB(1, 1), cB + hstep + kstep, voffB);
    PG8_WAIT_V(6); PG8_BAR;
    for (;;) {
        const bool has_next = S.next(ui + 1, nxt);
        const char* nA = has_next ? (const char*)g.A + (size_t)nxt.pm * tstep : cA; const char* nB = has_next ? (const char*)g.Bt + (size_t)nxt.pn * tstep : cB;
        for (int t = 0; t < nt; t += 2) {
            const bool last = (t == nt - 2);
            const char* a1 = cA + (size_t)(t + 1) * kstep;
            const char* a2 = last ? nA : cA + (size_t)(t + 2) * kstep; const char* b2 = last ? nB : cB + (size_t)(t + 2) * kstep;
            const char* a3 = a2 + kstep; const char* b3 = b2 + kstep;
            PG8_LDB(B0, 0, 0); PG8_SCHED; PG8_LDA(At, 0, 0); PG8_STAGE(PG8_SA(1, 1), a1 + hstep, voffA);
            PG8_WAIT_L(8); PG8_BAR; PG8_WAIT_L(0); PG8_MMA(0, 0, At, B0); PG8_BAR; PG8_SCHED;
            PG8_LDB(B1, 0, 1); PG8_STAGE(PG8_SB(0, 0), b2, voffB);
            PG8_BAR; PG8_WAIT_L(0); PG8_MMA(0, 1, At, B1); PG8_BAR;
            PG8_LDA(At, 0, 1); PG8_STAGE(PG8_SA(0, 0), a2, voffA);
            PG8_BAR; PG8_WAIT_L(0); PG8_MMA(1, 0, At, B0); PG8_BAR; PG8_SCHED;
            PG8_STAGE(PG8_SB(0, 1), b2 + hstep, voffB);
            PG8_WAIT_V(6); PG8_BAR; PG8_MMA(1, 1, At, B1); PG8_BAR;
            PG8_LDB(B0, 1, 0); PG8_SCHED; PG8_LDA(At, 1, 0); PG8_STAGE(PG8_SA(0, 1), a2 + hstep, voffA);
            PG8_WAIT_L(8); PG8_BAR; PG8_WAIT_L(0); PG8_MMA(0, 0, At, B0); PG8_BAR; PG8_SCHED;
            PG8_LDB(B1, 1, 1); PG8_STAGE(PG8_SB(1, 0), b3, voffB);
            PG8_BAR; PG8_WAIT_L(0); PG8_MMA(0, 1, At, B1); PG8_BAR;
            PG8_LDA(At, 1, 1); PG8_STAGE(PG8_SA(1, 0), a3, voffA);
            PG8_BAR; PG8_WAIT_L(0); PG8_MMA(1, 0, At, B0); PG8_BAR; PG8_SCHED;
            PG8_STAGE(PG8_SB(1, 1), b3 + hstep, voffB);
            PG8_WAIT_V(6); PG8_BAR; PG8_MMA(1, 1, At, B1); PG8_BAR;
        }
        { Unit eu = cur; asm volatile("" : "+s"(eu.pm), "+s"(eu.pn)); E(acc, eu, wr, wc, fr, fq); }
        if (!has_next) break;
#pragma unroll
        for (int a = 0; a < 2; ++a)
#pragma unroll
            for (int b = 0; b < 2; ++b)
#pragma unroll
                for (int m = 0; m < 4; ++m)
#pragma unroll
                    for (int n = 0; n < 2; ++n) acc[a][b][m][n] = (f32x4){0.f, 0.f, 0.f, 0.f};
        cur = nxt; cA = nA; cB = nB; ++ui;
    }
    PG8_WAIT_V(0);
    if (wr == 0) PG8_BAR;
    PG8_BAR;
#undef PG8_SA
#undef PG8_SB
#undef PG8_STAGE
#undef PG8_LDA
#undef PG8_LDB
#undef PG8_MMA
#undef PG8_WAIT_V
#undef PG8_WAIT_L
#undef PG8_BAR
#undef PG8_SCHED
}
}

typedef f32x4 AccT[2][2][4][2];
struct Epi1 {
    bf16_t* U; float* sf;
    __device__ __forceinline__ void operator()(const AccT& acc, const pg8::Unit& u, int wr, int wc, int fr, int fq) const {
        const int row0 = u.pm * 256 + wr * 64 + fr, col0 = u.pn * 256 + wc * 32 + 8 * fq;
        const bool side_dt = (u.pn == 18 && wc == 0), side_if = (u.pn == 34 && wc == 1);
#pragma unroll
        for (int ai = 0; ai < 2; ++ai)
#pragma unroll
            for (int m = 0; m < 4; ++m) {
                const int row = row0 + ai * 128 + m * 16;
                bf16_t* rowp = U + (size_t)row * N1P + col0;
#pragma unroll
                for (int bj = 0; bj < 2; ++bj) {
                    const f32x4 v0 = acc[ai][bj][m][0], v1 = acc[ai][bj][m][1];
                    u32x4 o; o[0] = pack2(v0[0], v0[1]); o[1] = pack2(v0[2], v0[3]); o[2] = pack2(v1[0], v1[1]); o[3] = pack2(v1[2], v1[3]);
                    *(u32x4*)(rowp + bj * 128) = o;
                }
                if (side_dt || side_if) {
                    float* sp = sf + (size_t)row * 64 + (side_if ? 32 : 0) + 8 * fq;
                    *(f32x4*)sp = acc[ai][0][m][0]; *(f32x4*)(sp + 4) = acc[ai][0][m][1];
                }
            }
    }
};
struct Epi2 {
    Params p;
    __device__ __forceinline__ void operator()(const AccT& acc, const pg8::Unit& u, int wr, int wc, int fr, int fq) const {
        float* H1 = (float*)(p.ws + WS_H1); bf16_t* A2 = (bf16_t*)(p.ws + WS_A2); float* SS2 = (float*)(p.ws + WS_SS2);
        const float* nw = p.in[21];
        const int row0 = u.pm * 256 + wr * 64 + fr, col0 = u.pn * 256 + wc * 32 + 8 * fq;
        f32x4 w[2][2];
#pragma unroll
        for (int bj = 0; bj < 2; ++bj) { w[bj][0] = *(const f32x4*)(nw + col0 + bj * 128); w[bj][1] = *(const f32x4*)(nw + col0 + bj * 128 + 4); }
#pragma unroll
        for (int ai = 0; ai < 2; ++ai)
#pragma unroll
            for (int m = 0; m < 4; ++m) {
                const int row = row0 + ai * 128 + m * 16;
                const float* rp = resid_row(p, row);
                float ss = 0.f;
#pragma unroll
                for (int bj = 0; bj < 2; ++bj) {
                    f32x4 v0 = acc[ai][bj][m][0], v1 = acc[ai][bj][m][1];
                    if (rp) { v0 += *(const f32x4*)(rp + col0 + bj * 128); v1 += *(const f32x4*)(rp + col0 + bj * 128 + 4); }
                    *(f32x4*)(H1 + (size_t)row * DM + col0 + bj * 128) = v0; *(f32x4*)(H1 + (size_t)row * DM + col0 + bj * 128 + 4) = v1;
                    ss += v0[0] * v0[0] + v0[1] * v0[1] + v0[2] * v0[2] + v0[3] * v0[3] + v1[0] * v1[0] + v1[1] * v1[1] + v1[2] * v1[2] + v1[3] * v1[3];
                    const f32x4 a0 = v0 * w[bj][0], a1 = v1 * w[bj][1];
                    u32x4 o; o[0] = pack2(a0[0], a0[1]); o[1] = pack2(a0[2], a0[3]); o[2] = pack2(a1[0], a1[1]); o[3] = pack2(a1[2], a1[3]);
                    *(u32x4*)(A2 + (size_t)row * DM + col0 + bj * 128) = o;
                }
                ss += __shfl_xor(ss, 16); ss += __shfl_xor(ss, 32);
                if (fq == 0) atomicAdd(SS2 + row, ss);
            }
    }
};
struct Epi3 {
    bf16_t* UP; const float* SS2;
    __device__ __forceinline__ void operator()(const AccT& acc, const pg8::Unit& u, int wr, int wc, int fr, int fq) const {
        const int row0 = u.pm * 256 + wr * 64 + fr, col0 = u.pn * 256 + wc * 32 + 8 * fq;
#pragma unroll
        for (int ai = 0; ai < 2; ++ai)
#pragma unroll
            for (int m = 0; m < 4; ++m) {
                const int row = row0 + ai * 128 + m * 16;
                const float r2 = rsqrtf(SS2[row] * (1.f / 2048.f) + EPS);
                bf16_t* rowp = UP + (size_t)row * N3 + col0;
#pragma unroll
                for (int bj = 0; bj < 2; ++bj) {
                    const f32x4 v0 = acc[ai][bj][m][0] * r2, v1 = acc[ai][bj][m][1] * r2;
                    u32x4 o; o[0] = pack2(v0[0], v0[1]); o[1] = pack2(v0[2], v0[3]); o[2] = pack2(v1[0], v1[1]); o[3] = pack2(v1[2], v1[3]);
                    *(u32x4*)(rowp + bj * 128) = o;
                }
            }
    }
};
struct Epi4 {
    const float* H1; float* out; float* SS3;
    __device__ __forceinline__ void operator()(const AccT& acc, const pg8::Unit& u, int wr, int wc, int fr, int fq) const {
        const int row0 = u.pm * 256 + wr * 64 + fr, col0 = u.pn * 256 + wc * 32 + 8 * fq;
#pragma unroll
        for (int ai = 0; ai < 2; ++ai)
#pragma unroll
            for (int m = 0; m < 4; ++m) {
                const int row = row0 + ai * 128 + m * 16;
                if (row < NOUTROWS) {
                    float ss = 0.f;
#pragma unroll
                    for (int bj = 0; bj < 2; ++bj) {
                        const f32x4 v0 = acc[ai][bj][m][0] + *(const f32x4*)(H1 + (size_t)row * DM + col0 + bj * 128);
                        const f32x4 v1 = acc[ai][bj][m][1] + *(const f32x4*)(H1 + (size_t)row * DM + col0 + bj * 128 + 4);
                        *(f32x4*)(out + (size_t)row * DM + col0 + bj * 128) = v0; *(f32x4*)(out + (size_t)row * DM + col0 + bj * 128 + 4) = v1;
                        ss += v0[0] * v0[0] + v0[1] * v0[1] + v0[2] * v0[2] + v0[3] * v0[3] + v1[0] * v1[0] + v1[1] * v1[1] + v1[2] * v1[2] + v1[3] * v1[3];
                    }
                    ss += __shfl_xor(ss, 16); ss += __shfl_xor(ss, 32);
                    if (fq == 0) atomicAdd(SS3 + row, ss);
                }
            }
    }
};

__device__ __forceinline__ void transpose_tile(const float* W, bf16_t* WT, int K, int N, int kt, int nt_, unsigned char* smem) {
    float* tile = (float*)smem;
    const int tid = opaque_tid(), k0 = kt * 64, n0 = nt_ * 256;
    f32x4 v[8];
    const int nc = (tid & 63) * 4, n = n0 + nc;
#pragma unroll
    for (int i = 0; i < 8; ++i) {
        const int kr = (tid >> 6) + 8 * i;
        v[i] = (f32x4){0.f, 0.f, 0.f, 0.f};
        if (n < N) v[i] = *(const f32x4*)(W + (size_t)(k0 + kr) * N + n);
    }
#pragma unroll
    for (int i = 0; i < 8; ++i) {
        const int kr = (tid >> 6) + 8 * i;
        tile[kr * 257 + nc] = v[i][0]; tile[kr * 257 + nc + 1] = v[i][1]; tile[kr * 257 + nc + 2] = v[i][2]; tile[kr * 257 + nc + 3] = v[i][3];
    }
    __syncthreads();
    const int kc = (tid & 7) * 8;
#pragma unroll
    for (int q = 0; q < 4; ++q) {
        const int nr = (tid >> 3) + 64 * q;
        u32x4 o;
        o[0] = pack2(tile[(kc + 0) * 257 + nr], tile[(kc + 1) * 257 + nr]); o[1] = pack2(tile[(kc + 2) * 257 + nr], tile[(kc + 3) * 257 + nr]);
        o[2] = pack2(tile[(kc + 4) * 257 + nr], tile[(kc + 5) * 257 + nr]); o[3] = pack2(tile[(kc + 6) * 257 + nr], tile[(kc + 7) * 257 + nr]);
        *(u32x4*)(WT + (size_t)(n0 + nr) * K + k0 + kc) = o;
    }
    __syncthreads();
}
__device__ __forceinline__ void phase_prep(const Params& p, unsigned char* smem) {
    const int tid = opaque_tid(), wid = tid >> 6, lane = tid & 63;
    { float* SS2 = (float*)(p.ws + WS_SS2); for (int i = opaque_bid() * 512 + tid; i < 2 * MP; i += gridDim.x * 512) SS2[i] = 0.f; }
    {
        bf16_t* XN = (bf16_t*)(p.ws + WS_XN); const float* nw = p.in[9];
        for (int row = opaque_bid() * 8 + wid; row < MP; row += gridDim.x * 8) {
            const float* src = resid_row(p, row);
            f32x4 v[8];
            float ss = 0.f;
#pragma unroll
            for (int it = 0; it < 4; ++it) {
                const int col = it * 512 + lane * 8;
                if (src) { v[2 * it] = *(const f32x4*)(src + col); v[2 * it + 1] = *(const f32x4*)(src + col + 4); }
                else { v[2 * it] = (f32x4){0.f, 0.f, 0.f, 0.f}; v[2 * it + 1] = (f32x4){0.f, 0.f, 0.f, 0.f}; }
#pragma unroll
                for (int j = 0; j < 4; ++j) ss += v[2 * it][j] * v[2 * it][j] + v[2 * it + 1][j] * v[2 * it + 1][j];
            }
            ss = wave_sum(ss);
            const float r = rsqrtf(ss * (1.f / 2048.f) + EPS);
#pragma unroll
            for (int it = 0; it < 4; ++it) {
                const int col = it * 512 + lane * 8;
                const f32x4 w0 = *(const f32x4*)(nw + col), w1 = *(const f32x4*)(nw + col + 4);
                const f32x4 a = v[2 * it] * r * w0, c = v[2 * it + 1] * r * w1;
                u32x4 o; o[0] = pack2(a[0], a[1]); o[1] = pack2(a[2], a[3]); o[2] = pack2(c[0], c[1]); o[3] = pack2(c[2], c[3]);
                *(u32x4*)(XN + (size_t)row * DM + col) = o;
            }
        }
    }
    constexpr int T_IN = 32 * 43, T_OUT = 64 * 8, T_UP = 32 * 44, T_DOWN = 88 * 8, T_ALL = T_IN + T_OUT + T_UP + T_DOWN;
    for (int t = opaque_bid(); t < T_ALL; t += gridDim.x) {
        if (t < T_IN) transpose_tile(p.in[10], (bf16_t*)(p.ws + WS_WIN), 2048, 10800, t % 32, t / 32, smem);
        else if (t < T_IN + T_OUT) { const int q = t - T_IN; transpose_tile(p.in[20], (bf16_t*)(p.ws + WS_WOUT), 4096, 2048, q % 64, q / 64, smem); }
        else if (t < T_IN + T_OUT + T_UP) { const int q = t - T_IN - T_OUT; transpose_tile(p.in[22], (bf16_t*)(p.ws + WS_WUP), 2048, N3, q % 32, q / 32, smem); }
        else { const int q = t - T_IN - T_OUT - T_UP; transpose_tile(p.in[25], (bf16_t*)(p.ws + WS_WDOWN), DFF, 2048, q % 88, q / 88, smem); }
    }
}

constexpr int RS = 272;
constexpr int L_QS = 0, L_KS = 34816, L_KT = 69632, L_VT = 104448, L_ST = 121856, L_SC = 139264;

template <bool ML>
__device__ __forceinline__ void load_block(const Params& p, float (&val)[8][4], int b, int p0, int Lv, int rb, int cg, int colbase, int chbase, float mlscale) {
    const bf16_t* U = (const bf16_t*)(p.ws + WS_U);
    const int t0 = rb * 8;
    if (t0 >= Lv) {
#pragma unroll
        for (int r = 0; r < 8; ++r)
#pragma unroll
            for (int i = 0; i < 4; ++i) val[r][i] = 0.f;
        return;
    }
    if (ML) {
#pragma unroll
        for (int r = 0; r < 8; ++r) {
            const int row = row_of(b, p0 + t0 + r);
            const u32x2 raw = *(const u32x2*)(U + (size_t)row * N1P + colbase + cg * 4);
            val[r][0] = bf_lo(raw[0]) * mlscale; val[r][1] = bf_hi(raw[0]) * mlscale; val[r][2] = bf_lo(raw[1]) * mlscale; val[r][3] = bf_hi(raw[1]) * mlscale;
        }
    } else {
        u32x2 raw[11];
#pragma unroll
        for (int rr = 0; rr < 11; ++rr) {
            const int pos = p0 + t0 - 3 + rr;
            if (pos >= 0) raw[rr] = *(const u32x2*)(U + (size_t)row_of(b, pos) * N1P + colbase + cg * 4);
            else raw[rr] = (u32x2){0u, 0u};
        }
        const float* cw = p.in[11]; const float* cb = p.in[12];
        const int ch = chbase + cg * 4;
        f32x4 w[4];
#pragma unroll
        for (int j = 0; j < 4; ++j) w[j] = *(const f32x4*)(cw + j * 2560 + ch);
        const f32x4 bi = *(const f32x4*)(cb + ch);
#pragma unroll
        for (int i = 0; i < 4; ++i) {
            float x[11];
#pragma unroll
            for (int rr = 0; rr < 11; ++rr) x[rr] = (i & 1) ? bf_hi(raw[rr][i >> 1]) : bf_lo(raw[rr][i >> 1]);
#pragma unroll
            for (int r = 0; r < 8; ++r) val[r][i] = silu_f(bi[i] + w[0][i] * x[r] + w[1][i] * x[r + 1] + w[2][i] * x[r + 2] + w[3][i] * x[r + 3]);
        }
    }
}
__device__ __forceinline__ void store_rows(unsigned char* base, const float (&val)[8][4], int rb, int cg) {
#pragma unroll
    for (int r = 0; r < 8; ++r) *(u32x2*)(base + (rb * 8 + r) * RS + cg * 8) = (u32x2){pack2(val[r][0], val[r][1]), pack2(val[r][2], val[r][3])};
}
__device__ __forceinline__ void store_cols(unsigned char* base, const float (&val)[8][4], int rb, int cg, const float* scale) {
    float s[8];
#pragma unroll
    for (int r = 0; r < 8; ++r) s[r] = scale ? scale[rb * 8 + r] : 1.f;
#pragma unroll
    for (int i = 0; i < 4; ++i) {
        const int row = cg * 4 + i;
        u32x4 o; o[0] = pack2(val[0][i] * s[0], val[1][i] * s[1]); o[1] = pack2(val[2][i] * s[2], val[3][i] * s[3]);
        o[2] = pack2(val[4][i] * s[4], val[5][i] * s[5]); o[3] = pack2(val[6][i] * s[6], val[7][i] * s[7]);
        *(u32x4*)(base + row * RS + ((rb ^ ((row >> 3) & 7)) << 4)) = o;
    }
}

template <bool ML>
__device__ __forceinline__ void prompt_scan(const Params& p, unsigned char* smem, int job) {
    const int tid = opaque_tid(), wid = __builtin_amdgcn_readfirstlane(tid >> 6), lane = tid & 63, fr = lane & 15, fq = lane >> 4;
    int b, h, vq = 0;
    if (ML) { b = job >> 5; h = (job >> 2) & 7; vq = job & 3; } else { b = job >> 5; h = job & 31; }
    const int g = h >> 4;
    const bf16_t* U = (const bf16_t*)(p.ws + WS_U);
    const float* SF = (const float*)(p.ws + WS_SF);
    bf16_t* MIX = (bf16_t*)(p.ws + WS_MIX);
    float* scb = (float*)(smem + L_SC);
    float *qn = scb + 1600, *nvec = scb + 1728, *mpp = scb + 1856;
    const int qcol = ML ? UC_Q + h * 128 : UC_XBC + 2304 + g * 128;
    const int kcol = ML ? UC_K + h * 128 : UC_XBC + 2048 + g * 128;
    const int vcol = ML ? UC_V + h * 256 + vq * 64 : UC_XBC + h * 64;
    const int gcol = ML ? UC_O + h * 256 + vq * 64 : UC_Z + h * 64;
    const int mixcol = ML ? 2048 + h * 256 + vq * 64 : h * 64;
    float A_h = 0.f, D_h = 0.f, dtb = 0.f, ib = 0.f, fb = 0.f;
    if (ML) { ib = p.in[17][h]; fb = p.in[18][h]; } else { A_h = -__expf(p.in[14][h]); D_h = p.in[15][h]; dtb = p.in[13][h]; }
    f32x4 st[4];
#pragma unroll
    for (int i = 0; i < 4; ++i) st[i] = (f32x4){0.f, 0.f, 0.f, 0.f};
    for (int i = tid; i < 64 * RS / 16; i += 512) *(u32x4*)(smem + L_ST + i * 16) = (u32x4){0u, 0u, 0u, 0u};
    if (tid < 128) nvec[tid] = 0.f;
    if (tid == 0) mpp[0] = 0.f;
    constexpr int CHLs = ML ? CHL_ML : CHL_SSD;
    auto scalars = [&](int cc) {
        const int p0 = cc == 0 ? 0 : 16 + (cc - 1) * CHLs, Lv = cc == 0 ? 16 : CHLs;
        float* sc = scb + (cc & 1) * 800;
        float *rowv = sc, *colv = sc + 128, *colm = sc + 256, *ev = sc + 384, *scv = sc + 512, *dden = sc + 640, *misc = sc + 768;
        const int t0 = 2 * lane, t1 = t0 + 1;
        if (!ML) {
            float d0 = 0.f, d1 = 0.f;
            if (t0 < Lv) d0 = softplus_f(SF[(size_t)row_of(b, p0 + t0) * 64 + h] + dtb);
            if (t1 < Lv) d1 = softplus_f(SF[(size_t)row_of(b, p0 + t1) * 64 + h] + dtb);
            const float a0 = d0 * A_h, a1 = d1 * A_h;
            float inc = a0 + a1;
#pragma unroll
            for (int o = 1; o < 64; o <<= 1) { const float y = __shfl_up(inc, o); if (lane >= o) inc += y; }
            const float c1 = inc, c0 = inc - a1, cl = __shfl(inc, 63);
            rowv[t0] = c0; rowv[t1] = c1; colv[t0] = -c0; colv[t1] = -c1; colm[t0] = d0; colm[t1] = d1;
            ev[t0] = __expf(c0); ev[t1] = __expf(c1); scv[t0] = __expf(cl - c0) * d0; scv[t1] = __expf(cl - c1) * d1;
            if (lane == 0) misc[0] = __expf(cl);
        } else {
            float i0 = -INFINITY, i1 = -INFINITY, f0 = 0.f, f1 = 0.f;
            if (t0 < Lv) { const size_t r = (size_t)row_of(b, p0 + t0) * 64; i0 = SF[r + 32 + h] + ib; f0 = logsig_f(SF[r + 40 + h] + fb); }
            if (t1 < Lv) { const size_t r = (size_t)row_of(b, p0 + t1) * 64; i1 = SF[r + 32 + h] + ib; f1 = logsig_f(SF[r + 40 + h] + fb); }
            float inc = f0 + f1;
#pragma unroll
            for (int o = 1; o < 64; o <<= 1) { const float y = __shfl_up(inc, o); if (lane >= o) inc += y; }
            const float F1 = inc, F0 = inc - f1;
            const float g0 = i0 - F0, g1 = i1 - F1;
            float mx = fmaxf(g0, g1);
#pragma unroll
            for (int o = 1; o < 64; o <<= 1) { const float y = __shfl_up(mx, o); if (lane >= o) mx = fmaxf(mx, y); }
            float ex = __shfl_up(mx, 1); if (lane == 0) ex = -INFINITY;
            const float mp = mpp[0];
            const float M0 = fmaxf(fmaxf(ex, g0), mp), M1 = fmaxf(mx, mp);
            const float Ml = __shfl(M1, 63), Fl = __shfl(F1, 63);
            rowv[t0] = -M0; rowv[t1] = -M1; colv[t0] = g0; colv[t1] = g1; colm[t0] = 1.f; colm[t1] = 1.f;
            ev[t0] = __expf(mp - M0); ev[t1] = __expf(mp - M1); dden[t0] = __expf(-(F0 + M0)); dden[t1] = __expf(-(F1 + M1));
            scv[t0] = __expf(g0 - Ml); scv[t1] = __expf(g1 - Ml);
            if (lane == 0) { misc[0] = __expf(mp - Ml); mpp[0] = Fl + Ml; }
        }
    };
    __syncthreads();
    if (wid == 0) scalars(0);
    __syncthreads();
    constexpr int CHL = ML ? CHL_ML : CHL_SSD, NCH = 1 + 2048 / CHL;
    const int tid_outer = tid;
    for (int c = 0; c < NCH; ++c) {
        int tid = tid_outer; asm volatile("" : "+v"(tid));
        const int lane = tid & 63, fr = lane & 15, fq = lane >> 4;
        const int p0 = c == 0 ? 0 : 16 + (c - 1) * CHL, Lv = c == 0 ? 16 : CHL;
        float* sc = scb + (c & 1) * 800;
        float *rowv = sc, *colv = sc + 128, *colm = sc + 256, *ev = sc + 384, *scv = sc + 512, *dden = sc + 640, *misc = sc + 768;
        if (wid == 0 && c + 1 < NCH) scalars(c + 1);
        {
            float val[8][4];
            load_block<ML>(p, val, b, p0, Lv, tid >> 5, tid & 31, qcol, 2304 + g * 128, 1.f);
            store_rows(smem + L_QS, val, tid >> 5, tid & 31);
            __builtin_amdgcn_sched_barrier(0);
            load_block<ML>(p, val, b, p0, Lv, tid >> 5, tid & 31, kcol, 2048 + g * 128, 0.08838834764831845f);
            store_rows(smem + L_KS, val, tid >> 5, tid & 31);
            store_cols(smem + L_KT, val, tid >> 5, tid & 31, scv);
            __builtin_amdgcn_sched_barrier(0);
            if (tid < 256) {
                load_block<ML>(p, val, b, p0, Lv, tid >> 4, tid & 15, vcol, h * 64, 1.f);
                store_cols(smem + L_VT, val, tid >> 4, tid & 15, nullptr);
            }
        }
        __syncthreads();
        const int t = 16 * wid + fr;
        const bool valid = t < Lv;
        const int row = row_of(b, p0 + (valid ? t : 0));
        u32x2 gate[4];
#pragma unroll
        for (int vb = 0; vb < 4; ++vb) gate[vb] = *(const u32x2*)(U + (size_t)row * N1P + gcol + 16 * vb + 4 * fq);
        if (ML) {
            const int tt = tid >> 2, part = tid & 3;
            float s = 0.f;
#pragma unroll
            for (int cc = 0; cc < 4; ++cc) {
                const u32x4 raw = *(const u32x4*)(smem + L_QS + tt * RS + (part * 4 + cc) * 16);
                const f32x4 n0 = *(const f32x4*)(nvec + (part * 4 + cc) * 8), n1 = *(const f32x4*)(nvec + (part * 4 + cc) * 8 + 4);
                s += bf_lo(raw[0]) * n0[0] + bf_hi(raw[0]) * n0[1] + bf_lo(raw[1]) * n0[2] + bf_hi(raw[1]) * n0[3]
                   + bf_lo(raw[2]) * n1[0] + bf_hi(raw[2]) * n1[1] + bf_lo(raw[3]) * n1[2] + bf_hi(raw[3]) * n1[3];
            }
            s += __shfl_xor(s, 1); s += __shfl_xor(s, 2);
            if (part == 0) qn[tt] = s;
        }
        bf16x8 qf[4];
#pragma unroll
        for (int kk = 0; kk < 4; ++kk) qf[kk] = *(const bf16x8*)(smem + L_QS + t * RS + (kk * 32 + fq * 8) * 2);
        const float rv = rowv[t];
        float rowsum = 0.f;
        u32x2 pk[8];
#pragma unroll
        for (int sb = 0; sb < 8; ++sb) {
            pk[sb] = (u32x2){0u, 0u};
            if (sb <= wid) {
                f32x4 acc = {0.f, 0.f, 0.f, 0.f};
#pragma unroll
                for (int kk = 0; kk < 4; ++kk) {
                    const bf16x8 kf = *(const bf16x8*)(smem + L_KS + (16 * sb + fr) * RS + (kk * 32 + fq * 8) * 2);
                    acc = __builtin_amdgcn_mfma_f32_16x16x32_bf16(kf, qf[kk], acc, 0, 0, 0);
                }
                const f32x4 cv = *(const f32x4*)(colv + 16 * sb + 4 * fq), cm = *(const f32x4*)(colm + 16 * sb + 4 * fq);
                float pv[4];
#pragma unroll
                for (int j = 0; j < 4; ++j) {
                    const int s = 16 * sb + 4 * fq + j;
                    const float w = (s <= t) ? __expf(rv + cv[j]) * cm[j] : 0.f;
                    pv[j] = acc[j] * w; rowsum += pv[j];
                }
                pk[sb] = (u32x2){pack2(pv[0], pv[1]), pack2(pv[2], pv[3])};
            }
        }
        __syncthreads();
#pragma unroll
        for (int sb = 0; sb < 8; ++sb) *(u32x2*)(smem + L_KS + t * RS + (16 * sb + 4 * fq) * 2) = pk[sb];
        rowsum += __shfl_xor(rowsum, 16); rowsum += __shfl_xor(rowsum, 32);
        if (ML) {
            const int d = tid >> 2, part = tid & 3;
            float s = 0.f;
#pragma unroll
            for (int cc = 0; cc < 4; ++cc) {
                const u32x4 raw = *(const u32x4*)(smem + L_KT + d * RS + (part * 4 + cc) * 16);
                s += bf_lo(raw[0]) + bf_hi(raw[0]) + bf_lo(raw[1]) + bf_hi(raw[1]) + bf_lo(raw[2]) + bf_hi(raw[2]) + bf_lo(raw[3]) + bf_hi(raw[3]);
            }
            s += __shfl_xor(s, 1); s += __shfl_xor(s, 2);
            if (part == 0) nvec[d] = misc[0] * nvec[d] + s;
        }
        __syncthreads();
        bf16x8 pf[4];
#pragma unroll
        for (int kk = 0; kk < 4; ++kk) pf[kk] = *(const bf16x8*)(smem + L_KS + t * RS + (kk * 32 + fq * 8) * 2);
        const float et = ev[t];
        float ddv = 1.f;
        if (ML) ddv = fmaxf(fabsf(rowsum + et * qn[t]), dden[t]);
        float ss = 0.f;
#pragma unroll
        for (int vb = 0; vb < 4; ++vb) {
            f32x4 acc = {0.f, 0.f, 0.f, 0.f};
            const int vrow = 16 * vb + fr;
#pragma unroll
            for (int kk = 0; kk < 4; ++kk) {
                const bf16x8 sf = *(const bf16x8*)(smem + L_ST + vrow * RS + (kk * 32 + fq * 8) * 2);
                acc = __builtin_amdgcn_mfma_f32_16x16x32_bf16(sf, qf[kk], acc, 0, 0, 0);
            }
            acc *= et;
#pragma unroll
            for (int kk = 0; kk < 4; ++kk) {
                const bf16x8 vf = *(const bf16x8*)(smem + L_VT + vrow * RS + (((kk * 4 + fq) ^ ((vrow >> 3) & 7)) << 4));
                acc = __builtin_amdgcn_mfma_f32_16x16x32_bf16(vf, pf[kk], acc, 0, 0, 0);
            }
            const float gz[4] = {bf_lo(gate[vb][0]), bf_hi(gate[vb][0]), bf_lo(gate[vb][1]), bf_hi(gate[vb][1])};
            float o[4];
#pragma unroll
            for (int j = 0; j < 4; ++j) {
                if (ML) { const float hv = acc[j]; ss += hv * hv; o[j] = hv * sigm_f(gz[j]); }
                else {
                    const int v = 16 * vb + 4 * fq + j;
                    const float xv = bf2f(*(const bf16_t*)(smem + L_VT + v * RS + (((t >> 3) ^ ((v >> 3) & 7)) << 4) + (t & 7) * 2));
                    const float y = (acc[j] + D_h * xv) * silu_f(gz[j]); ss += y * y; o[j] = y;
                }
            }
            if (valid) *(u32x2*)(MIX + (size_t)row * MIXW + mixcol + 16 * vb + 4 * fq) = (u32x2){pack2(o[0], o[1]), pack2(o[2], o[3])};
        }
        ss += __shfl_xor(ss, 16); ss += __shfl_xor(ss, 32);
        if (valid && fq == 0) {
            if (ML) { ((float*)(p.ws + WS_SSQM))[(size_t)row * 32 + h * 4 + vq] = ss; if (vq == 0) ((float*)(p.ws + WS_DD))[(size_t)row * 8 + h] = ddv; }
            else ((float*)(p.ws + WS_SSQ))[(size_t)row * 32 + h] = ss;
        }
        const float dec = misc[0];
#pragma unroll
        for (int vb = 0; vb < 4; ++vb) st[vb] *= dec;
#pragma unroll
        for (int kk = 0; kk < 4; ++kk) {
            const int drow = 16 * wid + fr;
            const bf16x8 kf = *(const bf16x8*)(smem + L_KT + drow * RS + (((kk * 4 + fq) ^ ((drow >> 3) & 7)) << 4));
#pragma unroll
            for (int vb = 0; vb < 4; ++vb) {
                const int vrow = 16 * vb + fr;
                const bf16x8 vf = *(const bf16x8*)(smem + L_VT + vrow * RS + (((kk * 4 + fq) ^ ((vrow >> 3) & 7)) << 4));
                st[vb] = __builtin_amdgcn_mfma_f32_16x16x32_bf16(kf, vf, st[vb], 0, 0, 0);
            }
        }
        __syncthreads();
#pragma unroll
        for (int vb = 0; vb < 4; ++vb)
            *(u32x2*)(smem + L_ST + (16 * vb + fr) * RS + (16 * wid + 4 * fq) * 2) = (u32x2){pack2(st[vb][0], st[vb][1]), pack2(st[vb][2], st[vb][3])};
    }
#pragma unroll
    for (int vb = 0; vb < 4; ++vb) {
        const int v = 16 * vb + fr, d0 = 16 * wid + 4 * fq;
        if (!ML) *(f32x4*)(p.out + O_P_SSD + ((size_t)(b * 32 + h) * 64 + v) * 128 + d0) = st[vb];
        else {
#pragma unroll
            for (int j = 0; j < 4; ++j) p.out[O_P_MLC + ((size_t)(b * 8 + h) * 128 + d0 + j) * 256 + vq * 64 + v] = st[vb][j];
        }
    }
    if (ML && vq == 0) {
        if (tid < 128) p.out[O_P_MLN + (size_t)(b * 8 + h) * 128 + tid] = nvec[tid];
        if (tid == 0) p.out[O_P_MLM + b * 8 + h] = mpp[0];
    }
    __syncthreads();
}

__device__ __forceinline__ void sample_ssd(const Params& p, unsigned char* smem, int job) {
    const int tid = opaque_tid(), wid = tid >> 6, lane = tid & 63;
    const int b = job >> 1, g = job & 1, rowb = ROW_SAMPLE + b * 8;
    const bf16_t* U = (const bf16_t*)(p.ws + WS_U);
    const float* SF = (const float*)(p.ws + WS_SF);
    bf16_t* MIX = (bf16_t*)(p.ws + WS_MIX);
    float* Bc = (float*)smem; float* Cc = Bc + 1024; float* xall = Cc + 1024; float* G = xall + 8192; float* dts = G + 64; float* ssqp = dts + 128;
    const float* sconv = p.in[2]; const float* cw = p.in[11]; const float* cb = p.in[12];
#pragma unroll
    for (int q = 0; q < 3; ++q) {
        int ch; float* dst; int dstride = 0;
        if (q < 2) { ch = g * 1024 + tid + q * 512; dst = xall + tid + q * 512; dstride = 1024; }
        else { if (tid >= 256) break; const int which = tid >> 7, n = tid & 127; ch = 2048 + which * 256 + g * 128 + n; dst = (which ? Cc : Bc) + n; dstride = 128; }
        float xm3 = sconv[(size_t)(b * 3 + 0) * 2560 + ch], xm2 = sconv[(size_t)(b * 3 + 1) * 2560 + ch], xm1 = sconv[(size_t)(b * 3 + 2) * 2560 + ch];
        const float w0 = cw[ch], w1 = cw[2560 + ch], w2 = cw[5120 + ch], w3 = cw[7680 + ch], bb = cb[ch];
#pragma unroll
        for (int t = 0; t < 8; ++t) {
            const float x = bf2f(U[(size_t)(rowb + t) * N1P + UC_XBC + ch]);
            dst[t * dstride] = silu_f(bb + w0 * xm3 + w1 * xm2 + w2 * xm1 + w3 * x);
            xm3 = xm2; xm2 = xm1; xm1 = x;
        }
    }
    if (tid < 128) { const int hh = tid >> 3, t = tid & 7; dts[tid] = softplus_f(SF[(size_t)(rowb + t) * 64 + g * 16 + hh] + p.in[13][g * 16 + hh]); }
    __syncthreads();
    {
        const int pair = tid >> 3, part = tid & 7, t = pair >> 3, s = pair & 7;
        float sum = 0.f;
#pragma unroll
        for (int i = 0; i < 4; ++i) {
            const f32x4 c4 = *(const f32x4*)(Cc + t * 128 + part * 16 + i * 4), b4 = *(const f32x4*)(Bc + s * 128 + part * 16 + i * 4);
            sum += c4[0] * b4[0] + c4[1] * b4[1] + c4[2] * b4[2] + c4[3] * b4[3];
        }
        sum += __shfl_xor(sum, 1); sum += __shfl_xor(sum, 2); sum += __shfl_xor(sum, 4);
        if (part == 0) G[pair] = sum;
    }
    __syncthreads();
    const int pp = tid >> 3, nq = tid & 7;
    f32x4 snext[4];
#pragma unroll
    for (int i = 0; i < 4; ++i) snext[i] = *(const f32x4*)(p.in[3] + ((size_t)(b * 32 + g * 16) * 64 + pp) * 128 + nq * 4 + 32 * i);
    for (int hh = 0; hh < 16; ++hh) {
        const int h = g * 16 + hh;
        const float A_h = -__expf(p.in[14][h]), D_h = p.in[15][h];
        float dtv[8], cum[8];
        { float run = 0.f;
#pragma unroll
          for (int t = 0; t < 8; ++t) { dtv[t] = dts[hh * 8 + t]; run += dtv[t] * A_h; cum[t] = run; } }
        const size_t soff = ((size_t)(b * 32 + h) * 64 + pp) * 128 + nq * 4;
        f32x4 s0[4];
#pragma unroll
        for (int i = 0; i < 4; ++i) s0[i] = snext[i];
        if (hh + 1 < 16) {
#pragma unroll
            for (int i = 0; i < 4; ++i) snext[i] = *(const f32x4*)(p.in[3] + soff + 64 * 128 + 32 * i);
        }
        float cs[8];
#pragma unroll
        for (int t = 0; t < 8; ++t) {
            float sum = 0.f;
#pragma unroll
            for (int i = 0; i < 4; ++i) { const f32x4 c4 = *(const f32x4*)(Cc + t * 128 + nq * 4 + 32 * i); sum += c4[0] * s0[i][0] + c4[1] * s0[i][1] + c4[2] * s0[i][2] + c4[3] * s0[i][3]; }
            sum += __shfl_xor(sum, 1); sum += __shfl_xor(sum, 2); sum += __shfl_xor(sum, 4);
            cs[t] = sum;
        }
        float ycs = 0.f, ct = 0.f;
#pragma unroll
        for (int t = 0; t < 8; ++t) { ycs = (nq == t) ? cs[t] : ycs; ct = (nq == t) ? cum[t] : ct; }
        float y = __expf(ct) * ycs, xt = 0.f;
#pragma unroll
        for (int s = 0; s < 8; ++s) {
            const float xs = xall[s * 1024 + hh * 64 + pp];
            const float term = (s <= nq) ? G[nq * 8 + s] * __expf(ct - cum[s]) * dtv[s] * xs : 0.f;
            y += term; xt = (s == nq) ? xs : xt;
        }
        y += D_h * xt;
        const float z = bf2f(U[(size_t)(rowb + nq) * N1P + UC_Z + h * 64 + pp]);
        y *= silu_f(z);
        { const unsigned pk = pack2(y, 0.f); MIX[(size_t)(rowb + nq) * MIXW + h * 64 + pp] = (bf16_t)(pk & 0xffffu); }
        float sq = y * y; sq += __shfl_xor(sq, 8); sq += __shfl_xor(sq, 16); sq += __shfl_xor(sq, 32);
        if (lane < 8) ssqp[(hh * 8 + wid) * 8 + lane] = sq;
        const float cl = cum[7], dec = __expf(cl);
        float xw[8];
#pragma unroll
        for (int s = 0; s < 8; ++s) xw[s] = __expf(cl - cum[s]) * dtv[s] * xall[s * 1024 + hh * 64 + pp];
#pragma unroll
        for (int i = 0; i < 4; ++i) {
            f32x4 acc = s0[i] * dec;
#pragma unroll
            for (int s = 0; s < 8; ++s) acc += xw[s] * *(const f32x4*)(Bc + s * 128 + nq * 4 + 32 * i);
            *(f32x4*)(p.out + O_S_SSD + soff + 32 * i) = acc;
        }
    }
    __syncthreads();
    if (tid < 128) {
        const int hh = tid >> 3, t = tid & 7; float tot = 0.f;
#pragma unroll
        for (int w = 0; w < 8; ++w) tot += ssqp[(hh * 8 + w) * 8 + t];
        ((float*)(p.ws + WS_SSQ))[(size_t)(rowb + t) * 32 + g * 16 + hh] = tot;
    }
    __syncthreads();
}

__device__ __forceinline__ void sample_ml(const Params& p, unsigned char* smem, int job) {
    const int tid = opaque_tid(), wid = __builtin_amdgcn_readfirstlane(tid >> 6), lane = tid & 63;
    const int b = job >> 3, h = job & 7, rowb = ROW_SAMPLE + b * 8;
    const bf16_t* U = (const bf16_t*)(p.ws + WS_U);
    const float* SF = (const float*)(p.ws + WS_SF);
    bf16_t* MIX = (bf16_t*)(p.ws + WS_MIX);
    float* qs = (float*)smem; float* ks = qs + 1024; float* vs = qs + 2048; float* QK = qs + 4096; float* sig = qs + 4160; float* slf = qs + 4168;
    float* qnv = qs + 4176; float* n0v = qs + 4192; float* red = qs + 4352;
    {
        const int t = tid >> 6, c = tid & 63;
        const size_t r = (size_t)(rowb + t) * N1P;
        const unsigned qq = *(const unsigned*)(U + r + UC_Q + h * 128 + 2 * c), kk = *(const unsigned*)(U + r + UC_K + h * 128 + 2 * c);
        const u32x2 vv = *(const u32x2*)(U + r + UC_V + h * 256 + 4 * c);
        qs[t * 128 + 2 * c] = bf_lo(qq); qs[t * 128 + 2 * c + 1] = bf_hi(qq);
        ks[t * 128 + 2 * c] = bf_lo(kk) * 0.08838834764831845f; ks[t * 128 + 2 * c + 1] = bf_hi(kk) * 0.08838834764831845f;
        *(f32x4*)(vs + t * 256 + 4 * c) = (f32x4){bf_lo(vv[0]), bf_hi(vv[0]), bf_lo(vv[1]), bf_hi(vv[1])};
        if (tid < 8) { sig[tid] = SF[(size_t)(rowb + tid) * 64 + 32 + h] + p.in[17][h]; slf[tid] = logsig_f(SF[(size_t)(rowb + tid) * 64 + 40 + h] + p.in[18][h]); }
        if (tid >= 128 && tid < 256) n0v[tid - 128] = p.in[5][(size_t)(b * 8 + h) * 128 + tid - 128];
    }
    const int v4 = lane, dg = wid;
    const size_t coff = ((size_t)(b * 8 + h) * 128 + dg * 16) * 256 + v4 * 4;
    f32x4 c0[16];
#pragma unroll
    for (int i = 0; i < 16; ++i) c0[i] = *(const f32x4*)(p.in[4] + coff + (size_t)i * 256);
    const float mp = p.in[6][b * 8 + h];
    __syncthreads();
    float F[8], gg[8], M[8];
    { float run = 0.f, pm = -INFINITY;
#pragma unroll
      for (int t = 0; t < 8; ++t) { run += slf[t]; F[t] = run; gg[t] = sig[t] - run; pm = fmaxf(pm, gg[t]); M[t] = fmaxf(pm, mp); } }
    const float Ml = M[7], dec = __expf(mp - Ml), m_new = F[7] + Ml;
    {
        const int pair = tid >> 3, part = tid & 7, t = pair >> 3, s = pair & 7;
        float sum = 0.f;
#pragma unroll
        for (int i = 0; i < 4; ++i) {
            const f32x4 a4 = *(const f32x4*)(qs + t * 128 + part * 16 + i * 4), b4 = *(const f32x4*)(ks + s * 128 + part * 16 + i * 4);
            sum += a4[0] * b4[0] + a4[1] * b4[1] + a4[2] * b4[2] + a4[3] * b4[3];
        }
        sum += __shfl_xor(sum, 1); sum += __shfl_xor(sum, 2); sum += __shfl_xor(sum, 4);
        if (part == 0) QK[pair] = sum;
        float qd = qs[wid * 128 + 2 * lane] * n0v[2 * lane] + qs[wid * 128 + 2 * lane + 1] * n0v[2 * lane + 1];
        qd = wave_sum(qd);
        if (lane == 0) qnv[wid] = qd;
    }
#pragma unroll
    for (int t = 0; t < 8; ++t) {
        f32x4 acc = {0.f, 0.f, 0.f, 0.f};
#pragma unroll
        for (int i4 = 0; i4 < 4; ++i4) {
            const f32x4 q4 = *(const f32x4*)(qs + t * 128 + dg * 16 + i4 * 4);
            acc += q4[0] * c0[i4 * 4] + q4[1] * c0[i4 * 4 + 1] + q4[2] * c0[i4 * 4 + 2] + q4[3] * c0[i4 * 4 + 3];
        }
        *(f32x4*)(red + (dg * 8 + t) * 256 + v4 * 4) = acc;
    }
    __syncthreads();
    f32x4 vv[8];
    float scs[8];
#pragma unroll
    for (int s = 0; s < 8; ++s) { vv[s] = *(const f32x4*)(vs + s * 256 + v4 * 4); scs[s] = __expf(gg[s] - Ml); }
#pragma unroll
    for (int i = 0; i < 16; ++i) {
        const int d = dg * 16 + i;
        f32x4 cn = c0[i] * dec;
#pragma unroll
        for (int s = 0; s < 8; ++s) cn += (scs[s] * ks[s * 128 + d]) * vv[s];
        *(f32x4*)(p.out + O_S_MLC + coff + (size_t)i * 256) = cn;
    }
    if (tid < 128) {
        float nn = dec * n0v[tid];
#pragma unroll
        for (int s = 0; s < 8; ++s) nn += scs[s] * ks[s * 128 + tid];
        p.out[O_S_MLN + (size_t)(b * 8 + h) * 128 + tid] = nn;
    }
    if (tid == 0) p.out[O_S_MLM + b * 8 + h] = m_new;
    {
        const int t = wid;
        float Mt = 0.f, Ft = 0.f;
#pragma unroll
        for (int q = 0; q < 8; ++q) { Mt = (t == q) ? M[q] : Mt; Ft = (t == q) ? F[q] : Ft; }
        f32x4 numc = {0.f, 0.f, 0.f, 0.f};
#pragma unroll
        for (int q = 0; q < 8; ++q) numc += *(const f32x4*)(red + (q * 8 + t) * 256 + lane * 4);
        const float et = __expf(mp - Mt);
        float den = et * qnv[t];
        f32x4 intra = {0.f, 0.f, 0.f, 0.f};
#pragma unroll
        for (int s = 0; s < 8; ++s) {
            if (s <= t) { const float w = __expf(gg[s] - Mt) * QK[t * 8 + s]; den += w; intra += w * vv[s]; }
        }
        const float dd = fmaxf(fabsf(den), __expf(-(Ft + Mt)));
        const f32x4 hv = (et * numc + intra) * (1.f / dd);
        float ss = hv[0] * hv[0] + hv[1] * hv[1] + hv[2] * hv[2] + hv[3] * hv[3];
        ss = wave_sum(ss);
        const u32x2 og = *(const u32x2*)(U + (size_t)(rowb + t) * N1P + UC_O + h * 256 + lane * 4);
        *(u32x2*)(MIX + (size_t)(rowb + t) * MIXW + 2048 + h * 256 + lane * 4) =
            (u32x2){pack2(hv[0] * sigm_f(bf_lo(og[0])), hv[1] * sigm_f(bf_hi(og[0]))), pack2(hv[2] * sigm_f(bf_lo(og[1])), hv[3] * sigm_f(bf_hi(og[1])))};
        if (lane < 4) ((float*)(p.ws + WS_SSQM))[(size_t)(rowb + t) * 32 + h * 4 + lane] = lane == 0 ? ss : 0.f;
        if (lane == 0) ((float*)(p.ws + WS_DD))[(size_t)(rowb + t) * 8 + h] = 1.f;
    }
    __syncthreads();
}

__device__ __forceinline__ void phase_scan(const Params& p, unsigned char* smem) {
#ifndef SC_MASK
#define SC_MASK 15
#endif
    for (int j = opaque_bid(); j < 256; j += gridDim.x) { if (j < 128) { if (SC_MASK & 1) prompt_scan<false>(p, smem, j); } else { if (SC_MASK & 2) prompt_scan<true>(p, smem, j - 128); } }
    if (SC_MASK & 4) for (int j = opaque_bid(); j < 256; j += gridDim.x) sample_ssd(p, smem, j);
    if (SC_MASK & 8) for (int j = opaque_bid(); j < 1024; j += gridDim.x) sample_ml(p, smem, j);
}

__device__ __forceinline__ void phase_mixnorm(const Params& p) {
    const int tid = opaque_tid(), wid = tid >> 6, lane = tid & 63;
    bf16_t* MIX = (bf16_t*)(p.ws + WS_MIX);
    const float* SSQ = (const float*)(p.ws + WS_SSQ); const float* SSQM = (const float*)(p.ws + WS_SSQM);
    const float* w1 = p.in[16]; const float* w2 = p.in[19];
    for (int row = opaque_bid() * 8 + wid; row < NVALID; row += gridDim.x * 8) {
        float s = lane < 32 ? SSQ[(size_t)row * 32 + lane] : 0.f;
        s = wave_sum(s);
        const float r1 = rsqrtf(s * (1.f / 2048.f) + EPS);
        float m = lane < 32 ? SSQM[(size_t)row * 32 + lane] : 0.f;
        m += __shfl_xor(m, 1); m += __shfl_xor(m, 2);
        const float ddh = lane < 32 ? ((const float*)(p.ws + WS_DD))[(size_t)row * 8 + (lane >> 2)] : 1.f;
        const float idd = 1.f / ddh;
        const float rh = rsqrtf(m * (1.f / 256.f) * idd * idd + EPS) * idd;
#pragma unroll
        for (int it = 0; it < 8; ++it) {
            const int col = it * 512 + lane * 8;
            const u32x4 raw = *(const u32x4*)(MIX + (size_t)row * MIXW + col);
            float scale; const float* wp;
            if (it < 4) { scale = r1; wp = w1 + col; }
            else { const int head = (it - 4) * 2 + (lane >> 5); scale = __shfl(rh, head * 4); wp = w2 + col - 2048; }
            const f32x4 wa = *(const f32x4*)wp, wb = *(const f32x4*)(wp + 4);
            u32x4 o;
            o[0] = pack2(bf_lo(raw[0]) * scale * wa[0], bf_hi(raw[0]) * scale * wa[1]); o[1] = pack2(bf_lo(raw[1]) * scale * wa[2], bf_hi(raw[1]) * scale * wa[3]);
            o[2] = pack2(bf_lo(raw[2]) * scale * wb[0], bf_hi(raw[2]) * scale * wb[1]); o[3] = pack2(bf_lo(raw[3]) * scale * wb[2], bf_hi(raw[3]) * scale * wb[3]);
            *(u32x4*)(MIX + (size_t)row * MIXW + col) = o;
        }
    }
    const bf16_t* U = (const bf16_t*)(p.ws + WS_U);
    for (int i = opaque_bid() * 512 + tid; i < 132 * 3 * 320; i += gridDim.x * 512) {
        const int cgp = i % 320, j = (i / 320) % 3, q = i / 960;
        int row; float* dst;
        if (q < 4) { row = q * 2048 + 2045 + j; dst = p.out + O_P_SSDCONV + (size_t)(q * 3 + j) * 2560 + cgp * 8; }
        else { row = ROW_SAMPLE + (q - 4) * 8 + 5 + j; dst = p.out + O_S_SSDCONV + (size_t)((q - 4) * 3 + j) * 2560 + cgp * 8; }
        const u32x4 raw = *(const u32x4*)(U + (size_t)row * N1P + UC_XBC + cgp * 8);
        *(f32x4*)dst = (f32x4){bf_lo(raw[0]), bf_hi(raw[0]), bf_lo(raw[1]), bf_hi(raw[1])};
        *(f32x4*)(dst + 4) = (f32x4){bf_lo(raw[2]), bf_hi(raw[2]), bf_lo(raw[3]), bf_hi(raw[3])};
    }
}

__device__ __forceinline__ void unpack8(const u32x4 raw, float (&x)[8]) {
#pragma unroll
    for (int i = 0; i < 4; ++i) { x[2 * i] = bf_lo(raw[i]); x[2 * i + 1] = bf_hi(raw[i]); }
}
__device__ __forceinline__ void phase_act(const Params& p) {
    const bf16_t* UP = (const bf16_t*)(p.ws + WS_UP); bf16_t* ACT = (bf16_t*)(p.ws + WS_ACT);
    const float* cw = p.in[23]; const float* cb = p.in[24]; const float* fst = p.in[7];
    constexpr int CGN = DFF / 8, TOTAL = (NVALID / 8) * CGN;
    const int tid = opaque_tid();
    for (int idx = opaque_bid() * 512 + tid; idx < TOTAL; idx += gridDim.x * 512) {
        const int rb = idx / CGN, cgp = idx % CGN, row0 = rb * 8, c0 = cgp * 8;
        float g2[8], g1[8], v2[8], v1[8];
        int prow = -1; bool from_state = false; int sb = 0, pb = -1;
        if (row0 < ROW_SAMPLE) { const int b = row0 >> 11, t0 = row0 & 2047; prow = t0 > 0 ? row0 - 2 : ROW_META + b * 16 + 14; if (t0 == 2040) pb = b; }
        else if (row0 < ROW_META) { from_state = true; sb = (row0 - ROW_SAMPLE) >> 3; }
        else { if ((row0 - ROW_META) & 15) prow = row0 - 2; }
        if (from_state) {
            const float* s0 = fst + (size_t)(sb * 2) * N3;
#pragma unroll
            for (int i = 0; i < 8; ++i) { g2[i] = s0[c0 + i]; g1[i] = s0[N3 + c0 + i]; v2[i] = s0[DFF + c0 + i]; v1[i] = s0[N3 + DFF + c0 + i]; }
        } else if (prow >= 0) {
            unpack8(*(const u32x4*)(UP + (size_t)prow * N3 + c0), g2); unpack8(*(const u32x4*)(UP + (size_t)(prow + 1) * N3 + c0), g1);
            unpack8(*(const u32x4*)(UP + (size_t)prow * N3 + DFF + c0), v2); unpack8(*(const u32x4*)(UP + (size_t)(prow + 1) * N3 + DFF + c0), v1);
        } else {
#pragma unroll
            for (int i = 0; i < 8; ++i) { g2[i] = 0.f; g1[i] = 0.f; v2[i] = 0.f; v1[i] = 0.f; }
        }
        float wg[3][8], wv[3][8], bg[8], bv[8];
#pragma unroll
        for (int j = 0; j < 3; ++j)
#pragma unroll
            for (int i = 0; i < 8; ++i) { wg[j][i] = cw[j * N3 + c0 + i]; wv[j][i] = cw[j * N3 + DFF + c0 + i]; }
#pragma unroll
        for (int i = 0; i < 8; ++i) { bg[i] = cb[c0 + i]; bv[i] = cb[DFF + c0 + i]; }
#pragma unroll
        for (int r = 0; r < 8; ++r) {
            float gx[8], vx[8];
            unpack8(*(const u32x4*)(UP + (size_t)(row0 + r) * N3 + c0), gx); unpack8(*(const u32x4*)(UP + (size_t)(row0 + r) * N3 + DFF + c0), vx);
            float o[8];
#pragma unroll
            for (int i = 0; i < 8; ++i) {
                const float yg = bg[i] + wg[0][i] * g2[i] + wg[1][i] * g1[i] + wg[2][i] * gx[i];
                const float yv = bv[i] + wv[0][i] * v2[i] + wv[1][i] * v1[i] + wv[2][i] * vx[i];
                o[i] = silu_f(yg) * yv;
                g2[i] = g1[i]; g1[i] = gx[i]; v2[i] = v1[i]; v1[i] = vx[i];
            }
            u32x4 ov; ov[0] = pack2(o[0], o[1]); ov[1] = pack2(o[2], o[3]); ov[2] = pack2(o[4], o[5]); ov[3] = pack2(o[6], o[7]);
            *(u32x4*)(ACT + (size_t)(row0 + r) * DFF + c0) = ov;
        }
        if (from_state || pb >= 0) {
            float* dst = from_state ? p.out + O_S_FFN + (size_t)(sb * 2) * N3 : p.out + O_P_FFN + (size_t)(pb * 2) * N3;
            *(f32x4*)(dst + c0) = (f32x4){g2[0], g2[1], g2[2], g2[3]}; *(f32x4*)(dst + c0 + 4) = (f32x4){g2[4], g2[5], g2[6], g2[7]};
            *(f32x4*)(dst + N3 + c0) = (f32x4){g1[0], g1[1], g1[2], g1[3]}; *(f32x4*)(dst + N3 + c0 + 4) = (f32x4){g1[4], g1[5], g1[6], g1[7]};
            *(f32x4*)(dst + DFF + c0) = (f32x4){v2[0], v2[1], v2[2], v2[3]}; *(f32x4*)(dst + DFF + c0 + 4) = (f32x4){v2[4], v2[5], v2[6], v2[7]};
            *(f32x4*)(dst + N3 + DFF + c0) = (f32x4){v1[0], v1[1], v1[2], v1[3]}; *(f32x4*)(dst + N3 + DFF + c0 + 4) = (f32x4){v1[4], v1[5], v1[6], v1[7]};
        }
    }
}

__device__ __forceinline__ void phase_final(const Params& p) {
    const int tid = opaque_tid(), wid = tid >> 6, lane = tid & 63;
    const float* SS3 = (const float*)(p.ws + WS_SS3); const float* nw = p.in[26];
    for (int row = opaque_bid() * 8 + wid; row < NOUTROWS; row += gridDim.x * 8) {
        const float r = rsqrtf(SS3[row] * (1.f / 2048.f) + EPS);
        float* rp = p.out + (size_t)row * DM;
#pragma unroll
        for (int it = 0; it < 8; ++it) {
            const int col = it * 256 + lane * 4;
            const f32x4 v = *(const f32x4*)(rp + col), w = *(const f32x4*)(nw + col);
            *(f32x4*)(rp + col) = v * r * w;
        }
    }
}

__global__ void __launch_bounds__(512, 2) hymba_fwd(Params p0) {
    extern __shared__ __attribute__((aligned(16))) unsigned char smem[];
    cg::grid_group grid = cg::this_grid();
#ifndef DUP_PHASE
#define DUP_PHASE -1
#endif
    for (int phx = p0.ph_lo; phx < p0.ph_hi + (DUP_PHASE >= 0 ? 1 : 0); ++phx) {
        const int ph = (DUP_PHASE >= 0 && phx > DUP_PHASE) ? phx - 1 : phx;
        Params p = p0;
        asm volatile("" : "+s"(p.ws), "+s"(p.out));
        switch (ph) {
        case 0: if (PH_MASK & 1) phase_prep(p, smem); break;
        case 1: if (PH_MASK & 2) { pg8::Gemm g{(const bf16_t*)(p.ws + WS_XN), (const bf16_t*)(p.ws + WS_WIN), MP, N1P, 2048}; pg8::StaticOrder S; S.init(MP, N1P, gridDim.x, opaque_bid());
                  Epi1 E{(bf16_t*)(p.ws + WS_U), (float*)(p.ws + WS_SF)}; pg8::gemm_phase((LAS unsigned char*)smem, g, S, E); } break;
        case 2: if (PH_MASK & 4) phase_scan(p, smem); break;
        case 3: if (PH_MASK & 8) phase_mixnorm(p); break;
        case 4: if (PH_MASK & 16) { pg8::Gemm g{(const bf16_t*)(p.ws + WS_MIX), (const bf16_t*)(p.ws + WS_WOUT), MP, 2048, 4096}; pg8::StaticOrder S; S.init(MP, 2048, gridDim.x, opaque_bid());
                  Epi2 E{p}; pg8::gemm_phase((LAS unsigned char*)smem, g, S, E); } break;
        case 5: if (PH_MASK & 32) { pg8::Gemm g{(const bf16_t*)(p.ws + WS_A2), (const bf16_t*)(p.ws + WS_WUP), MP, N3, 2048}; pg8::StaticOrder S; S.init(MP, N3, gridDim.x, opaque_bid());
                  Epi3 E{(bf16_t*)(p.ws + WS_UP), (const float*)(p.ws + WS_SS2)}; pg8::gemm_phase((LAS unsigned char*)smem, g, S, E); } break;
        case 6: if (PH_MASK & 64) phase_act(p); break;
        case 7: if (PH_MASK & 128) { pg8::Gemm g{(const bf16_t*)(p.ws + WS_ACT), (const bf16_t*)(p.ws + WS_WDOWN), MP, 2048, DFF}; pg8::StaticOrder S; S.init(MP, 2048, gridDim.x, opaque_bid());
                  Epi4 E{(const float*)(p.ws + WS_H1), p.out, (float*)(p.ws + WS_SS3)}; pg8::gemm_phase((LAS unsigned char*)smem, g, S, E); } break;
        default: if (PH_MASK & 256) phase_final(p); break;
        }
        if (phx + 1 < p0.ph_hi + (DUP_PHASE >= 0 ? 1 : 0)) grid.sync();
    }
}

extern "C" void kernel_launch(void* const* d_in, const int* in_sizes, int n_in, void* d_out, int out_size, void* d_ws, size_t ws_size, hipStream_t stream) {
    static int grid_blocks = 0;
    if (grid_blocks == 0) {
        if (n_in != 27 || (size_t)out_size != O_END || ws_size < WS_END) {
            fprintf(stderr, "kernel_launch: unexpected shapes: n_in %d out %d ws %zu (need %zu)\n", n_in, out_size, ws_size, (size_t)WS_END); grid_blocks = -1; return; }
        int dev = 0, cus = 0, per_cu = 0;
        (void)hipGetDevice(&dev);
        (void)hipDeviceGetAttribute(&cus, hipDeviceAttributeMultiprocessorCount, dev);
        (void)hipFuncSetAttribute((const void*)hymba_fwd, hipFuncAttributeMaxDynamicSharedMemorySize, LDS_BYTES);
        (void)hipOccupancyMaxActiveBlocksPerMultiprocessor(&per_cu, (const void*)hymba_fwd, 512, LDS_BYTES);
        if (per_cu < 1) { fprintf(stderr, "kernel_launch: occupancy query says %d blocks per CU\n", per_cu); per_cu = 1; }
        grid_blocks = cus;
    }
    if (grid_blocks < 0) return;
    Params p{};
    for (int i = 0; i < 27; ++i) p.in[i] = (const float*)d_in[i];
    p.out = (float*)d_out; p.ws = (unsigned char*)d_ws; p.ph_lo = 0; p.ph_hi = NPHASE;
    void* args[] = {&p};
    hipError_t e = hipLaunchCooperativeKernel((const void*)hymba_fwd, dim3(grid_blocks), dim3(512), args, LDS_BYTES, stream);
    if (e != hipSuccess) fprintf(stderr, "cooperative launch failed: %s (grid %d)\n", hipGetErrorString(e), grid_blocks);
}
```

```cpp
#include <hip/hip_runtime.h>
#include <hip/hip_cooperative_groups.h>
#include <cstdio>
namespace cg = cooperative_groups;

#define LAS __attribute__((address_space(3)))
typedef unsigned short bf16_t;
typedef short bf16x8 __attribute__((ext_vector_type(8)));
typedef float f32x4 __attribute__((ext_vector_type(4)));
typedef unsigned u32x4 __attribute__((ext_vector_type(4)));
typedef unsigned u32x2 __attribute__((ext_vector_type(2)));

constexpr int DM = 2048, MP = 9472, NVALID = 9280, NOUTROWS = 9216;
constexpr int N1P = 11008, N3 = 11264, DFF = 5632, MIXW = 4096;
constexpr int ROW_SAMPLE = 8192, ROW_META = 9216;
constexpr float EPS = 1e-6f;
constexpr int UC_Z = 0, UC_XBC = 2048, UC_Q = 4640, UC_K = 5664, UC_V = 6688, UC_O = 8752;
constexpr size_t WS_WIN = 0;
constexpr size_t WS_WOUT = WS_WIN + (size_t)N1P * 2048 * 2;
constexpr size_t WS_WUP = WS_WOUT + (size_t)2048 * 4096 * 2;
constexpr size_t WS_WDOWN = WS_WUP + (size_t)N3 * 2048 * 2;
constexpr size_t WS_XN = WS_WDOWN + (size_t)2048 * DFF * 2;
constexpr size_t WS_MIX = WS_XN + (size_t)MP * 2048 * 2;
constexpr size_t WS_ACT = WS_XN;
constexpr size_t WS_U = WS_MIX + (size_t)MP * MIXW * 2;
constexpr size_t WS_UP = WS_U;
constexpr size_t WS_H1 = WS_U + (size_t)MP * N3 * 2;
constexpr size_t WS_A2 = WS_H1 + (size_t)MP * 2048 * 4;
constexpr size_t WS_SF = WS_A2 + (size_t)MP * 2048 * 2;
constexpr size_t WS_SSQ = WS_SF + (size_t)MP * 64 * 4;
constexpr size_t WS_SSQM = WS_SSQ + (size_t)MP * 32 * 4;
constexpr size_t WS_SS2 = WS_SSQM + (size_t)MP * 32 * 4;
constexpr size_t WS_SS3 = WS_SS2 + (size_t)MP * 4;
constexpr size_t WS_DD = WS_SS3 + (size_t)MP * 4;
constexpr size_t WS_END = WS_DD + (size_t)MP * 8 * 4;
constexpr size_t O_Y = 0;
constexpr size_t O_P_SSDCONV = 18874368, O_P_SSD = 18905088, O_P_MLC = 19953664, O_P_MLN = 21002240, O_P_MLM = 21006336, O_P_FFN = 21006368;
constexpr size_t O_S_SSDCONV = 21096480, O_S_SSD = 22079520, O_S_MLC = 55633952, O_S_MLN = 89188384, O_S_MLM = 89319456, O_S_FFN = 89320480;
constexpr size_t O_END = 92204064;
constexpr int LDS_BYTES = 147456;
constexpr int NPHASE = 9;
#ifndef CHL_SSD
#define CHL_SSD 128
#endif
#ifndef CHL_ML
#define CHL_ML 128
#endif
#ifndef PH_MASK
#define PH_MASK 0x1ff
#endif

struct Params {
    const float* in[27];
    float* out;
    unsigned char* ws;
    int ph_lo, ph_hi;
};

__device__ __forceinline__ unsigned pack2(float lo, float hi) { unsigned r; asm("v_cvt_pk_bf16_f32 %0, %1, %2" : "=v"(r) : "v"(lo), "v"(hi)); return r; }
__device__ __forceinline__ float bf_lo(unsigned u) { return __uint_as_float(u << 16); }
__device__ __forceinline__ float bf_hi(unsigned u) { return __uint_as_float(u & 0xffff0000u); }
__device__ __forceinline__ float bf2f(bf16_t h) { return __uint_as_float((unsigned)h << 16); }
__device__ __forceinline__ float silu_f(float x) { return x / (1.f + __expf(-x)); }
__device__ __forceinline__ float sigm_f(float x) { return 1.f / (1.f + __expf(-x)); }
__device__ __forceinline__ float softplus_f(float x) { return x > 20.f ? x : log1pf(__expf(x)); }
__device__ __forceinline__ float logsig_f(float x) { return fminf(x, 0.f) - log1pf(__expf(-fabsf(x))); }
__device__ __forceinline__ int opaque_tid() { int t = threadIdx.x; asm volatile("" : "+v"(t)); return t; }
__device__ __forceinline__ int opaque_bid() { int t = blockIdx.x; asm volatile("" : "+s"(t)); return t; }
__device__ __forceinline__ int row_of(int b, int pos) { return pos < 16 ? ROW_META + b * 16 + pos : b * 2048 + pos - 16; }
__device__ __forceinline__ float wave_sum(float v) {
    v += __shfl_xor(v, 32); v += __shfl_xor(v, 16); v += __shfl_xor(v, 8); v += __shfl_xor(v, 4); v += __shfl_xor(v, 2); v += __shfl_xor(v, 1); return v;
}
__device__ __forceinline__ const float* resid_row(const Params& p, int row) {
    if (row < ROW_SAMPLE) return p.in[0] + (size_t)row * DM;
    if (row < ROW_META) return p.in[1] + (size_t)(row - ROW_SAMPLE) * DM;
    if (row < NVALID) return p.in[8] + (size_t)((row - ROW_META) & 15) * DM;
    return nullptr;
}

namespace pg8 {
constexpr int BM = 256, BK = 64, HALF = 128, HTB = HALF * BK * 2, STAGE_BYTES = 8 * HTB, NXCD = 8, WGM = 8;
__device__ __forceinline__ int lds_byte(int r, int c) { const int st = (r >> 4) * 2 + (c >> 5), rr = r & 15, cc = c & 31, ob = rr * 64 + cc * 2; return st * 1024 + (ob ^ (((ob >> 9) & 1) << 5)); }
__device__ __forceinline__ void stage_rc(int b, int& R, int& C) { const int st = b / 1024, sb = b % 1024, swz = sb ^ (((sb >> 9) & 1) << 5); R = (st >> 1) * 16 + swz / 64; C = (st & 1) * 32 + (swz % 64) / 2; }
__device__ __forceinline__ int perm32(int rho) { const int n = rho >> 4, i = rho & 15; return 8 * (i >> 2) + 4 * n + (i & 3); }
struct Unit { int pm, pn; };
struct Gemm { const bf16_t* A; const bf16_t* Bt; int M, N, K; };
struct StaticOrder {
    int nM, nN, nwg, G, c;
    __device__ void init(int M, int N, int G_, int c_) { nM = M / BM; nN = N / BM; nwg = nM * nN; G = G_; c = c_; }
    __device__ bool next(int i, Unit& u) const {
        const long L = (long)i * G + c; if (L >= nwg) return false;
        int wgid = (int)L; { const int q = nwg / NXCD, r = nwg % NXCD, xcd = wgid % NXCD, off = wgid / NXCD; wgid = (xcd < r ? xcd * (q + 1) : r * (q + 1) + (xcd - r) * q) + off; }
        const int nig = WGM * nN, gid = wgid / nig, fm = gid * WGM, gsz = (nM - fm) < WGM ? (nM - fm) : WGM;
        u.pm = fm + ((wgid % nig) % gsz); u.pn = (wgid % nig) / gsz; return true;
    }
};

template <class Epi>
__device__ __forceinline__ void gemm_phase(LAS unsigned char* lds, const Gemm g, const StaticOrder& S, const Epi& E) {
    const int tid = opaque_tid(), wid = __builtin_amdgcn_readfirstlane(tid >> 6), lane = tid & 63, wr = wid >> 2, wc = wid & 3, fr = lane & 15, fq = lane >> 4;
    const int K = g.K, nt = K / BK;
    unsigned voffA[2], voffB[2];
#pragma unroll
    for (int i = 0; i < 2; ++i) { int R, C; stage_rc(tid * 16 + i * 8192, R, C); const int Rb = ((R & ~31) + perm32(R & 31));
        voffA[i] = (unsigned)(R * K + C) * 2u; voffB[i] = (unsigned)(Rb * K + C) * 2u; }
    const size_t kstep = (size_t)(BK * 2);
    const size_t hstep = (size_t)HALF * K * 2;
    const size_t tstep = 2 * hstep;
    const unsigned ldsw = (unsigned)wid * 1024u;
    const int aoff = lds_byte(wr * 64 + fr, fq * 8), boff = lds_byte(wc * 32 + fr, fq * 8);
#define PG8_SA(b, h) (((b) * 2 + (h)) * HTB)
#define PG8_SB(b, h) ((4 + (b) * 2 + (h)) * HTB)
#define PG8_STAGE(bufoff, gbase, voff) do { _Pragma("unroll") for (int _i = 0; _i < 2; ++_i) \
        __builtin_amdgcn_global_load_lds((const unsigned*)((const char*)(gbase) + (voff)[_i]), (LAS unsigned*)(lds + (bufoff) + ldsw + _i * 8192), 16, 0, 0); } while (0)
#define PG8_LDA(dst, b, h) do { _Pragma("unroll") for (int m = 0; m < 4; ++m) _Pragma("unroll") for (int k = 0; k < 2; ++k) dst[m][k] = *(const LAS bf16x8*)(lds + PG8_SA(b, h) + aoff + m * 2048 + k * 1024); } while (0)
#define PG8_LDB(dst, b, h) do { _Pragma("unroll") for (int n = 0; n < 2; ++n) _Pragma("unroll") for (int k = 0; k < 2; ++k) dst[n][k] = *(const LAS bf16x8*)(lds + PG8_SB(b, h) + boff + n * 2048 + k * 1024); } while (0)
#define PG8_MMA(ai, bj, At, Bt) do { __builtin_amdgcn_s_setprio(1); _Pragma("unroll") for (int m = 0; m < 4; ++m) _Pragma("unroll") for (int n = 0; n < 2; ++n) _Pragma("unroll") for (int k = 0; k < 2; ++k) \
        acc[ai][bj][m][n] = __builtin_amdgcn_mfma_f32_16x16x32_bf16(Bt[n][k], At[m][k], acc[ai][bj][m][n], 0, 0, 0); __builtin_amdgcn_s_setprio(0); } while (0)
#define PG8_WAIT_V(n) asm volatile("s_waitcnt vmcnt(" #n ")" ::: "memory")
#define PG8_WAIT_L(n) asm volatile("s_waitcnt lgkmcnt(" #n ")" ::: "memory")
#define PG8_BAR __builtin_amdgcn_s_barrier()
#define PG8_SCHED __builtin_amdgcn_sched_barrier(0)
    Unit cur, nxt; int ui = 0;
    if (!S.next(0, cur)) return;
    f32x4 acc[2][2][4][2];
#pragma unroll
    for (int a = 0; a < 2; ++a)
#pragma unroll
        for (int b = 0; b < 2; ++b)
#pragma unroll
            for (int m = 0; m < 4; ++m)
#pragma unroll
                for (int n = 0; n < 2; ++n) acc[a][b][m][n] = (f32x4){0.f, 0.f, 0.f, 0.f};
    bf16x8 At[4][2], B0[2][2], B1[2][2];
    const char* cA = (const char*)g.A + (size_t)cur.pm * tstep; const char* cB = (const char*)g.Bt + (size_t)cur.pn * tstep;
    PG8_STAGE(PG8_SB(0, 0), cB, voffB); PG8_STAGE(PG8_SA(0, 0), cA, voffA); PG8_STAGE(PG8_SB(0, 1), cB + hstep, voffB); PG8_STAGE(PG8_SA(0, 1), cA + hstep, voffA);
    if (wr == 1) PG8_BAR;
    PG8_WAIT_V(4); PG8_BAR;
    PG8_STAGE(PG8_SB(1, 0), cB + kstep, voffB); PG8_STAGE(PG8_SA(1, 0), cA + kstep, voffA); PG8_STAGE(PG8_SB(1, 1), cB + hstep + kstep, voffB);
    PG8_WAIT_V(6); PG8_BAR;
    for (;;) {
        const bool has_next = S.next(ui + 1, nxt);
        const char* nA = has_next ? (const char*)g.A + (size_t)nxt.pm * tstep : cA; const char* nB = has_next ? (const char*)g.Bt + (size_t)nxt.pn * tstep : cB;
        for (int t = 0; t < nt; t += 2) {
            const bool last = (t == nt - 2);
            const char* a1 = cA + (size_t)(t + 1) * kstep;
            const char* a2 = last ? nA : cA + (size_t)(t + 2) * kstep; const char* b2 = last ? nB : cB + (size_t)(t + 2) * kstep;
            const char* a3 = a2 + kstep; const char* b3 = b2 + kstep;
            PG8_LDB(B0, 0, 0); PG8_SCHED; PG8_LDA(At, 0, 0); PG8_STAGE(PG8_SA(1, 1), a1 + hstep, voffA);
            PG8_WAIT_L(8); PG8_BAR; PG8_WAIT_L(0); PG8_MMA(0, 0, At, B0); PG8_BAR; PG8_SCHED;
            PG8_LDB(B1, 0, 1); PG8_STAGE(PG8_SB(0, 0), b2, voffB);
            PG8_BAR; PG8_WAIT_L(0); PG8_MMA(0, 1, At, B1); PG8_BAR;
            PG8_LDA(At, 0, 1); PG8_STAGE(PG8_SA(0, 0), a2, voffA);
            PG8_BAR; PG8_WAIT_L(0); PG8_MMA(1, 0, At, B0); PG8_BAR; PG8_SCHED;
            PG8_STAGE(PG8_SB(0, 1), b2 + hstep, voffB);
            PG8_WAIT_V(6); PG8_BAR; PG8_MMA(1, 1, At, B1); PG8_BAR;
            PG8_LDB(B0, 1, 0); PG8_SCHED; PG8_LDA(At, 1, 0); PG8_STAGE(PG8_SA(0, 1), a2 + hstep, voffA);
            PG8_WAIT_L(8); PG8_BAR; PG8_WAIT_L(0); PG8_MMA(0, 0, At, B0); PG8_BAR; PG8_SCHED;
            PG8_LDB(B1, 1, 1); PG8_STAGE(PG8_SB(1, 0), b3, voffB);
            PG8_BAR; PG8_WAIT_L(0); PG8_MMA(0, 1, At, B1); PG8_BAR;
            PG8_LDA(At, 1, 1); PG8_STAGE(PG8_SA(1, 0), a3, voffA);
            PG8_BAR; PG8_WAIT_L(0); PG8_MMA(1, 0, At, B0); PG8_BAR; PG8_SCHED;
            PG8_STAGE(PG8_SB(1, 1), b3 + hstep, voffB);
            PG8_WAIT_V(6); PG8_BAR; PG8_MMA(1, 1, At, B1); PG8_BAR;
        }
        { Unit eu = cur; asm volatile("" : "+s"(eu.pm), "+s"(eu.pn)); E(acc, eu, wr, wc, fr, fq); }
        if (!has_next) break;
#pragma unroll
        for (int a = 0; a < 2; ++a)
#pragma unroll
            for (int b = 0; b < 2; ++b)
#pragma unroll
                for (int m = 0; m < 4; ++m)
#pragma unroll
                    for (int n = 0; n < 2; ++n) acc[a][b][m][n] = (f32x4){0.f, 0.f, 0.f, 0.f};
        cur = nxt; cA = nA; cB = nB; ++ui;
    }
    PG8_WAIT_V(0);
    if (wr == 0) PG8_BAR;
    PG8_BAR;
#undef PG8_SA
#undef PG8_SB
#undef PG8_STAGE
#undef PG8_LDA
#undef PG8_LDB
#undef PG8_MMA
#undef PG8_WAIT_V
#undef PG8_WAIT_L
#undef PG8_BAR
#undef PG8_SCHED
}
}

typedef f32x4 AccT[2][2][4][2];
struct Epi1 {
    bf16_t* U; float* sf;
    __device__ __forceinline__ void operator()(const AccT& acc, const pg8::Unit& u, int wr, int wc, int fr, int fq) const {
        const int row0 = u.pm * 256 + wr * 64 + fr, col0 = u.pn * 256 + wc * 32 + 8 * fq;
        const bool side_dt = (u.pn == 18 && wc == 0), side_if = (u.pn == 34 && wc == 1);
#pragma unroll
        for (int ai = 0; ai < 2; ++ai)
#pragma unroll
            for (int m = 0; m < 4; ++m) {
                const int row = row0 + ai * 128 + m * 16;
                bf16_t* rowp = U + (size_t)row * N1P + col0;
#pragma unroll
                for (int bj = 0; bj < 2; ++bj) {
                    const f32x4 v0 = acc[ai][bj][m][0], v1 = acc[ai][bj][m][1];
                    u32x4 o; o[0] = pack2(v0[0], v0[1]); o[1] = pack2(v0[2], v0[3]); o[2] = pack2(v1[0], v1[1]); o[3] = pack2(v1[2], v1[3]);
                    *(u32x4*)(rowp + bj * 128) = o;
                }
                if (side_dt || side_if) {
                    float* sp = sf + (size_t)row * 64 + (side_if ? 32 : 0) + 8 * fq;
                    *(f32x4*)sp = acc[ai][0][m][0]; *(f32x4*)(sp + 4) = acc[ai][0][m][1];
                }
            }
    }
};
struct Epi2 {
    Params p;
    __device__ __forceinline__ void operator()(const AccT& acc, const pg8::Unit& u, int wr, int wc, int fr, int fq) const {
        float* H1 = (float*)(p.ws + WS_H1); bf16_t* A2 = (bf16_t*)(p.ws + WS_A2); float* SS2 = (float*)(p.ws + WS_SS2);
        const float* nw = p.in[21];
        const int row0 = u.pm * 256 + wr * 64 + fr, col0 = u.pn * 256 + wc * 32 + 8 * fq;
        f32x4 w[2][2];
#pragma unroll
        for (int bj = 0; bj < 2; ++bj) { w[bj][0] = *(const f32x4*)(nw + col0 + bj * 128); w[bj][1] = *(const f32x4*)(nw + col0 + bj * 128 + 4); }
#pragma unroll
        for (int ai = 0; ai < 2; ++ai)
#pragma unroll
            for (int m = 0; m < 4; ++m) {
                const int row = row0 + ai * 128 + m * 16;
                const float* rp = resid_row(p, row);
                float ss = 0.f;
#pragma unroll
                for (int bj = 0; bj < 2; ++bj) {
                    f32x4 v0 = acc[ai][bj][m][0], v1 = acc[ai][bj][m][1];
                    if (rp) { v0 += *(const f32x4*)(rp + col0 + bj * 128); v1 += *(const f32x4*)(rp + col0 + bj * 128 + 4); }
                    *(f32x4*)(H1 + (size_t)row * DM + col0 + bj * 128) = v0; *(f32x4*)(H1 + (size_t)row * DM + col0 + bj * 128 + 4) = v1;
                    ss += v0[0] * v0[0] + v0[1] * v0[1] + v0[2] * v0[2] + v0[3] * v0[3] + v1[0] * v1[0] + v1[1] * v1[1] + v1[2] * v1[2] + v1[3] * v1[3];
                    const f32x4 a0 = v0 * w[bj][0], a1 = v1 * w[bj][1];
                    u32x4 o; o[0] = pack2(a0[0], a0[1]); o[1] = pack2(a0[2], a0[3]); o[2] = pack2(a1[0], a1[1]); o[3] = pack2(a1[2], a1[3]);
                    *(u32x4*)(A2 + (size_t)row * DM + col0 + bj * 128) = o;
                }
                ss += __shfl_xor(ss, 16); ss += __shfl_xor(ss, 32);
                if (fq == 0) atomicAdd(SS2 + row, ss);
            }
    }
};
struct Epi3 {
    bf16_t* UP; const float* SS2;
    __device__ __forceinline__ void operator()(const AccT& acc, const pg8::Unit& u, int wr, int wc, int fr, int fq) const {
        const int row0 = u.pm * 256 + wr * 64 + fr, col0 = u.pn * 256 + wc * 32 + 8 * fq;
#pragma unroll
        for (int ai = 0; ai < 2; ++ai)
#pragma unroll
            for (int m = 0; m < 4; ++m) {
                const int row = row0 + ai * 128 + m * 16;
                const float r2 = rsqrtf(SS2[row] * (1.f / 2048.f) + EPS);
                bf16_t* rowp = UP + (size_t)row * N3 + col0;
#pragma unroll
                for (int bj = 0; bj < 2; ++bj) {
                    const f32x4 v0 = acc[ai][bj][m][0] * r2, v1 = acc[ai][bj][m][1] * r2;
                    u32x4 o; o[0] = pack2(v0[0], v0[1]); o[1] = pack2(v0[2], v0[3]); o[2] = pack2(v1[0], v1[1]); o[3] = pack2(v1[2], v1[3]);
                    *(u32x4*)(rowp + bj * 128) = o;
                }
            }
    }
};
struct Epi4 {
    const float* H1; float* out; float* SS3;
    __device__ __forceinline__ void operator()(const AccT& acc, const pg8::Unit& u, int wr, int wc, int fr, int fq) const {
        const int row0 = u.pm * 256 + wr * 64 + fr, col0 = u.pn * 256 + wc * 32 + 8 * fq;
#pragma unroll
        for (int ai = 0; ai < 2; ++ai)
#pragma unroll
            for (int m = 0; m < 4; ++m) {
                const int row = row0 + ai * 128 + m * 16;
                if (row < NOUTROWS) {
                    float ss = 0.f;
#pragma unroll
                    for (int bj = 0; bj < 2; ++bj) {
                        const f32x4 v0 = acc[ai][bj][m][0] + *(const f32x4*)(H1 + (size_t)row * DM + col0 + bj * 128);
                        const f32x4 v1 = acc[ai][bj][m][1] + *(const f32x4*)(H1 + (size_t)row * DM + col0 + bj * 128 + 4);
                        *(f32x4*)(out + (size_t)row * DM + col0 + bj * 128) = v0; *(f32x4*)(out + (size_t)row * DM + col0 + bj * 128 + 4) = v1;
                        ss += v0[0] * v0[0] + v0[1] * v0[1] + v0[2] * v0[2] + v0[3] * v0[3] + v1[0] * v1[0] + v1[1] * v1[1] + v1[2] * v1[2] + v1[3] * v1[3];
                    }
                    ss += __shfl_xor(ss, 16); ss += __shfl_xor(ss, 32);
                    if (fq == 0) atomicAdd(SS3 + row, ss);
                }
            }
    }
};

struct TileRef { const float* W; bf16_t* WT; int K, N, kt, nt; };
__device__ __forceinline__ TileRef tile_ref(const Params& p, int t) {
    constexpr int T_IN = 32 * 43, T_OUT = 64 * 8, T_UP = 32 * 44;
    TileRef r;
    if (t < T_IN) { r.W = p.in[10]; r.WT = (bf16_t*)(p.ws + WS_WIN); r.K = 2048; r.N = 10800; r.kt = t % 32; r.nt = t / 32; }
    else if (t < T_IN + T_OUT) { const int q = t - T_IN; r.W = p.in[20]; r.WT = (bf16_t*)(p.ws + WS_WOUT); r.K = 4096; r.N = 2048; r.kt = q % 64; r.nt = q / 64; }
    else if (t < T_IN + T_OUT + T_UP) { const int q = t - T_IN - T_OUT; r.W = p.in[22]; r.WT = (bf16_t*)(p.ws + WS_WUP); r.K = 2048; r.N = N3; r.kt = q % 32; r.nt = q / 32; }
    else { const int q = t - T_IN - T_OUT - T_UP; r.W = p.in[25]; r.WT = (bf16_t*)(p.ws + WS_WDOWN); r.K = DFF; r.N = 2048; r.kt = q % 88; r.nt = q / 88; }
    return r;
}
__device__ __forceinline__ void tile_load(const TileRef& r, f32x4 (&v)[8], int tid) {
    const int nc = (tid & 63) * 4, n = r.nt * 256 + nc;
#pragma unroll
    for (int i = 0; i < 8; ++i) {
        const int kr = (tid >> 6) + 8 * i;
        v[i] = (f32x4){0.f, 0.f, 0.f, 0.f};
        if (n < r.N) v[i] = *(const f32x4*)(r.W + (size_t)(r.kt * 64 + kr) * r.N + n);
    }
}
__device__ __forceinline__ void tile_lds_write(const f32x4 (&v)[8], int tid, unsigned char* smem) {
    float* tile = (float*)smem;
    const int nc = (tid & 63) * 4;
#pragma unroll
    for (int i = 0; i < 8; ++i) {
        const int kr = (tid >> 6) + 8 * i;
        tile[kr * 257 + nc] = v[i][0]; tile[kr * 257 + nc + 1] = v[i][1]; tile[kr * 257 + nc + 2] = v[i][2]; tile[kr * 257 + nc + 3] = v[i][3];
    }
}
__device__ __forceinline__ void tile_store(const TileRef& r, int tid, unsigned char* smem) {
    const float* tile = (const float*)smem;
    const int kc = (tid & 7) * 8;
#pragma unroll
    for (int q = 0; q < 4; ++q) {
        const int nr = (tid >> 3) + 64 * q;
        u32x4 o;
        o[0] = pack2(tile[(kc + 0) * 257 + nr], tile[(kc + 1) * 257 + nr]); o[1] = pack2(tile[(kc + 2) * 257 + nr], tile[(kc + 3) * 257 + nr]);
        o[2] = pack2(tile[(kc + 4) * 257 + nr], tile[(kc + 5) * 257 + nr]); o[3] = pack2(tile[(kc + 6) * 257 + nr], tile[(kc + 7) * 257 + nr]);
        *(u32x4*)(r.WT + (size_t)(r.nt * 256 + nr) * r.K + r.kt * 64 + kc) = o;
    }
}
__device__ __forceinline__ void phase_prep(const Params& p, unsigned char* smem) {
    const int tid = opaque_tid(), wid = tid >> 6, lane = tid & 63;
    { float* SS2 = (float*)(p.ws + WS_SS2); for (int i = opaque_bid() * 512 + tid; i < 2 * MP; i += gridDim.x * 512) SS2[i] = 0.f; }
    {
        bf16_t* XN = (bf16_t*)(p.ws + WS_XN); const float* nw = p.in[9];
        for (int row = opaque_bid() * 8 + wid; row < MP; row += gridDim.x * 8) {
            const float* src = resid_row(p, row);
            f32x4 v[8];
            float ss = 0.f;
#pragma unroll
            for (int it = 0; it < 4; ++it) {
                const int col = it * 512 + lane * 8;
                if (src) { v[2 * it] = *(const f32x4*)(src + col); v[2 * it + 1] = *(const f32x4*)(src + col + 4); }
                else { v[2 * it] = (f32x4){0.f, 0.f, 0.f, 0.f}; v[2 * it + 1] = (f32x4){0.f, 0.f, 0.f, 0.f}; }
#pragma unroll
                for (int j = 0; j < 4; ++j) ss += v[2 * it][j] * v[2 * it][j] + v[2 * it + 1][j] * v[2 * it + 1][j];
            }
            ss = wave_sum(ss);
            const float r = rsqrtf(ss * (1.f / 2048.f) + EPS);
#pragma unroll
            for (int it = 0; it < 4; ++it) {
                const int col = it * 512 + lane * 8;
                const f32x4 w0 = *(const f32x4*)(nw + col), w1 = *(const f32x4*)(nw + col + 4);
                const f32x4 a = v[2 * it] * r * w0, c = v[2 * it + 1] * r * w1;
                u32x4 o; o[0] = pack2(a[0], a[1]); o[1] = pack2(a[2], a[3]); o[2] = pack2(c[0], c[1]); o[3] = pack2(c[2], c[3]);
                *(u32x4*)(XN + (size_t)row * DM + col) = o;
            }
        }
    }
    constexpr int T_ALL = 32 * 43 + 64 * 8 + 32 * 44 + 88 * 8;
    {
        int t = opaque_bid();
        f32x4 v[8];
        TileRef cur{};
        if (t < T_ALL) { cur = tile_ref(p, t); tile_load(cur, v, tid); }
        while (t < T_ALL) {
            tile_lds_write(v, tid, smem);
            __syncthreads();
            const int tn = t + gridDim.x;
            TileRef nxt{};
            if (tn < T_ALL) { nxt = tile_ref(p, tn); tile_load(nxt, v, tid); }
            tile_store(cur, tid, smem);
            __syncthreads();
            cur = nxt; t = tn;
        }
    }
}

constexpr int RS = 272;
constexpr int L_QS = 0, L_KS = 34816, L_KT = 69632, L_VT = 104448, L_ST = 121856, L_SC = 139264;

template <bool ML>
__device__ __forceinline__ void load_block(const Params& p, float (&val)[8][4], int b, int p0, int Lv, int rb, int cg, int colbase, int chbase, float mlscale) {
    const bf16_t* U = (const bf16_t*)(p.ws + WS_U);
    const int t0 = rb * 8;
    if (t0 >= Lv) {
#pragma unroll
        for (int r = 0; r < 8; ++r)
#pragma unroll
            for (int i = 0; i < 4; ++i) val[r][i] = 0.f;
        return;
    }
    if (ML) {
#pragma unroll
        for (int r = 0; r < 8; ++r) {
            const int row = row_of(b, p0 + t0 + r);
            const u32x2 raw = *(const u32x2*)(U + (size_t)row * N1P + colbase + cg * 4);
            val[r][0] = bf_lo(raw[0]) * mlscale; val[r][1] = bf_hi(raw[0]) * mlscale; val[r][2] = bf_lo(raw[1]) * mlscale; val[r][3] = bf_hi(raw[1]) * mlscale;
        }
    } else {
        u32x2 raw[11];
#pragma unroll
        for (int rr = 0; rr < 11; ++rr) {
            const int pos = p0 + t0 - 3 + rr;
            if (pos >= 0) raw[rr] = *(const u32x2*)(U + (size_t)row_of(b, pos) * N1P + colbase + cg * 4);
            else raw[rr] = (u32x2){0u, 0u};
        }
        const float* cw = p.in[11]; const float* cb = p.in[12];
        const int ch = chbase + cg * 4;
        f32x4 w[4];
#pragma unroll
        for (int j = 0; j < 4; ++j) w[j] = *(const f32x4*)(cw + j * 2560 + ch);
        const f32x4 bi = *(const f32x4*)(cb + ch);
#pragma unroll
        for (int i = 0; i < 4; ++i) {
            float x[11];
#pragma unroll
            for (int rr = 0; rr < 11; ++rr) x[rr] = (i & 1) ? bf_hi(raw[rr][i >> 1]) : bf_lo(raw[rr][i >> 1]);
#pragma unroll
            for (int r = 0; r < 8; ++r) val[r][i] = silu_f(bi[i] + w[0][i] * x[r] + w[1][i] * x[r + 1] + w[2][i] * x[r + 2] + w[3][i] * x[r + 3]);
        }
    }
}
__device__ __forceinline__ void store_rows(unsigned char* base, const float (&val)[8][4], int rb, int cg) {
#pragma unroll
    for (int r = 0; r < 8; ++r) *(u32x2*)(base + (rb * 8 + r) * RS + cg * 8) = (u32x2){pack2(val[r][0], val[r][1]), pack2(val[r][2], val[r][3])};
}
__device__ __forceinline__ void store_cols(unsigned char* base, const float (&val)[8][4], int rb, int cg, const float* scale) {
    float s[8];
#pragma unroll
    for (int r = 0; r < 8; ++r) s[r] = scale ? scale[rb * 8 + r] : 1.f;
#pragma unroll
    for (int i = 0; i < 4; ++i) {
        const int row = cg * 4 + i;
        u32x4 o; o[0] = pack2(val[0][i] * s[0], val[1][i] * s[1]); o[1] = pack2(val[2][i] * s[2], val[3][i] * s[3]);
        o[2] = pack2(val[4][i] * s[4], val[5][i] * s[5]); o[3] = pack2(val[6][i] * s[6], val[7][i] * s[7]);
        *(u32x4*)(base + row * RS + ((rb ^ ((row >> 3) & 7)) << 4)) = o;
    }
}

template <bool ML>
__device__ __forceinline__ void prompt_scan(const Params& p, unsigned char* smem, int job) {
    const int tid = opaque_tid(), wid = __builtin_amdgcn_readfirstlane(tid >> 6), lane = tid & 63, fr = lane & 15, fq = lane >> 4;
    int b, h, vq = 0;
    if (ML) { b = job >> 5; h = (job >> 2) & 7; vq = job & 3; } else { b = job >> 5; h = job & 31; }
    const int g = h >> 4;
    const bf16_t* U = (const bf16_t*)(p.ws + WS_U);
    const float* SF = (const float*)(p.ws + WS_SF);
    bf16_t* MIX = (bf16_t*)(p.ws + WS_MIX);
    float* scb = (float*)(smem + L_SC);
    float *qn = scb + 1600, *nvec = scb + 1728, *mpp = scb + 1856;
    const int qcol = ML ? UC_Q + h * 128 : UC_XBC + 2304 + g * 128;
    const int kcol = ML ? UC_K + h * 128 : UC_XBC + 2048 + g * 128;
    const int vcol = ML ? UC_V + h * 256 + vq * 64 : UC_XBC + h * 64;
    const int gcol = ML ? UC_O + h * 256 + vq * 64 : UC_Z + h * 64;
    const int mixcol = ML ? 2048 + h * 256 + vq * 64 : h * 64;
    float A_h = 0.f, D_h = 0.f, dtb = 0.f, ib = 0.f, fb = 0.f;
    if (ML) { ib = p.in[17][h]; fb = p.in[18][h]; } else { A_h = -__expf(p.in[14][h]); D_h = p.in[15][h]; dtb = p.in[13][h]; }
    f32x4 st[4];
#pragma unroll
    for (int i = 0; i < 4; ++i) st[i] = (f32x4){0.f, 0.f, 0.f, 0.f};
    for (int i = tid; i < 64 * RS / 16; i += 512) *(u32x4*)(smem + L_ST + i * 16) = (u32x4){0u, 0u, 0u, 0u};
    if (tid < 128) nvec[tid] = 0.f;
    if (tid == 0) mpp[0] = 0.f;
    constexpr int CHLs = ML ? CHL_ML : CHL_SSD;
    auto scalars = [&](int cc) {
        const int p0 = cc == 0 ? 0 : 16 + (cc - 1) * CHLs, Lv = cc == 0 ? 16 : CHLs;
        float* sc = scb + (cc & 1) * 800;
        float *rowv = sc, *colv = sc + 128, *colm = sc + 256, *ev = sc + 384, *scv = sc + 512, *dden = sc + 640, *misc = sc + 768;
        const int t0 = 2 * lane, t1 = t0 + 1;
        if (!ML) {
            float d0 = 0.f, d1 = 0.f;
            if (t0 < Lv) d0 = softplus_f(SF[(size_t)row_of(b, p0 + t0) * 64 + h] + dtb);
            if (t1 < Lv) d1 = softplus_f(SF[(size_t)row_of(b, p0 + t1) * 64 + h] + dtb);
            const float a0 = d0 * A_h, a1 = d1 * A_h;
            float inc = a0 + a1;
#pragma unroll
            for (int o = 1; o < 64; o <<= 1) { const float y = __shfl_up(inc, o); if (lane >= o) inc += y; }
            const float c1 = inc, c0 = inc - a1, cl = __shfl(inc, 63);
            rowv[t0] = c0; rowv[t1] = c1; colv[t0] = -c0; colv[t1] = -c1; colm[t0] = d0; colm[t1] = d1;
            ev[t0] = __expf(c0); ev[t1] = __expf(c1); scv[t0] = __expf(cl - c0) * d0; scv[t1] = __expf(cl - c1) * d1;
            if (lane == 0) misc[0] = __expf(cl);
        } else {
            float i0 = -INFINITY, i1 = -INFINITY, f0 = 0.f, f1 = 0.f;
            if (t0 < Lv) { const size_t r = (size_t)row_of(b, p0 + t0) * 64; i0 = SF[r + 32 + h] + ib; f0 = logsig_f(SF[r + 40 + h] + fb); }
            if (t1 < Lv) { const size_t r = (size_t)row_of(b, p0 + t1) * 64; i1 = SF[r + 32 + h] + ib; f1 = logsig_f(SF[r + 40 + h] + fb); }
            float inc = f0 + f1;
#pragma unroll
            for (int o = 1; o < 64; o <<= 1) { const float y = __shfl_up(inc, o); if (lane >= o) inc += y; }
            const float F1 = inc, F0 = inc - f1;
            const float g0 = i0 - F0, g1 = i1 - F1;
            float mx = fmaxf(g0, g1);
#pragma unroll
            for (int o = 1; o < 64; o <<= 1) { const float y = __shfl_up(mx, o); if (lane >= o) mx = fmaxf(mx, y); }
            float ex = __shfl_up(mx, 1); if (lane == 0) ex = -INFINITY;
            const float mp = mpp[0];
            const float M0 = fmaxf(fmaxf(ex, g0), mp), M1 = fmaxf(mx, mp);
            const float Ml = __shfl(M1, 63), Fl = __shfl(F1, 63);
            rowv[t0] = -M0; rowv[t1] = -M1; colv[t0] = g0; colv[t1] = g1; colm[t0] = 1.f; colm[t1] = 1.f;
            ev[t0] = __expf(mp - M0); ev[t1] = __expf(mp - M1); dden[t0] = __expf(-(F0 + M0)); dden[t1] = __expf(-(F1 + M1));
            scv[t0] = __expf(g0 - Ml); scv[t1] = __expf(g1 - Ml);
            if (lane == 0) { misc[0] = __expf(mp - Ml); mpp[0] = Fl + Ml; }
        }
    };
    __syncthreads();
    if (wid == 0) scalars(0);
    __syncthreads();
    constexpr int CHL = ML ? CHL_ML : CHL_SSD, NCH = 1 + 2048 / CHL;
    const int tid_outer = tid;
    for (int c = 0; c < NCH; ++c) {
        int tid = tid_outer; asm volatile("" : "+v"(tid));
        const int lane = tid & 63, fr = lane & 15, fq = lane >> 4;
        const int p0 = c == 0 ? 0 : 16 + (c - 1) * CHL, Lv = c == 0 ? 16 : CHL;
        float* sc = scb + (c & 1) * 800;
        float *rowv = sc, *colv = sc + 128, *colm = sc + 256, *ev = sc + 384, *scv = sc + 512, *dden = sc + 640, *misc = sc + 768;
        if (wid == 0 && c + 1 < NCH) scalars(c + 1);
        {
            float val[8][4];
            load_block<ML>(p, val, b, p0, Lv, tid >> 5, tid & 31, qcol, 2304 + g * 128, 1.f);
            store_rows(smem + L_QS, val, tid >> 5, tid & 31);
            __builtin_amdgcn_sched_barrier(0);
            load_block<ML>(p, val, b, p0, Lv, tid >> 5, tid & 31, kcol, 2048 + g * 128, 0.08838834764831845f);
            store_rows(smem + L_KS, val, tid >> 5, tid & 31);
            store_cols(smem + L_KT, val, tid >> 5, tid & 31, scv);
            __builtin_amdgcn_sched_barrier(0);
            if (tid < 256) {
                load_block<ML>(p, val, b, p0, Lv, tid >> 4, tid & 15, vcol, h * 64, 1.f);
                store_cols(smem + L_VT, val, tid >> 4, tid & 15, nullptr);
            }
        }
        __syncthreads();
        const int t = 16 * wid + fr;
        const bool valid = t < Lv;
        const int row = row_of(b, p0 + (valid ? t : 0));
        u32x2 gate[4];
#pragma unroll
        for (int vb = 0; vb < 4; ++vb) gate[vb] = *(const u32x2*)(U + (size_t)row * N1P + gcol + 16 * vb + 4 * fq);
        if (ML) {
            const int tt = tid >> 2, part = tid & 3;
            float s = 0.f;
#pragma unroll
            for (int cc = 0; cc < 4; ++cc) {
                const u32x4 raw = *(const u32x4*)(smem + L_QS + tt * RS + (part * 4 + cc) * 16);
                const f32x4 n0 = *(const f32x4*)(nvec + (part * 4 + cc) * 8), n1 = *(const f32x4*)(nvec + (part * 4 + cc) * 8 + 4);
                s += bf_lo(raw[0]) * n0[0] + bf_hi(raw[0]) * n0[1] + bf_lo(raw[1]) * n0[2] + bf_hi(raw[1]) * n0[3]
                   + bf_lo(raw[2]) * n1[0] + bf_hi(raw[2]) * n1[1] + bf_lo(raw[3]) * n1[2] + bf_hi(raw[3]) * n1[3];
            }
            s += __shfl_xor(s, 1); s += __shfl_xor(s, 2);
            if (part == 0) qn[tt] = s;
        }
        bf16x8 qf[4];
#pragma unroll
        for (int kk = 0; kk < 4; ++kk) qf[kk] = *(const bf16x8*)(smem + L_QS + t * RS + (kk * 32 + fq * 8) * 2);
        const float rv = rowv[t];
        float rowsum = 0.f;
        u32x2 pk[8];
#pragma unroll
        for (int sb = 0; sb < 8; ++sb) {
            pk[sb] = (u32x2){0u, 0u};
            if (sb <= wid) {
                f32x4 acc = {0.f, 0.f, 0.f, 0.f};
#pragma unroll
                for (int kk = 0; kk < 4; ++kk) {
                    const bf16x8 kf = *(const bf16x8*)(smem + L_KS + (16 * sb + fr) * RS + (kk * 32 + fq * 8) * 2);
                    acc = __builtin_amdgcn_mfma_f32_16x16x32_bf16(kf, qf[kk], acc, 0, 0, 0);
                }
                const f32x4 cv = *(const f32x4*)(colv + 16 * sb + 4 * fq), cm = *(const f32x4*)(colm + 16 * sb + 4 * fq);
                float pv[4];
#pragma unroll
                for (int j = 0; j < 4; ++j) {
                    const int s = 16 * sb + 4 * fq + j;
                    const float w = (s <= t) ? __expf(rv + cv[j]) * cm[j] : 0.f;
                    pv[j] = acc[j] * w; rowsum += pv[j];
                }
                pk[sb] = (u32x2){pack2(pv[0], pv[1]), pack2(pv[2], pv[3])};
            }
        }
        __syncthreads();
#pragma unroll
        for (int sb = 0; sb < 8; ++sb) *(u32x2*)(smem + L_KS + t * RS + (16 * sb + 4 * fq) * 2) = pk[sb];
        rowsum += __shfl_xor(rowsum, 16); rowsum += __shfl_xor(rowsum, 32);
        if (ML) {
            const int d = tid >> 2, part = tid & 3;
            float s = 0.f;
#pragma unroll
            for (int cc = 0; cc < 4; ++cc) {
                const u32x4 raw = *(const u32x4*)(smem + L_KT + d * RS + (part * 4 + cc) * 16);
                s += bf_lo(raw[0]) + bf_hi(raw[0]) + bf_lo(raw[1]) + bf_hi(raw[1]) + bf_lo(raw[2]) + bf_hi(raw[2]) + bf_lo(raw[3]) + bf_hi(raw[3]);
            }
            s += __shfl_xor(s, 1); s += __shfl_xor(s, 2);
            if (part == 0) nvec[d] = misc[0] * nvec[d] + s;
        }
        __syncthreads();
        bf16x8 pf[4];
#pragma unroll
        for (int kk = 0; kk < 4; ++kk) pf[kk] = *(const bf16x8*)(smem + L_KS + t * RS + (kk * 32 + fq * 8) * 2);
        const float et = ev[t];
        float ddv = 1.f;
        if (ML) ddv = fmaxf(fabsf(rowsum + et * qn[t]), dden[t]);
        float ss = 0.f;
#pragma unroll
        for (int vb = 0; vb < 4; ++vb) {
            f32x4 acc = {0.f, 0.f, 0.f, 0.f};
            const int vrow = 16 * vb + fr;
#pragma unroll
            for (int kk = 0; kk < 4; ++kk) {
                const bf16x8 sf = *(const bf16x8*)(smem + L_ST + vrow * RS + (kk * 32 + fq * 8) * 2);
                acc = __builtin_amdgcn_mfma_f32_16x16x32_bf16(sf, qf[kk], acc, 0, 0, 0);
            }
            acc *= et;
#pragma unroll
            for (int kk = 0; kk < 4; ++kk) {
                const bf16x8 vf = *(const bf16x8*)(smem + L_VT + vrow * RS + (((kk * 4 + fq) ^ ((vrow >> 3) & 7)) << 4));
                acc = __builtin_amdgcn_mfma_f32_16x16x32_bf16(vf, pf[kk], acc, 0, 0, 0);
            }
            const float gz[4] = {bf_lo(gate[vb][0]), bf_hi(gate[vb][0]), bf_lo(gate[vb][1]), bf_hi(gate[vb][1])};
            float o[4];
#pragma unroll
            for (int j = 0; j < 4; ++j) {
                if (ML) { const float hv = acc[j]; ss += hv * hv; o[j] = hv * sigm_f(gz[j]); }
                else {
                    const int v = 16 * vb + 4 * fq + j;
                    const float xv = bf2f(*(const bf16_t*)(smem + L_VT + v * RS + (((t >> 3) ^ ((v >> 3) & 7)) << 4) + (t & 7) * 2));
                    const float y = (acc[j] + D_h * xv) * silu_f(gz[j]); ss += y * y; o[j] = y;
                }
            }
            if (valid) *(u32x2*)(MIX + (size_t)row * MIXW + mixcol + 16 * vb + 4 * fq) = (u32x2){pack2(o[0], o[1]), pack2(o[2], o[3])};
        }
        ss += __shfl_xor(ss, 16); ss += __shfl_xor(ss, 32);
        if (valid && fq == 0) {
            if (ML) { ((float*)(p.ws + WS_SSQM))[(size_t)row * 32 + h * 4 + vq] = ss; if (vq == 0) ((float*)(p.ws + WS_DD))[(size_t)row * 8 + h] = ddv; }
            else ((float*)(p.ws + WS_SSQ))[(size_t)row * 32 + h] = ss;
        }
        const float dec = misc[0];
#pragma unroll
        for (int vb = 0; vb < 4; ++vb) st[vb] *= dec;
#pragma unroll
        for (int kk = 0; kk < 4; ++kk) {
            const int drow = 16 * wid + fr;
            const bf16x8 kf = *(const bf16x8*)(smem + L_KT + drow * RS + (((kk * 4 + fq) ^ ((drow >> 3) & 7)) << 4));
#pragma unroll
            for (int vb = 0; vb < 4; ++vb) {
                const int vrow = 16 * vb + fr;
                const bf16x8 vf = *(const bf16x8*)(smem + L_VT + vrow * RS + (((kk * 4 + fq) ^ ((vrow >> 3) & 7)) << 4));
                st[vb] = __builtin_amdgcn_mfma_f32_16x16x32_bf16(kf, vf, st[vb], 0, 0, 0);
            }
        }
        __syncthreads();
#pragma unroll
        for (int vb = 0; vb < 4; ++vb)
            *(u32x2*)(smem + L_ST + (16 * vb + fr) * RS + (16 * wid + 4 * fq) * 2) = (u32x2){pack2(st[vb][0], st[vb][1]), pack2(st[vb][2], st[vb][3])};
    }
#pragma unroll
    for (int vb = 0; vb < 4; ++vb) {
        const int v = 16 * vb + fr, d0 = 16 * wid + 4 * fq;
        if (!ML) *(f32x4*)(p.out + O_P_SSD + ((size_t)(b * 32 + h) * 64 + v) * 128 + d0) = st[vb];
        else {
#pragma unroll
            for (int j = 0; j < 4; ++j) p.out[O_P_MLC + ((size_t)(b * 8 + h) * 128 + d0 + j) * 256 + vq * 64 + v] = st[vb][j];
        }
    }
    if (ML && vq == 0) {
        if (tid < 128) p.out[O_P_MLN + (size_t)(b * 8 + h) * 128 + tid] = nvec[tid];
        if (tid == 0) p.out[O_P_MLM + b * 8 + h] = mpp[0];
    }
    __syncthreads();
}

__device__ __forceinline__ void sample_ssd(const Params& p, unsigned char* smem, int job) {
    const int tid = opaque_tid(), wid = tid >> 6, lane = tid & 63;
    const int b = job >> 1, g = job & 1, rowb = ROW_SAMPLE + b * 8;
    const bf16_t* U = (const bf16_t*)(p.ws + WS_U);
    const float* SF = (const float*)(p.ws + WS_SF);
    bf16_t* MIX = (bf16_t*)(p.ws + WS_MIX);
    float* Bc = (float*)smem; float* Cc = Bc + 1024; float* xall = Cc + 1024; float* G = xall + 8192; float* dts = G + 64; float* ssqp = dts + 128;
    const float* sconv = p.in[2]; const float* cw = p.in[11]; const float* cb = p.in[12];
#pragma unroll
    for (int q = 0; q < 3; ++q) {
        int ch; float* dst; int dstride = 0;
        if (q < 2) { ch = g * 1024 + tid + q * 512; dst = xall + tid + q * 512; dstride = 1024; }
        else { if (tid >= 256) break; const int which = tid >> 7, n = tid & 127; ch = 2048 + which * 256 + g * 128 + n; dst = (which ? Cc : Bc) + n; dstride = 128; }
        float xm3 = sconv[(size_t)(b * 3 + 0) * 2560 + ch], xm2 = sconv[(size_t)(b * 3 + 1) * 2560 + ch], xm1 = sconv[(size_t)(b * 3 + 2) * 2560 + ch];
        const float w0 = cw[ch], w1 = cw[2560 + ch], w2 = cw[5120 + ch], w3 = cw[7680 + ch], bb = cb[ch];
#pragma unroll
        for (int t = 0; t < 8; ++t) {
            const float x = bf2f(U[(size_t)(rowb + t) * N1P + UC_XBC + ch]);
            dst[t * dstride] = silu_f(bb + w0 * xm3 + w1 * xm2 + w2 * xm1 + w3 * x);
            xm3 = xm2; xm2 = xm1; xm1 = x;
        }
    }
    if (tid < 128) { const int hh = tid >> 3, t = tid & 7; dts[tid] = softplus_f(SF[(size_t)(rowb + t) * 64 + g * 16 + hh] + p.in[13][g * 16 + hh]); }
    __syncthreads();
    {
        const int pair = tid >> 3, part = tid & 7, t = pair >> 3, s = pair & 7;
        float sum = 0.f;
#pragma unroll
        for (int i = 0; i < 4; ++i) {
            const f32x4 c4 = *(const f32x4*)(Cc + t * 128 + part * 16 + i * 4), b4 = *(const f32x4*)(Bc + s * 128 + part * 16 + i * 4);
            sum += c4[0] * b4[0] + c4[1] * b4[1] + c4[2] * b4[2] + c4[3] * b4[3];
        }
        sum += __shfl_xor(sum, 1); sum += __shfl_xor(sum, 2); sum += __shfl_xor(sum, 4);
        if (part == 0) G[pair] = sum;
    }
    __syncthreads();
    const int pp = tid >> 3, nq = tid & 7;
    f32x4 snext[4];
#pragma unroll
    for (int i = 0; i < 4; ++i) snext[i] = *(const f32x4*)(p.in[3] + ((size_t)(b * 32 + g * 16) * 64 + pp) * 128 + nq * 4 + 32 * i);
    for (int hh = 0; hh < 16; ++hh) {
        const int h = g * 16 + hh;
        const float A_h = -__expf(p.in[14][h]), D_h = p.in[15][h];
        float dtv[8], cum[8];
        { float run = 0.f;
#pragma unroll
          for (int t = 0; t < 8; ++t) { dtv[t] = dts[hh * 8 + t]; run += dtv[t] * A_h; cum[t] = run; } }
        const size_t soff = ((size_t)(b * 32 + h) * 64 + pp) * 128 + nq * 4;
        f32x4 s0[4];
#pragma unroll
        for (int i = 0; i < 4; ++i) s0[i] = snext[i];
        if (hh + 1 < 16) {
#pragma unroll
            for (int i = 0; i < 4; ++i) snext[i] = *(const f32x4*)(p.in[3] + soff + 64 * 128 + 32 * i);
        }
        float cs[8];
#pragma unroll
        for (int t = 0; t < 8; ++t) {
            float sum = 0.f;
#pragma unroll
            for (int i = 0; i < 4; ++i) { const f32x4 c4 = *(const f32x4*)(Cc + t * 128 + nq * 4 + 32 * i); sum += c4[0] * s0[i][0] + c4[1] * s0[i][1] + c4[2] * s0[i][2] + c4[3] * s0[i][3]; }
            sum += __shfl_xor(sum, 1); sum += __shfl_xor(sum, 2); sum += __shfl_xor(sum, 4);
            cs[t] = sum;
        }
        float ycs = 0.f, ct = 0.f;
#pragma unroll
        for (int t = 0; t < 8; ++t) { ycs = (nq == t) ? cs[t] : ycs; ct = (nq == t) ? cum[t] : ct; }
        float y = __expf(ct) * ycs, xt = 0.f;
#pragma unroll
        for (int s = 0; s < 8; ++s) {
            const float xs = xall[s * 1024 + hh * 64 + pp];
            const float term = (s <= nq) ? G[nq * 8 + s] * __expf(ct - cum[s]) * dtv[s] * xs : 0.f;
            y += term; xt = (s == nq) ? xs : xt;
        }
        y += D_h * xt;
        const float z = bf2f(U[(size_t)(rowb + nq) * N1P + UC_Z + h * 64 + pp]);
        y *= silu_f(z);
        { const unsigned pk = pack2(y, 0.f); MIX[(size_t)(rowb + nq) * MIXW + h * 64 + pp] = (bf16_t)(pk & 0xffffu); }
        float sq = y * y; sq += __shfl_xor(sq, 8); sq += __shfl_xor(sq, 16); sq += __shfl_xor(sq, 32);
        if (lane < 8) ssqp[(hh * 8 + wid) * 8 + lane] = sq;
        const float cl = cum[7], dec = __expf(cl);
        float xw[8];
#pragma unroll
        for (int s = 0; s < 8; ++s) xw[s] = __expf(cl - cum[s]) * dtv[s] * xall[s * 1024 + hh * 64 + pp];
#pragma unroll
        for (int i = 0; i < 4; ++i) {
            f32x4 acc = s0[i] * dec;
#pragma unroll
            for (int s = 0; s < 8; ++s) acc += xw[s] * *(const f32x4*)(Bc + s * 128 + nq * 4 + 32 * i);
            *(f32x4*)(p.out + O_S_SSD + soff + 32 * i) = acc;
        }
    }
    __syncthreads();
    if (tid < 128) {
        const int hh = tid >> 3, t = tid & 7; float tot = 0.f;
#pragma unroll
        for (int w = 0; w < 8; ++w) tot += ssqp[(hh * 8 + w) * 8 + t];
        ((float*)(p.ws + WS_SSQ))[(size_t)(rowb + t) * 32 + g * 16 + hh] = tot;
    }
    __syncthreads();
}

__device__ __forceinline__ void sample_ml(const Params& p, unsigned char* smem, int job) {
    const int tid = opaque_tid(), wid = __builtin_amdgcn_readfirstlane(tid >> 6), lane = tid & 63;
    const int b = job >> 3, h = job & 7, rowb = ROW_SAMPLE + b * 8;
    const bf16_t* U = (const bf16_t*)(p.ws + WS_U);
    const float* SF = (const float*)(p.ws + WS_SF);
    bf16_t* MIX = (bf16_t*)(p.ws + WS_MIX);
    float* qs = (float*)smem; float* ks = qs + 1024; float* vs = qs + 2048; float* QK = qs + 4096; float* sig = qs + 4160; float* slf = qs + 4168;
    float* qnv = qs + 4176; float* n0v = qs + 4192; float* red = qs + 4352;
    {
        const int t = tid >> 6, c = tid & 63;
        const size_t r = (size_t)(rowb + t) * N1P;
        const unsigned qq = *(const unsigned*)(U + r + UC_Q + h * 128 + 2 * c), kk = *(const unsigned*)(U + r + UC_K + h * 128 + 2 * c);
        const u32x2 vv = *(const u32x2*)(U + r + UC_V + h * 256 + 4 * c);
        qs[t * 128 + 2 * c] = bf_lo(qq); qs[t * 128 + 2 * c + 1] = bf_hi(qq);
        ks[t * 128 + 2 * c] = bf_lo(kk) * 0.08838834764831845f; ks[t * 128 + 2 * c + 1] = bf_hi(kk) * 0.08838834764831845f;
        *(f32x4*)(vs + t * 256 + 4 * c) = (f32x4){bf_lo(vv[0]), bf_hi(vv[0]), bf_lo(vv[1]), bf_hi(vv[1])};
        if (tid < 8) { sig[tid] = SF[(size_t)(rowb + tid) * 64 + 32 + h] + p.in[17][h]; slf[tid] = logsig_f(SF[(size_t)(rowb + tid) * 64 + 40 + h] + p.in[18][h]); }
        if (tid >= 128 && tid < 256) n0v[tid - 128] = p.in[5][(size_t)(b * 8 + h) * 128 + tid - 128];
    }
    const int v4 = lane, dg = wid;
    const size_t coff = ((size_t)(b * 8 + h) * 128 + dg * 16) * 256 + v4 * 4;
    f32x4 c0[16];
#pragma unroll
    for (int i = 0; i < 16; ++i) c0[i] = *(const f32x4*)(p.in[4] + coff + (size_t)i * 256);
    const float mp = p.in[6][b * 8 + h];
    __syncthreads();
    float F[8], gg[8], M[8];
    { float run = 0.f, pm = -INFINITY;
#pragma unroll
      for (int t = 0; t < 8; ++t) { run += slf[t]; F[t] = run; gg[t] = sig[t] - run; pm = fmaxf(pm, gg[t]); M[t] = fmaxf(pm, mp); } }
    const float Ml = M[7], dec = __expf(mp - Ml), m_new = F[7] + Ml;
    {
        const int pair = tid >> 3, part = tid & 7, t = pair >> 3, s = pair & 7;
        float sum = 0.f;
#pragma unroll
        for (int i = 0; i < 4; ++i) {
            const f32x4 a4 = *(const f32x4*)(qs + t * 128 + part * 16 + i * 4), b4 = *(const f32x4*)(ks + s * 128 + part * 16 + i * 4);
            sum += a4[0] * b4[0] + a4[1] * b4[1] + a4[2] * b4[2] + a4[3] * b4[3];
        }
        sum += __shfl_xor(sum, 1); sum += __shfl_xor(sum, 2); sum += __shfl_xor(sum, 4);
        if (part == 0) QK[pair] = sum;
        float qd = qs[wid * 128 + 2 * lane] * n0v[2 * lane] + qs[wid * 128 + 2 * lane + 1] * n0v[2 * lane + 1];
        qd = wave_sum(qd);
        if (lane == 0) qnv[wid] = qd;
    }
#pragma unroll
    for (int t = 0; t < 8; ++t) {
        f32x4 acc = {0.f, 0.f, 0.f, 0.f};
#pragma unroll
        for (int i4 = 0; i4 < 4; ++i4) {
            const f32x4 q4 = *(const f32x4*)(qs + t * 128 + dg * 16 + i4 * 4);
            acc += q4[0] * c0[i4 * 4] + q4[1] * c0[i4 * 4 + 1] + q4[2] * c0[i4 * 4 + 2] + q4[3] * c0[i4 * 4 + 3];
        }
        *(f32x4*)(red + (dg * 8 + t) * 256 + v4 * 4) = acc;
    }
    __syncthreads();
    f32x4 vv[8];
    float scs[8];
#pragma unroll
    for (int s = 0; s < 8; ++s) { vv[s] = *(const f32x4*)(vs + s * 256 + v4 * 4); scs[s] = __expf(gg[s] - Ml); }
#pragma unroll
    for (int i = 0; i < 16; ++i) {
        const int d = dg * 16 + i;
        f32x4 cn = c0[i] * dec;
#pragma unroll
        for (int s = 0; s < 8; ++s) cn += (scs[s] * ks[s * 128 + d]) * vv[s];
        *(f32x4*)(p.out + O_S_MLC + coff + (size_t)i * 256) = cn;
    }
    if (tid < 128) {
        float nn = dec * n0v[tid];
#pragma unroll
        for (int s = 0; s < 8; ++s) nn += scs[s] * ks[s * 128 + tid];
        p.out[O_S_MLN + (size_t)(b * 8 + h) * 128 + tid] = nn;
    }
    if (tid == 0) p.out[O_S_MLM + b * 8 + h] = m_new;
    {
        const int t = wid;
        float Mt = 0.f, Ft = 0.f;
#pragma unroll
        for (int q = 0; q < 8; ++q) { Mt = (t == q) ? M[q] : Mt; Ft = (t == q) ? F[q] : Ft; }
        f32x4 numc = {0.f, 0.f, 0.f, 0.f};
#pragma unroll
        for (int q = 0; q < 8; ++q) numc += *(const f32x4*)(red + (q * 8 + t) * 256 + lane * 4);
        const float et = __expf(mp - Mt);
        float den = et * qnv[t];
        f32x4 intra = {0.f, 0.f, 0.f, 0.f};
#pragma unroll
        for (int s = 0; s < 8; ++s) {
            if (s <= t) { const float w = __expf(gg[s] - Mt) * QK[t * 8 + s]; den += w; intra += w * vv[s]; }
        }
        const float dd = fmaxf(fabsf(den), __expf(-(Ft + Mt)));
        const f32x4 hv = (et * numc + intra) * (1.f / dd);
        float ss = hv[0] * hv[0] + hv[1] * hv[1] + hv[2] * hv[2] + hv[3] * hv[3];
        ss = wave_sum(ss);
        const u32x2 og = *(const u32x2*)(U + (size_t)(rowb + t) * N1P + UC_O + h * 256 + lane * 4);
        *(u32x2*)(MIX + (size_t)(rowb + t) * MIXW + 2048 + h * 256 + lane * 4) =
            (u32x2){pack2(hv[0] * sigm_f(bf_lo(og[0])), hv[1] * sigm_f(bf_hi(og[0]))), pack2(hv[2] * sigm_f(bf_lo(og[1])), hv[3] * sigm_f(bf_hi(og[1])))};
        if (lane < 4) ((float*)(p.ws + WS_SSQM))[(size_t)(rowb + t) * 32 + h * 4 + lane] = lane == 0 ? ss : 0.f;
        if (lane == 0) ((float*)(p.ws + WS_DD))[(size_t)(rowb + t) * 8 + h] = 1.f;
    }
    __syncthreads();
}

__device__ __forceinline__ void phase_scan(const Params& p, unsigned char* smem) {
#ifndef SC_MASK
#define SC_MASK 15
#endif
    for (int j = opaque_bid(); j < 256; j += gridDim.x) { if (j < 128) { if (SC_MASK & 1) prompt_scan<false>(p, smem, j); } else { if (SC_MASK & 2) prompt_scan<true>(p, smem, j - 128); } }
    if (SC_MASK & 4) for (int j = opaque_bid(); j < 256; j += gridDim.x) sample_ssd(p, smem, j);
    if (SC_MASK & 8) for (int j = opaque_bid(); j < 1024; j += gridDim.x) sample_ml(p, smem, j);
}

__device__ __forceinline__ void phase_mixnorm(const Params& p) {
    const int tid = opaque_tid(), wid = tid >> 6, lane = tid & 63;
    bf16_t* MIX = (bf16_t*)(p.ws + WS_MIX);
    const float* SSQ = (const float*)(p.ws + WS_SSQ); const float* SSQM = (const float*)(p.ws + WS_SSQM);
    const float* w1 = p.in[16]; const float* w2 = p.in[19];
    for (int row = opaque_bid() * 8 + wid; row < NVALID; row += gridDim.x * 8) {
        float s = lane < 32 ? SSQ[(size_t)row * 32 + lane] : 0.f;
        s = wave_sum(s);
        const float r1 = rsqrtf(s * (1.f / 2048.f) + EPS);
        float m = lane < 32 ? SSQM[(size_t)row * 32 + lane] : 0.f;
        m += __shfl_xor(m, 1); m += __shfl_xor(m, 2);
        const float ddh = lane < 32 ? ((const float*)(p.ws + WS_DD))[(size_t)row * 8 + (lane >> 2)] : 1.f;
        const float idd = 1.f / ddh;
        const float rh = rsqrtf(m * (1.f / 256.f) * idd * idd + EPS) * idd;
#pragma unroll
        for (int it = 0; it < 8; ++it) {
            const int col = it * 512 + lane * 8;
            const u32x4 raw = *(const u32x4*)(MIX + (size_t)row * MIXW + col);
            float scale; const float* wp;
            if (it < 4) { scale = r1; wp = w1 + col; }
            else { const int head = (it - 4) * 2 + (lane >> 5); scale = __shfl(rh, head * 4); wp = w2 + col - 2048; }
            const f32x4 wa = *(const f32x4*)wp, wb = *(const f32x4*)(wp + 4);
            u32x4 o;
            o[0] = pack2(bf_lo(raw[0]) * scale * wa[0], bf_hi(raw[0]) * scale * wa[1]); o[1] = pack2(bf_lo(raw[1]) * scale * wa[2], bf_hi(raw[1]) * scale * wa[3]);
            o[2] = pack2(bf_lo(raw[2]) * scale * wb[0], bf_hi(raw[2]) * scale * wb[1]); o[3] = pack2(bf_lo(raw[3]) * scale * wb[2], bf_hi(raw[3]) * scale * wb[3]);
            *(u32x4*)(MIX + (size_t)row * MIXW + col) = o;
        }
    }
    const bf16_t* U = (const bf16_t*)(p.ws + WS_U);
    for (int i = opaque_bid() * 512 + tid; i < 132 * 3 * 320; i += gridDim.x * 512) {
        const int cgp = i % 320, j = (i / 320) % 3, q = i / 960;
        int row; float* dst;
        if (q < 4) { row = q * 2048 + 2045 + j; dst = p.out + O_P_SSDCONV + (size_t)(q * 3 + j) * 2560 + cgp * 8; }
        else { row = ROW_SAMPLE + (q - 4) * 8 + 5 + j; dst = p.out + O_S_SSDCONV + (size_t)((q - 4) * 3 + j) * 2560 + cgp * 8; }
        const u32x4 raw = *(const u32x4*)(U + (size_t)row * N1P + UC_XBC + cgp * 8);
        *(f32x4*)dst = (f32x4){bf_lo(raw[0]), bf_hi(raw[0]), bf_lo(raw[1]), bf_hi(raw[1])};
        *(f32x4*)(dst + 4) = (f32x4){bf_lo(raw[2]), bf_hi(raw[2]), bf_lo(raw[3]), bf_hi(raw[3])};
    }
}

__device__ __forceinline__ void unpack8(const u32x4 raw, float (&x)[8]) {
#pragma unroll
    for (int i = 0; i < 4; ++i) { x[2 * i] = bf_lo(raw[i]); x[2 * i + 1] = bf_hi(raw[i]); }
}
__device__ __forceinline__ void phase_act(const Params& p) {
    const bf16_t* UP = (const bf16_t*)(p.ws + WS_UP); bf16_t* ACT = (bf16_t*)(p.ws + WS_ACT);
    const float* cw = p.in[23]; const float* cb = p.in[24]; const float* fst = p.in[7];
    constexpr int CGN = DFF / 8, TOTAL = (NVALID / 8) * CGN;
    const int tid = opaque_tid();
    for (int idx = opaque_bid() * 512 + tid; idx < TOTAL; idx += gridDim.x * 512) {
        const int rb = idx / CGN, cgp = idx % CGN, row0 = rb * 8, c0 = cgp * 8;
        float g2[8], g1[8], v2[8], v1[8];
        int prow = -1; bool from_state = false; int sb = 0, pb = -1;
        if (row0 < ROW_SAMPLE) { const int b = row0 >> 11, t0 = row0 & 2047; prow = t0 > 0 ? row0 - 2 : ROW_META + b * 16 + 14; if (t0 == 2040) pb = b; }
        else if (row0 < ROW_META) { from_state = true; sb = (row0 - ROW_SAMPLE) >> 3; }
        else { if ((row0 - ROW_META) & 15) prow = row0 - 2; }
        if (from_state) {
            const float* s0 = fst + (size_t)(sb * 2) * N3;
#pragma unroll
            for (int i = 0; i < 8; ++i) { g2[i] = s0[c0 + i]; g1[i] = s0[N3 + c0 + i]; v2[i] = s0[DFF + c0 + i]; v1[i] = s0[N3 + DFF + c0 + i]; }
        } else if (prow >= 0) {
            unpack8(*(const u32x4*)(UP + (size_t)prow * N3 + c0), g2); unpack8(*(const u32x4*)(UP + (size_t)(prow + 1) * N3 + c0), g1);
            unpack8(*(const u32x4*)(UP + (size_t)prow * N3 + DFF + c0), v2); unpack8(*(const u32x4*)(UP + (size_t)(prow + 1) * N3 + DFF + c0), v1);
        } else {
#pragma unroll
            for (int i = 0; i < 8; ++i) { g2[i] = 0.f; g1[i] = 0.f; v2[i] = 0.f; v1[i] = 0.f; }
        }
        float wg[3][8], wv[3][8], bg[8], bv[8];
#pragma unroll
        for (int j = 0; j < 3; ++j)
#pragma unroll
            for (int i = 0; i < 8; ++i) { wg[j][i] = cw[j * N3 + c0 + i]; wv[j][i] = cw[j * N3 + DFF + c0 + i]; }
#pragma unroll
        for (int i = 0; i < 8; ++i) { bg[i] = cb[c0 + i]; bv[i] = cb[DFF + c0 + i]; }
#pragma unroll
        for (int r = 0; r < 8; ++r) {
            float gx[8], vx[8];
            unpack8(*(const u32x4*)(UP + (size_t)(row0 + r) * N3 + c0), gx); unpack8(*(const u32x4*)(UP + (size_t)(row0 + r) * N3 + DFF + c0), vx);
            float o[8];
#pragma unroll
            for (int i = 0; i < 8; ++i) {
                const float yg = bg[i] + wg[0][i] * g2[i] + wg[1][i] * g1[i] + wg[2][i] * gx[i];
                const float yv = bv[i] + wv[0][i] * v2[i] + wv[1][i] * v1[i] + wv[2][i] * vx[i];
                o[i] = silu_f(yg) * yv;
                g2[i] = g1[i]; g1[i] = gx[i]; v2[i] = v1[i]; v1[i] = vx[i];
            }
            u32x4 ov; ov[0] = pack2(o[0], o[1]); ov[1] = pack2(o[2], o[3]); ov[2] = pack2(o[4], o[5]); ov[3] = pack2(o[6], o[7]);
            *(u32x4*)(ACT + (size_t)(row0 + r) * DFF + c0) = ov;
        }
        if (from_state || pb >= 0) {
            float* dst = from_state ? p.out + O_S_FFN + (size_t)(sb * 2) * N3 : p.out + O_P_FFN + (size_t)(pb * 2) * N3;
            *(f32x4*)(dst + c0) = (f32x4){g2[0], g2[1], g2[2], g2[3]}; *(f32x4*)(dst + c0 + 4) = (f32x4){g2[4], g2[5], g2[6], g2[7]};
            *(f32x4*)(dst + N3 + c0) = (f32x4){g1[0], g1[1], g1[2], g1[3]}; *(f32x4*)(dst + N3 + c0 + 4) = (f32x4){g1[4], g1[5], g1[6], g1[7]};
            *(f32x4*)(dst + DFF + c0) = (f32x4){v2[0], v2[1], v2[2], v2[3]}; *(f32x4*)(dst + DFF + c0 + 4) = (f32x4){v2[4], v2[5], v2[6], v2[7]};
            *(f32x4*)(dst + N3 + DFF + c0) = (f32x4){v1[0], v1[1], v1[2], v1[3]}; *(f32x4*)(dst + N3 + DFF + c0 + 4) = (f32x4){v1[4], v1[5], v1[6], v1[7]};
        }
    }
}

__device__ __forceinline__ void phase_final(const Params& p) {
    const int tid = opaque_tid(), wid = tid >> 6, lane = tid & 63;
    const float* SS3 = (const float*)(p.ws + WS_SS3); const float* nw = p.in[26];
    for (int row = opaque_bid() * 8 + wid; row < NOUTROWS; row += gridDim.x * 8) {
        const float r = rsqrtf(SS3[row] * (1.f / 2048.f) + EPS);
        float* rp = p.out + (size_t)row * DM;
#pragma unroll
        for (int it = 0; it < 8; ++it) {
            const int col = it * 256 + lane * 4;
            const f32x4 v = *(const f32x4*)(rp + col), w = *(const f32x4*)(nw + col);
            *(f32x4*)(rp + col) = v * r * w;
        }
    }
}

__global__ void __launch_bounds__(512, 2) hymba_fwd(Params p0) {
    extern __shared__ __attribute__((aligned(16))) unsigned char smem[];
    cg::grid_group grid = cg::this_grid();
#ifndef DUP_PHASE
#define DUP_PHASE -1
#endif
    for (int phx = p0.ph_lo; phx < p0.ph_hi + (DUP_PHASE >= 0 ? 1 : 0); ++phx) {
        const int ph = (DUP_PHASE >= 0 && phx > DUP_PHASE) ? phx - 1 : phx;
        Params p = p0;
        asm volatile("" : "+s"(p.ws), "+s"(p.out));
        switch (ph) {
        case 0: if (PH_MASK & 1) phase_prep(p, smem); break;
        case 1: if (PH_MASK & 2) { pg8::Gemm g{(const bf16_t*)(p.ws + WS_XN), (const bf16_t*)(p.ws + WS_WIN), MP, N1P, 2048}; pg8::StaticOrder S; S.init(MP, N1P, gridDim.x, opaque_bid());
                  Epi1 E{(bf16_t*)(p.ws + WS_U), (float*)(p.ws + WS_SF)}; pg8::gemm_phase((LAS unsigned char*)smem, g, S, E); } break;
        case 2: if (PH_MASK & 4) phase_scan(p, smem); break;
        case 3: if (PH_MASK & 8) phase_mixnorm(p); break;
        case 4: if (PH_MASK & 16) { pg8::Gemm g{(const bf16_t*)(p.ws + WS_MIX), (const bf16_t*)(p.ws + WS_WOUT), MP, 2048, 4096}; pg8::StaticOrder S; S.init(MP, 2048, gridDim.x, opaque_bid());
                  Epi2 E{p}; pg8::gemm_phase((LAS unsigned char*)smem, g, S, E); } break;
        case 5: if (PH_MASK & 32) { pg8::Gemm g{(const bf16_t*)(p.ws + WS_A2), (const bf16_t*)(p.ws + WS_WUP), MP, N3, 2048}; pg8::StaticOrder S; S.init(MP, N3, gridDim.x, opaque_bid());
                  Epi3 E{(bf16_t*)(p.ws + WS_UP), (const float*)(p.ws + WS_SS2)}; pg8::gemm_phase((LAS unsigned char*)smem, g, S, E); } break;
        case 6: if (PH_MASK & 64) phase_act(p); break;
        case 7: if (PH_MASK & 128) { pg8::Gemm g{(const bf16_t*)(p.ws + WS_ACT), (const bf16_t*)(p.ws + WS_WDOWN), MP, 2048, DFF}; pg8::StaticOrder S; S.init(MP, 2048, gridDim.x, opaque_bid());
                  Epi4 E{(const float*)(p.ws + WS_H1), p.out, (float*)(p.ws + WS_SS3)}; pg8::gemm_phase((LAS unsigned char*)smem, g, S, E); } break;
        default: if (PH_MASK & 256) phase_final(p); break;
        }
        if (phx + 1 < p0.ph_hi + (DUP_PHASE >= 0 ? 1 : 0)) grid.sync();
    }
}

extern "C" void kernel_launch(void* const* d_in, const int* in_sizes, int n_in, void* d_out, int out_size, void* d_ws, size_t ws_size, hipStream_t stream) {
    static int grid_blocks = 0;
    if (grid_blocks == 0) {
        if (n_in != 27 || (size_t)out_size != O_END || ws_size < WS_END) {
            fprintf(stderr, "kernel_launch: unexpected shapes: n_in %d out %d ws %zu (need %zu)\n", n_in, out_size, ws_size, (size_t)WS_END); grid_blocks = -1; return; }
        int dev = 0, cus = 0, per_cu = 0;
        (void)hipGetDevice(&dev);
        (void)hipDeviceGetAttribute(&cus, hipDeviceAttributeMultiprocessorCount, dev);
        (void)hipFuncSetAttribute((const void*)hymba_fwd, hipFuncAttributeMaxDynamicSharedMemorySize, LDS_BYTES);
        (void)hipOccupancyMaxActiveBlocksPerMultiprocessor(&per_cu, (const void*)hymba_fwd, 512, LDS_BYTES);
        if (per_cu < 1) { fprintf(stderr, "kernel_launch: occupancy query says %d blocks per CU\n", per_cu); per_cu = 1; }
        grid_blocks = cus;
    }
    if (grid_blocks < 0) return;
    Params p{};
    for (int i = 0; i < 27; ++i) p.in[i] = (const float*)d_in[i];
    p.out = (float*)d_out; p.ws = (unsigned char*)d_ws; p.ph_lo = 0; p.ph_hi = NPHASE;
    void* args[] = {&p};
    hipError_t e = hipLaunchCooperativeKernel((const void*)hymba_fwd, dim3(grid_blocks), dim3(512), args, LDS_BYTES, stream);
    if (e != hipSuccess) fprintf(stderr, "cooperative launch failed: %s (grid %d)\n", hipGetErrorString(e), grid_blocks);
}
```

```cpp
#include <hip/hip_runtime.h>
#include <hip/hip_cooperative_groups.h>
#include <cstdio>
namespace cg = cooperative_groups;

#define LAS __attribute__((address_space(3)))
typedef unsigned short bf16_t;
typedef short bf16x8 __attribute__((ext_vector_type(8)));
typedef float f32x4 __attribute__((ext_vector_type(4)));
typedef unsigned u32x4 __attribute__((ext_vector_type(4)));
typedef unsigned u32x2 __attribute__((ext_vector_type(2)));

constexpr int DM = 2048, MP = 9472, NVALID = 9280, NOUTROWS = 9216;
constexpr int N1P = 11008, N3 = 11264, DFF = 5632, MIXW = 4096;
constexpr int ROW_SAMPLE = 8192, ROW_META = 9216;
constexpr float EPS = 1e-6f;
constexpr int UC_Z = 0, UC_XBC = 2048, UC_Q = 4640, UC_K = 5664, UC_V = 6688, UC_O = 8752;
constexpr size_t WS_WIN = 0;
constexpr size_t WS_WOUT = WS_WIN + (size_t)N1P * 2048 * 2;
constexpr size_t WS_WUP = WS_WOUT + (size_t)2048 * 4096 * 2;
constexpr size_t WS_WDOWN = WS_WUP + (size_t)N3 * 2048 * 2;
constexpr size_t WS_XN = WS_WDOWN + (size_t)2048 * DFF * 2;
constexpr size_t WS_MIX = WS_XN + (size_t)MP * 2048 * 2;
constexpr size_t WS_ACT = WS_XN;
constexpr size_t WS_U = WS_MIX + (size_t)MP * MIXW * 2;
constexpr size_t WS_UP = WS_U;
constexpr size_t WS_H1 = WS_U + (size_t)MP * N3 * 2;
constexpr size_t WS_A2 = WS_H1 + (size_t)MP * 2048 * 4;
constexpr size_t WS_SF = WS_A2 + (size_t)MP * 2048 * 2;
constexpr size_t WS_SSQ = WS_SF + (size_t)MP * 64 * 4;
constexpr size_t WS_SSQM = WS_SSQ + (size_t)MP * 32 * 4;
constexpr size_t WS_SS2 = WS_SSQM + (size_t)MP * 32 * 4;
constexpr size_t WS_SS3 = WS_SS2 + (size_t)MP * 4;
constexpr size_t WS_DD = WS_SS3 + (size_t)MP * 4;
constexpr size_t WS_END = WS_DD + (size_t)MP * 8 * 4;
constexpr size_t O_Y = 0;
constexpr size_t O_P_SSDCONV = 18874368, O_P_SSD = 18905088, O_P_MLC = 19953664, O_P_MLN = 21002240, O_P_MLM = 21006336, O_P_FFN = 21006368;
constexpr size_t O_S_SSDCONV = 21096480, O_S_SSD = 22079520, O_S_MLC = 55633952, O_S_MLN = 89188384, O_S_MLM = 89319456, O_S_FFN = 89320480;
constexpr size_t O_END = 92204064;
constexpr int LDS_BYTES = 147456;
constexpr int NPHASE = 9;
#ifndef CHL_SSD
#define CHL_SSD 128
#endif
#ifndef CHL_ML
#define CHL_ML 128
#endif
#ifndef PH_MASK
#define PH_MASK 0x1ff
#endif

struct Params {
    const float* in[27];
    float* out;
    unsigned char* ws;
    int ph_lo, ph_hi;
};

__device__ __forceinline__ unsigned pack2(float lo, float hi) { unsigned r; asm("v_cvt_pk_bf16_f32 %0, %1, %2" : "=v"(r) : "v"(lo), "v"(hi)); return r; }
__device__ __forceinline__ float bf_lo(unsigned u) { return __uint_as_float(u << 16); }
__device__ __forceinline__ float bf_hi(unsigned u) { return __uint_as_float(u & 0xffff0000u); }
__device__ __forceinline__ float bf2f(bf16_t h) { return __uint_as_float((unsigned)h << 16); }
__device__ __forceinline__ float sigm_f(float x) { const float d = 1.f + __expf(fminf(-x, 80.f)); float r = __builtin_amdgcn_rcpf(d); return r * (2.f - d * r); }
__device__ __forceinline__ float silu_f(float x) { return x * sigm_f(x); }
__device__ __forceinline__ float softplus_f(float x) { return x > 20.f ? x : log1pf(__expf(x)); }
__device__ __forceinline__ float logsig_f(float x) { return fminf(x, 0.f) - log1pf(__expf(-fabsf(x))); }
__device__ __forceinline__ int opaque_tid() { int t = threadIdx.x; asm volatile("" : "+v"(t)); return t; }
__device__ __forceinline__ int opaque_bid() { int t = blockIdx.x; asm volatile("" : "+s"(t)); return t; }
__device__ __forceinline__ int row_of(int b, int pos) { return pos < 16 ? ROW_META + b * 16 + pos : b * 2048 + pos - 16; }
__device__ __forceinline__ float wave_sum(float v) {
    v += __shfl_xor(v, 32); v += __shfl_xor(v, 16); v += __shfl_xor(v, 8); v += __shfl_xor(v, 4); v += __shfl_xor(v, 2); v += __shfl_xor(v, 1); return v;
}
__device__ __forceinline__ const float* resid_row(const Params& p, int row) {
    if (row < ROW_SAMPLE) return p.in[0] + (size_t)row * DM;
    if (row < ROW_META) return p.in[1] + (size_t)(row - ROW_SAMPLE) * DM;
    if (row < NVALID) return p.in[8] + (size_t)((row - ROW_META) & 15) * DM;
    return nullptr;
}

namespace pg8 {
constexpr int BM = 256, BK = 64, HALF = 128, HTB = HALF * BK * 2, STAGE_BYTES = 8 * HTB, NXCD = 8, WGM = 8;
__device__ __forceinline__ int lds_byte(int r, int c) { const int st = (r >> 4) * 2 + (c >> 5), rr = r & 15, cc = c & 31, ob = rr * 64 + cc * 2; return st * 1024 + (ob ^ (((ob >> 9) & 1) << 5)); }
__device__ __forceinline__ void stage_rc(int b, int& R, int& C) { const int st = b / 1024, sb = b % 1024, swz = sb ^ (((sb >> 9) & 1) << 5); R = (st >> 1) * 16 + swz / 64; C = (st & 1) * 32 + (swz % 64) / 2; }
__device__ __forceinline__ int perm32(int rho) { const int n = rho >> 4, i = rho & 15; return 8 * (i >> 2) + 4 * n + (i & 3); }
struct Unit { int pm, pn; };
struct Gemm { const bf16_t* A; const bf16_t* Bt; int M, N, K; };
struct StaticOrder {
    int nM, nN, nwg, G, c;
    __device__ void init(int M, int N, int G_, int c_) { nM = M / BM; nN = N / BM; nwg = nM * nN; G = G_; c = c_; }
    __device__ bool next(int i, Unit& u) const {
        const long L = (long)i * G + c; if (L >= nwg) return false;
        int wgid = (int)L; { const int q = nwg / NXCD, r = nwg % NXCD, xcd = wgid % NXCD, off = wgid / NXCD; wgid = (xcd < r ? xcd * (q + 1) : r * (q + 1) + (xcd - r) * q) + off; }
        const int nig = WGM * nN, gid = wgid / nig, fm = gid * WGM, gsz = (nM - fm) < WGM ? (nM - fm) : WGM;
        u.pm = fm + ((wgid % nig) % gsz); u.pn = (wgid % nig) / gsz; return true;
    }
};

template <class Epi>
__device__ __forceinline__ void gemm_phase(LAS unsigned char* lds, const Gemm g, const StaticOrder& S, const Epi& E) {
    const int tid = opaque_tid(), wid = __builtin_amdgcn_readfirstlane(tid >> 6), lane = tid & 63, wr = wid >> 2, wc = wid & 3, fr = lane & 15, fq = lane >> 4;
    const int K = g.K, nt = K / BK;
    unsigned voffA[2], voffB[2];
#pragma unroll
    for (int i = 0; i < 2; ++i) { int R, C; stage_rc(tid * 16 + i * 8192, R, C); const int Rb = ((R & ~31) + perm32(R & 31));
        voffA[i] = (unsigned)(R * K + C) * 2u; voffB[i] = (unsigned)(Rb * K + C) * 2u; }
    const size_t kstep = (size_t)(BK * 2);
    const size_t hstep = (size_t)HALF * K * 2;
    const size_t tstep = 2 * hstep;
    const unsigned ldsw = (unsigned)wid * 1024u;
    const int aoff = lds_byte(wr * 64 + fr, fq * 8), boff = lds_byte(wc * 32 + fr, fq * 8);
#define PG8_SA(b, h) (((b) * 2 + (h)) * HTB)
#define PG8_SB(b, h) ((4 + (b) * 2 + (h)) * HTB)
#define PG8_STAGE(bufoff, gbase, voff) do { _Pragma("unroll") for (int _i = 0; _i < 2; ++_i) \
        __builtin_amdgcn_global_load_lds((const unsigned*)((const char*)(gbase) + (voff)[_i]), (LAS unsigned*)(lds + (bufoff) + ldsw + _i * 8192), 16, 0, 0); } while (0)
#define PG8_LDA(dst, b, h) do { _Pragma("unroll") for (int m = 0; m < 4; ++m) _Pragma("unroll") for (int k = 0; k < 2; ++k) dst[m][k] = *(const LAS bf16x8*)(lds + PG8_SA(b, h) + aoff + m * 2048 + k * 1024); } while (0)
#define PG8_LDB(dst, b, h) do { _Pragma("unroll") for (int n = 0; n < 2; ++n) _Pragma("unroll") for (int k = 0; k < 2; ++k) dst[n][k] = *(const LAS bf16x8*)(lds + PG8_SB(b, h) + boff + n * 2048 + k * 1024); } while (0)
#define PG8_MMA(ai, bj, At, Bt) do { __builtin_amdgcn_s_setprio(1); _Pragma("unroll") for (int m = 0; m < 4; ++m) _Pragma("unroll") for (int n = 0; n < 2; ++n) _Pragma("unroll") for (int k = 0; k < 2; ++k) \
        acc[ai][bj][m][n] = __builtin_amdgcn_mfma_f32_16x16x32_bf16(Bt[n][k], At[m][k], acc[ai][bj][m][n], 0, 0, 0); __builtin_amdgcn_s_setprio(0); } while (0)
#define PG8_WAIT_V(n) asm volatile("s_waitcnt vmcnt(" #n ")" ::: "memory")
#define PG8_WAIT_L(n) asm volatile("s_waitcnt lgkmcnt(" #n ")" ::: "memory")
#define PG8_BAR __builtin_amdgcn_s_barrier()
#define PG8_SCHED __builtin_amdgcn_sched_barrier(0)
    Unit cur, nxt; int ui = 0;
    if (!S.next(0, cur)) return;
    f32x4 acc[2][2][4][2];
#pragma unroll
    for (int a = 0; a < 2; ++a)
#pragma unroll
        for (int b = 0; b < 2; ++b)
#pragma unroll
            for (int m = 0; m < 4; ++m)
#pragma unroll
                for (int n = 0; n < 2; ++n) acc[a][b][m][n] = (f32x4){0.f, 0.f, 0.f, 0.f};
    bf16x8 At[4][2], B0[2][2], B1[2][2];
    const char* cA = (const char*)g.A + (size_t)cur.pm * tstep; const char* cB = (const char*)g.Bt + (size_t)cur.pn * tstep;
    PG8_STAGE(PG8_SB(0, 0), cB, voffB); PG8_STAGE(PG8_SA(0, 0), cA, voffA); PG8_STAGE(PG8_SB(0, 1), cB + hstep, voffB); PG8_STAGE(PG8_SA(0, 1), cA + hstep, voffA);
    if (wr == 1) PG8_BAR;
    PG8_WAIT_V(4); PG8_BAR;
    PG8_STAGE(PG8_SB(1, 0), cB + kstep, voffB); PG8_STAGE(PG8_SA(1, 0), cA + kstep, voffA); PG8_STAGE(PG8_SB(1, 1), cB + hstep + kstep, voffB);
    PG8_WAIT_V(6); PG8_BAR;
    for (;;) {
        const bool has_next = S.next(ui + 1, nxt);
        const char* nA = has_next ? (const char*)g.A + (size_t)nxt.pm * tstep : cA; const char* nB = has_next ? (const char*)g.Bt + (size_t)nxt.pn * tstep : cB;
        for (int t = 0; t < nt; t += 2) {
            const bool last = (t == nt - 2);
            const char* a1 = cA + (size_t)(t + 1) * kstep;
            const char* a2 = last ? nA : cA + (size_t)(t + 2) * kstep; const char* b2 = last ? nB : cB + (size_t)(t + 2) * kstep;
            const char* a3 = a2 + kstep; const char* b3 = b2 + kstep;
            PG8_LDB(B0, 0, 0); PG8_SCHED; PG8_LDA(At, 0, 0); PG8_STAGE(PG8_SA(1, 1), a1 + hstep, voffA);
            PG8_WAIT_L(8); PG8_BAR; PG8_WAIT_L(0); PG8_MMA(0, 0, At, B0); PG8_BAR; PG8_SCHED;
            PG8_LDB(B1, 0, 1); PG8_STAGE(PG8_SB(0, 0), b2, voffB);
            PG8_BAR; PG8_WAIT_L(0); PG8_MMA(0, 1, At, B1); PG8_BAR;
            PG8_LDA(At, 0, 1); PG8_STAGE(PG8_SA(0, 0), a2, voffA);
            PG8_BAR; PG8_WAIT_L(0); PG8_MMA(1, 0, At, B0); PG8_BAR; PG8_SCHED;
            PG8_STAGE(PG8_SB(0, 1), b2 + hstep, voffB);
            PG8_WAIT_V(6); PG8_BAR; PG8_MMA(1, 1, At, B1); PG8_BAR;
            PG8_LDB(B0, 1, 0); PG8_SCHED; PG8_LDA(At, 1, 0); PG8_STAGE(PG8_SA(0, 1), a2 + hstep, voffA);
            PG8_WAIT_L(8); PG8_BAR; PG8_WAIT_L(0); PG8_MMA(0, 0, At, B0); PG8_BAR; PG8_SCHED;
            PG8_LDB(B1, 1, 1); PG8_STAGE(PG8_SB(1, 0), b3, voffB);
            PG8_BAR; PG8_WAIT_L(0); PG8_MMA(0, 1, At, B1); PG8_BAR;
            PG8_LDA(At, 1, 1); PG8_STAGE(PG8_SA(1, 0), a3, voffA);
            PG8_BAR; PG8_WAIT_L(0); PG8_MMA(1, 0, At, B0); PG8_BAR; PG8_SCHED;
            PG8_STAGE(PG8_SB(1, 1), b3 + hstep, voffB);
            PG8_WAIT_V(6); PG8_BAR; PG8_MMA(1, 1, At, B1); PG8_BAR;
        }
        { Unit eu = cur; asm volatile("" : "+s"(eu.pm), "+s"(eu.pn)); E(acc, eu, wr, wc, fr, fq); }
        if (!has_next) break;
#pragma unroll
        for (int a = 0; a < 2; ++a)
#pragma unroll
            for (int b = 0; b < 2; ++b)
#pragma unroll
                for (int m = 0; m < 4; ++m)
#pragma unroll
                    for (int n = 0; n < 2; ++n) acc[a][b][m][n] = (f32x4){0.f, 0.f, 0.f, 0.f};
        cur = nxt; cA = nA; cB = nB; ++ui;
    }
    PG8_WAIT_V(0);
    if (wr == 0) PG8_BAR;
    PG8_BAR;
#undef PG8_SA
#undef PG8_SB
#undef PG8_STAGE
#undef PG8_LDA
#undef PG8_LDB
#undef PG8_MMA
#undef PG8_WAIT_V
#undef PG8_WAIT_L
#undef PG8_BAR
#undef PG8_SCHED
}
}

typedef f32x4 AccT[2][2][4][2];
struct Epi1 {
    bf16_t* U; float* sf;
    __device__ __forceinline__ void operator()(const AccT& acc, const pg8::Unit& u, int wr, int wc, int fr, int fq) const {
        const int row0 = u.pm * 256 + wr * 64 + fr, col0 = u.pn * 256 + wc * 32 + 8 * fq;
        const bool side_dt = (u.pn == 18 && wc == 0), side_if = (u.pn == 34 && wc == 1);
#pragma unroll
        for (int ai = 0; ai < 2; ++ai)
#pragma unroll
            for (int m = 0; m < 4; ++m) {
                const int row = row0 + ai * 128 + m * 16;
                bf16_t* rowp = U + (size_t)row * N1P + col0;
#pragma unroll
                for (int bj = 0; bj < 2; ++bj) {
                    const f32x4 v0 = acc[ai][bj][m][0], v1 = acc[ai][bj][m][1];
                    u32x4 o; o[0] = pack2(v0[0], v0[1]); o[1] = pack2(v0[2], v0[3]); o[2] = pack2(v1[0], v1[1]); o[3] = pack2(v1[2], v1[3]);
                    *(u32x4*)(rowp + bj * 128) = o;
                }
                if (side_dt || side_if) {
                    float* sp = sf + (size_t)row * 64 + (side_if ? 32 : 0) + 8 * fq;
                    *(f32x4*)sp = acc[ai][0][m][0]; *(f32x4*)(sp + 4) = acc[ai][0][m][1];
                }
            }
    }
};
struct Epi2 {
    Params p;
    __device__ __forceinline__ void operator()(const AccT& acc, const pg8::Unit& u, int wr, int wc, int fr, int fq) const {
        float* H1 = (float*)(p.ws + WS_H1); bf16_t* A2 = (bf16_t*)(p.ws + WS_A2); float* SS2 = (float*)(p.ws + WS_SS2);
        const float* nw = p.in[21];
        const int row0 = u.pm * 256 + wr * 64 + fr, col0 = u.pn * 256 + wc * 32 + 8 * fq;
        f32x4 w[2][2];
#pragma unroll
        for (int bj = 0; bj < 2; ++bj) { w[bj][0] = *(const f32x4*)(nw + col0 + bj * 128); w[bj][1] = *(const f32x4*)(nw + col0 + bj * 128 + 4); }
#pragma unroll
        for (int ai = 0; ai < 2; ++ai)
#pragma unroll
            for (int m = 0; m < 4; ++m) {
                const int row = row0 + ai * 128 + m * 16;
                const float* rp = resid_row(p, row);
                float ss = 0.f;
#pragma unroll
                for (int bj = 0; bj < 2; ++bj) {
                    f32x4 v0 = acc[ai][bj][m][0], v1 = acc[ai][bj][m][1];
                    if (rp) { v0 += *(const f32x4*)(rp + col0 + bj * 128); v1 += *(const f32x4*)(rp + col0 + bj * 128 + 4); }
                    *(f32x4*)(H1 + (size_t)row * DM + col0 + bj * 128) = v0; *(f32x4*)(H1 + (size_t)row * DM + col0 + bj * 128 + 4) = v1;
                    ss += v0[0] * v0[0] + v0[1] * v0[1] + v0[2] * v0[2] + v0[3] * v0[3] + v1[0] * v1[0] + v1[1] * v1[1] + v1[2] * v1[2] + v1[3] * v1[3];
                    const f32x4 a0 = v0 * w[bj][0], a1 = v1 * w[bj][1];
                    u32x4 o; o[0] = pack2(a0[0], a0[1]); o[1] = pack2(a0[2], a0[3]); o[2] = pack2(a1[0], a1[1]); o[3] = pack2(a1[2], a1[3]);
                    *(u32x4*)(A2 + (size_t)row * DM + col0 + bj * 128) = o;
                }
                ss += __shfl_xor(ss, 16); ss += __shfl_xor(ss, 32);
                if (fq == 0) atomicAdd(SS2 + row, ss);
            }
    }
};
struct Epi3 {
    bf16_t* UP; const float* SS2;
    __device__ __forceinline__ void operator()(const AccT& acc, const pg8::Unit& u, int wr, int wc, int fr, int fq) const {
        const int row0 = u.pm * 256 + wr * 64 + fr, col0 = u.pn * 256 + wc * 32 + 8 * fq;
#pragma unroll
        for (int ai = 0; ai < 2; ++ai)
#pragma unroll
            for (int m = 0; m < 4; ++m) {
                const int row = row0 + ai * 128 + m * 16;
                const float r2 = rsqrtf(SS2[row] * (1.f / 2048.f) + EPS);
                bf16_t* rowp = UP + (size_t)row * N3 + col0;
#pragma unroll
                for (int bj = 0; bj < 2; ++bj) {
                    const f32x4 v0 = acc[ai][bj][m][0] * r2, v1 = acc[ai][bj][m][1] * r2;
                    u32x4 o; o[0] = pack2(v0[0], v0[1]); o[1] = pack2(v0[2], v0[3]); o[2] = pack2(v1[0], v1[1]); o[3] = pack2(v1[2], v1[3]);
                    *(u32x4*)(rowp + bj * 128) = o;
                }
            }
    }
};
struct Epi4 {
    const float* H1; float* out; float* SS3;
    __device__ __forceinline__ void operator()(const AccT& acc, const pg8::Unit& u, int wr, int wc, int fr, int fq) const {
        const int row0 = u.pm * 256 + wr * 64 + fr, col0 = u.pn * 256 + wc * 32 + 8 * fq;
#pragma unroll
        for (int ai = 0; ai < 2; ++ai)
#pragma unroll
            for (int m = 0; m < 4; ++m) {
                const int row = row0 + ai * 128 + m * 16;
                if (row < NOUTROWS) {
                    float ss = 0.f;
#pragma unroll
                    for (int bj = 0; bj < 2; ++bj) {
                        const f32x4 v0 = acc[ai][bj][m][0] + *(const f32x4*)(H1 + (size_t)row * DM + col0 + bj * 128);
                        const f32x4 v1 = acc[ai][bj][m][1] + *(const f32x4*)(H1 + (size_t)row * DM + col0 + bj * 128 + 4);
                        *(f32x4*)(out + (size_t)row * DM + col0 + bj * 128) = v0; *(f32x4*)(out + (size_t)row * DM + col0 + bj * 128 + 4) = v1;
                        ss += v0[0] * v0[0] + v0[1] * v0[1] + v0[2] * v0[2] + v0[3] * v0[3] + v1[0] * v1[0] + v1[1] * v1[1] + v1[2] * v1[2] + v1[3] * v1[3];
                    }
                    ss += __shfl_xor(ss, 16); ss += __shfl_xor(ss, 32);
                    if (fq == 0) atomicAdd(SS3 + row, ss);
                }
            }
    }
};

struct TileRef { const float* W; bf16_t* WT; int K, N, kt, nt; };
__device__ __forceinline__ TileRef tile_ref(const Params& p, int t) {
    constexpr int T_IN = 32 * 43, T_OUT = 64 * 8, T_UP = 32 * 44;
    TileRef r;
    if (t < T_IN) { r.W = p.in[10]; r.WT = (bf16_t*)(p.ws + WS_WIN); r.K = 2048; r.N = 10800; r.kt = t % 32; r.nt = t / 32; }
    else if (t < T_IN + T_OUT) { const int q = t - T_IN; r.W = p.in[20]; r.WT = (bf16_t*)(p.ws + WS_WOUT); r.K = 4096; r.N = 2048; r.kt = q % 64; r.nt = q / 64; }
    else if (t < T_IN + T_OUT + T_UP) { const int q = t - T_IN - T_OUT; r.W = p.in[22]; r.WT = (bf16_t*)(p.ws + WS_WUP); r.K = 2048; r.N = N3; r.kt = q % 32; r.nt = q / 32; }
    else { const int q = t - T_IN - T_OUT - T_UP; r.W = p.in[25]; r.WT = (bf16_t*)(p.ws + WS_WDOWN); r.K = DFF; r.N = 2048; r.kt = q % 88; r.nt = q / 88; }
    return r;
}
__device__ __forceinline__ void tile_load(const TileRef& r, f32x4 (&v)[8], int tid) {
    const int nc = (tid & 63) * 4, n = r.nt * 256 + nc;
#pragma unroll
    for (int i = 0; i < 8; ++i) {
        const int kr = (tid >> 6) + 8 * i;
        v[i] = (f32x4){0.f, 0.f, 0.f, 0.f};
        if (n < r.N) v[i] = *(const f32x4*)(r.W + (size_t)(r.kt * 64 + kr) * r.N + n);
    }
}
__device__ __forceinline__ void tile_lds_write(const f32x4 (&v)[8], int tid, unsigned char* smem) {
    float* tile = (float*)smem;
    const int nc = (tid & 63) * 4;
#pragma unroll
    for (int i = 0; i < 8; ++i) {
        const int kr = (tid >> 6) + 8 * i;
        tile[kr * 257 + nc] = v[i][0]; tile[kr * 257 + nc + 1] = v[i][1]; tile[kr * 257 + nc + 2] = v[i][2]; tile[kr * 257 + nc + 3] = v[i][3];
    }
}
__device__ __forceinline__ void tile_store(const TileRef& r, int tid, unsigned char* smem) {
    const float* tile = (const float*)smem;
    const int kc = (tid & 7) * 8;
#pragma unroll
    for (int q = 0; q < 4; ++q) {
        const int nr = (tid >> 3) + 64 * q;
        u32x4 o;
        o[0] = pack2(tile[(kc + 0) * 257 + nr], tile[(kc + 1) * 257 + nr]); o[1] = pack2(tile[(kc + 2) * 257 + nr], tile[(kc + 3) * 257 + nr]);
        o[2] = pack2(tile[(kc + 4) * 257 + nr], tile[(kc + 5) * 257 + nr]); o[3] = pack2(tile[(kc + 6) * 257 + nr], tile[(kc + 7) * 257 + nr]);
        *(u32x4*)(r.WT + (size_t)(r.nt * 256 + nr) * r.K + r.kt * 64 + kc) = o;
    }
}
__device__ __forceinline__ void phase_prep(const Params& p, unsigned char* smem) {
    const int tid = opaque_tid(), wid = tid >> 6, lane = tid & 63;
    { float* SS2 = (float*)(p.ws + WS_SS2); for (int i = opaque_bid() * 512 + tid; i < 2 * MP; i += gridDim.x * 512) SS2[i] = 0.f; }
    {
        bf16_t* XN = (bf16_t*)(p.ws + WS_XN); const float* nw = p.in[9];
        for (int row = opaque_bid() * 8 + wid; row < MP; row += gridDim.x * 8) {
            const float* src = resid_row(p, row);
            f32x4 v[8];
            float ss = 0.f;
#pragma unroll
            for (int it = 0; it < 4; ++it) {
                const int col = it * 512 + lane * 8;
                if (src) { v[2 * it] = *(const f32x4*)(src + col); v[2 * it + 1] = *(const f32x4*)(src + col + 4); }
                else { v[2 * it] = (f32x4){0.f, 0.f, 0.f, 0.f}; v[2 * it + 1] = (f32x4){0.f, 0.f, 0.f, 0.f}; }
#pragma unroll
                for (int j = 0; j < 4; ++j) ss += v[2 * it][j] * v[2 * it][j] + v[2 * it + 1][j] * v[2 * it + 1][j];
            }
            ss = wave_sum(ss);
            const float r = rsqrtf(ss * (1.f / 2048.f) + EPS);
#pragma unroll
            for (int it = 0; it < 4; ++it) {
                const int col = it * 512 + lane * 8;
                const f32x4 w0 = *(const f32x4*)(nw + col), w1 = *(const f32x4*)(nw + col + 4);
                const f32x4 a = v[2 * it] * r * w0, c = v[2 * it + 1] * r * w1;
                u32x4 o; o[0] = pack2(a[0], a[1]); o[1] = pack2(a[2], a[3]); o[2] = pack2(c[0], c[1]); o[3] = pack2(c[2], c[3]);
                *(u32x4*)(XN + (size_t)row * DM + col) = o;
            }
        }
    }
    constexpr int T_ALL = 32 * 43 + 64 * 8 + 32 * 44 + 88 * 8;
    {
        int t = opaque_bid();
        f32x4 v[8];
        TileRef cur{};
        if (t < T_ALL) { cur = tile_ref(p, t); tile_load(cur, v, tid); }
        while (t < T_ALL) {
            tile_lds_write(v, tid, smem);
            __syncthreads();
            const int tn = t + gridDim.x;
            TileRef nxt{};
            if (tn < T_ALL) { nxt = tile_ref(p, tn); tile_load(nxt, v, tid); }
            tile_store(cur, tid, smem);
            __syncthreads();
            cur = nxt; t = tn;
        }
    }
}

constexpr int RS = 272;
constexpr int L_QS = 0, L_KS = 34816, L_KT = 69632, L_VT = 104448, L_ST = 121856, L_SC = 139264;

template <bool ML>
__device__ __forceinline__ void load_block(const Params& p, float (&val)[8][4], int b, int p0, int Lv, int rb, int cg, int colbase, int chbase, float mlscale) {
    const bf16_t* U = (const bf16_t*)(p.ws + WS_U);
    const int t0 = rb * 8;
    if (t0 >= Lv) {
#pragma unroll
        for (int r = 0; r < 8; ++r)
#pragma unroll
            for (int i = 0; i < 4; ++i) val[r][i] = 0.f;
        return;
    }
    if (ML) {
#pragma unroll
        for (int r = 0; r < 8; ++r) {
            const int row = row_of(b, p0 + t0 + r);
            const u32x2 raw = *(const u32x2*)(U + (size_t)row * N1P + colbase + cg * 4);
            val[r][0] = bf_lo(raw[0]) * mlscale; val[r][1] = bf_hi(raw[0]) * mlscale; val[r][2] = bf_lo(raw[1]) * mlscale; val[r][3] = bf_hi(raw[1]) * mlscale;
        }
    } else {
        u32x2 raw[11];
#pragma unroll
        for (int rr = 0; rr < 11; ++rr) {
            const int pos = p0 + t0 - 3 + rr;
            if (pos >= 0) raw[rr] = *(const u32x2*)(U + (size_t)row_of(b, pos) * N1P + colbase + cg * 4);
            else raw[rr] = (u32x2){0u, 0u};
        }
        const float* cw = p.in[11]; const float* cb = p.in[12];
        const int ch = chbase + cg * 4;
        f32x4 w[4];
#pragma unroll
        for (int j = 0; j < 4; ++j) w[j] = *(const f32x4*)(cw + j * 2560 + ch);
        const f32x4 bi = *(const f32x4*)(cb + ch);
#pragma unroll
        for (int i = 0; i < 4; ++i) {
            float x[11];
#pragma unroll
            for (int rr = 0; rr < 11; ++rr) x[rr] = (i & 1) ? bf_hi(raw[rr][i >> 1]) : bf_lo(raw[rr][i >> 1]);
#pragma unroll
            for (int r = 0; r < 8; ++r) val[r][i] = silu_f(bi[i] + w[0][i] * x[r] + w[1][i] * x[r + 1] + w[2][i] * x[r + 2] + w[3][i] * x[r + 3]);
        }
    }
}
__device__ __forceinline__ void store_rows(unsigned char* base, const float (&val)[8][4], int rb, int cg) {
#pragma unroll
    for (int r = 0; r < 8; ++r) *(u32x2*)(base + (rb * 8 + r) * RS + cg * 8) = (u32x2){pack2(val[r][0], val[r][1]), pack2(val[r][2], val[r][3])};
}
__device__ __forceinline__ void store_cols(unsigned char* base, const float (&val)[8][4], int rb, int cg, const float* scale) {
    float s[8];
#pragma unroll
    for (int r = 0; r < 8; ++r) s[r] = scale ? scale[rb * 8 + r] : 1.f;
#pragma unroll
    for (int i = 0; i < 4; ++i) {
        const int row = cg * 4 + i;
        u32x4 o; o[0] = pack2(val[0][i] * s[0], val[1][i] * s[1]); o[1] = pack2(val[2][i] * s[2], val[3][i] * s[3]);
        o[2] = pack2(val[4][i] * s[4], val[5][i] * s[5]); o[3] = pack2(val[6][i] * s[6], val[7][i] * s[7]);
        *(u32x4*)(base + row * RS + ((rb ^ ((row >> 3) & 7)) << 4)) = o;
    }
}

template <bool ML>
__device__ __forceinline__ void prompt_scan(const Params& p, unsigned char* smem, int job) {
    const int tid = opaque_tid(), wid = __builtin_amdgcn_readfirstlane(tid >> 6), lane = tid & 63, fr = lane & 15, fq = lane >> 4;
    int b, h, vq = 0;
    if (ML) { b = job >> 5; h = (job >> 2) & 7; vq = job & 3; } else { b = job >> 5; h = job & 31; }
    const int g = h >> 4;
    const bf16_t* U = (const bf16_t*)(p.ws + WS_U);
    const float* SF = (const float*)(p.ws + WS_SF);
    bf16_t* MIX = (bf16_t*)(p.ws + WS_MIX);
    float* scb = (float*)(smem + L_SC);
    float *qn = scb + 1600, *nvec = scb + 1728, *mpp = scb + 1856;
    const int qcol = ML ? UC_Q + h * 128 : UC_XBC + 2304 + g * 128;
    const int kcol = ML ? UC_K + h * 128 : UC_XBC + 2048 + g * 128;
    const int vcol = ML ? UC_V + h * 256 + vq * 64 : UC_XBC + h * 64;
    const int gcol = ML ? UC_O + h * 256 + vq * 64 : UC_Z + h * 64;
    const int mixcol = ML ? 2048 + h * 256 + vq * 64 : h * 64;
    float A_h = 0.f, D_h = 0.f, dtb = 0.f, ib = 0.f, fb = 0.f;
    if (ML) { ib = p.in[17][h]; fb = p.in[18][h]; } else { A_h = -__expf(p.in[14][h]); D_h = p.in[15][h]; dtb = p.in[13][h]; }
    f32x4 st[4];
#pragma unroll
    for (int i = 0; i < 4; ++i) st[i] = (f32x4){0.f, 0.f, 0.f, 0.f};
    for (int i = tid; i < 64 * RS / 16; i += 512) *(u32x4*)(smem + L_ST + i * 16) = (u32x4){0u, 0u, 0u, 0u};
    if (tid < 128) nvec[tid] = 0.f;
    if (tid == 0) mpp[0] = 0.f;
    constexpr int CHLs = ML ? CHL_ML : CHL_SSD;
    auto scalars = [&](int cc) {
        const int p0 = cc == 0 ? 0 : 16 + (cc - 1) * CHLs, Lv = cc == 0 ? 16 : CHLs;
        float* sc = scb + (cc & 1) * 800;
        float *rowv = sc, *colv = sc + 128, *colm = sc + 256, *ev = sc + 384, *scv = sc + 512, *dden = sc + 640, *misc = sc + 768;
        const int t0 = 2 * lane, t1 = t0 + 1;
        if (!ML) {
            float d0 = 0.f, d1 = 0.f;
            if (t0 < Lv) d0 = softplus_f(SF[(size_t)row_of(b, p0 + t0) * 64 + h] + dtb);
            if (t1 < Lv) d1 = softplus_f(SF[(size_t)row_of(b, p0 + t1) * 64 + h] + dtb);
            const float a0 = d0 * A_h, a1 = d1 * A_h;
            float inc = a0 + a1;
#pragma unroll
            for (int o = 1; o < 64; o <<= 1) { const float y = __shfl_up(inc, o); if (lane >= o) inc += y; }
            const float c1 = inc, c0 = inc - a1, cl = __shfl(inc, 63);
            rowv[t0] = c0; rowv[t1] = c1; colv[t0] = -c0; colv[t1] = -c1; colm[t0] = d0; colm[t1] = d1;
            ev[t0] = __expf(c0); ev[t1] = __expf(c1); scv[t0] = __expf(cl - c0) * d0; scv[t1] = __expf(cl - c1) * d1;
            if (lane == 0) misc[0] = __expf(cl);
        } else {
            float i0 = -INFINITY, i1 = -INFINITY, f0 = 0.f, f1 = 0.f;
            if (t0 < Lv) { const size_t r = (size_t)row_of(b, p0 + t0) * 64; i0 = SF[r + 32 + h] + ib; f0 = logsig_f(SF[r + 40 + h] + fb); }
            if (t1 < Lv) { const size_t r = (size_t)row_of(b, p0 + t1) * 64; i1 = SF[r + 32 + h] + ib; f1 = logsig_f(SF[r + 40 + h] + fb); }
            float inc = f0 + f1;
#pragma unroll
            for (int o = 1; o < 64; o <<= 1) { const float y = __shfl_up(inc, o); if (lane >= o) inc += y; }
            const float F1 = inc, F0 = inc - f1;
            const float g0 = i0 - F0, g1 = i1 - F1;
            float mx = fmaxf(g0, g1);
#pragma unroll
            for (int o = 1; o < 64; o <<= 1) { const float y = __shfl_up(mx, o); if (lane >= o) mx = fmaxf(mx, y); }
            float ex = __shfl_up(mx, 1); if (lane == 0) ex = -INFINITY;
            const float mp = mpp[0];
            const float M0 = fmaxf(fmaxf(ex, g0), mp), M1 = fmaxf(mx, mp);
            const float Ml = __shfl(M1, 63), Fl = __shfl(F1, 63);
            rowv[t0] = -M0; rowv[t1] = -M1; colv[t0] = g0; colv[t1] = g1; colm[t0] = 1.f; colm[t1] = 1.f;
            ev[t0] = __expf(mp - M0); ev[t1] = __expf(mp - M1); dden[t0] = __expf(-(F0 + M0)); dden[t1] = __expf(-(F1 + M1));
            scv[t0] = __expf(g0 - Ml); scv[t1] = __expf(g1 - Ml);
            if (lane == 0) { misc[0] = __expf(mp - Ml); mpp[0] = Fl + Ml; }
        }
    };
    __syncthreads();
    if (wid == 0) scalars(0);
    __syncthreads();
    constexpr int CHL = ML ? CHL_ML : CHL_SSD, NCH = 1 + 2048 / CHL;
    const int tid_outer = tid;
    for (int c = 0; c < NCH; ++c) {
        int tid = tid_outer; asm volatile("" : "+v"(tid));
        const int lane = tid & 63, fr = lane & 15, fq = lane >> 4;
        const int p0 = c == 0 ? 0 : 16 + (c - 1) * CHL, Lv = c == 0 ? 16 : CHL;
        float* sc = scb + (c & 1) * 800;
        float *rowv = sc, *colv = sc + 128, *colm = sc + 256, *ev = sc + 384, *scv = sc + 512, *dden = sc + 640, *misc = sc + 768;
        if (wid == 0 && c + 1 < NCH) scalars(c + 1);
        {
            float val[8][4];
            load_block<ML>(p, val, b, p0, Lv, tid >> 5, tid & 31, qcol, 2304 + g * 128, 1.f);
            store_rows(smem + L_QS, val, tid >> 5, tid & 31);
            __builtin_amdgcn_sched_barrier(0);
            load_block<ML>(p, val, b, p0, Lv, tid >> 5, tid & 31, kcol, 2048 + g * 128, 0.08838834764831845f);
            store_rows(smem + L_KS, val, tid >> 5, tid & 31);
            store_cols(smem + L_KT, val, tid >> 5, tid & 31, scv);
            __builtin_amdgcn_sched_barrier(0);
            if (tid < 256) {
                load_block<ML>(p, val, b, p0, Lv, tid >> 4, tid & 15, vcol, h * 64, 1.f);
                store_cols(smem + L_VT, val, tid >> 4, tid & 15, nullptr);
            }
        }
        __syncthreads();
        const int t = 16 * wid + fr;
        const bool valid = t < Lv;
        const int row = row_of(b, p0 + (valid ? t : 0));
        u32x2 gate[4];
#pragma unroll
        for (int vb = 0; vb < 4; ++vb) gate[vb] = *(const u32x2*)(U + (size_t)row * N1P + gcol + 16 * vb + 4 * fq);
        if (ML) {
            const int tt = tid >> 2, part = tid & 3;
            float s = 0.f;
#pragma unroll
            for (int cc = 0; cc < 4; ++cc) {
                const u32x4 raw = *(const u32x4*)(smem + L_QS + tt * RS + (part * 4 + cc) * 16);
                const f32x4 n0 = *(const f32x4*)(nvec + (part * 4 + cc) * 8), n1 = *(const f32x4*)(nvec + (part * 4 + cc) * 8 + 4);
                s += bf_lo(raw[0]) * n0[0] + bf_hi(raw[0]) * n0[1] + bf_lo(raw[1]) * n0[2] + bf_hi(raw[1]) * n0[3]
                   + bf_lo(raw[2]) * n1[0] + bf_hi(raw[2]) * n1[1] + bf_lo(raw[3]) * n1[2] + bf_hi(raw[3]) * n1[3];
            }
            s += __shfl_xor(s, 1); s += __shfl_xor(s, 2);
            if (part == 0) qn[tt] = s;
        }
        bf16x8 qf[4];
#pragma unroll
        for (int kk = 0; kk < 4; ++kk) qf[kk] = *(const bf16x8*)(smem + L_QS + t * RS + (kk * 32 + fq * 8) * 2);
        const float rv = rowv[t];
        float rowsum = 0.f;
        u32x2 pk[8];
#pragma unroll
        for (int sb = 0; sb < 8; ++sb) {
            pk[sb] = (u32x2){0u, 0u};
            if (sb <= wid) {
                f32x4 acc = {0.f, 0.f, 0.f, 0.f};
#pragma unroll
                for (int kk = 0; kk < 4; ++kk) {
                    const bf16x8 kf = *(const bf16x8*)(smem + L_KS + (16 * sb + fr) * RS + (kk * 32 + fq * 8) * 2);
                    acc = __builtin_amdgcn_mfma_f32_16x16x32_bf16(kf, qf[kk], acc, 0, 0, 0);
                }
                const f32x4 cv = *(const f32x4*)(colv + 16 * sb + 4 * fq), cm = *(const f32x4*)(colm + 16 * sb + 4 * fq);
                float pv[4];
#pragma unroll
                for (int j = 0; j < 4; ++j) {
                    const int s = 16 * sb + 4 * fq + j;
                    const float w = (s <= t) ? __expf(rv + cv[j]) * cm[j] : 0.f;
                    pv[j] = acc[j] * w; rowsum += pv[j];
                }
                pk[sb] = (u32x2){pack2(pv[0], pv[1]), pack2(pv[2], pv[3])};
            }
        }
        __syncthreads();
#pragma unroll
        for (int sb = 0; sb < 8; ++sb) *(u32x2*)(smem + L_KS + t * RS + (16 * sb + 4 * fq) * 2) = pk[sb];
        rowsum += __shfl_xor(rowsum, 16); rowsum += __shfl_xor(rowsum, 32);
        if (ML) {
            const int d = tid >> 2, part = tid & 3;
            float s = 0.f;
#pragma unroll
            for (int cc = 0; cc < 4; ++cc) {
                const u32x4 raw = *(const u32x4*)(smem + L_KT + d * RS + (part * 4 + cc) * 16);
                s += bf_lo(raw[0]) + bf_hi(raw[0]) + bf_lo(raw[1]) + bf_hi(raw[1]) + bf_lo(raw[2]) + bf_hi(raw[2]) + bf_lo(raw[3]) + bf_hi(raw[3]);
            }
            s += __shfl_xor(s, 1); s += __shfl_xor(s, 2);
            if (part == 0) nvec[d] = misc[0] * nvec[d] + s;
        }
        __syncthreads();
        bf16x8 pf[4];
#pragma unroll
        for (int kk = 0; kk < 4; ++kk) pf[kk] = *(const bf16x8*)(smem + L_KS + t * RS + (kk * 32 + fq * 8) * 2);
        const float et = ev[t];
        float ddv = 1.f;
        if (ML) ddv = fmaxf(fabsf(rowsum + et * qn[t]), dden[t]);
        float ss = 0.f;
#pragma unroll
        for (int vb = 0; vb < 4; ++vb) {
            f32x4 acc = {0.f, 0.f, 0.f, 0.f};
            const int vrow = 16 * vb + fr;
#pragma unroll
            for (int kk = 0; kk < 4; ++kk) {
                const bf16x8 sf = *(const bf16x8*)(smem + L_ST + vrow * RS + (kk * 32 + fq * 8) * 2);
                acc = __builtin_amdgcn_mfma_f32_16x16x32_bf16(sf, qf[kk], acc, 0, 0, 0);
            }
            acc *= et;
#pragma unroll
            for (int kk = 0; kk < 4; ++kk) {
                const bf16x8 vf = *(const bf16x8*)(smem + L_VT + vrow * RS + (((kk * 4 + fq) ^ ((vrow >> 3) & 7)) << 4));
                acc = __builtin_amdgcn_mfma_f32_16x16x32_bf16(vf, pf[kk], acc, 0, 0, 0);
            }
            const float gz[4] = {bf_lo(gate[vb][0]), bf_hi(gate[vb][0]), bf_lo(gate[vb][1]), bf_hi(gate[vb][1])};
            float o[4];
#pragma unroll
            for (int j = 0; j < 4; ++j) {
                if (ML) { const float hv = acc[j]; ss += hv * hv; o[j] = hv * sigm_f(gz[j]); }
                else {
                    const int v = 16 * vb + 4 * fq + j;
                    const float xv = bf2f(*(const bf16_t*)(smem + L_VT + v * RS + (((t >> 3) ^ ((v >> 3) & 7)) << 4) + (t & 7) * 2));
                    const float y = (acc[j] + D_h * xv) * silu_f(gz[j]); ss += y * y; o[j] = y;
                }
            }
            if (valid) *(u32x2*)(MIX + (size_t)row * MIXW + mixcol + 16 * vb + 4 * fq) = (u32x2){pack2(o[0], o[1]), pack2(o[2], o[3])};
        }
        ss += __shfl_xor(ss, 16); ss += __shfl_xor(ss, 32);
        if (valid && fq == 0) {
            if (ML) { ((float*)(p.ws + WS_SSQM))[(size_t)row * 32 + h * 4 + vq] = ss; if (vq == 0) ((float*)(p.ws + WS_DD))[(size_t)row * 8 + h] = ddv; }
            else ((float*)(p.ws + WS_SSQ))[(size_t)row * 32 + h] = ss;
        }
        const float dec = misc[0];
#pragma unroll
        for (int vb = 0; vb < 4; ++vb) st[vb] *= dec;
#pragma unroll
        for (int kk = 0; kk < 4; ++kk) {
            const int drow = 16 * wid + fr;
            const bf16x8 kf = *(const bf16x8*)(smem + L_KT + drow * RS + (((kk * 4 + fq) ^ ((drow >> 3) & 7)) << 4));
#pragma unroll
            for (int vb = 0; vb < 4; ++vb) {
                const int vrow = 16 * vb + fr;
                const bf16x8 vf = *(const bf16x8*)(smem + L_VT + vrow * RS + (((kk * 4 + fq) ^ ((vrow >> 3) & 7)) << 4));
                st[vb] = __builtin_amdgcn_mfma_f32_16x16x32_bf16(kf, vf, st[vb], 0, 0, 0);
            }
        }
        __syncthreads();
#pragma unroll
        for (int vb = 0; vb < 4; ++vb)
            *(u32x2*)(smem + L_ST + (16 * vb + fr) * RS + (16 * wid + 4 * fq) * 2) = (u32x2){pack2(st[vb][0], st[vb][1]), pack2(st[vb][2], st[vb][3])};
    }
#pragma unroll
    for (int vb = 0; vb < 4; ++vb) {
        const int v = 16 * vb + fr, d0 = 16 * wid + 4 * fq;
        if (!ML) *(f32x4*)(p.out + O_P_SSD + ((size_t)(b * 32 + h) * 64 + v) * 128 + d0) = st[vb];
        else {
#pragma unroll
            for (int j = 0; j < 4; ++j) p.out[O_P_MLC + ((size_t)(b * 8 + h) * 128 + d0 + j) * 256 + vq * 64 + v] = st[vb][j];
        }
    }
    if (ML && vq == 0) {
        if (tid < 128) p.out[O_P_MLN + (size_t)(b * 8 + h) * 128 + tid] = nvec[tid];
        if (tid == 0) p.out[O_P_MLM + b * 8 + h] = mpp[0];
    }
    __syncthreads();
}

__device__ __forceinline__ void sample_ssd(const Params& p, unsigned char* smem, int job) {
    const int tid = opaque_tid(), wid = tid >> 6, lane = tid & 63;
    const int b = job >> 1, g = job & 1, rowb = ROW_SAMPLE + b * 8;
    const bf16_t* U = (const bf16_t*)(p.ws + WS_U);
    const float* SF = (const float*)(p.ws + WS_SF);
    bf16_t* MIX = (bf16_t*)(p.ws + WS_MIX);
    float* Bc = (float*)smem; float* Cc = Bc + 1024; float* xall = Cc + 1024; float* G = xall + 8192; float* dts = G + 64; float* ssqp = dts + 128;
    const float* sconv = p.in[2]; const float* cw = p.in[11]; const float* cb = p.in[12];
#pragma unroll
    for (int q = 0; q < 3; ++q) {
        int ch; float* dst; int dstride = 0;
        if (q < 2) { ch = g * 1024 + tid + q * 512; dst = xall + tid + q * 512; dstride = 1024; }
        else { if (tid >= 256) break; const int which = tid >> 7, n = tid & 127; ch = 2048 + which * 256 + g * 128 + n; dst = (which ? Cc : Bc) + n; dstride = 128; }
        float xm3 = sconv[(size_t)(b * 3 + 0) * 2560 + ch], xm2 = sconv[(size_t)(b * 3 + 1) * 2560 + ch], xm1 = sconv[(size_t)(b * 3 + 2) * 2560 + ch];
        const float w0 = cw[ch], w1 = cw[2560 + ch], w2 = cw[5120 + ch], w3 = cw[7680 + ch], bb = cb[ch];
#pragma unroll
        for (int t = 0; t < 8; ++t) {
            const float x = bf2f(U[(size_t)(rowb + t) * N1P + UC_XBC + ch]);
            dst[t * dstride] = silu_f(bb + w0 * xm3 + w1 * xm2 + w2 * xm1 + w3 * x);
            xm3 = xm2; xm2 = xm1; xm1 = x;
        }
    }
    if (tid < 128) { const int hh = tid >> 3, t = tid & 7; dts[tid] = softplus_f(SF[(size_t)(rowb + t) * 64 + g * 16 + hh] + p.in[13][g * 16 + hh]); }
    __syncthreads();
    {
        const int pair = tid >> 3, part = tid & 7, t = pair >> 3, s = pair & 7;
        float sum = 0.f;
#pragma unroll
        for (int i = 0; i < 4; ++i) {
            const f32x4 c4 = *(const f32x4*)(Cc + t * 128 + part * 16 + i * 4), b4 = *(const f32x4*)(Bc + s * 128 + part * 16 + i * 4);
            sum += c4[0] * b4[0] + c4[1] * b4[1] + c4[2] * b4[2] + c4[3] * b4[3];
        }
        sum += __shfl_xor(sum, 1); sum += __shfl_xor(sum, 2); sum += __shfl_xor(sum, 4);
        if (part == 0) G[pair] = sum;
    }
    __syncthreads();
    const int pp = tid >> 3, nq = tid & 7;
    f32x4 snext[4];
#pragma unroll
    for (int i = 0; i < 4; ++i) snext[i] = *(const f32x4*)(p.in[3] + ((size_t)(b * 32 + g * 16) * 64 + pp) * 128 + nq * 4 + 32 * i);
    for (int hh = 0; hh < 16; ++hh) {
        const int h = g * 16 + hh;
        const float A_h = -__expf(p.in[14][h]), D_h = p.in[15][h];
        float dtv[8], cum[8];
        { float run = 0.f;
#pragma unroll
          for (int t = 0; t < 8; ++t) { dtv[t] = dts[hh * 8 + t]; run += dtv[t] * A_h; cum[t] = run; } }
        const size_t soff = ((size_t)(b * 32 + h) * 64 + pp) * 128 + nq * 4;
        f32x4 s0[4];
#pragma unroll
        for (int i = 0; i < 4; ++i) s0[i] = snext[i];
        if (hh + 1 < 16) {
#pragma unroll
            for (int i = 0; i < 4; ++i) snext[i] = *(const f32x4*)(p.in[3] + soff + 64 * 128 + 32 * i);
        }
        float cs[8];
#pragma unroll
        for (int t = 0; t < 8; ++t) {
            float sum = 0.f;
#pragma unroll
            for (int i = 0; i < 4; ++i) { const f32x4 c4 = *(const f32x4*)(Cc + t * 128 + nq * 4 + 32 * i); sum += c4[0] * s0[i][0] + c4[1] * s0[i][1] + c4[2] * s0[i][2] + c4[3] * s0[i][3]; }
            sum += __shfl_xor(sum, 1); sum += __shfl_xor(sum, 2); sum += __shfl_xor(sum, 4);
            cs[t] = sum;
        }
        float ycs = 0.f, ct = 0.f;
#pragma unroll
        for (int t = 0; t < 8; ++t) { ycs = (nq == t) ? cs[t] : ycs; ct = (nq == t) ? cum[t] : ct; }
        float y = __expf(ct) * ycs, xt = 0.f;
#pragma unroll
        for (int s = 0; s < 8; ++s) {
            const float xs = xall[s * 1024 + hh * 64 + pp];
            const float term = (s <= nq) ? G[nq * 8 + s] * __expf(ct - cum[s]) * dtv[s] * xs : 0.f;
            y += term; xt = (s == nq) ? xs : xt;
        }
        y += D_h * xt;
        const float z = bf2f(U[(size_t)(rowb + nq) * N1P + UC_Z + h * 64 + pp]);
        y *= silu_f(z);
        { const unsigned pk = pack2(y, 0.f); MIX[(size_t)(rowb + nq) * MIXW + h * 64 + pp] = (bf16_t)(pk & 0xffffu); }
        float sq = y * y; sq += __shfl_xor(sq, 8); sq += __shfl_xor(sq, 16); sq += __shfl_xor(sq, 32);
        if (lane < 8) ssqp[(hh * 8 + wid) * 8 + lane] = sq;
        const float cl = cum[7], dec = __expf(cl);
        float xw[8];
#pragma unroll
        for (int s = 0; s < 8; ++s) xw[s] = __expf(cl - cum[s]) * dtv[s] * xall[s * 1024 + hh * 64 + pp];
#pragma unroll
        for (int i = 0; i < 4; ++i) {
            f32x4 acc = s0[i] * dec;
#pragma unroll
            for (int s = 0; s < 8; ++s) acc += xw[s] * *(const f32x4*)(Bc + s * 128 + nq * 4 + 32 * i);
            *(f32x4*)(p.out + O_S_SSD + soff + 32 * i) = acc;
        }
    }
    __syncthreads();
    if (tid < 128) {
        const int hh = tid >> 3, t = tid & 7; float tot = 0.f;
#pragma unroll
        for (int w = 0; w < 8; ++w) tot += ssqp[(hh * 8 + w) * 8 + t];
        ((float*)(p.ws + WS_SSQ))[(size_t)(rowb + t) * 32 + g * 16 + hh] = tot;
    }
    __syncthreads();
}

__device__ __forceinline__ void sample_ml(const Params& p, unsigned char* smem, int job) {
    const int tid = opaque_tid(), wid = __builtin_amdgcn_readfirstlane(tid >> 6), lane = tid & 63;
    const int b = job >> 3, h = job & 7, rowb = ROW_SAMPLE + b * 8;
    const bf16_t* U = (const bf16_t*)(p.ws + WS_U);
    const float* SF = (const float*)(p.ws + WS_SF);
    bf16_t* MIX = (bf16_t*)(p.ws + WS_MIX);
    float* qs = (float*)smem; float* ks = qs + 1024; float* vs = qs + 2048; float* QK = qs + 4096; float* sig = qs + 4160; float* slf = qs + 4168;
    float* qnv = qs + 4176; float* n0v = qs + 4192; float* red = qs + 4352;
    {
        const int t = tid >> 6, c = tid & 63;
        const size_t r = (size_t)(rowb + t) * N1P;
        const unsigned qq = *(const unsigned*)(U + r + UC_Q + h * 128 + 2 * c), kk = *(const unsigned*)(U + r + UC_K + h * 128 + 2 * c);
        const u32x2 vv = *(const u32x2*)(U + r + UC_V + h * 256 + 4 * c);
        qs[t * 128 + 2 * c] = bf_lo(qq); qs[t * 128 + 2 * c + 1] = bf_hi(qq);
        ks[t * 128 + 2 * c] = bf_lo(kk) * 0.08838834764831845f; ks[t * 128 + 2 * c + 1] = bf_hi(kk) * 0.08838834764831845f;
        *(f32x4*)(vs + t * 256 + 4 * c) = (f32x4){bf_lo(vv[0]), bf_hi(vv[0]), bf_lo(vv[1]), bf_hi(vv[1])};
        if (tid < 8) { sig[tid] = SF[(size_t)(rowb + tid) * 64 + 32 + h] + p.in[17][h]; slf[tid] = logsig_f(SF[(size_t)(rowb + tid) * 64 + 40 + h] + p.in[18][h]); }
        if (tid >= 128 && tid < 256) n0v[tid - 128] = p.in[5][(size_t)(b * 8 + h) * 128 + tid - 128];
    }
    const int v4 = lane, dg = wid;
    const size_t coff = ((size_t)(b * 8 + h) * 128 + dg * 16) * 256 + v4 * 4;
    f32x4 c0[16];
#pragma unroll
    for (int i = 0; i < 16; ++i) c0[i] = *(const f32x4*)(p.in[4] + coff + (size_t)i * 256);
    const float mp = p.in[6][b * 8 + h];
    __syncthreads();
    float F[8], gg[8], M[8];
    { float run = 0.f, pm = -INFINITY;
#pragma unroll
      for (int t = 0; t < 8; ++t) { run += slf[t]; F[t] = run; gg[t] = sig[t] - run; pm = fmaxf(pm, gg[t]); M[t] = fmaxf(pm, mp); } }
    const float Ml = M[7], dec = __expf(mp - Ml), m_new = F[7] + Ml;
    {
        const int pair = tid >> 3, part = tid & 7, t = pair >> 3, s = pair & 7;
        float sum = 0.f;
#pragma unroll
        for (int i = 0; i < 4; ++i) {
            const f32x4 a4 = *(const f32x4*)(qs + t * 128 + part * 16 + i * 4), b4 = *(const f32x4*)(ks + s * 128 + part * 16 + i * 4);
            sum += a4[0] * b4[0] + a4[1] * b4[1] + a4[2] * b4[2] + a4[3] * b4[3];
        }
        sum += __shfl_xor(sum, 1); sum += __shfl_xor(sum, 2); sum += __shfl_xor(sum, 4);
        if (part == 0) QK[pair] = sum;
        float qd = qs[wid * 128 + 2 * lane] * n0v[2 * lane] + qs[wid * 128 + 2 * lane + 1] * n0v[2 * lane + 1];
        qd = wave_sum(qd);
        if (lane == 0) qnv[wid] = qd;
    }
#pragma unroll
    for (int t = 0; t < 8; ++t) {
        f32x4 acc = {0.f, 0.f, 0.f, 0.f};
#pragma unroll
        for (int i4 = 0; i4 < 4; ++i4) {
            const f32x4 q4 = *(const f32x4*)(qs + t * 128 + dg * 16 + i4 * 4);
            acc += q4[0] * c0[i4 * 4] + q4[1] * c0[i4 * 4 + 1] + q4[2] * c0[i4 * 4 + 2] + q4[3] * c0[i4 * 4 + 3];
        }
        *(f32x4*)(red + (dg * 8 + t) * 256 + v4 * 4) = acc;
    }
    __syncthreads();
    f32x4 vv[8];
    float scs[8];
#pragma unroll
    for (int s = 0; s < 8; ++s) { vv[s] = *(const f32x4*)(vs + s * 256 + v4 * 4); scs[s] = __expf(gg[s] - Ml); }
#pragma unroll
    for (int i = 0; i < 16; ++i) {
        const int d = dg * 16 + i;
        f32x4 cn = c0[i] * dec;
#pragma unroll
        for (int s = 0; s < 8; ++s) cn += (scs[s] * ks[s * 128 + d]) * vv[s];
        *(f32x4*)(p.out + O_S_MLC + coff + (size_t)i * 256) = cn;
    }
    if (tid < 128) {
        float nn = dec * n0v[tid];
#pragma unroll
        for (int s = 0; s < 8; ++s) nn += scs[s] * ks[s * 128 + tid];
        p.out[O_S_MLN + (size_t)(b * 8 + h) * 128 + tid] = nn;
    }
    if (tid == 0) p.out[O_S_MLM + b * 8 + h] = m_new;
    {
        const int t = wid;
        float Mt = 0.f, Ft = 0.f;
#pragma unroll
        for (int q = 0; q < 8; ++q) { Mt = (t == q) ? M[q] : Mt; Ft = (t == q) ? F[q] : Ft; }
        f32x4 numc = {0.f, 0.f, 0.f, 0.f};
#pragma unroll
        for (int q = 0; q < 8; ++q) numc += *(const f32x4*)(red + (q * 8 + t) * 256 + lane * 4);
        const float et = __expf(mp - Mt);
        float den = et * qnv[t];
        f32x4 intra = {0.f, 0.f, 0.f, 0.f};
#pragma unroll
        for (int s = 0; s < 8; ++s) {
            if (s <= t) { const float w = __expf(gg[s] - Mt) * QK[t * 8 + s]; den += w; intra += w * vv[s]; }
        }
        const float dd = fmaxf(fabsf(den), __expf(-(Ft + Mt)));
        const f32x4 hv = (et * numc + intra) * (1.f / dd);
        float ss = hv[0] * hv[0] + hv[1] * hv[1] + hv[2] * hv[2] + hv[3] * hv[3];
        ss = wave_sum(ss);
        const u32x2 og = *(const u32x2*)(U + (size_t)(rowb + t) * N1P + UC_O + h * 256 + lane * 4);
        *(u32x2*)(MIX + (size_t)(rowb + t) * MIXW + 2048 + h * 256 + lane * 4) =
            (u32x2){pack2(hv[0] * sigm_f(bf_lo(og[0])), hv[1] * sigm_f(bf_hi(og[0]))), pack2(hv[2] * sigm_f(bf_lo(og[1])), hv[3] * sigm_f(bf_hi(og[1])))};
        if (lane < 4) ((float*)(p.ws + WS_SSQM))[(size_t)(rowb + t) * 32 + h * 4 + lane] = lane == 0 ? ss : 0.f;
        if (lane == 0) ((float*)(p.ws + WS_DD))[(size_t)(rowb + t) * 8 + h] = 1.f;
    }
    __syncthreads();
}

__device__ __forceinline__ void phase_scan(const Params& p, unsigned char* smem) {
#ifndef SC_MASK
#define SC_MASK 15
#endif
    for (int j = opaque_bid(); j < 256; j += gridDim.x) { if (j < 128) { if (SC_MASK & 1) prompt_scan<false>(p, smem, j); } else { if (SC_MASK & 2) prompt_scan<true>(p, smem, j - 128); } }
    if (SC_MASK & 4) for (int j = opaque_bid(); j < 256; j += gridDim.x) sample_ssd(p, smem, j);
    if (SC_MASK & 8) for (int j = opaque_bid(); j < 1024; j += gridDim.x) sample_ml(p, smem, j);
}

__device__ __forceinline__ void phase_mixnorm(const Params& p) {
    const int tid = opaque_tid(), wid = tid >> 6, lane = tid & 63;
    bf16_t* MIX = (bf16_t*)(p.ws + WS_MIX);
    const float* SSQ = (const float*)(p.ws + WS_SSQ); const float* SSQM = (const float*)(p.ws + WS_SSQM);
    const float* w1 = p.in[16]; const float* w2 = p.in[19];
    for (int row = opaque_bid() * 8 + wid; row < NVALID; row += gridDim.x * 8) {
        float s = lane < 32 ? SSQ[(size_t)row * 32 + lane] : 0.f;
        s = wave_sum(s);
        const float r1 = rsqrtf(s * (1.f / 2048.f) + EPS);
        float m = lane < 32 ? SSQM[(size_t)row * 32 + lane] : 0.f;
        m += __shfl_xor(m, 1); m += __shfl_xor(m, 2);
        const float ddh = lane < 32 ? ((const float*)(p.ws + WS_DD))[(size_t)row * 8 + (lane >> 2)] : 1.f;
        const float idd = 1.f / ddh;
        const float rh = rsqrtf(m * (1.f / 256.f) * idd * idd + EPS) * idd;
#pragma unroll
        for (int it = 0; it < 8; ++it) {
            const int col = it * 512 + lane * 8;
            const u32x4 raw = *(const u32x4*)(MIX + (size_t)row * MIXW + col);
            float scale; const float* wp;
            if (it < 4) { scale = r1; wp = w1 + col; }
            else { const int head = (it - 4) * 2 + (lane >> 5); scale = __shfl(rh, head * 4); wp = w2 + col - 2048; }
            const f32x4 wa = *(const f32x4*)wp, wb = *(const f32x4*)(wp + 4);
            u32x4 o;
            o[0] = pack2(bf_lo(raw[0]) * scale * wa[0], bf_hi(raw[0]) * scale * wa[1]); o[1] = pack2(bf_lo(raw[1]) * scale * wa[2], bf_hi(raw[1]) * scale * wa[3]);
            o[2] = pack2(bf_lo(raw[2]) * scale * wb[0], bf_hi(raw[2]) * scale * wb[1]); o[3] = pack2(bf_lo(raw[3]) * scale * wb[2], bf_hi(raw[3]) * scale * wb[3]);
            *(u32x4*)(MIX + (size_t)row * MIXW + col) = o;
        }
    }
    const bf16_t* U = (const bf16_t*)(p.ws + WS_U);
    for (int i = opaque_bid() * 512 + tid; i < 132 * 3 * 320; i += gridDim.x * 512) {
        const int cgp = i % 320, j = (i / 320) % 3, q = i / 960;
        int row; float* dst;
        if (q < 4) { row = q * 2048 + 2045 + j; dst = p.out + O_P_SSDCONV + (size_t)(q * 3 + j) * 2560 + cgp * 8; }
        else { row = ROW_SAMPLE + (q - 4) * 8 + 5 + j; dst = p.out + O_S_SSDCONV + (size_t)((q - 4) * 3 + j) * 2560 + cgp * 8; }
        const u32x4 raw = *(const u32x4*)(U + (size_t)row * N1P + UC_XBC + cgp * 8);
        *(f32x4*)dst = (f32x4){bf_lo(raw[0]), bf_hi(raw[0]), bf_lo(raw[1]), bf_hi(raw[1])};
        *(f32x4*)(dst + 4) = (f32x4){bf_lo(raw[2]), bf_hi(raw[2]), bf_lo(raw[3]), bf_hi(raw[3])};
    }
}

__device__ __forceinline__ void unpack8(const u32x4 raw, float (&x)[8]) {
#pragma unroll
    for (int i = 0; i < 4; ++i) { x[2 * i] = bf_lo(raw[i]); x[2 * i + 1] = bf_hi(raw[i]); }
}
__device__ __forceinline__ void phase_act(const Params& p) {
    const bf16_t* UP = (const bf16_t*)(p.ws + WS_UP); bf16_t* ACT = (bf16_t*)(p.ws + WS_ACT);
    const float* cw = p.in[23]; const float* cb = p.in[24]; const float* fst = p.in[7];
    constexpr int CGN = DFF / 8, TOTAL = (NVALID / 8) * CGN;
    const int tid = opaque_tid();
    for (int idx = opaque_bid() * 512 + tid; idx < TOTAL; idx += gridDim.x * 512) {
        const int rb = idx / CGN, cgp = idx % CGN, row0 = rb * 8, c0 = cgp * 8;
        float g2[8], g1[8], v2[8], v1[8];
        int prow = -1; bool from_state = false; int sb = 0, pb = -1;
        if (row0 < ROW_SAMPLE) { const int b = row0 >> 11, t0 = row0 & 2047; prow = t0 > 0 ? row0 - 2 : ROW_META + b * 16 + 14; if (t0 == 2040) pb = b; }
        else if (row0 < ROW_META) { from_state = true; sb = (row0 - ROW_SAMPLE) >> 3; }
        else { if ((row0 - ROW_META) & 15) prow = row0 - 2; }
        if (from_state) {
            const float* s0 = fst + (size_t)(sb * 2) * N3;
#pragma unroll
            for (int i = 0; i < 8; ++i) { g2[i] = s0[c0 + i]; g1[i] = s0[N3 + c0 + i]; v2[i] = s0[DFF + c0 + i]; v1[i] = s0[N3 + DFF + c0 + i]; }
        } else if (prow >= 0) {
            unpack8(*(const u32x4*)(UP + (size_t)prow * N3 + c0), g2); unpack8(*(const u32x4*)(UP + (size_t)(prow + 1) * N3 + c0), g1);
            unpack8(*(const u32x4*)(UP + (size_t)prow * N3 + DFF + c0), v2); unpack8(*(const u32x4*)(UP + (size_t)(prow + 1) * N3 + DFF + c0), v1);
        } else {
#pragma unroll
            for (int i = 0; i < 8; ++i) { g2[i] = 0.f; g1[i] = 0.f; v2[i] = 0.f; v1[i] = 0.f; }
        }
        float wg[3][8], wv[3][8], bg[8], bv[8];
#pragma unroll
        for (int j = 0; j < 3; ++j)
#pragma unroll
            for (int i = 0; i < 8; ++i) { wg[j][i] = cw[j * N3 + c0 + i]; wv[j][i] = cw[j * N3 + DFF + c0 + i]; }
#pragma unroll
        for (int i = 0; i < 8; ++i) { bg[i] = cb[c0 + i]; bv[i] = cb[DFF + c0 + i]; }
#pragma unroll
        for (int r = 0; r < 8; ++r) {
            float gx[8], vx[8];
            unpack8(*(const u32x4*)(UP + (size_t)(row0 + r) * N3 + c0), gx); unpack8(*(const u32x4*)(UP + (size_t)(row0 + r) * N3 + DFF + c0), vx);
            float o[8];
#pragma unroll
            for (int i = 0; i < 8; ++i) {
                const float yg = bg[i] + wg[0][i] * g2[i] + wg[1][i] * g1[i] + wg[2][i] * gx[i];
                const float yv = bv[i] + wv[0][i] * v2[i] + wv[1][i] * v1[i] + wv[2][i] * vx[i];
                o[i] = silu_f(yg) * yv;
                g2[i] = g1[i]; g1[i] = gx[i]; v2[i] = v1[i]; v1[i] = vx[i];
            }
            u32x4 ov; ov[0] = pack2(o[0], o[1]); ov[1] = pack2(o[2], o[3]); ov[2] = pack2(o[4], o[5]); ov[3] = pack2(o[6], o[7]);
            *(u32x4*)(ACT + (size_t)(row0 + r) * DFF + c0) = ov;
        }
        if (from_state || pb >= 0) {
            float* dst = from_state ? p.out + O_S_FFN + (size_t)(sb * 2) * N3 : p.out + O_P_FFN + (size_t)(pb * 2) * N3;
            *(f32x4*)(dst + c0) = (f32x4){g2[0], g2[1], g2[2], g2[3]}; *(f32x4*)(dst + c0 + 4) = (f32x4){g2[4], g2[5], g2[6], g2[7]};
            *(f32x4*)(dst + N3 + c0) = (f32x4){g1[0], g1[1], g1[2], g1[3]}; *(f32x4*)(dst + N3 + c0 + 4) = (f32x4){g1[4], g1[5], g1[6], g1[7]};
            *(f32x4*)(dst + DFF + c0) = (f32x4){v2[0], v2[1], v2[2], v2[3]}; *(f32x4*)(dst + DFF + c0 + 4) = (f32x4){v2[4], v2[5], v2[6], v2[7]};
            *(f32x4*)(dst + N3 + DFF + c0) = (f32x4){v1[0], v1[1], v1[2], v1[3]}; *(f32x4*)(dst + N3 + DFF + c0 + 4) = (f32x4){v1[4], v1[5], v1[6], v1[7]};
        }
    }
}

__device__ __forceinline__ void phase_final(const Params& p) {
    const int tid = opaque_tid(), wid = tid >> 6, lane = tid & 63;
    const float* SS3 = (const float*)(p.ws + WS_SS3); const float* nw = p.in[26];
    for (int row = opaque_bid() * 8 + wid; row < NOUTROWS; row += gridDim.x * 8) {
        const float r = rsqrtf(SS3[row] * (1.f / 2048.f) + EPS);
        float* rp = p.out + (size_t)row * DM;
#pragma unroll
        for (int it = 0; it < 8; ++it) {
            const int col = it * 256 + lane * 4;
            const f32x4 v = *(const f32x4*)(rp + col), w = *(const f32x4*)(nw + col);
            *(f32x4*)(rp + col) = v * r * w;
        }
    }
}

__global__ void __launch_bounds__(512, 2) hymba_fwd(Params p0) {
    extern __shared__ __attribute__((aligned(16))) unsigned char smem[];
    cg::grid_group grid = cg::this_grid();
#ifndef DUP_PHASE
#define DUP_PHASE -1
#endif
    for (int phx = p0.ph_lo; phx < p0.ph_hi + (DUP_PHASE >= 0 ? 1 : 0); ++phx) {
        const int ph = (DUP_PHASE >= 0 && phx > DUP_PHASE) ? phx - 1 : phx;
        Params p = p0;
        asm volatile("" : "+s"(p.ws), "+s"(p.out));
        switch (ph) {
        case 0: if (PH_MASK & 1) phase_prep(p, smem); break;
        case 1: if (PH_MASK & 2) { pg8::Gemm g{(const bf16_t*)(p.ws + WS_XN), (const bf16_t*)(p.ws + WS_WIN), MP, N1P, 2048}; pg8::StaticOrder S; S.init(MP, N1P, gridDim.x, opaque_bid());
                  Epi1 E{(bf16_t*)(p.ws + WS_U), (float*)(p.ws + WS_SF)}; pg8::gemm_phase((LAS unsigned char*)smem, g, S, E); } break;
        case 2: if (PH_MASK & 4) phase_scan(p, smem); break;
        case 3: if (PH_MASK & 8) phase_mixnorm(p); break;
        case 4: if (PH_MASK & 16) { pg8::Gemm g{(const bf16_t*)(p.ws + WS_MIX), (const bf16_t*)(p.ws + WS_WOUT), MP, 2048, 4096}; pg8::StaticOrder S; S.init(MP, 2048, gridDim.x, opaque_bid());
                  Epi2 E{p}; pg8::gemm_phase((LAS unsigned char*)smem, g, S, E); } break;
        case 5: if (PH_MASK & 32) { pg8::Gemm g{(const bf16_t*)(p.ws + WS_A2), (const bf16_t*)(p.ws + WS_WUP), MP, N3, 2048}; pg8::StaticOrder S; S.init(MP, N3, gridDim.x, opaque_bid());
                  Epi3 E{(bf16_t*)(p.ws + WS_UP), (const float*)(p.ws + WS_SS2)}; pg8::gemm_phase((LAS unsigned char*)smem, g, S, E); } break;
        case 6: if (PH_MASK & 64) phase_act(p); break;
        case 7: if (PH_MASK & 128) { pg8::Gemm g{(const bf16_t*)(p.ws + WS_ACT), (const bf16_t*)(p.ws + WS_WDOWN), MP, 2048, DFF}; pg8::StaticOrder S; S.init(MP, 2048, gridDim.x, opaque_bid());
                  Epi4 E{(const float*)(p.ws + WS_H1), p.out, (float*)(p.ws + WS_SS3)}; pg8::gemm_phase((LAS unsigned char*)smem, g, S, E); } break;
        default: if (PH_MASK & 256) phase_final(p); break;
        }
        if (phx + 1 < p0.ph_hi + (DUP_PHASE >= 0 ? 1 : 0)) grid.sync();
    }
}

extern "C" void kernel_launch(void* const* d_in, const int* in_sizes, int n_in, void* d_out, int out_size, void* d_ws, size_t ws_size, hipStream_t stream) {
    static int grid_blocks = 0;
    if (grid_blocks == 0) {
        if (n_in != 27 || (size_t)out_size != O_END || ws_size < WS_END) {
            fprintf(stderr, "kernel_launch: unexpected shapes: n_in %d out %d ws %zu (need %zu)\n", n_in, out_size, ws_size, (size_t)WS_END); grid_blocks = -1; return; }
        int dev = 0, cus = 0, per_cu = 0;
        (void)hipGetDevice(&dev);
        (void)hipDeviceGetAttribute(&cus, hipDeviceAttributeMultiprocessorCount, dev);
        (void)hipFuncSetAttribute((const void*)hymba_fwd, hipFuncAttributeMaxDynamicSharedMemorySize, LDS_BYTES);
        (void)hipOccupancyMaxActiveBlocksPerMultiprocessor(&per_cu, (const void*)hymba_fwd, 512, LDS_BYTES);
        if (per_cu < 1) { fprintf(stderr, "kernel_launch: occupancy query says %d blocks per CU\n", per_cu); per_cu = 1; }
        grid_blocks = cus;
    }
    if (grid_blocks < 0) return;
    Params p{};
    for (int i = 0; i < 27; ++i) p.in[i] = (const float*)d_in[i];
    p.out = (float*)d_out; p.ws = (unsigned char*)d_ws; p.ph_lo = 0; p.ph_hi = NPHASE;
    void* args[] = {&p};
    hipError_t e = hipLaunchCooperativeKernel((const void*)hymba_fwd, dim3(grid_blocks), dim3(512), args, LDS_BYTES, stream);
    if (e != hipSuccess) fprintf(stderr, "cooperative launch failed: %s (grid %d)\n", hipGetErrorString(e), grid_blocks);
}
```

```cpp
#include <hip/hip_runtime.h>
#include <hip/hip_cooperative_groups.h>
#include <cstdio>
namespace cg = cooperative_groups;

#define LAS __attribute__((address_space(3)))
typedef unsigned short bf16_t;
typedef short bf16x8 __attribute__((ext_vector_type(8)));
typedef float f32x4 __attribute__((ext_vector_type(4)));
typedef unsigned u32x4 __attribute__((ext_vector_type(4)));
typedef unsigned u32x2 __attribute__((ext_vector_type(2)));

constexpr int DM = 2048, MP = 9472, NVALID = 9280, NOUTROWS = 9216;
constexpr int N1P = 11008, N3 = 11264, DFF = 5632, MIXW = 4096;
constexpr int ROW_SAMPLE = 8192, ROW_META = 9216;
constexpr float EPS = 1e-6f;
constexpr int UC_Z = 0, UC_XBC = 2048, UC_Q = 4640, UC_K = 5664, UC_V = 6688, UC_O = 8752;
constexpr size_t WS_WIN = 0;
constexpr size_t WS_WOUT = WS_WIN + (size_t)N1P * 2048 * 2;
constexpr size_t WS_WUP = WS_WOUT + (size_t)2048 * 4096 * 2;
constexpr size_t WS_WDOWN = WS_WUP + (size_t)N3 * 2048 * 2;
constexpr size_t WS_XN = WS_WDOWN + (size_t)2048 * DFF * 2;
constexpr size_t WS_MIX = WS_XN + (size_t)MP * 2048 * 2;
constexpr size_t WS_ACT = WS_XN;
constexpr size_t WS_U = WS_MIX + (size_t)MP * MIXW * 2;
constexpr size_t WS_UP = WS_U;
constexpr size_t WS_H1 = WS_U + (size_t)MP * N3 * 2;
constexpr size_t WS_A2 = WS_H1 + (size_t)MP * 2048 * 4;
constexpr size_t WS_SF = WS_A2 + (size_t)MP * 2048 * 2;
constexpr size_t WS_SSQ = WS_SF + (size_t)MP * 64 * 4;
constexpr size_t WS_SSQM = WS_SSQ + (size_t)MP * 32 * 4;
constexpr size_t WS_SS2 = WS_SSQM + (size_t)MP * 32 * 4;
constexpr size_t WS_SS3 = WS_SS2 + (size_t)MP * 4;
constexpr size_t WS_DD = WS_SS3 + (size_t)MP * 4;
constexpr size_t WS_END = WS_DD + (size_t)MP * 8 * 4;
constexpr size_t O_Y = 0;
constexpr size_t O_P_SSDCONV = 18874368, O_P_SSD = 18905088, O_P_MLC = 19953664, O_P_MLN = 21002240, O_P_MLM = 21006336, O_P_FFN = 21006368;
constexpr size_t O_S_SSDCONV = 21096480, O_S_SSD = 22079520, O_S_MLC = 55633952, O_S_MLN = 89188384, O_S_MLM = 89319456, O_S_FFN = 89320480;
constexpr size_t O_END = 92204064;
constexpr int LDS_BYTES = 147456;
constexpr int NPHASE = 9;
#ifndef CHL_SSD
#define CHL_SSD 128
#endif
#ifndef CHL_ML
#define CHL_ML 128
#endif
#ifndef PH_MASK
#define PH_MASK 0x1ff
#endif

struct Params {
    const float* in[27];
    float* out;
    unsigned char* ws;
    int ph_lo, ph_hi;
};

__device__ __forceinline__ unsigned pack2(float lo, float hi) { unsigned r; asm("v_cvt_pk_bf16_f32 %0, %1, %2" : "=v"(r) : "v"(lo), "v"(hi)); return r; }
__device__ __forceinline__ float bf_lo(unsigned u) { return __uint_as_float(u << 16); }
__device__ __forceinline__ float bf_hi(unsigned u) { return __uint_as_float(u & 0xffff0000u); }
__device__ __forceinline__ float bf2f(bf16_t h) { return __uint_as_float((unsigned)h << 16); }
__device__ __forceinline__ float sigm_f(float x) { const float d = 1.f + __expf(fminf(-x, 80.f)); float r = __builtin_amdgcn_rcpf(d); return r * (2.f - d * r); }
__device__ __forceinline__ float silu_f(float x) { return x * sigm_f(x); }
__device__ __forceinline__ float softplus_f(float x) { return x > 20.f ? x : log1pf(__expf(x)); }
__device__ __forceinline__ float logsig_f(float x) { return fminf(x, 0.f) - log1pf(__expf(-fabsf(x))); }
__device__ __forceinline__ int opaque_tid() { int t = threadIdx.x; asm volatile("" : "+v"(t)); return t; }
__device__ __forceinline__ int opaque_bid() { int t = blockIdx.x; asm volatile("" : "+s"(t)); return t; }
__device__ __forceinline__ int row_of(int b, int pos) { return pos < 16 ? ROW_META + b * 16 + pos : b * 2048 + pos - 16; }
__device__ __forceinline__ float wave_sum(float v) {
    v += __shfl_xor(v, 32); v += __shfl_xor(v, 16); v += __shfl_xor(v, 8); v += __shfl_xor(v, 4); v += __shfl_xor(v, 2); v += __shfl_xor(v, 1); return v;
}
__device__ __forceinline__ const float* resid_row(const Params& p, int row) {
    if (row < ROW_SAMPLE) return p.in[0] + (size_t)row * DM;
    if (row < ROW_META) return p.in[1] + (size_t)(row - ROW_SAMPLE) * DM;
    if (row < NVALID) return p.in[8] + (size_t)((row - ROW_META) & 15) * DM;
    return nullptr;
}

namespace pg8 {
constexpr int BM = 256, BK = 64, HALF = 128, HTB = HALF * BK * 2, STAGE_BYTES = 8 * HTB, NXCD = 8, WGM = 8;
__device__ __forceinline__ int lds_byte(int r, int c) { const int st = (r >> 4) * 2 + (c >> 5), rr = r & 15, cc = c & 31, ob = rr * 64 + cc * 2; return st * 1024 + (ob ^ (((ob >> 9) & 1) << 5)); }
__device__ __forceinline__ void stage_rc(int b, int& R, int& C) { const int st = b / 1024, sb = b % 1024, swz = sb ^ (((sb >> 9) & 1) << 5); R = (st >> 1) * 16 + swz / 64; C = (st & 1) * 32 + (swz % 64) / 2; }
__device__ __forceinline__ int perm32(int rho) { const int n = rho >> 4, i = rho & 15; return 8 * (i >> 2) + 4 * n + (i & 3); }
struct Unit { int pm, pn; };
struct Gemm { const bf16_t* A; const bf16_t* Bt; int M, N, K; };
struct StaticOrder {
    int nM, nN, nwg, G, c;
    __device__ void init(int M, int N, int G_, int c_) { nM = M / BM; nN = N / BM; nwg = nM * nN; G = G_; c = c_; }
    __device__ bool next(int i, Unit& u) const {
        const long L = (long)i * G + c; if (L >= nwg) return false;
        int wgid = (int)L; { const int q = nwg / NXCD, r = nwg % NXCD, xcd = wgid % NXCD, off = wgid / NXCD; wgid = (xcd < r ? xcd * (q + 1) : r * (q + 1) + (xcd - r) * q) + off; }
        const int nig = WGM * nN, gid = wgid / nig, fm = gid * WGM, gsz = (nM - fm) < WGM ? (nM - fm) : WGM;
        u.pm = fm + ((wgid % nig) % gsz); u.pn = (wgid % nig) / gsz; return true;
    }
};

template <class Epi>
__device__ __forceinline__ void gemm_phase(LAS unsigned char* lds, const Gemm g, const StaticOrder& S, const Epi& E) {
    const int tid = opaque_tid(), wid = __builtin_amdgcn_readfirstlane(tid >> 6), lane = tid & 63, wr = wid >> 2, wc = wid & 3, fr = lane & 15, fq = lane >> 4;
    const int K = g.K, nt = K / BK;
    unsigned voffA[2], voffB[2];
#pragma unroll
    for (int i = 0; i < 2; ++i) { int R, C; stage_rc(tid * 16 + i * 8192, R, C); const int Rb = ((R & ~31) + perm32(R & 31));
        voffA[i] = (unsigned)(R * K + C) * 2u; voffB[i] = (unsigned)(Rb * K + C) * 2u; }
    const size_t kstep = (size_t)(BK * 2);
    const size_t hstep = (size_t)HALF * K * 2;
    const size_t tstep = 2 * hstep;
    const unsigned ldsw = (unsigned)wid * 1024u;
    const int aoff = lds_byte(wr * 64 + fr, fq * 8), boff = lds_byte(wc * 32 + fr, fq * 8);
#define PG8_SA(b, h) (((b) * 2 + (h)) * HTB)
#define PG8_SB(b, h) ((4 + (b) * 2 + (h)) * HTB)
#define PG8_STAGE(bufoff, gbase, voff) do { _Pragma("unroll") for (int _i = 0; _i < 2; ++_i) \
        __builtin_amdgcn_global_load_lds((const unsigned*)((const char*)(gbase) + (voff)[_i]), (LAS unsigned*)(lds + (bufoff) + ldsw + _i * 8192), 16, 0, 0); } while (0)
#define PG8_LDA(dst, b, h) do { _Pragma("unroll") for (int m = 0; m < 4; ++m) _Pragma("unroll") for (int k = 0; k < 2; ++k) dst[m][k] = *(const LAS bf16x8*)(lds + PG8_SA(b, h) + aoff + m * 2048 + k * 1024); } while (0)
#define PG8_LDB(dst, b, h) do { _Pragma("unroll") for (int n = 0; n < 2; ++n) _Pragma("unroll") for (int k = 0; k < 2; ++k) dst[n][k] = *(const LAS bf16x8*)(lds + PG8_SB(b, h) + boff + n * 2048 + k * 1024); } while (0)
#define PG8_MMA(ai, bj, At, Bt) do { __builtin_amdgcn_s_setprio(1); _Pragma("unroll") for (int m = 0; m < 4; ++m) _Pragma("unroll") for (int n = 0; n < 2; ++n) _Pragma("unroll") for (int k = 0; k < 2; ++k) \
        acc[ai][bj][m][n] = __builtin_amdgcn_mfma_f32_16x16x32_bf16(Bt[n][k], At[m][k], acc[ai][bj][m][n], 0, 0, 0); __builtin_amdgcn_s_setprio(0); } while (0)
#define PG8_WAIT_V(n) asm volatile("s_waitcnt vmcnt(" #n ")" ::: "memory")
#define PG8_WAIT_L(n) asm volatile("s_waitcnt lgkmcnt(" #n ")" ::: "memory")
#define PG8_BAR __builtin_amdgcn_s_barrier()
#define PG8_SCHED __builtin_amdgcn_sched_barrier(0)
    Unit cur, nxt; int ui = 0;
    if (!S.next(0, cur)) return;
    f32x4 acc[2][2][4][2];
#pragma unroll
    for (int a = 0; a < 2; ++a)
#pragma unroll
        for (int b = 0; b < 2; ++b)
#pragma unroll
            for (int m = 0; m < 4; ++m)
#pragma unroll
                for (int n = 0; n < 2; ++n) acc[a][b][m][n] = (f32x4){0.f, 0.f, 0.f, 0.f};
    bf16x8 At[4][2], B0[2][2], B1[2][2];
    const char* cA = (const char*)g.A + (size_t)cur.pm * tstep; const char* cB = (const char*)g.Bt + (size_t)cur.pn * tstep;
    PG8_STAGE(PG8_SB(0, 0), cB, voffB); PG8_STAGE(PG8_SA(0, 0), cA, voffA); PG8_STAGE(PG8_SB(0, 1), cB + hstep, voffB); PG8_STAGE(PG8_SA(0, 1), cA + hstep, voffA);
    if (wr == 1) PG8_BAR;
    PG8_WAIT_V(4); PG8_BAR;
    PG8_STAGE(PG8_SB(1, 0), cB + kstep, voffB); PG8_STAGE(PG8_SA(1, 0), cA + kstep, voffA); PG8_STAGE(PG8_SB(1, 1), cB + hstep + kstep, voffB);
    PG8_WAIT_V(6); PG8_BAR;
    for (;;) {
        const bool has_next = S.next(ui + 1, nxt);
        const char* nA = has_next ? (const char*)g.A + (size_t)nxt.pm * tstep : cA; const char* nB = has_next ? (const char*)g.Bt + (size_t)nxt.pn * tstep : cB;
        for (int t = 0; t < nt; t += 2) {
            const bool last = (t == nt - 2);
            const char* a1 = cA + (size_t)(t + 1) * kstep;
            const char* a2 = last ? nA : cA + (size_t)(t + 2) * kstep; const char* b2 = last ? nB : cB + (size_t)(t + 2) * kstep;
            const char* a3 = a2 + kstep; const char* b3 = b2 + kstep;
            PG8_LDB(B0, 0, 0); PG8_SCHED; PG8_LDA(At, 0, 0); PG8_STAGE(PG8_SA(1, 1), a1 + hstep, voffA);
            PG8_WAIT_L(8); PG8_BAR; PG8_WAIT_L(0); PG8_MMA(0, 0, At, B0); PG8_BAR; PG8_SCHED;
            PG8_LDB(B1, 0, 1); PG8_STAGE(PG8_SB(0, 0), b2, voffB);
            PG8_BAR; PG8_WAIT_L(0); PG8_MMA(0, 1, At, B1); PG8_BAR;
            PG8_LDA(At, 0, 1); PG8_STAGE(PG8_SA(0, 0), a2, voffA);
            PG8_BAR; PG8_WAIT_L(0); PG8_MMA(1, 0, At, B0); PG8_BAR; PG8_SCHED;
            PG8_STAGE(PG8_SB(0, 1), b2 + hstep, voffB);
            PG8_WAIT_V(6); PG8_BAR; PG8_MMA(1, 1, At, B1); PG8_BAR;
            PG8_LDB(B0, 1, 0); PG8_SCHED; PG8_LDA(At, 1, 0); PG8_STAGE(PG8_SA(0, 1), a2 + hstep, voffA);
            PG8_WAIT_L(8); PG8_BAR; PG8_WAIT_L(0); PG8_MMA(0, 0, At, B0); PG8_BAR; PG8_SCHED;
            PG8_LDB(B1, 1, 1); PG8_STAGE(PG8_SB(1, 0), b3, voffB);
            PG8_BAR; PG8_WAIT_L(0); PG8_MMA(0, 1, At, B1); PG8_BAR;
            PG8_LDA(At, 1, 1); PG8_STAGE(PG8_SA(1, 0), a3, voffA);
            PG8_BAR; PG8_WAIT_L(0); PG8_MMA(1, 0, At, B0); PG8_BAR; PG8_SCHED;
            PG8_STAGE(PG8_SB(1, 1), b3 + hstep, voffB);
            PG8_WAIT_V(6); PG8_BAR; PG8_MMA(1, 1, At, B1); PG8_BAR;
        }
        { Unit eu = cur; asm volatile("" : "+s"(eu.pm), "+s"(eu.pn)); E(acc, eu, wr, wc, fr, fq); }
        if (!has_next) break;
#pragma unroll
        for (int a = 0; a < 2; ++a)
#pragma unroll
            for (int b = 0; b < 2; ++b)
#pragma unroll
                for (int m = 0; m < 4; ++m)
#pragma unroll
                    for (int n = 0; n < 2; ++n) acc[a][b][m][n] = (f32x4){0.f, 0.f, 0.f, 0.f};
        cur = nxt; cA = nA; cB = nB; ++ui;
    }
    PG8_WAIT_V(0);
    if (wr == 0) PG8_BAR;
    PG8_BAR;
#undef PG8_SA
#undef PG8_SB
#undef PG8_STAGE
#undef PG8_LDA
#undef PG8_LDB
#undef PG8_MMA
#undef PG8_WAIT_V
#undef PG8_WAIT_L
#undef PG8_BAR
#undef PG8_SCHED
}
}

typedef f32x4 AccT[2][2][4][2];
struct Epi1 {
    bf16_t* U; float* sf;
    __device__ __forceinline__ void operator()(const AccT& acc, const pg8::Unit& u, int wr, int wc, int fr, int fq) const {
        const int row0 = u.pm * 256 + wr * 64 + fr, col0 = u.pn * 256 + wc * 32 + 8 * fq;
        const bool side_dt = (u.pn == 18 && wc == 0), side_if = (u.pn == 34 && wc == 1);
#pragma unroll
        for (int ai = 0; ai < 2; ++ai)
#pragma unroll
            for (int m = 0; m < 4; ++m) {
                const int row = row0 + ai * 128 + m * 16;
                bf16_t* rowp = U + (size_t)row * N1P + col0;
#pragma unroll
                for (int bj = 0; bj < 2; ++bj) {
                    const f32x4 v0 = acc[ai][bj][m][0], v1 = acc[ai][bj][m][1];
                    u32x4 o; o[0] = pack2(v0[0], v0[1]); o[1] = pack2(v0[2], v0[3]); o[2] = pack2(v1[0], v1[1]); o[3] = pack2(v1[2], v1[3]);
                    *(u32x4*)(rowp + bj * 128) = o;
                }
                if (side_dt || side_if) {
                    float* sp = sf + (size_t)row * 64 + (side_if ? 32 : 0) + 8 * fq;
                    *(f32x4*)sp = acc[ai][0][m][0]; *(f32x4*)(sp + 4) = acc[ai][0][m][1];
                }
            }
    }
};
struct Epi2 {
    Params p;
    __device__ __forceinline__ void operator()(const AccT& acc, const pg8::Unit& u, int wr, int wc, int fr, int fq) const {
        float* H1 = (float*)(p.ws + WS_H1); bf16_t* A2 = (bf16_t*)(p.ws + WS_A2); float* SS2 = (float*)(p.ws + WS_SS2);
        const float* nw = p.in[21];
        const int row0 = u.pm * 256 + wr * 64 + fr, col0 = u.pn * 256 + wc * 32 + 8 * fq;
        f32x4 w[2][2];
#pragma unroll
        for (int bj = 0; bj < 2; ++bj) { w[bj][0] = *(const f32x4*)(nw + col0 + bj * 128); w[bj][1] = *(const f32x4*)(nw + col0 + bj * 128 + 4); }
#pragma unroll
        for (int ai = 0; ai < 2; ++ai)
#pragma unroll
            for (int m = 0; m < 4; ++m) {
                const int row = row0 + ai * 128 + m * 16;
                const float* rp = resid_row(p, row);
                float ss = 0.f;
#pragma unroll
                for (int bj = 0; bj < 2; ++bj) {
                    f32x4 v0 = acc[ai][bj][m][0], v1 = acc[ai][bj][m][1];
                    if (rp) { v0 += *(const f32x4*)(rp + col0 + bj * 128); v1 += *(const f32x4*)(rp + col0 + bj * 128 + 4); }
                    *(f32x4*)(H1 + (size_t)row * DM + col0 + bj * 128) = v0; *(f32x4*)(H1 + (size_t)row * DM + col0 + bj * 128 + 4) = v1;
                    ss += v0[0] * v0[0] + v0[1] * v0[1] + v0[2] * v0[2] + v0[3] * v0[3] + v1[0] * v1[0] + v1[1] * v1[1] + v1[2] * v1[2] + v1[3] * v1[3];
                    const f32x4 a0 = v0 * w[bj][0], a1 = v1 * w[bj][1];
                    u32x4 o; o[0] = pack2(a0[0], a0[1]); o[1] = pack2(a0[2], a0[3]); o[2] = pack2(a1[0], a1[1]); o[3] = pack2(a1[2], a1[3]);
                    *(u32x4*)(A2 + (size_t)row * DM + col0 + bj * 128) = o;
                }
                ss += __shfl_xor(ss, 16); ss += __shfl_xor(ss, 32);
                if (fq == 0) atomicAdd(SS2 + row, ss);
            }
    }
};
struct Epi3 {
    bf16_t* UP; const float* SS2;
    __device__ __forceinline__ void operator()(const AccT& acc, const pg8::Unit& u, int wr, int wc, int fr, int fq) const {
        const int row0 = u.pm * 256 + wr * 64 + fr, col0 = u.pn * 256 + wc * 32 + 8 * fq;
#pragma unroll
        for (int ai = 0; ai < 2; ++ai)
#pragma unroll
            for (int m = 0; m < 4; ++m) {
                const int row = row0 + ai * 128 + m * 16;
                const float r2 = rsqrtf(SS2[row] * (1.f / 2048.f) + EPS);
                bf16_t* rowp = UP + (size_t)row * N3 + col0;
#pragma unroll
                for (int bj = 0; bj < 2; ++bj) {
                    const f32x4 v0 = acc[ai][bj][m][0] * r2, v1 = acc[ai][bj][m][1] * r2;
                    u32x4 o; o[0] = pack2(v0[0], v0[1]); o[1] = pack2(v0[2], v0[3]); o[2] = pack2(v1[0], v1[1]); o[3] = pack2(v1[2], v1[3]);
                    *(u32x4*)(rowp + bj * 128) = o;
                }
            }
    }
};
struct Epi4 {
    const float* H1; float* out; float* SS3;
    __device__ __forceinline__ void operator()(const AccT& acc, const pg8::Unit& u, int wr, int wc, int fr, int fq) const {
        const int row0 = u.pm * 256 + wr * 64 + fr, col0 = u.pn * 256 + wc * 32 + 8 * fq;
#pragma unroll
        for (int ai = 0; ai < 2; ++ai)
#pragma unroll
            for (int m = 0; m < 4; ++m) {
                const int row = row0 + ai * 128 + m * 16;
                if (row < NOUTROWS) {
                    float ss = 0.f;
#pragma unroll
                    for (int bj = 0; bj < 2; ++bj) {
                        const f32x4 v0 = acc[ai][bj][m][0] + *(const f32x4*)(H1 + (size_t)row * DM + col0 + bj * 128);
                        const f32x4 v1 = acc[ai][bj][m][1] + *(const f32x4*)(H1 + (size_t)row * DM + col0 + bj * 128 + 4);
                        *(f32x4*)(out + (size_t)row * DM + col0 + bj * 128) = v0; *(f32x4*)(out + (size_t)row * DM + col0 + bj * 128 + 4) = v1;
                        ss += v0[0] * v0[0] + v0[1] * v0[1] + v0[2] * v0[2] + v0[3] * v0[3] + v1[0] * v1[0] + v1[1] * v1[1] + v1[2] * v1[2] + v1[3] * v1[3];
                    }
                    ss += __shfl_xor(ss, 16); ss += __shfl_xor(ss, 32);
                    if (fq == 0) atomicAdd(SS3 + row, ss);
                }
            }
    }
};

struct TileRef { const float* W; bf16_t* WT; int K, N, kt, nt; };
__device__ __forceinline__ TileRef tile_ref(const Params& p, int t) {
    constexpr int T_IN = 32 * 43, T_OUT = 64 * 8, T_UP = 32 * 44;
    TileRef r;
    if (t < T_IN) { r.W = p.in[10]; r.WT = (bf16_t*)(p.ws + WS_WIN); r.K = 2048; r.N = 10800; r.kt = t % 32; r.nt = t / 32; }
    else if (t < T_IN + T_OUT) { const int q = t - T_IN; r.W = p.in[20]; r.WT = (bf16_t*)(p.ws + WS_WOUT); r.K = 4096; r.N = 2048; r.kt = q % 64; r.nt = q / 64; }
    else if (t < T_IN + T_OUT + T_UP) { const int q = t - T_IN - T_OUT; r.W = p.in[22]; r.WT = (bf16_t*)(p.ws + WS_WUP); r.K = 2048; r.N = N3; r.kt = q % 32; r.nt = q / 32; }
    else { const int q = t - T_IN - T_OUT - T_UP; r.W = p.in[25]; r.WT = (bf16_t*)(p.ws + WS_WDOWN); r.K = DFF; r.N = 2048; r.kt = q % 88; r.nt = q / 88; }
    return r;
}
__device__ __forceinline__ void tile_load(const TileRef& r, f32x4 (&v)[8], int tid) {
    const int nc = (tid & 63) * 4, n = r.nt * 256 + nc;
#pragma unroll
    for (int i = 0; i < 8; ++i) {
        const int kr = (tid >> 6) + 8 * i;
        v[i] = (f32x4){0.f, 0.f, 0.f, 0.f};
        if (n < r.N) v[i] = *(const f32x4*)(r.W + (size_t)(r.kt * 64 + kr) * r.N + n);
    }
}
__device__ __forceinline__ void tile_lds_write(const f32x4 (&v)[8], int tid, unsigned char* smem) {
    float* tile = (float*)smem;
    const int nc = (tid & 63) * 4;
#pragma unroll
    for (int i = 0; i < 8; ++i) {
        const int kr = (tid >> 6) + 8 * i;
        tile[kr * 257 + nc] = v[i][0]; tile[kr * 257 + nc + 1] = v[i][1]; tile[kr * 257 + nc + 2] = v[i][2]; tile[kr * 257 + nc + 3] = v[i][3];
    }
}
__device__ __forceinline__ void tile_store(const TileRef& r, int tid, unsigned char* smem) {
    const float* tile = (const float*)smem;
    const int kc = (tid & 7) * 8;
#pragma unroll
    for (int q = 0; q < 4; ++q) {
        const int nr = (tid >> 3) + 64 * q;
        u32x4 o;
        o[0] = pack2(tile[(kc + 0) * 257 + nr], tile[(kc + 1) * 257 + nr]); o[1] = pack2(tile[(kc + 2) * 257 + nr], tile[(kc + 3) * 257 + nr]);
        o[2] = pack2(tile[(kc + 4) * 257 + nr], tile[(kc + 5) * 257 + nr]); o[3] = pack2(tile[(kc + 6) * 257 + nr], tile[(kc + 7) * 257 + nr]);
        *(u32x4*)(r.WT + (size_t)(r.nt * 256 + nr) * r.K + r.kt * 64 + kc) = o;
    }
}
__device__ __forceinline__ void phase_prep(const Params& p, unsigned char* smem) {
    const int tid = opaque_tid(), wid = tid >> 6, lane = tid & 63;
    { float* SS2 = (float*)(p.ws + WS_SS2); for (int i = opaque_bid() * 512 + tid; i < 2 * MP; i += gridDim.x * 512) SS2[i] = 0.f; }
    {
        bf16_t* XN = (bf16_t*)(p.ws + WS_XN); const float* nw = p.in[9];
        for (int row = opaque_bid() * 8 + wid; row < MP; row += gridDim.x * 8) {
            const float* src = resid_row(p, row);
            f32x4 v[8];
            float ss = 0.f;
#pragma unroll
            for (int it = 0; it < 4; ++it) {
                const int col = it * 512 + lane * 8;
                if (src) { v[2 * it] = *(const f32x4*)(src + col); v[2 * it + 1] = *(const f32x4*)(src + col + 4); }
                else { v[2 * it] = (f32x4){0.f, 0.f, 0.f, 0.f}; v[2 * it + 1] = (f32x4){0.f, 0.f, 0.f, 0.f}; }
#pragma unroll
                for (int j = 0; j < 4; ++j) ss += v[2 * it][j] * v[2 * it][j] + v[2 * it + 1][j] * v[2 * it + 1][j];
            }
            ss = wave_sum(ss);
            const float r = rsqrtf(ss * (1.f / 2048.f) + EPS);
#pragma unroll
            for (int it = 0; it < 4; ++it) {
                const int col = it * 512 + lane * 8;
                const f32x4 w0 = *(const f32x4*)(nw + col), w1 = *(const f32x4*)(nw + col + 4);
                const f32x4 a = v[2 * it] * r * w0, c = v[2 * it + 1] * r * w1;
                u32x4 o; o[0] = pack2(a[0], a[1]); o[1] = pack2(a[2], a[3]); o[2] = pack2(c[0], c[1]); o[3] = pack2(c[2], c[3]);
                *(u32x4*)(XN + (size_t)row * DM + col) = o;
            }
        }
    }
    constexpr int T_ALL = 32 * 43 + 64 * 8 + 32 * 44 + 88 * 8;
    {
        int t = opaque_bid();
        f32x4 v[8];
        TileRef cur{};
        if (t < T_ALL) { cur = tile_ref(p, t); tile_load(cur, v, tid); }
        while (t < T_ALL) {
            tile_lds_write(v, tid, smem);
            __syncthreads();
            const int tn = t + gridDim.x;
            TileRef nxt{};
            if (tn < T_ALL) { nxt = tile_ref(p, tn); tile_load(nxt, v, tid); }
            tile_store(cur, tid, smem);
            __syncthreads();
            cur = nxt; t = tn;
        }
    }
}

constexpr int RS = 272;
constexpr int L_QS = 0, L_KS = 34816, L_KT = 69632, L_VT = 104448, L_ST = 121856, L_SC = 139264;

template <bool ML>
__device__ __forceinline__ void load_block(const Params& p, float (&val)[8][4], int b, int p0, int Lv, int rb, int cg, int colbase, int chbase, float mlscale) {
    const bf16_t* U = (const bf16_t*)(p.ws + WS_U);
    const int t0 = rb * 8;
    if (t0 >= Lv) {
#pragma unroll
        for (int r = 0; r < 8; ++r)
#pragma unroll
            for (int i = 0; i < 4; ++i) val[r][i] = 0.f;
        return;
    }
    if (ML) {
#pragma unroll
        for (int r = 0; r < 8; ++r) {
            const int row = row_of(b, p0 + t0 + r);
            const u32x2 raw = *(const u32x2*)(U + (size_t)row * N1P + colbase + cg * 4);
            val[r][0] = bf_lo(raw[0]) * mlscale; val[r][1] = bf_hi(raw[0]) * mlscale; val[r][2] = bf_lo(raw[1]) * mlscale; val[r][3] = bf_hi(raw[1]) * mlscale;
        }
    } else {
        u32x2 raw[11];
#pragma unroll
        for (int rr = 0; rr < 11; ++rr) {
            const int pos = p0 + t0 - 3 + rr;
            if (pos >= 0) raw[rr] = *(const u32x2*)(U + (size_t)row_of(b, pos) * N1P + colbase + cg * 4);
            else raw[rr] = (u32x2){0u, 0u};
        }
        const float* cw = p.in[11]; const float* cb = p.in[12];
        const int ch = chbase + cg * 4;
        f32x4 w[4];
#pragma unroll
        for (int j = 0; j < 4; ++j) w[j] = *(const f32x4*)(cw + j * 2560 + ch);
        const f32x4 bi = *(const f32x4*)(cb + ch);
#pragma unroll
        for (int i = 0; i < 4; ++i) {
            float x[11];
#pragma unroll
            for (int rr = 0; rr < 11; ++rr) x[rr] = (i & 1) ? bf_hi(raw[rr][i >> 1]) : bf_lo(raw[rr][i >> 1]);
#pragma unroll
            for (int r = 0; r < 8; ++r) val[r][i] = silu_f(bi[i] + w[0][i] * x[r] + w[1][i] * x[r + 1] + w[2][i] * x[r + 2] + w[3][i] * x[r + 3]);
        }
    }
}
__device__ __forceinline__ void store_rows(unsigned char* base, const float (&val)[8][4], int rb, int cg) {
#pragma unroll
    for (int r = 0; r < 8; ++r) *(u32x2*)(base + (rb * 8 + r) * RS + cg * 8) = (u32x2){pack2(val[r][0], val[r][1]), pack2(val[r][2], val[r][3])};
}
__device__ __forceinline__ void store_cols(unsigned char* base, const float (&val)[8][4], int rb, int cg, const float* scale) {
    float s[8];
#pragma unroll
    for (int r = 0; r < 8; ++r) s[r] = scale ? scale[rb * 8 + r] : 1.f;
#pragma unroll
    for (int i = 0; i < 4; ++i) {
        const int row = cg * 4 + i;
        u32x4 o; o[0] = pack2(val[0][i] * s[0], val[1][i] * s[1]); o[1] = pack2(val[2][i] * s[2], val[3][i] * s[3]);
        o[2] = pack2(val[4][i] * s[4], val[5][i] * s[5]); o[3] = pack2(val[6][i] * s[6], val[7][i] * s[7]);
        *(u32x4*)(base + row * RS + ((rb ^ ((row >> 3) & 7)) << 4)) = o;
    }
}

template <bool ML>
__device__ __forceinline__ void prompt_scan(const Params& p, unsigned char* smem, int job) {
    const int tid = opaque_tid(), wid = __builtin_amdgcn_readfirstlane(tid >> 6), lane = tid & 63, fr = lane & 15, fq = lane >> 4;
    int b, h, vq = 0;
    if (ML) { b = job >> 5; h = (job >> 2) & 7; vq = job & 3; } else { b = job >> 5; h = job & 31; }
    const int g = h >> 4;
    const bf16_t* U = (const bf16_t*)(p.ws + WS_U);
    const float* SF = (const float*)(p.ws + WS_SF);
    bf16_t* MIX = (bf16_t*)(p.ws + WS_MIX);
    float* scb = (float*)(smem + L_SC);
    float *qn = scb + 1600, *nvec = scb + 1728, *mpp = scb + 1856;
    const int qcol = ML ? UC_Q + h * 128 : UC_XBC + 2304 + g * 128;
    const int kcol = ML ? UC_K + h * 128 : UC_XBC + 2048 + g * 128;
    const int vcol = ML ? UC_V + h * 256 + vq * 64 : UC_XBC + h * 64;
    const int gcol = ML ? UC_O + h * 256 + vq * 64 : UC_Z + h * 64;
    const int mixcol = ML ? 2048 + h * 256 + vq * 64 : h * 64;
    float A_h = 0.f, D_h = 0.f, dtb = 0.f, ib = 0.f, fb = 0.f;
    if (ML) { ib = p.in[17][h]; fb = p.in[18][h]; } else { A_h = -__expf(p.in[14][h]); D_h = p.in[15][h]; dtb = p.in[13][h]; }
    f32x4 st[4];
#pragma unroll
    for (int i = 0; i < 4; ++i) st[i] = (f32x4){0.f, 0.f, 0.f, 0.f};
    for (int i = tid; i < 64 * RS / 16; i += 512) *(u32x4*)(smem + L_ST + i * 16) = (u32x4){0u, 0u, 0u, 0u};
    if (tid < 128) nvec[tid] = 0.f;
    if (tid == 0) mpp[0] = 0.f;
    constexpr int CHLs = ML ? CHL_ML : CHL_SSD;
    float sraw[4] = {0.f, 0.f, 0.f, 0.f};
    auto scal_load = [&](int cc) {
        const int p0 = cc == 0 ? 0 : 16 + (cc - 1) * CHLs, Lv = cc == 0 ? 16 : CHLs;
        const int t0 = 2 * lane, t1 = t0 + 1;
        if (!ML) {
            if (t0 < Lv) sraw[0] = SF[(size_t)row_of(b, p0 + t0) * 64 + h];
            if (t1 < Lv) sraw[1] = SF[(size_t)row_of(b, p0 + t1) * 64 + h];
        } else {
            if (t0 < Lv) { const size_t r = (size_t)row_of(b, p0 + t0) * 64; sraw[0] = SF[r + 32 + h]; sraw[2] = SF[r + 40 + h]; }
            if (t1 < Lv) { const size_t r = (size_t)row_of(b, p0 + t1) * 64; sraw[1] = SF[r + 32 + h]; sraw[3] = SF[r + 40 + h]; }
        }
    };
    auto scalars = [&](int cc) {
        const int Lv = cc == 0 ? 16 : CHLs;
        float* sc = scb + (cc & 1) * 800;
        float *rowv = sc, *colv = sc + 128, *colm = sc + 256, *ev = sc + 384, *scv = sc + 512, *dden = sc + 640, *misc = sc + 768;
        const int t0 = 2 * lane, t1 = t0 + 1;
        if (!ML) {
            float d0 = 0.f, d1 = 0.f;
            if (t0 < Lv) d0 = softplus_f(sraw[0] + dtb);
            if (t1 < Lv) d1 = softplus_f(sraw[1] + dtb);
            const float a0 = d0 * A_h, a1 = d1 * A_h;
            float inc = a0 + a1;
#pragma unroll
            for (int o = 1; o < 64; o <<= 1) { const float y = __shfl_up(inc, o); if (lane >= o) inc += y; }
            const float c1 = inc, c0 = inc - a1, cl = __shfl(inc, 63);
            rowv[t0] = c0; rowv[t1] = c1; colv[t0] = -c0; colv[t1] = -c1; colm[t0] = d0; colm[t1] = d1;
            ev[t0] = __expf(c0); ev[t1] = __expf(c1); scv[t0] = __expf(cl - c0) * d0; scv[t1] = __expf(cl - c1) * d1;
            if (lane == 0) misc[0] = __expf(cl);
        } else {
            float i0 = -INFINITY, i1 = -INFINITY, f0 = 0.f, f1 = 0.f;
            if (t0 < Lv) { i0 = sraw[0] + ib; f0 = logsig_f(sraw[2] + fb); }
            if (t1 < Lv) { i1 = sraw[1] + ib; f1 = logsig_f(sraw[3] + fb); }
            float inc = f0 + f1;
#pragma unroll
            for (int o = 1; o < 64; o <<= 1) { const float y = __shfl_up(inc, o); if (lane >= o) inc += y; }
            const float F1 = inc, F0 = inc - f1;
            const float g0 = i0 - F0, g1 = i1 - F1;
            float mx = fmaxf(g0, g1);
#pragma unroll
            for (int o = 1; o < 64; o <<= 1) { const float y = __shfl_up(mx, o); if (lane >= o) mx = fmaxf(mx, y); }
            float ex = __shfl_up(mx, 1); if (lane == 0) ex = -INFINITY;
            const float mp = mpp[0];
            const float M0 = fmaxf(fmaxf(ex, g0), mp), M1 = fmaxf(mx, mp);
            const float Ml = __shfl(M1, 63), Fl = __shfl(F1, 63);
            rowv[t0] = -M0; rowv[t1] = -M1; colv[t0] = g0; colv[t1] = g1; colm[t0] = 1.f; colm[t1] = 1.f;
            ev[t0] = __expf(mp - M0); ev[t1] = __expf(mp - M1); dden[t0] = __expf(-(F0 + M0)); dden[t1] = __expf(-(F1 + M1));
            scv[t0] = __expf(g0 - Ml); scv[t1] = __expf(g1 - Ml);
            if (lane == 0) { misc[0] = __expf(mp - Ml); mpp[0] = Fl + Ml; }
        }
    };
    __syncthreads();
    if (wid == 0) { scal_load(0); scalars(0); }
    __syncthreads();
    constexpr int CHL = ML ? CHL_ML : CHL_SSD, NCH = 1 + 2048 / CHL;
    const int tid_outer = tid;
    for (int c = 0; c < NCH; ++c) {
        int tid = tid_outer; asm volatile("" : "+v"(tid));
        const int lane = tid & 63, fr = lane & 15, fq = lane >> 4;
        const int p0 = c == 0 ? 0 : 16 + (c - 1) * CHL, Lv = c == 0 ? 16 : CHL;
        float* sc = scb + (c & 1) * 800;
        float *rowv = sc, *colv = sc + 128, *colm = sc + 256, *ev = sc + 384, *scv = sc + 512, *dden = sc + 640, *misc = sc + 768;
        if (wid == 0 && c + 1 < NCH) scal_load(c + 1);
        {
            float val[8][4];
            load_block<ML>(p, val, b, p0, Lv, tid >> 5, tid & 31, qcol, 2304 + g * 128, 1.f);
            store_rows(smem + L_QS, val, tid >> 5, tid & 31);
            __builtin_amdgcn_sched_barrier(0);
            load_block<ML>(p, val, b, p0, Lv, tid >> 5, tid & 31, kcol, 2048 + g * 128, 0.08838834764831845f);
            store_rows(smem + L_KS, val, tid >> 5, tid & 31);
            store_cols(smem + L_KT, val, tid >> 5, tid & 31, scv);
            __builtin_amdgcn_sched_barrier(0);
            if (tid < 256) {
                load_block<ML>(p, val, b, p0, Lv, tid >> 4, tid & 15, vcol, h * 64, 1.f);
                store_cols(smem + L_VT, val, tid >> 4, tid & 15, nullptr);
            }
        }
        __syncthreads();
        const int t = 16 * wid + fr;
        const bool valid = t < Lv;
        const int row = row_of(b, p0 + (valid ? t : 0));
        u32x2 gate[4];
#pragma unroll
        for (int vb = 0; vb < 4; ++vb) gate[vb] = *(const u32x2*)(U + (size_t)row * N1P + gcol + 16 * vb + 4 * fq);
        if (ML) {
            const int tt = tid >> 2, part = tid & 3;
            float s = 0.f;
#pragma unroll
            for (int cc = 0; cc < 4; ++cc) {
                const u32x4 raw = *(const u32x4*)(smem + L_QS + tt * RS + (part * 4 + cc) * 16);
                const f32x4 n0 = *(const f32x4*)(nvec + (part * 4 + cc) * 8), n1 = *(const f32x4*)(nvec + (part * 4 + cc) * 8 + 4);
                s += bf_lo(raw[0]) * n0[0] + bf_hi(raw[0]) * n0[1] + bf_lo(raw[1]) * n0[2] + bf_hi(raw[1]) * n0[3]
                   + bf_lo(raw[2]) * n1[0] + bf_hi(raw[2]) * n1[1] + bf_lo(raw[3]) * n1[2] + bf_hi(raw[3]) * n1[3];
            }
            s += __shfl_xor(s, 1); s += __shfl_xor(s, 2);
            if (part == 0) qn[tt] = s;
        }
        bf16x8 qf[4];
#pragma unroll
        for (int kk = 0; kk < 4; ++kk) qf[kk] = *(const bf16x8*)(smem + L_QS + t * RS + (kk * 32 + fq * 8) * 2);
        const float rv = rowv[t];
        float rowsum = 0.f;
        u32x2 pk[8];
#pragma unroll
        for (int sb = 0; sb < 8; ++sb) {
            pk[sb] = (u32x2){0u, 0u};
            if (sb <= wid) {
                f32x4 acc = {0.f, 0.f, 0.f, 0.f};
#pragma unroll
                for (int kk = 0; kk < 4; ++kk) {
                    const bf16x8 kf = *(const bf16x8*)(smem + L_KS + (16 * sb + fr) * RS + (kk * 32 + fq * 8) * 2);
                    acc = __builtin_amdgcn_mfma_f32_16x16x32_bf16(kf, qf[kk], acc, 0, 0, 0);
                }
                const f32x4 cv = *(const f32x4*)(colv + 16 * sb + 4 * fq), cm = *(const f32x4*)(colm + 16 * sb + 4 * fq);
                float pv[4];
#pragma unroll
                for (int j = 0; j < 4; ++j) {
                    const int s = 16 * sb + 4 * fq + j;
                    const float w = (s <= t) ? __expf(rv + cv[j]) * cm[j] : 0.f;
                    pv[j] = acc[j] * w; rowsum += pv[j];
                }
                pk[sb] = (u32x2){pack2(pv[0], pv[1]), pack2(pv[2], pv[3])};
            }
        }
        if (wid == 0 && c + 1 < NCH) scalars(c + 1);
        __syncthreads();
#pragma unroll
        for (int sb = 0; sb < 8; ++sb) *(u32x2*)(smem + L_KS + t * RS + (16 * sb + 4 * fq) * 2) = pk[sb];
        rowsum += __shfl_xor(rowsum, 16); rowsum += __shfl_xor(rowsum, 32);
        if (ML) {
            const int d = tid >> 2, part = tid & 3;
            float s = 0.f;
#pragma unroll
            for (int cc = 0; cc < 4; ++cc) {
                const u32x4 raw = *(const u32x4*)(smem + L_KT + d * RS + (part * 4 + cc) * 16);
                s += bf_lo(raw[0]) + bf_hi(raw[0]) + bf_lo(raw[1]) + bf_hi(raw[1]) + bf_lo(raw[2]) + bf_hi(raw[2]) + bf_lo(raw[3]) + bf_hi(raw[3]);
            }
            s += __shfl_xor(s, 1); s += __shfl_xor(s, 2);
            if (part == 0) nvec[d] = misc[0] * nvec[d] + s;
        }
        __syncthreads();
        bf16x8 pf[4];
#pragma unroll
        for (int kk = 0; kk < 4; ++kk) pf[kk] = *(const bf16x8*)(smem + L_KS + t * RS + (kk * 32 + fq * 8) * 2);
        const float et = ev[t];
        float ddv = 1.f;
        if (ML) ddv = fmaxf(fabsf(rowsum + et * qn[t]), dden[t]);
        float ss = 0.f;
#pragma unroll
        for (int vb = 0; vb < 4; ++vb) {
            f32x4 acc = {0.f, 0.f, 0.f, 0.f};
            const int vrow = 16 * vb + fr;
#pragma unroll
            for (int kk = 0; kk < 4; ++kk) {
                const bf16x8 sf = *(const bf16x8*)(smem + L_ST + vrow * RS + (kk * 32 + fq * 8) * 2);
                acc = __builtin_amdgcn_mfma_f32_16x16x32_bf16(sf, qf[kk], acc, 0, 0, 0);
            }
            acc *= et;
#pragma unroll
            for (int kk = 0; kk < 4; ++kk) {
                const bf16x8 vf = *(const bf16x8*)(smem + L_VT + vrow * RS + (((kk * 4 + fq) ^ ((vrow >> 3) & 7)) << 4));
                acc = __builtin_amdgcn_mfma_f32_16x16x32_bf16(vf, pf[kk], acc, 0, 0, 0);
            }
            const float gz[4] = {bf_lo(gate[vb][0]), bf_hi(gate[vb][0]), bf_lo(gate[vb][1]), bf_hi(gate[vb][1])};
            float o[4];
#pragma unroll
            for (int j = 0; j < 4; ++j) {
                if (ML) { const float hv = acc[j]; ss += hv * hv; o[j] = hv * sigm_f(gz[j]); }
                else {
                    const int v = 16 * vb + 4 * fq + j;
                    const float xv = bf2f(*(const bf16_t*)(smem + L_VT + v * RS + (((t >> 3) ^ ((v >> 3) & 7)) << 4) + (t & 7) * 2));
                    const float y = (acc[j] + D_h * xv) * silu_f(gz[j]); ss += y * y; o[j] = y;
                }
            }
            if (valid) *(u32x2*)(MIX + (size_t)row * MIXW + mixcol + 16 * vb + 4 * fq) = (u32x2){pack2(o[0], o[1]), pack2(o[2], o[3])};
        }
        ss += __shfl_xor(ss, 16); ss += __shfl_xor(ss, 32);
        if (valid && fq == 0) {
            if (ML) { ((float*)(p.ws + WS_SSQM))[(size_t)row * 32 + h * 4 + vq] = ss; if (vq == 0) ((float*)(p.ws + WS_DD))[(size_t)row * 8 + h] = ddv; }
            else ((float*)(p.ws + WS_SSQ))[(size_t)row * 32 + h] = ss;
        }
        const float dec = misc[0];
#pragma unroll
        for (int vb = 0; vb < 4; ++vb) st[vb] *= dec;
#pragma unroll
        for (int kk = 0; kk < 4; ++kk) {
            const int drow = 16 * wid + fr;
            const bf16x8 kf = *(const bf16x8*)(smem + L_KT + drow * RS + (((kk * 4 + fq) ^ ((drow >> 3) & 7)) << 4));
#pragma unroll
            for (int vb = 0; vb < 4; ++vb) {
                const int vrow = 16 * vb + fr;
                const bf16x8 vf = *(const bf16x8*)(smem + L_VT + vrow * RS + (((kk * 4 + fq) ^ ((vrow >> 3) & 7)) << 4));
                st[vb] = __builtin_amdgcn_mfma_f32_16x16x32_bf16(kf, vf, st[vb], 0, 0, 0);
            }
        }
        __syncthreads();
#pragma unroll
        for (int vb = 0; vb < 4; ++vb)
            *(u32x2*)(smem + L_ST + (16 * vb + fr) * RS + (16 * wid + 4 * fq) * 2) = (u32x2){pack2(st[vb][0], st[vb][1]), pack2(st[vb][2], st[vb][3])};
    }
#pragma unroll
    for (int vb = 0; vb < 4; ++vb) {
        const int v = 16 * vb + fr, d0 = 16 * wid + 4 * fq;
        if (!ML) *(f32x4*)(p.out + O_P_SSD + ((size_t)(b * 32 + h) * 64 + v) * 128 + d0) = st[vb];
        else {
#pragma unroll
            for (int j = 0; j < 4; ++j) p.out[O_P_MLC + ((size_t)(b * 8 + h) * 128 + d0 + j) * 256 + vq * 64 + v] = st[vb][j];
        }
    }
    if (ML && vq == 0) {
        if (tid < 128) p.out[O_P_MLN + (size_t)(b * 8 + h) * 128 + tid] = nvec[tid];
        if (tid == 0) p.out[O_P_MLM + b * 8 + h] = mpp[0];
    }
    __syncthreads();
}

__device__ __forceinline__ void sample_ssd(const Params& p, unsigned char* smem, int job) {
    const int tid = opaque_tid(), wid = tid >> 6, lane = tid & 63;
    const int b = job >> 1, g = job & 1, rowb = ROW_SAMPLE + b * 8;
    const bf16_t* U = (const bf16_t*)(p.ws + WS_U);
    const float* SF = (const float*)(p.ws + WS_SF);
    bf16_t* MIX = (bf16_t*)(p.ws + WS_MIX);
    float* Bc = (float*)smem; float* Cc = Bc + 1024; float* xall = Cc + 1024; float* G = xall + 8192; float* dts = G + 64; float* ssqp = dts + 128;
    const float* sconv = p.in[2]; const float* cw = p.in[11]; const float* cb = p.in[12];
#pragma unroll
    for (int q = 0; q < 3; ++q) {
        int ch; float* dst; int dstride = 0;
        if (q < 2) { ch = g * 1024 + tid + q * 512; dst = xall + tid + q * 512; dstride = 1024; }
        else { if (tid >= 256) break; const int which = tid >> 7, n = tid & 127; ch = 2048 + which * 256 + g * 128 + n; dst = (which ? Cc : Bc) + n; dstride = 128; }
        float xm3 = sconv[(size_t)(b * 3 + 0) * 2560 + ch], xm2 = sconv[(size_t)(b * 3 + 1) * 2560 + ch], xm1 = sconv[(size_t)(b * 3 + 2) * 2560 + ch];
        const float w0 = cw[ch], w1 = cw[2560 + ch], w2 = cw[5120 + ch], w3 = cw[7680 + ch], bb = cb[ch];
#pragma unroll
        for (int t = 0; t < 8; ++t) {
            const float x = bf2f(U[(size_t)(rowb + t) * N1P + UC_XBC + ch]);
            dst[t * dstride] = silu_f(bb + w0 * xm3 + w1 * xm2 + w2 * xm1 + w3 * x);
            xm3 = xm2; xm2 = xm1; xm1 = x;
        }
    }
    if (tid < 128) { const int hh = tid >> 3, t = tid & 7; dts[tid] = softplus_f(SF[(size_t)(rowb + t) * 64 + g * 16 + hh] + p.in[13][g * 16 + hh]); }
    __syncthreads();
    {
        const int pair = tid >> 3, part = tid & 7, t = pair >> 3, s = pair & 7;
        float sum = 0.f;
#pragma unroll
        for (int i = 0; i < 4; ++i) {
            const f32x4 c4 = *(const f32x4*)(Cc + t * 128 + part * 16 + i * 4), b4 = *(const f32x4*)(Bc + s * 128 + part * 16 + i * 4);
            sum += c4[0] * b4[0] + c4[1] * b4[1] + c4[2] * b4[2] + c4[3] * b4[3];
        }
        sum += __shfl_xor(sum, 1); sum += __shfl_xor(sum, 2); sum += __shfl_xor(sum, 4);
        if (part == 0) G[pair] = sum;
    }
    __syncthreads();
    const int pp = tid >> 3, nq = tid & 7;
    f32x4 snext[4];
#pragma unroll
    for (int i = 0; i < 4; ++i) snext[i] = *(const f32x4*)(p.in[3] + ((size_t)(b * 32 + g * 16) * 64 + pp) * 128 + nq * 4 + 32 * i);
    for (int hh = 0; hh < 16; ++hh) {
        const int h = g * 16 + hh;
        const float A_h = -__expf(p.in[14][h]), D_h = p.in[15][h];
        float dtv[8], cum[8];
        { float run = 0.f;
#pragma unroll
          for (int t = 0; t < 8; ++t) { dtv[t] = dts[hh * 8 + t]; run += dtv[t] * A_h; cum[t] = run; } }
        const size_t soff = ((size_t)(b * 32 + h) * 64 + pp) * 128 + nq * 4;
        f32x4 s0[4];
#pragma unroll
        for (int i = 0; i < 4; ++i) s0[i] = snext[i];
        if (hh + 1 < 16) {
#pragma unroll
            for (int i = 0; i < 4; ++i) snext[i] = *(const f32x4*)(p.in[3] + soff + 64 * 128 + 32 * i);
        }
        float cs[8];
#pragma unroll
        for (int t = 0; t < 8; ++t) {
            float sum = 0.f;
#pragma unroll
            for (int i = 0; i < 4; ++i) { const f32x4 c4 = *(const f32x4*)(Cc + t * 128 + nq * 4 + 32 * i); sum += c4[0] * s0[i][0] + c4[1] * s0[i][1] + c4[2] * s0[i][2] + c4[3] * s0[i][3]; }
            sum += __shfl_xor(sum, 1); sum += __shfl_xor(sum, 2); sum += __shfl_xor(sum, 4);
            cs[t] = sum;
        }
        float ycs = 0.f, ct = 0.f;
#pragma unroll
        for (int t = 0; t < 8; ++t) { ycs = (nq == t) ? cs[t] : ycs; ct = (nq == t) ? cum[t] : ct; }
        float y = __expf(ct) * ycs, xt = 0.f;
#pragma unroll
        for (int s = 0; s < 8; ++s) {
            const float xs = xall[s * 1024 + hh * 64 + pp];
            const float term = (s <= nq) ? G[nq * 8 + s] * __expf(ct - cum[s]) * dtv[s] * xs : 0.f;
            y += term; xt = (s == nq) ? xs : xt;
        }
        y += D_h * xt;
        const float z = bf2f(U[(size_t)(rowb + nq) * N1P + UC_Z + h * 64 + pp]);
        y *= silu_f(z);
        { const unsigned pk = pack2(y, 0.f); MIX[(size_t)(rowb + nq) * MIXW + h * 64 + pp] = (bf16_t)(pk & 0xffffu); }
        float sq = y * y; sq += __shfl_xor(sq, 8); sq += __shfl_xor(sq, 16); sq += __shfl_xor(sq, 32);
        if (lane < 8) ssqp[(hh * 8 + wid) * 8 + lane] = sq;
        const float cl = cum[7], dec = __expf(cl);
        float xw[8];
#pragma unroll
        for (int s = 0; s < 8; ++s) xw[s] = __expf(cl - cum[s]) * dtv[s] * xall[s * 1024 + hh * 64 + pp];
#pragma unroll
        for (int i = 0; i < 4; ++i) {
            f32x4 acc = s0[i] * dec;
#pragma unroll
            for (int s = 0; s < 8; ++s) acc += xw[s] * *(const f32x4*)(Bc + s * 128 + nq * 4 + 32 * i);
            *(f32x4*)(p.out + O_S_SSD + soff + 32 * i) = acc;
        }
    }
    __syncthreads();
    if (tid < 128) {
        const int hh = tid >> 3, t = tid & 7; float tot = 0.f;
#pragma unroll
        for (int w = 0; w < 8; ++w) tot += ssqp[(hh * 8 + w) * 8 + t];
        ((float*)(p.ws + WS_SSQ))[(size_t)(rowb + t) * 32 + g * 16 + hh] = tot;
    }
    __syncthreads();
}

__device__ __forceinline__ void sample_ml(const Params& p, unsigned char* smem, int job) {
    const int tid = opaque_tid(), wid = __builtin_amdgcn_readfirstlane(tid >> 6), lane = tid & 63;
    const int b = job >> 3, h = job & 7, rowb = ROW_SAMPLE + b * 8;
    const bf16_t* U = (const bf16_t*)(p.ws + WS_U);
    const float* SF = (const float*)(p.ws + WS_SF);
    bf16_t* MIX = (bf16_t*)(p.ws + WS_MIX);
    float* qs = (float*)smem; float* ks = qs + 1024; float* vs = qs + 2048; float* QK = qs + 4096; float* sig = qs + 4160; float* slf = qs + 4168;
    float* qnv = qs + 4176; float* n0v = qs + 4192; float* red = qs + 4352;
    {
        const int t = tid >> 6, c = tid & 63;
        const size_t r = (size_t)(rowb + t) * N1P;
        const unsigned qq = *(const unsigned*)(U + r + UC_Q + h * 128 + 2 * c), kk = *(const unsigned*)(U + r + UC_K + h * 128 + 2 * c);
        const u32x2 vv = *(const u32x2*)(U + r + UC_V + h * 256 + 4 * c);
        qs[t * 128 + 2 * c] = bf_lo(qq); qs[t * 128 + 2 * c + 1] = bf_hi(qq);
        ks[t * 128 + 2 * c] = bf_lo(kk) * 0.08838834764831845f; ks[t * 128 + 2 * c + 1] = bf_hi(kk) * 0.08838834764831845f;
        *(f32x4*)(vs + t * 256 + 4 * c) = (f32x4){bf_lo(vv[0]), bf_hi(vv[0]), bf_lo(vv[1]), bf_hi(vv[1])};
        if (tid < 8) { sig[tid] = SF[(size_t)(rowb + tid) * 64 + 32 + h] + p.in[17][h]; slf[tid] = logsig_f(SF[(size_t)(rowb + tid) * 64 + 40 + h] + p.in[18][h]); }
        if (tid >= 128 && tid < 256) n0v[tid - 128] = p.in[5][(size_t)(b * 8 + h) * 128 + tid - 128];
    }
    const int v4 = lane, dg = wid;
    const size_t coff = ((size_t)(b * 8 + h) * 128 + dg * 16) * 256 + v4 * 4;
    f32x4 c0[16];
#pragma unroll
    for (int i = 0; i < 16; ++i) c0[i] = *(const f32x4*)(p.in[4] + coff + (size_t)i * 256);
    const float mp = p.in[6][b * 8 + h];
    __syncthreads();
    float F[8], gg[8], M[8];
    { float run = 0.f, pm = -INFINITY;
#pragma unroll
      for (int t = 0; t < 8; ++t) { run += slf[t]; F[t] = run; gg[t] = sig[t] - run; pm = fmaxf(pm, gg[t]); M[t] = fmaxf(pm, mp); } }
    const float Ml = M[7], dec = __expf(mp - Ml), m_new = F[7] + Ml;
    {
        const int pair = tid >> 3, part = tid & 7, t = pair >> 3, s = pair & 7;
        float sum = 0.f;
#pragma unroll
        for (int i = 0; i < 4; ++i) {
            const f32x4 a4 = *(const f32x4*)(qs + t * 128 + part * 16 + i * 4), b4 = *(const f32x4*)(ks + s * 128 + part * 16 + i * 4);
            sum += a4[0] * b4[0] + a4[1] * b4[1] + a4[2] * b4[2] + a4[3] * b4[3];
        }
        sum += __shfl_xor(sum, 1); sum += __shfl_xor(sum, 2); sum += __shfl_xor(sum, 4);
        if (part == 0) QK[pair] = sum;
        float qd = qs[wid * 128 + 2 * lane] * n0v[2 * lane] + qs[wid * 128 + 2 * lane + 1] * n0v[2 * lane + 1];
        qd = wave_sum(qd);
        if (lane == 0) qnv[wid] = qd;
    }
#pragma unroll
    for (int t = 0; t < 8; ++t) {
        f32x4 acc = {0.f, 0.f, 0.f, 0.f};
#pragma unroll
        for (int i4 = 0; i4 < 4; ++i4) {
            const f32x4 q4 = *(const f32x4*)(qs + t * 128 + dg * 16 + i4 * 4);
            acc += q4[0] * c0[i4 * 4] + q4[1] * c0[i4 * 4 + 1] + q4[2] * c0[i4 * 4 + 2] + q4[3] * c0[i4 * 4 + 3];
        }
        *(f32x4*)(red + (dg * 8 + t) * 256 + v4 * 4) = acc;
    }
    __syncthreads();
    f32x4 vv[8];
    float scs[8];
#pragma unroll
    for (int s = 0; s < 8; ++s) { vv[s] = *(const f32x4*)(vs + s * 256 + v4 * 4); scs[s] = __expf(gg[s] - Ml); }
#pragma unroll
    for (int i = 0; i < 16; ++i) {
        const int d = dg * 16 + i;
        f32x4 cn = c0[i] * dec;
#pragma unroll
        for (int s = 0; s < 8; ++s) cn += (scs[s] * ks[s * 128 + d]) * vv[s];
        *(f32x4*)(p.out + O_S_MLC + coff + (size_t)i * 256) = cn;
    }
    if (tid < 128) {
        float nn = dec * n0v[tid];
#pragma unroll
        for (int s = 0; s < 8; ++s) nn += scs[s] * ks[s * 128 + tid];
        p.out[O_S_MLN + (size_t)(b * 8 + h) * 128 + tid] = nn;
    }
    if (tid == 0) p.out[O_S_MLM + b * 8 + h] = m_new;
    {
        const int t = wid;
        float Mt = 0.f, Ft = 0.f;
#pragma unroll
        for (int q = 0; q < 8; ++q) { Mt = (t == q) ? M[q] : Mt; Ft = (t == q) ? F[q] : Ft; }
        f32x4 numc = {0.f, 0.f, 0.f, 0.f};
#pragma unroll
        for (int q = 0; q < 8; ++q) numc += *(const f32x4*)(red + (q * 8 + t) * 256 + lane * 4);
        const float et = __expf(mp - Mt);
        float den = et * qnv[t];
        f32x4 intra = {0.f, 0.f, 0.f, 0.f};
#pragma unroll
        for (int s = 0; s < 8; ++s) {
            if (s <= t) { const float w = __expf(gg[s] - Mt) * QK[t * 8 + s]; den += w; intra += w * vv[s]; }
        }
        const float dd = fmaxf(fabsf(den), __expf(-(Ft + Mt)));
        const f32x4 hv = (et * numc + intra) * (1.f / dd);
        float ss = hv[0] * hv[0] + hv[1] * hv[1] + hv[2] * hv[2] + hv[3] * hv[3];
        ss = wave_sum(ss);
        const u32x2 og = *(const u32x2*)(U + (size_t)(rowb + t) * N1P + UC_O + h * 256 + lane * 4);
        *(u32x2*)(MIX + (size_t)(rowb + t) * MIXW + 2048 + h * 256 + lane * 4) =
            (u32x2){pack2(hv[0] * sigm_f(bf_lo(og[0])), hv[1] * sigm_f(bf_hi(og[0]))), pack2(hv[2] * sigm_f(bf_lo(og[1])), hv[3] * sigm_f(bf_hi(og[1])))};
        if (lane < 4) ((float*)(p.ws + WS_SSQM))[(size_t)(rowb + t) * 32 + h * 4 + lane] = lane == 0 ? ss : 0.f;
        if (lane == 0) ((float*)(p.ws + WS_DD))[(size_t)(rowb + t) * 8 + h] = 1.f;
    }
    __syncthreads();
}

__device__ __forceinline__ void phase_scan(const Params& p, unsigned char* smem) {
#ifndef SC_MASK
#define SC_MASK 15
#endif
    for (int j = opaque_bid(); j < 256; j += gridDim.x) { if (j < 128) { if (SC_MASK & 1) prompt_scan<false>(p, smem, j); } else { if (SC_MASK & 2) prompt_scan<true>(p, smem, j - 128); } }
    if (SC_MASK & 4) for (int j = opaque_bid(); j < 256; j += gridDim.x) sample_ssd(p, smem, j);
    if (SC_MASK & 8) for (int j = opaque_bid(); j < 1024; j += gridDim.x) sample_ml(p, smem, j);
}

__device__ __forceinline__ void phase_mixnorm(const Params& p) {
    const int tid = opaque_tid(), wid = tid >> 6, lane = tid & 63;
    bf16_t* MIX = (bf16_t*)(p.ws + WS_MIX);
    const float* SSQ = (const float*)(p.ws + WS_SSQ); const float* SSQM = (const float*)(p.ws + WS_SSQM);
    const float* w1 = p.in[16]; const float* w2 = p.in[19];
    for (int row = opaque_bid() * 8 + wid; row < NVALID; row += gridDim.x * 8) {
        float s = lane < 32 ? SSQ[(size_t)row * 32 + lane] : 0.f;
        s = wave_sum(s);
        const float r1 = rsqrtf(s * (1.f / 2048.f) + EPS);
        float m = lane < 32 ? SSQM[(size_t)row * 32 + lane] : 0.f;
        m += __shfl_xor(m, 1); m += __shfl_xor(m, 2);
        const float ddh = lane < 32 ? ((const float*)(p.ws + WS_DD))[(size_t)row * 8 + (lane >> 2)] : 1.f;
        const float idd = 1.f / ddh;
        const float rh = rsqrtf(m * (1.f / 256.f) * idd * idd + EPS) * idd;
#pragma unroll
        for (int it = 0; it < 8; ++it) {
            const int col = it * 512 + lane * 8;
            const u32x4 raw = *(const u32x4*)(MIX + (size_t)row * MIXW + col);
            float scale; const float* wp;
            if (it < 4) { scale = r1; wp = w1 + col; }
            else { const int head = (it - 4) * 2 + (lane >> 5); scale = __shfl(rh, head * 4); wp = w2 + col - 2048; }
            const f32x4 wa = *(const f32x4*)wp, wb = *(const f32x4*)(wp + 4);
            u32x4 o;
            o[0] = pack2(bf_lo(raw[0]) * scale * wa[0], bf_hi(raw[0]) * scale * wa[1]); o[1] = pack2(bf_lo(raw[1]) * scale * wa[2], bf_hi(raw[1]) * scale * wa[3]);
            o[2] = pack2(bf_lo(raw[2]) * scale * wb[0], bf_hi(raw[2]) * scale * wb[1]); o[3] = pack2(bf_lo(raw[3]) * scale * wb[2], bf_hi(raw[3]) * scale * wb[3]);
            *(u32x4*)(MIX + (size_t)row * MIXW + col) = o;
        }
    }
    const bf16_t* U = (const bf16_t*)(p.ws + WS_U);
    for (int i = opaque_bid() * 512 + tid; i < 132 * 3 * 320; i += gridDim.x * 512) {
        const int cgp = i % 320, j = (i / 320) % 3, q = i / 960;
        int row; float* dst;
        if (q < 4) { row = q * 2048 + 2045 + j; dst = p.out + O_P_SSDCONV + (size_t)(q * 3 + j) * 2560 + cgp * 8; }
        else { row = ROW_SAMPLE + (q - 4) * 8 + 5 + j; dst = p.out + O_S_SSDCONV + (size_t)((q - 4) * 3 + j) * 2560 + cgp * 8; }
        const u32x4 raw = *(const u32x4*)(U + (size_t)row * N1P + UC_XBC + cgp * 8);
        *(f32x4*)dst = (f32x4){bf_lo(raw[0]), bf_hi(raw[0]), bf_lo(raw[1]), bf_hi(raw[1])};
        *(f32x4*)(dst + 4) = (f32x4){bf_lo(raw[2]), bf_hi(raw[2]), bf_lo(raw[3]), bf_hi(raw[3])};
    }
}

__device__ __forceinline__ void unpack8(const u32x4 raw, float (&x)[8]) {
#pragma unroll
    for (int i = 0; i < 4; ++i) { x[2 * i] = bf_lo(raw[i]); x[2 * i + 1] = bf_hi(raw[i]); }
}
__device__ __forceinline__ void phase_act(const Params& p) {
    const bf16_t* UP = (const bf16_t*)(p.ws + WS_UP); bf16_t* ACT = (bf16_t*)(p.ws + WS_ACT);
    const float* cw = p.in[23]; const float* cb = p.in[24]; const float* fst = p.in[7];
    constexpr int CGN = DFF / 8, TOTAL = (NVALID / 8) * CGN;
    const int tid = opaque_tid();
    for (int idx = opaque_bid() * 512 + tid; idx < TOTAL; idx += gridDim.x * 512) {
        const int rb = idx / CGN, cgp = idx % CGN, row0 = rb * 8, c0 = cgp * 8;
        float g2[8], g1[8], v2[8], v1[8];
        int prow = -1; bool from_state = false; int sb = 0, pb = -1;
        if (row0 < ROW_SAMPLE) { const int b = row0 >> 11, t0 = row0 & 2047; prow = t0 > 0 ? row0 - 2 : ROW_META + b * 16 + 14; if (t0 == 2040) pb = b; }
        else if (row0 < ROW_META) { from_state = true; sb = (row0 - ROW_SAMPLE) >> 3; }
        else { if ((row0 - ROW_META) & 15) prow = row0 - 2; }
        if (from_state) {
            const float* s0 = fst + (size_t)(sb * 2) * N3;
#pragma unroll
            for (int i = 0; i < 8; ++i) { g2[i] = s0[c0 + i]; g1[i] = s0[N3 + c0 + i]; v2[i] = s0[DFF + c0 + i]; v1[i] = s0[N3 + DFF + c0 + i]; }
        } else if (prow >= 0) {
            unpack8(*(const u32x4*)(UP + (size_t)prow * N3 + c0), g2); unpack8(*(const u32x4*)(UP + (size_t)(prow + 1) * N3 + c0), g1);
            unpack8(*(const u32x4*)(UP + (size_t)prow * N3 + DFF + c0), v2); unpack8(*(const u32x4*)(UP + (size_t)(prow + 1) * N3 + DFF + c0), v1);
        } else {
#pragma unroll
            for (int i = 0; i < 8; ++i) { g2[i] = 0.f; g1[i] = 0.f; v2[i] = 0.f; v1[i] = 0.f; }
        }
        float wg[3][8], wv[3][8], bg[8], bv[8];
#pragma unroll
        for (int j = 0; j < 3; ++j)
#pragma unroll
            for (int i = 0; i < 8; ++i) { wg[j][i] = cw[j * N3 + c0 + i]; wv[j][i] = cw[j * N3 + DFF + c0 + i]; }
#pragma unroll
        for (int i = 0; i < 8; ++i) { bg[i] = cb[c0 + i]; bv[i] = cb[DFF + c0 + i]; }
#pragma unroll
        for (int r = 0; r < 8; ++r) {
            float gx[8], vx[8];
            unpack8(*(const u32x4*)(UP + (size_t)(row0 + r) * N3 + c0), gx); unpack8(*(const u32x4*)(UP + (size_t)(row0 + r) * N3 + DFF + c0), vx);
            float o[8];
#pragma unroll
            for (int i = 0; i < 8; ++i) {
                const float yg = bg[i] + wg[0][i] * g2[i] + wg[1][i] * g1[i] + wg[2][i] * gx[i];
                const float yv = bv[i] + wv[0][i] * v2[i] + wv[1][i] * v1[i] + wv[2][i] * vx[i];
                o[i] = silu_f(yg) * yv;
                g2[i] = g1[i]; g1[i] = gx[i]; v2[i] = v1[i]; v1[i] = vx[i];
            }
            u32x4 ov; ov[0] = pack2(o[0], o[1]); ov[1] = pack2(o[2], o[3]); ov[2] = pack2(o[4], o[5]); ov[3] = pack2(o[6], o[7]);
            *(u32x4*)(ACT + (size_t)(row0 + r) * DFF + c0) = ov;
        }
        if (from_state || pb >= 0) {
            float* dst = from_state ? p.out + O_S_FFN + (size_t)(sb * 2) * N3 : p.out + O_P_FFN + (size_t)(pb * 2) * N3;
            *(f32x4*)(dst + c0) = (f32x4){g2[0], g2[1], g2[2], g2[3]}; *(f32x4*)(dst + c0 + 4) = (f32x4){g2[4], g2[5], g2[6], g2[7]};
            *(f32x4*)(dst + N3 + c0) = (f32x4){g1[0], g1[1], g1[2], g1[3]}; *(f32x4*)(dst + N3 + c0 + 4) = (f32x4){g1[4], g1[5], g1[6], g1[7]};
            *(f32x4*)(dst + DFF + c0) = (f32x4){v2[0], v2[1], v2[2], v2[3]}; *(f32x4*)(dst + DFF + c0 + 4) = (f32x4){v2[4], v2[5], v2[6], v2[7]};
            *(f32x4*)(dst + N3 + DFF + c0) = (f32x4){v1[0], v1[1], v1[2], v1[3]}; *(f32x4*)(dst + N3 + DFF + c0 + 4) = (f32x4){v1[4], v1[5], v1[6], v1[7]};
        }
    }
}

__device__ __forceinline__ void phase_final(const Params& p) {
    const int tid = opaque_tid(), wid = tid >> 6, lane = tid & 63;
    const float* SS3 = (const float*)(p.ws + WS_SS3); const float* nw = p.in[26];
    for (int row = opaque_bid() * 8 + wid; row < NOUTROWS; row += gridDim.x * 8) {
        const float r = rsqrtf(SS3[row] * (1.f / 2048.f) + EPS);
        float* rp = p.out + (size_t)row * DM;
#pragma unroll
        for (int it = 0; it < 8; ++it) {
            const int col = it * 256 + lane * 4;
            const f32x4 v = *(const f32x4*)(rp + col), w = *(const f32x4*)(nw + col);
            *(f32x4*)(rp + col) = v * r * w;
        }
    }
}

__global__ void __launch_bounds__(512, 2) hymba_fwd(Params p0) {
    extern __shared__ __attribute__((aligned(16))) unsigned char smem[];
    cg::grid_group grid = cg::this_grid();
#ifndef DUP_PHASE
#define DUP_PHASE -1
#endif
    for (int phx = p0.ph_lo; phx < p0.ph_hi + (DUP_PHASE >= 0 ? 1 : 0); ++phx) {
        const int ph = (DUP_PHASE >= 0 && phx > DUP_PHASE) ? phx - 1 : phx;
        Params p = p0;
        asm volatile("" : "+s"(p.ws), "+s"(p.out));
        switch (ph) {
        case 0: if (PH_MASK & 1) phase_prep(p, smem); break;
        case 1: if (PH_MASK & 2) { pg8::Gemm g{(const bf16_t*)(p.ws + WS_XN), (const bf16_t*)(p.ws + WS_WIN), MP, N1P, 2048}; pg8::StaticOrder S; S.init(MP, N1P, gridDim.x, opaque_bid());
                  Epi1 E{(bf16_t*)(p.ws + WS_U), (float*)(p.ws + WS_SF)}; pg8::gemm_phase((LAS unsigned char*)smem, g, S, E); } break;
        case 2: if (PH_MASK & 4) phase_scan(p, smem); break;
        case 3: if (PH_MASK & 8) phase_mixnorm(p); break;
        case 4: if (PH_MASK & 16) { pg8::Gemm g{(const bf16_t*)(p.ws + WS_MIX), (const bf16_t*)(p.ws + WS_WOUT), MP, 2048, 4096}; pg8::StaticOrder S; S.init(MP, 2048, gridDim.x, opaque_bid());
                  Epi2 E{p}; pg8::gemm_phase((LAS unsigned char*)smem, g, S, E); } break;
        case 5: if (PH_MASK & 32) { pg8::Gemm g{(const bf16_t*)(p.ws + WS_A2), (const bf16_t*)(p.ws + WS_WUP), MP, N3, 2048}; pg8::StaticOrder S; S.init(MP, N3, gridDim.x, opaque_bid());
                  Epi3 E{(bf16_t*)(p.ws + WS_UP), (const float*)(p.ws + WS_SS2)}; pg8::gemm_phase((LAS unsigned char*)smem, g, S, E); } break;
        case 6: if (PH_MASK & 64) phase_act(p); break;
        case 7: if (PH_MASK & 128) { pg8::Gemm g{(const bf16_t*)(p.ws + WS_ACT), (const bf16_t*)(p.ws + WS_WDOWN), MP, 2048, DFF}; pg8::StaticOrder S; S.init(MP, 2048, gridDim.x, opaque_bid());
                  Epi4 E{(const float*)(p.ws + WS_H1), p.out, (float*)(p.ws + WS_SS3)}; pg8::gemm_phase((LAS unsigned char*)smem, g, S, E); } break;
        default: if (PH_MASK & 256) phase_final(p); break;
        }
        if (phx + 1 < p0.ph_hi + (DUP_PHASE >= 0 ? 1 : 0)) grid.sync();
    }
}

extern "C" void kernel_launch(void* const* d_in, const int* in_sizes, int n_in, void* d_out, int out_size, void* d_ws, size_t ws_size, hipStream_t stream) {
    static int grid_blocks = 0;
    if (grid_blocks == 0) {
        if (n_in != 27 || (size_t)out_size != O_END || ws_size < WS_END) {
            fprintf(stderr, "kernel_launch: unexpected shapes: n_in %d out %d ws %zu (need %zu)\n", n_in, out_size, ws_size, (size_t)WS_END); grid_blocks = -1; return; }
        int dev = 0, cus = 0, per_cu = 0;
        (void)hipGetDevice(&dev);
        (void)hipDeviceGetAttribute(&cus, hipDeviceAttributeMultiprocessorCount, dev);
        (void)hipFuncSetAttribute((const void*)hymba_fwd, hipFuncAttributeMaxDynamicSharedMemorySize, LDS_BYTES);
        (void)hipOccupancyMaxActiveBlocksPerMultiprocessor(&per_cu, (const void*)hymba_fwd, 512, LDS_BYTES);
        if (per_cu < 1) { fprintf(stderr, "kernel_launch: occupancy query says %d blocks per CU\n", per_cu); per_cu = 1; }
        grid_blocks = cus;
    }
    if (grid_blocks < 0) return;
    Params p{};
    for (int i = 0; i < 27; ++i) p.in[i] = (const float*)d_in[i];
    p.out = (float*)d_out; p.ws = (unsigned char*)d_ws; p.ph_lo = 0; p.ph_hi = NPHASE;
    void* args[] = {&p};
    hipError_t e = hipLaunchCooperativeKernel((const void*)hymba_fwd, dim3(grid_blocks), dim3(512), args, LDS_BYTES, stream);
    if (e != hipSuccess) fprintf(stderr, "cooperative launch failed: %s (grid %d)\n", hipGetErrorString(e), grid_blocks);
}
```

```cpp
#include <hip/hip_runtime.h>
#include <hip/hip_cooperative_groups.h>
#include <cstdio>
namespace cg = cooperative_groups;

#define LAS __attribute__((address_space(3)))
typedef unsigned short bf16_t;
typedef short bf16x8 __attribute__((ext_vector_type(8)));
typedef float f32x4 __attribute__((ext_vector_type(4)));
typedef unsigned u32x4 __attribute__((ext_vector_type(4)));
typedef unsigned u32x2 __attribute__((ext_vector_type(2)));

constexpr int DM = 2048, MP = 9472, NVALID = 9280, NOUTROWS = 9216;
constexpr int N1P = 11008, N3 = 11264, DFF = 5632, MIXW = 4096;
constexpr int ROW_SAMPLE = 8192, ROW_META = 9216;
constexpr float EPS = 1e-6f;
constexpr int UC_Z = 0, UC_XBC = 2048, UC_Q = 4640, UC_K = 5664, UC_V = 6688, UC_O = 8752;
constexpr size_t WS_WIN = 0;
constexpr size_t WS_WOUT = WS_WIN + (size_t)N1P * 2048 * 2;
constexpr size_t WS_WUP = WS_WOUT + (size_t)2048 * 4096 * 2;
constexpr size_t WS_WDOWN = WS_WUP + (size_t)N3 * 2048 * 2;
constexpr size_t WS_XN = WS_WDOWN + (size_t)2048 * DFF * 2;
constexpr size_t WS_MIX = WS_XN + (size_t)MP * 2048 * 2;
constexpr size_t WS_ACT = WS_XN;
constexpr size_t WS_U = WS_MIX + (size_t)MP * MIXW * 2;
constexpr size_t WS_UP = WS_U;
constexpr size_t WS_H1 = WS_U + (size_t)MP * N3 * 2;
constexpr size_t WS_A2 = WS_H1 + (size_t)MP * 2048 * 4;
constexpr size_t WS_SF = WS_A2 + (size_t)MP * 2048 * 2;
constexpr size_t WS_SSQ = WS_SF + (size_t)MP * 64 * 4;
constexpr size_t WS_SSQM = WS_SSQ + (size_t)MP * 32 * 4;
constexpr size_t WS_SS2 = WS_SSQM + (size_t)MP * 32 * 4;
constexpr size_t WS_SS3 = WS_SS2 + (size_t)MP * 4;
constexpr size_t WS_DD = WS_SS3 + (size_t)MP * 4;
constexpr size_t WS_END = WS_DD + (size_t)MP * 8 * 4;
constexpr size_t O_Y = 0;
constexpr size_t O_P_SSDCONV = 18874368, O_P_SSD = 18905088, O_P_MLC = 19953664, O_P_MLN = 21002240, O_P_MLM = 21006336, O_P_FFN = 21006368;
constexpr size_t O_S_SSDCONV = 21096480, O_S_SSD = 22079520, O_S_MLC = 55633952, O_S_MLN = 89188384, O_S_MLM = 89319456, O_S_FFN = 89320480;
constexpr size_t O_END = 92204064;
constexpr int LDS_BYTES = 147456;
constexpr int NPHASE = 9;
#ifndef CHL_SSD
#define CHL_SSD 128
#endif
#ifndef CHL_ML
#define CHL_ML 128
#endif
#ifndef PH_MASK
#define PH_MASK 0x1ff
#endif

struct Params {
    const float* in[27];
    float* out;
    unsigned char* ws;
    int ph_lo, ph_hi;
};

__device__ __forceinline__ unsigned pack2(float lo, float hi) { unsigned r; asm("v_cvt_pk_bf16_f32 %0, %1, %2" : "=v"(r) : "v"(lo), "v"(hi)); return r; }
__device__ __forceinline__ float bf_lo(unsigned u) { return __uint_as_float(u << 16); }
__device__ __forceinline__ float bf_hi(unsigned u) { return __uint_as_float(u & 0xffff0000u); }
__device__ __forceinline__ float bf2f(bf16_t h) { return __uint_as_float((unsigned)h << 16); }
__device__ __forceinline__ float sigm_f(float x) { const float d = 1.f + __expf(fminf(-x, 80.f)); float r = __builtin_amdgcn_rcpf(d); return r * (2.f - d * r); }
__device__ __forceinline__ float silu_f(float x) { return x * sigm_f(x); }
__device__ __forceinline__ float softplus_f(float x) { return x > 20.f ? x : log1pf(__expf(x)); }
__device__ __forceinline__ float logsig_f(float x) { return fminf(x, 0.f) - log1pf(__expf(-fabsf(x))); }
__device__ __forceinline__ int opaque_tid() { int t = threadIdx.x; asm volatile("" : "+v"(t)); return t; }
__device__ __forceinline__ int opaque_bid() { int t = blockIdx.x; asm volatile("" : "+s"(t)); return t; }
__device__ __forceinline__ int row_of(int b, int pos) { return pos < 16 ? ROW_META + b * 16 + pos : b * 2048 + pos - 16; }
__device__ __forceinline__ float wave_sum(float v) {
    v += __shfl_xor(v, 32); v += __shfl_xor(v, 16); v += __shfl_xor(v, 8); v += __shfl_xor(v, 4); v += __shfl_xor(v, 2); v += __shfl_xor(v, 1); return v;
}
__device__ __forceinline__ const float* resid_row(const Params& p, int row) {
    if (row < ROW_SAMPLE) return p.in[0] + (size_t)row * DM;
    if (row < ROW_META) return p.in[1] + (size_t)(row - ROW_SAMPLE) * DM;
    if (row < NVALID) return p.in[8] + (size_t)((row - ROW_META) & 15) * DM;
    return nullptr;
}

namespace pg8 {
constexpr int BM = 256, BK = 64, HALF = 128, HTB = HALF * BK * 2, STAGE_BYTES = 8 * HTB, NXCD = 8, WGM = 8;
__device__ __forceinline__ int lds_byte(int r, int c) { const int st = (r >> 4) * 2 + (c >> 5), rr = r & 15, cc = c & 31, ob = rr * 64 + cc * 2; return st * 1024 + (ob ^ (((ob >> 9) & 1) << 5)); }
__device__ __forceinline__ void stage_rc(int b, int& R, int& C) { const int st = b / 1024, sb = b % 1024, swz = sb ^ (((sb >> 9) & 1) << 5); R = (st >> 1) * 16 + swz / 64; C = (st & 1) * 32 + (swz % 64) / 2; }
__device__ __forceinline__ int perm32(int rho) { const int n = rho >> 4, i = rho & 15; return 8 * (i >> 2) + 4 * n + (i & 3); }
struct Unit { int pm, pn; };
struct Gemm { const bf16_t* A; const bf16_t* Bt; int M, N, K; };
struct StaticOrder {
    int nM, nN, nwg, G, c;
    __device__ void init(int M, int N, int G_, int c_) { nM = M / BM; nN = N / BM; nwg = nM * nN; G = G_; c = c_; }
    __device__ bool next(int i, Unit& u) const {
        const long L = (long)i * G + c; if (L >= nwg) return false;
        int wgid = (int)L; { const int q = nwg / NXCD, r = nwg % NXCD, xcd = wgid % NXCD, off = wgid / NXCD; wgid = (xcd < r ? xcd * (q + 1) : r * (q + 1) + (xcd - r) * q) + off; }
        const int nig = WGM * nN, gid = wgid / nig, fm = gid * WGM, gsz = (nM - fm) < WGM ? (nM - fm) : WGM;
        u.pm = fm + ((wgid % nig) % gsz); u.pn = (wgid % nig) / gsz; return true;
    }
};

template <class Epi>
__device__ __forceinline__ void gemm_phase(LAS unsigned char* lds, const Gemm g, const StaticOrder& S, const Epi& E) {
    const int tid = opaque_tid(), wid = __builtin_amdgcn_readfirstlane(tid >> 6), lane = tid & 63, wr = wid >> 2, wc = wid & 3, fr = lane & 15, fq = lane >> 4;
    const int K = g.K, nt = K / BK;
    unsigned voffA[2], voffB[2];
#pragma unroll
    for (int i = 0; i < 2; ++i) { int R, C; stage_rc(tid * 16 + i * 8192, R, C); const int Rb = ((R & ~31) + perm32(R & 31));
        voffA[i] = (unsigned)(R * K + C) * 2u; voffB[i] = (unsigned)(Rb * K + C) * 2u; }
    const size_t kstep = (size_t)(BK * 2);
    const size_t hstep = (size_t)HALF * K * 2;
    const size_t tstep = 2 * hstep;
    const unsigned ldsw = (unsigned)wid * 1024u;
    const int aoff = lds_byte(wr * 64 + fr, fq * 8), boff = lds_byte(wc * 32 + fr, fq * 8);
#define PG8_SA(b, h) (((b) * 2 + (h)) * HTB)
#define PG8_SB(b, h) ((4 + (b) * 2 + (h)) * HTB)
#define PG8_STAGE(bufoff, gbase, voff) do { _Pragma("unroll") for (int _i = 0; _i < 2; ++_i) \
        __builtin_amdgcn_global_load_lds((const unsigned*)((const char*)(gbase) + (voff)[_i]), (LAS unsigned*)(lds + (bufoff) + ldsw + _i * 8192), 16, 0, 0); } while (0)
#define PG8_LDA(dst, b, h) do { _Pragma("unroll") for (int m = 0; m < 4; ++m) _Pragma("unroll") for (int k = 0; k < 2; ++k) dst[m][k] = *(const LAS bf16x8*)(lds + PG8_SA(b, h) + aoff + m * 2048 + k * 1024); } while (0)
#define PG8_LDB(dst, b, h) do { _Pragma("unroll") for (int n = 0; n < 2; ++n) _Pragma("unroll") for (int k = 0; k < 2; ++k) dst[n][k] = *(const LAS bf16x8*)(lds + PG8_SB(b, h) + boff + n * 2048 + k * 1024); } while (0)
#define PG8_MMA(ai, bj, At, Bt) do { __builtin_amdgcn_s_setprio(1); _Pragma("unroll") for (int m = 0; m < 4; ++m) _Pragma("unroll") for (int n = 0; n < 2; ++n) _Pragma("unroll") for (int k = 0; k < 2; ++k) \
        acc[ai][bj][m][n] = __builtin_amdgcn_mfma_f32_16x16x32_bf16(Bt[n][k], At[m][k], acc[ai][bj][m][n], 0, 0, 0); __builtin_amdgcn_s_setprio(0); } while (0)
#define PG8_WAIT_V(n) asm volatile("s_waitcnt vmcnt(" #n ")" ::: "memory")
#define PG8_WAIT_L(n) asm volatile("s_waitcnt lgkmcnt(" #n ")" ::: "memory")
#define PG8_BAR __builtin_amdgcn_s_barrier()
#define PG8_SCHED __builtin_amdgcn_sched_barrier(0)
    Unit cur, nxt; int ui = 0;
    if (!S.next(0, cur)) return;
    f32x4 acc[2][2][4][2];
#pragma unroll
    for (int a = 0; a < 2; ++a)
#pragma unroll
        for (int b = 0; b < 2; ++b)
#pragma unroll
            for (int m = 0; m < 4; ++m)
#pragma unroll
                for (int n = 0; n < 2; ++n) acc[a][b][m][n] = (f32x4){0.f, 0.f, 0.f, 0.f};
    bf16x8 At[4][2], B0[2][2], B1[2][2];
    const char* cA = (const char*)g.A + (size_t)cur.pm * tstep; const char* cB = (const char*)g.Bt + (size_t)cur.pn * tstep;
    PG8_STAGE(PG8_SB(0, 0), cB, voffB); PG8_STAGE(PG8_SA(0, 0), cA, voffA); PG8_STAGE(PG8_SB(0, 1), cB + hstep, voffB); PG8_STAGE(PG8_SA(0, 1), cA + hstep, voffA);
    if (wr == 1) PG8_BAR;
    PG8_WAIT_V(4); PG8_BAR;
    PG8_STAGE(PG8_SB(1, 0), cB + kstep, voffB); PG8_STAGE(PG8_SA(1, 0), cA + kstep, voffA); PG8_STAGE(PG8_SB(1, 1), cB + hstep + kstep, voffB);
    PG8_WAIT_V(6); PG8_BAR;
    for (;;) {
        const bool has_next = S.next(ui + 1, nxt);
        const char* nA = has_next ? (const char*)g.A + (size_t)nxt.pm * tstep : cA; const char* nB = has_next ? (const char*)g.Bt + (size_t)nxt.pn * tstep : cB;
        for (int t = 0; t < nt; t += 2) {
            const bool last = (t == nt - 2);
            const char* a1 = cA + (size_t)(t + 1) * kstep;
            const char* a2 = last ? nA : cA + (size_t)(t + 2) * kstep; const char* b2 = last ? nB : cB + (size_t)(t + 2) * kstep;
            const char* a3 = a2 + kstep; const char* b3 = b2 + kstep;
            PG8_LDB(B0, 0, 0); PG8_SCHED; PG8_LDA(At, 0, 0); PG8_STAGE(PG8_SA(1, 1), a1 + hstep, voffA);
            PG8_WAIT_L(8); PG8_BAR; PG8_WAIT_L(0); PG8_MMA(0, 0, At, B0); PG8_BAR; PG8_SCHED;
            PG8_LDB(B1, 0, 1); PG8_STAGE(PG8_SB(0, 0), b2, voffB);
            PG8_BAR; PG8_WAIT_L(0); PG8_MMA(0, 1, At, B1); PG8_BAR;
            PG8_LDA(At, 0, 1); PG8_STAGE(PG8_SA(0, 0), a2, voffA);
            PG8_BAR; PG8_WAIT_L(0); PG8_MMA(1, 0, At, B0); PG8_BAR; PG8_SCHED;
            PG8_STAGE(PG8_SB(0, 1), b2 + hstep, voffB);
            PG8_WAIT_V(6); PG8_BAR; PG8_MMA(1, 1, At, B1); PG8_BAR;
            PG8_LDB(B0, 1, 0); PG8_SCHED; PG8_LDA(At, 1, 0); PG8_STAGE(PG8_SA(0, 1), a2 + hstep, voffA);
            PG8_WAIT_L(8); PG8_BAR; PG8_WAIT_L(0); PG8_MMA(0, 0, At, B0); PG8_BAR; PG8_SCHED;
            PG8_LDB(B1, 1, 1); PG8_STAGE(PG8_SB(1, 0), b3, voffB);
            PG8_BAR; PG8_WAIT_L(0); PG8_MMA(0, 1, At, B1); PG8_BAR;
            PG8_LDA(At, 1, 1); PG8_STAGE(PG8_SA(1, 0), a3, voffA);
            PG8_BAR; PG8_WAIT_L(0); PG8_MMA(1, 0, At, B0); PG8_BAR; PG8_SCHED;
            PG8_STAGE(PG8_SB(1, 1), b3 + hstep, voffB);
            PG8_WAIT_V(6); PG8_BAR; PG8_MMA(1, 1, At, B1); PG8_BAR;
        }
        { Unit eu = cur; asm volatile("" : "+s"(eu.pm), "+s"(eu.pn)); E(acc, eu, wr, wc, fr, fq); }
        if (!has_next) break;
#pragma unroll
        for (int a = 0; a < 2; ++a)
#pragma unroll
            for (int b = 0; b < 2; ++b)
#pragma unroll
                for (int m = 0; m < 4; ++m)
#pragma unroll
                    for (int n = 0; n < 2; ++n) acc[a][b][m][n] = (f32x4){0.f, 0.f, 0.f, 0.f};
        cur = nxt; cA = nA; cB = nB; ++ui;
    }
    PG8_WAIT_V(0);
    if (wr == 0) PG8_BAR;
    PG8_BAR;
#undef PG8_SA
#undef PG8_SB
#undef PG8_STAGE
#undef PG8_LDA
#undef PG8_LDB
#undef PG8_MMA
#undef PG8_WAIT_V
#undef PG8_WAIT_L
#undef PG8_BAR
#undef PG8_SCHED
}
}

typedef f32x4 AccT[2][2][4][2];
struct Epi1 {
    bf16_t* U; float* sf;
    __device__ __forceinline__ void operator()(const AccT& acc, const pg8::Unit& u, int wr, int wc, int fr, int fq) const {
        const int row0 = u.pm * 256 + wr * 64 + fr, col0 = u.pn * 256 + wc * 32 + 8 * fq;
        const bool side_dt = (u.pn == 18 && wc == 0), side_if = (u.pn == 34 && wc == 1);
#pragma unroll
        for (int ai = 0; ai < 2; ++ai)
#pragma unroll
            for (int m = 0; m < 4; ++m) {
                const int row = row0 + ai * 128 + m * 16;
                bf16_t* rowp = U + (size_t)row * N1P + col0;
#pragma unroll
                for (int bj = 0; bj < 2; ++bj) {
                    const f32x4 v0 = acc[ai][bj][m][0], v1 = acc[ai][bj][m][1];
                    u32x4 o; o[0] = pack2(v0[0], v0[1]); o[1] = pack2(v0[2], v0[3]); o[2] = pack2(v1[0], v1[1]); o[3] = pack2(v1[2], v1[3]);
                    *(u32x4*)(rowp + bj * 128) = o;
                }
                if (side_dt || side_if) {
                    float* sp = sf + (size_t)row * 64 + (side_if ? 32 : 0) + 8 * fq;
                    *(f32x4*)sp = acc[ai][0][m][0]; *(f32x4*)(sp + 4) = acc[ai][0][m][1];
                }
            }
    }
};
struct Epi2 {
    Params p;
    __device__ __forceinline__ void operator()(const AccT& acc, const pg8::Unit& u, int wr, int wc, int fr, int fq) const {
        float* H1 = (float*)(p.ws + WS_H1); bf16_t* A2 = (bf16_t*)(p.ws + WS_A2); float* SS2 = (float*)(p.ws + WS_SS2);
        const float* nw = p.in[21];
        const int row0 = u.pm * 256 + wr * 64 + fr, col0 = u.pn * 256 + wc * 32 + 8 * fq;
        f32x4 w[2][2];
#pragma unroll
        for (int bj = 0; bj < 2; ++bj) { w[bj][0] = *(const f32x4*)(nw + col0 + bj * 128); w[bj][1] = *(const f32x4*)(nw + col0 + bj * 128 + 4); }
#pragma unroll
        for (int ai = 0; ai < 2; ++ai)
#pragma unroll
            for (int m = 0; m < 4; ++m) {
                const int row = row0 + ai * 128 + m * 16;
                const float* rp = resid_row(p, row);
                float ss = 0.f;
#pragma unroll
                for (int bj = 0; bj < 2; ++bj) {
                    f32x4 v0 = acc[ai][bj][m][0], v1 = acc[ai][bj][m][1];
                    if (rp) { v0 += *(const f32x4*)(rp + col0 + bj * 128); v1 += *(const f32x4*)(rp + col0 + bj * 128 + 4); }
                    *(f32x4*)(H1 + (size_t)row * DM + col0 + bj * 128) = v0; *(f32x4*)(H1 + (size_t)row * DM + col0 + bj * 128 + 4) = v1;
                    ss += v0[0] * v0[0] + v0[1] * v0[1] + v0[2] * v0[2] + v0[3] * v0[3] + v1[0] * v1[0] + v1[1] * v1[1] + v1[2] * v1[2] + v1[3] * v1[3];
                    const f32x4 a0 = v0 * w[bj][0], a1 = v1 * w[bj][1];
                    u32x4 o; o[0] = pack2(a0[0], a0[1]); o[1] = pack2(a0[2], a0[3]); o[2] = pack2(a1[0], a1[1]); o[3] = pack2(a1[2], a1[3]);
                    *(u32x4*)(A2 + (size_t)row * DM + col0 + bj * 128) = o;
                }
                ss += __shfl_xor(ss, 16); ss += __shfl_xor(ss, 32);
                if (fq == 0) atomicAdd(SS2 + row, ss);
            }
    }
};
struct Epi3 {
    bf16_t* UP; const float* SS2;
    __device__ __forceinline__ void operator()(const AccT& acc, const pg8::Unit& u, int wr, int wc, int fr, int fq) const {
        const int row0 = u.pm * 256 + wr * 64 + fr, col0 = u.pn * 256 + wc * 32 + 8 * fq;
#pragma unroll
        for (int ai = 0; ai < 2; ++ai)
#pragma unroll
            for (int m = 0; m < 4; ++m) {
                const int row = row0 + ai * 128 + m * 16;
                const float r2 = rsqrtf(SS2[row] * (1.f / 2048.f) + EPS);
                bf16_t* rowp = UP + (size_t)row * N3 + col0;
#pragma unroll
                for (int bj = 0; bj < 2; ++bj) {
                    const f32x4 v0 = acc[ai][bj][m][0] * r2, v1 = acc[ai][bj][m][1] * r2;
                    u32x4 o; o[0] = pack2(v0[0], v0[1]); o[1] = pack2(v0[2], v0[3]); o[2] = pack2(v1[0], v1[1]); o[3] = pack2(v1[2], v1[3]);
                    *(u32x4*)(rowp + bj * 128) = o;
                }
            }
    }
};
struct Epi4 {
    const float* H1; float* out; float* SS3;
    __device__ __forceinline__ void operator()(const AccT& acc, const pg8::Unit& u, int wr, int wc, int fr, int fq) const {
        const int row0 = u.pm * 256 + wr * 64 + fr, col0 = u.pn * 256 + wc * 32 + 8 * fq;
#pragma unroll
        for (int ai = 0; ai < 2; ++ai)
#pragma unroll
            for (int m = 0; m < 4; ++m) {
                const int row = row0 + ai * 128 + m * 16;
                if (row < NOUTROWS) {
                    float ss = 0.f;
#pragma unroll
                    for (int bj = 0; bj < 2; ++bj) {
                        const f32x4 v0 = acc[ai][bj][m][0] + *(const f32x4*)(H1 + (size_t)row * DM + col0 + bj * 128);
                        const f32x4 v1 = acc[ai][bj][m][1] + *(const f32x4*)(H1 + (size_t)row * DM + col0 + bj * 128 + 4);
                        *(f32x4*)(out + (size_t)row * DM + col0 + bj * 128) = v0; *(f32x4*)(out + (size_t)row * DM + col0 + bj * 128 + 4) = v1;
                        ss += v0[0] * v0[0] + v0[1] * v0[1] + v0[2] * v0[2] + v0[3] * v0[3] + v1[0] * v1[0] + v1[1] * v1[1] + v1[2] * v1[2] + v1[3] * v1[3];
                    }
                    ss += __shfl_xor(ss, 16); ss += __shfl_xor(ss, 32);
                    if (fq == 0) atomicAdd(SS3 + row, ss);
                }
            }
    }
};

struct TileRef { const float* W; bf16_t* WT; int K, N, kt, nt; };
__device__ __forceinline__ TileRef tile_ref(const Params& p, int t) {
    constexpr int T_IN = 32 * 43, T_OUT = 64 * 8, T_UP = 32 * 44;
    TileRef r;
    if (t < T_IN) { r.W = p.in[10]; r.WT = (bf16_t*)(p.ws + WS_WIN); r.K = 2048; r.N = 10800; r.kt = t % 32; r.nt = t / 32; }
    else if (t < T_IN + T_OUT) { const int q = t - T_IN; r.W = p.in[20]; r.WT = (bf16_t*)(p.ws + WS_WOUT); r.K = 4096; r.N = 2048; r.kt = q % 64; r.nt = q / 64; }
    else if (t < T_IN + T_OUT + T_UP) { const int q = t - T_IN - T_OUT; r.W = p.in[22]; r.WT = (bf16_t*)(p.ws + WS_WUP); r.K = 2048; r.N = N3; r.kt = q % 32; r.nt = q / 32; }
    else { const int q = t - T_IN - T_OUT - T_UP; r.W = p.in[25]; r.WT = (bf16_t*)(p.ws + WS_WDOWN); r.K = DFF; r.N = 2048; r.kt = q % 88; r.nt = q / 88; }
    return r;
}
__device__ __forceinline__ void tile_load(const TileRef& r, f32x4 (&v)[8], int tid) {
    const int nc = (tid & 63) * 4, n = r.nt * 256 + nc;
#pragma unroll
    for (int i = 0; i < 8; ++i) {
        const int kr = (tid >> 6) + 8 * i;
        v[i] = (f32x4){0.f, 0.f, 0.f, 0.f};
        if (n < r.N) v[i] = *(const f32x4*)(r.W + (size_t)(r.kt * 64 + kr) * r.N + n);
    }
}
__device__ __forceinline__ void tile_lds_write(const f32x4 (&v)[8], int tid, unsigned char* smem) {
    float* tile = (float*)smem;
    const int nc = (tid & 63) * 4;
#pragma unroll
    for (int i = 0; i < 8; ++i) {
        const int kr = (tid >> 6) + 8 * i;
        tile[kr * 257 + nc] = v[i][0]; tile[kr * 257 + nc + 1] = v[i][1]; tile[kr * 257 + nc + 2] = v[i][2]; tile[kr * 257 + nc + 3] = v[i][3];
    }
}
__device__ __forceinline__ void tile_store(const TileRef& r, int tid, unsigned char* smem) {
    const float* tile = (const float*)smem;
    const int kc = (tid & 7) * 8;
#pragma unroll
    for (int q = 0; q < 4; ++q) {
        const int nr = (tid >> 3) + 64 * q;
        u32x4 o;
        o[0] = pack2(tile[(kc + 0) * 257 + nr], tile[(kc + 1) * 257 + nr]); o[1] = pack2(tile[(kc + 2) * 257 + nr], tile[(kc + 3) * 257 + nr]);
        o[2] = pack2(tile[(kc + 4) * 257 + nr], tile[(kc + 5) * 257 + nr]); o[3] = pack2(tile[(kc + 6) * 257 + nr], tile[(kc + 7) * 257 + nr]);
        *(u32x4*)(r.WT + (size_t)(r.nt * 256 + nr) * r.K + r.kt * 64 + kc) = o;
    }
}
__device__ __forceinline__ void phase_prep(const Params& p, unsigned char* smem) {
    const int tid = opaque_tid(), wid = tid >> 6, lane = tid & 63;
    { float* SS2 = (float*)(p.ws + WS_SS2); for (int i = opaque_bid() * 512 + tid; i < 2 * MP; i += gridDim.x * 512) SS2[i] = 0.f; }
    {
        bf16_t* XN = (bf16_t*)(p.ws + WS_XN); const float* nw = p.in[9];
        for (int row = opaque_bid() * 8 + wid; row < MP; row += gridDim.x * 8) {
            const float* src = resid_row(p, row);
            f32x4 v[8];
            float ss = 0.f;
#pragma unroll
            for (int it = 0; it < 4; ++it) {
                const int col = it * 512 + lane * 8;
                if (src) { v[2 * it] = *(const f32x4*)(src + col); v[2 * it + 1] = *(const f32x4*)(src + col + 4); }
                else { v[2 * it] = (f32x4){0.f, 0.f, 0.f, 0.f}; v[2 * it + 1] = (f32x4){0.f, 0.f, 0.f, 0.f}; }
#pragma unroll
                for (int j = 0; j < 4; ++j) ss += v[2 * it][j] * v[2 * it][j] + v[2 * it + 1][j] * v[2 * it + 1][j];
            }
            ss = wave_sum(ss);
            const float r = rsqrtf(ss * (1.f / 2048.f) + EPS);
#pragma unroll
            for (int it = 0; it < 4; ++it) {
                const int col = it * 512 + lane * 8;
                const f32x4 w0 = *(const f32x4*)(nw + col), w1 = *(const f32x4*)(nw + col + 4);
                const f32x4 a = v[2 * it] * r * w0, c = v[2 * it + 1] * r * w1;
                u32x4 o; o[0] = pack2(a[0], a[1]); o[1] = pack2(a[2], a[3]); o[2] = pack2(c[0], c[1]); o[3] = pack2(c[2], c[3]);
                *(u32x4*)(XN + (size_t)row * DM + col) = o;
            }
        }
    }
    constexpr int T_ALL = 32 * 43 + 64 * 8 + 32 * 44 + 88 * 8;
    {
        int t = opaque_bid();
        f32x4 v[8];
        TileRef cur{};
        if (t < T_ALL) { cur = tile_ref(p, t); tile_load(cur, v, tid); }
        while (t < T_ALL) {
            tile_lds_write(v, tid, smem);
            __syncthreads();
            const int tn = t + gridDim.x;
            TileRef nxt{};
            if (tn < T_ALL) { nxt = tile_ref(p, tn); tile_load(nxt, v, tid); }
            tile_store(cur, tid, smem);
            __syncthreads();
            cur = nxt; t = tn;
        }
    }
}

constexpr int RS = 272;
constexpr int L_QS = 0, L_KS = 34816, L_KT = 69632, L_VT = 104448, L_ST = 121856, L_SC = 139264;

template <bool ML>
__device__ __forceinline__ void load_block(const Params& p, float (&val)[8][4], int b, int p0, int Lv, int rb, int cg, int colbase, int chbase, float mlscale) {
    const bf16_t* U = (const bf16_t*)(p.ws + WS_U);
    const int t0 = rb * 8;
    if (t0 >= Lv) {
#pragma unroll
        for (int r = 0; r < 8; ++r)
#pragma unroll
            for (int i = 0; i < 4; ++i) val[r][i] = 0.f;
        return;
    }
    if (ML) {
#pragma unroll
        for (int r = 0; r < 8; ++r) {
            const int row = row_of(b, p0 + t0 + r);
            const u32x2 raw = *(const u32x2*)(U + (size_t)row * N1P + colbase + cg * 4);
            val[r][0] = bf_lo(raw[0]) * mlscale; val[r][1] = bf_hi(raw[0]) * mlscale; val[r][2] = bf_lo(raw[1]) * mlscale; val[r][3] = bf_hi(raw[1]) * mlscale;
        }
    } else {
        u32x2 raw[11];
#pragma unroll
        for (int rr = 0; rr < 11; ++rr) {
            const int pos = p0 + t0 - 3 + rr;
            if (pos >= 0) raw[rr] = *(const u32x2*)(U + (size_t)row_of(b, pos) * N1P + colbase + cg * 4);
            else raw[rr] = (u32x2){0u, 0u};
        }
        const float* cw = p.in[11]; const float* cb = p.in[12];
        const int ch = chbase + cg * 4;
        f32x4 w[4];
#pragma unroll
        for (int j = 0; j < 4; ++j) w[j] = *(const f32x4*)(cw + j * 2560 + ch);
        const f32x4 bi = *(const f32x4*)(cb + ch);
#pragma unroll
        for (int i = 0; i < 4; ++i) {
            float x[11];
#pragma unroll
            for (int rr = 0; rr < 11; ++rr) x[rr] = (i & 1) ? bf_hi(raw[rr][i >> 1]) : bf_lo(raw[rr][i >> 1]);
#pragma unroll
            for (int r = 0; r < 8; ++r) val[r][i] = silu_f(bi[i] + w[0][i] * x[r] + w[1][i] * x[r + 1] + w[2][i] * x[r + 2] + w[3][i] * x[r + 3]);
        }
    }
}
__device__ __forceinline__ void store_rows(unsigned char* base, const float (&val)[8][4], int rb, int cg) {
#pragma unroll
    for (int r = 0; r < 8; ++r) *(u32x2*)(base + (rb * 8 + r) * RS + cg * 8) = (u32x2){pack2(val[r][0], val[r][1]), pack2(val[r][2], val[r][3])};
}
__device__ __forceinline__ void store_cols(unsigned char* base, const float (&val)[8][4], int rb, int cg, const float* scale) {
    float s[8];
#pragma unroll
    for (int r = 0; r < 8; ++r) s[r] = scale ? scale[rb * 8 + r] : 1.f;
#pragma unroll
    for (int i = 0; i < 4; ++i) {
        const int row = cg * 4 + i;
        u32x4 o; o[0] = pack2(val[0][i] * s[0], val[1][i] * s[1]); o[1] = pack2(val[2][i] * s[2], val[3][i] * s[3]);
        o[2] = pack2(val[4][i] * s[4], val[5][i] * s[5]); o[3] = pack2(val[6][i] * s[6], val[7][i] * s[7]);
        *(u32x4*)(base + row * RS + ((rb ^ ((row >> 3) & 7)) << 4)) = o;
    }
}

template <bool ML>
__device__ __forceinline__ void prompt_scan(const Params& p, unsigned char* smem, int job) {
    const int tid = opaque_tid(), wid = __builtin_amdgcn_readfirstlane(tid >> 6), lane = tid & 63, fr = lane & 15, fq = lane >> 4;
    int b, h, vq = 0;
    if (ML) { b = job >> 5; h = (job >> 2) & 7; vq = job & 3; } else { b = job >> 5; h = job & 31; }
    const int g = h >> 4;
    const bf16_t* U = (const bf16_t*)(p.ws + WS_U);
    const float* SF = (const float*)(p.ws + WS_SF);
    bf16_t* MIX = (bf16_t*)(p.ws + WS_MIX);
    float* scb = (float*)(smem + L_SC);
    float *qn = scb + 1600, *nvec = scb + 1728, *mpp = scb + 1856;
    const int qcol = ML ? UC_Q + h * 128 : UC_XBC + 2304 + g * 128;
    const int kcol = ML ? UC_K + h * 128 : UC_XBC + 2048 + g * 128;
    const int vcol = ML ? UC_V + h * 256 + vq * 64 : UC_XBC + h * 64;
    const int gcol = ML ? UC_O + h * 256 + vq * 64 : UC_Z + h * 64;
    const int mixcol = ML ? 2048 + h * 256 + vq * 64 : h * 64;
    float A_h = 0.f, D_h = 0.f, dtb = 0.f, ib = 0.f, fb = 0.f;
    if (ML) { ib = p.in[17][h]; fb = p.in[18][h]; } else { A_h = -__expf(p.in[14][h]); D_h = p.in[15][h]; dtb = p.in[13][h]; }
    f32x4 st[4];
#pragma unroll
    for (int i = 0; i < 4; ++i) st[i] = (f32x4){0.f, 0.f, 0.f, 0.f};
    for (int i = tid; i < 64 * RS / 16; i += 512) *(u32x4*)(smem + L_ST + i * 16) = (u32x4){0u, 0u, 0u, 0u};
    if (tid < 128) nvec[tid] = 0.f;
    if (tid == 0) mpp[0] = 0.f;
    constexpr int CHLs = ML ? CHL_ML : CHL_SSD;
    float sraw[4] = {0.f, 0.f, 0.f, 0.f};
    auto scal_load = [&](int cc) {
        const int p0 = cc == 0 ? 0 : 16 + (cc - 1) * CHLs, Lv = cc == 0 ? 16 : CHLs;
        const int t0 = 2 * lane, t1 = t0 + 1;
        if (!ML) {
            if (t0 < Lv) sraw[0] = SF[(size_t)row_of(b, p0 + t0) * 64 + h];
            if (t1 < Lv) sraw[1] = SF[(size_t)row_of(b, p0 + t1) * 64 + h];
        } else {
            if (t0 < Lv) { const size_t r = (size_t)row_of(b, p0 + t0) * 64; sraw[0] = SF[r + 32 + h]; sraw[2] = SF[r + 40 + h]; }
            if (t1 < Lv) { const size_t r = (size_t)row_of(b, p0 + t1) * 64; sraw[1] = SF[r + 32 + h]; sraw[3] = SF[r + 40 + h]; }
        }
    };
    auto scalars = [&](int cc) {
        const int Lv = cc == 0 ? 16 : CHLs;
        float* sc = scb + (cc & 1) * 800;
        float *rowv = sc, *colv = sc + 128, *colm = sc + 256, *ev = sc + 384, *scv = sc + 512, *dden = sc + 640, *misc = sc + 768;
        const int t0 = 2 * lane, t1 = t0 + 1;
        if (!ML) {
            float d0 = 0.f, d1 = 0.f;
            if (t0 < Lv) d0 = softplus_f(sraw[0] + dtb);
            if (t1 < Lv) d1 = softplus_f(sraw[1] + dtb);
            const float a0 = d0 * A_h, a1 = d1 * A_h;
            float inc = a0 + a1;
#pragma unroll
            for (int o = 1; o < 64; o <<= 1) { const float y = __shfl_up(inc, o); if (lane >= o) inc += y; }
            const float c1 = inc, c0 = inc - a1, cl = __shfl(inc, 63);
            rowv[t0] = c0; rowv[t1] = c1; colv[t0] = -c0; colv[t1] = -c1; colm[t0] = d0; colm[t1] = d1;
            ev[t0] = __expf(c0); ev[t1] = __expf(c1); scv[t0] = __expf(cl - c0) * d0; scv[t1] = __expf(cl - c1) * d1;
            if (lane == 0) misc[0] = __expf(cl);
        } else {
            float i0 = -INFINITY, i1 = -INFINITY, f0 = 0.f, f1 = 0.f;
            if (t0 < Lv) { i0 = sraw[0] + ib; f0 = logsig_f(sraw[2] + fb); }
            if (t1 < Lv) { i1 = sraw[1] + ib; f1 = logsig_f(sraw[3] + fb); }
            float inc = f0 + f1;
#pragma unroll
            for (int o = 1; o < 64; o <<= 1) { const float y = __shfl_up(inc, o); if (lane >= o) inc += y; }
            const float F1 = inc, F0 = inc - f1;
            const float g0 = i0 - F0, g1 = i1 - F1;
            float mx = fmaxf(g0, g1);
#pragma unroll
            for (int o = 1; o < 64; o <<= 1) { const float y = __shfl_up(mx, o); if (lane >= o) mx = fmaxf(mx, y); }
            float ex = __shfl_up(mx, 1); if (lane == 0) ex = -INFINITY;
            const float mp = mpp[0];
            const float M0 = fmaxf(fmaxf(ex, g0), mp), M1 = fmaxf(mx, mp);
            const float Ml = __shfl(M1, 63), Fl = __shfl(F1, 63);
            rowv[t0] = -M0; rowv[t1] = -M1; colv[t0] = g0; colv[t1] = g1; colm[t0] = 1.f; colm[t1] = 1.f;
            ev[t0] = __expf(mp - M0); ev[t1] = __expf(mp - M1); dden[t0] = __expf(-(F0 + M0)); dden[t1] = __expf(-(F1 + M1));
            scv[t0] = __expf(g0 - Ml); scv[t1] = __expf(g1 - Ml);
            if (lane == 0) { misc[0] = __expf(mp - Ml); mpp[0] = Fl + Ml; }
        }
    };
    __syncthreads();
    if (wid == 0) { scal_load(0); scalars(0); }
    __syncthreads();
    constexpr int CHL = ML ? CHL_ML : CHL_SSD, NCH = 1 + 2048 / CHL;
    const int tid_outer = tid;
    for (int c = 0; c < NCH; ++c) {
        int tid = tid_outer; asm volatile("" : "+v"(tid));
        const int lane = tid & 63, fr = lane & 15, fq = lane >> 4;
        const int p0 = c == 0 ? 0 : 16 + (c - 1) * CHL, Lv = c == 0 ? 16 : CHL;
        float* sc = scb + (c & 1) * 800;
        float *rowv = sc, *colv = sc + 128, *colm = sc + 256, *ev = sc + 384, *scv = sc + 512, *dden = sc + 640, *misc = sc + 768;
        if (wid == 0 && c + 1 < NCH) scal_load(c + 1);
        {
            float val[8][4];
            load_block<ML>(p, val, b, p0, Lv, tid >> 5, tid & 31, qcol, 2304 + g * 128, 1.f);
            store_rows(smem + L_QS, val, tid >> 5, tid & 31);
            __builtin_amdgcn_sched_barrier(0);
            load_block<ML>(p, val, b, p0, Lv, tid >> 5, tid & 31, kcol, 2048 + g * 128, 0.08838834764831845f);
            store_rows(smem + L_KS, val, tid >> 5, tid & 31);
            store_cols(smem + L_KT, val, tid >> 5, tid & 31, scv);
            __builtin_amdgcn_sched_barrier(0);
            if (tid < 256) {
                load_block<ML>(p, val, b, p0, Lv, tid >> 4, tid & 15, vcol, h * 64, 1.f);
                store_cols(smem + L_VT, val, tid >> 4, tid & 15, nullptr);
            }
        }
        __syncthreads();
        const int t = 16 * wid + fr;
        const bool valid = t < Lv;
        const int row = row_of(b, p0 + (valid ? t : 0));
        u32x2 gate[4];
#pragma unroll
        for (int vb = 0; vb < 4; ++vb) gate[vb] = *(const u32x2*)(U + (size_t)row * N1P + gcol + 16 * vb + 4 * fq);
        if (ML) {
            const int tt = tid >> 2, part = tid & 3;
            float s = 0.f;
#pragma unroll
            for (int cc = 0; cc < 4; ++cc) {
                const u32x4 raw = *(const u32x4*)(smem + L_QS + tt * RS + (part * 4 + cc) * 16);
                const f32x4 n0 = *(const f32x4*)(nvec + (part * 4 + cc) * 8), n1 = *(const f32x4*)(nvec + (part * 4 + cc) * 8 + 4);
                s += bf_lo(raw[0]) * n0[0] + bf_hi(raw[0]) * n0[1] + bf_lo(raw[1]) * n0[2] + bf_hi(raw[1]) * n0[3]
                   + bf_lo(raw[2]) * n1[0] + bf_hi(raw[2]) * n1[1] + bf_lo(raw[3]) * n1[2] + bf_hi(raw[3]) * n1[3];
            }
            s += __shfl_xor(s, 1); s += __shfl_xor(s, 2);
            if (part == 0) qn[tt] = s;
        }
        bf16x8 qf[4];
#pragma unroll
        for (int kk = 0; kk < 4; ++kk) qf[kk] = *(const bf16x8*)(smem + L_QS + t * RS + (kk * 32 + fq * 8) * 2);
        const float rv = rowv[t];
        float rowsum = 0.f;
        u32x2 pk[8];
#pragma unroll
        for (int sb = 0; sb < 8; ++sb) {
            pk[sb] = (u32x2){0u, 0u};
            if (sb <= wid) {
                f32x4 acc = {0.f, 0.f, 0.f, 0.f};
#pragma unroll
                for (int kk = 0; kk < 4; ++kk) {
                    const bf16x8 kf = *(const bf16x8*)(smem + L_KS + (16 * sb + fr) * RS + (kk * 32 + fq * 8) * 2);
                    acc = __builtin_amdgcn_mfma_f32_16x16x32_bf16(kf, qf[kk], acc, 0, 0, 0);
                }
                const f32x4 cv = *(const f32x4*)(colv + 16 * sb + 4 * fq), cm = *(const f32x4*)(colm + 16 * sb + 4 * fq);
                float pv[4];
#pragma unroll
                for (int j = 0; j < 4; ++j) {
                    const int s = 16 * sb + 4 * fq + j;
                    const float w = (s <= t) ? __expf(rv + cv[j]) * cm[j] : 0.f;
                    pv[j] = acc[j] * w; rowsum += pv[j];
                }
                pk[sb] = (u32x2){pack2(pv[0], pv[1]), pack2(pv[2], pv[3])};
            }
        }
        if (wid == 0 && c + 1 < NCH) scalars(c + 1);
        __syncthreads();
#pragma unroll
        for (int sb = 0; sb < 8; ++sb) *(u32x2*)(smem + L_KS + t * RS + (16 * sb + 4 * fq) * 2) = pk[sb];
        rowsum += __shfl_xor(rowsum, 16); rowsum += __shfl_xor(rowsum, 32);
        if (ML) {
            const int d = tid >> 2, part = tid & 3;
            float s = 0.f;
#pragma unroll
            for (int cc = 0; cc < 4; ++cc) {
                const u32x4 raw = *(const u32x4*)(smem + L_KT + d * RS + (part * 4 + cc) * 16);
                s += bf_lo(raw[0]) + bf_hi(raw[0]) + bf_lo(raw[1]) + bf_hi(raw[1]) + bf_lo(raw[2]) + bf_hi(raw[2]) + bf_lo(raw[3]) + bf_hi(raw[3]);
            }
            s += __shfl_xor(s, 1); s += __shfl_xor(s, 2);
            if (part == 0) nvec[d] = misc[0] * nvec[d] + s;
        }
        __syncthreads();
        bf16x8 pf[4];
#pragma unroll
        for (int kk = 0; kk < 4; ++kk) pf[kk] = *(const bf16x8*)(smem + L_KS + t * RS + (kk * 32 + fq * 8) * 2);
        const float et = ev[t];
        float ddv = 1.f;
        if (ML) ddv = fmaxf(fabsf(rowsum + et * qn[t]), dden[t]);
        float ss = 0.f;
#pragma unroll
        for (int vb = 0; vb < 4; ++vb) {
            f32x4 acc = {0.f, 0.f, 0.f, 0.f};
            const int vrow = 16 * vb + fr;
#pragma unroll
            for (int kk = 0; kk < 4; ++kk) {
                const bf16x8 sf = *(const bf16x8*)(smem + L_ST + vrow * RS + (kk * 32 + fq * 8) * 2);
                acc = __builtin_amdgcn_mfma_f32_16x16x32_bf16(sf, qf[kk], acc, 0, 0, 0);
            }
            acc *= et;
#pragma unroll
            for (int kk = 0; kk < 4; ++kk) {
                const bf16x8 vf = *(const bf16x8*)(smem + L_VT + vrow * RS + (((kk * 4 + fq) ^ ((vrow >> 3) & 7)) << 4));
                acc = __builtin_amdgcn_mfma_f32_16x16x32_bf16(vf, pf[kk], acc, 0, 0, 0);
            }
            const float gz[4] = {bf_lo(gate[vb][0]), bf_hi(gate[vb][0]), bf_lo(gate[vb][1]), bf_hi(gate[vb][1])};
            float o[4];
#pragma unroll
            for (int j = 0; j < 4; ++j) {
                if (ML) { const float hv = acc[j]; ss += hv * hv; o[j] = hv * sigm_f(gz[j]); }
                else {
                    const int v = 16 * vb + 4 * fq + j;
                    const float xv = bf2f(*(const bf16_t*)(smem + L_VT + v * RS + (((t >> 3) ^ ((v >> 3) & 7)) << 4) + (t & 7) * 2));
                    const float y = (acc[j] + D_h * xv) * silu_f(gz[j]); ss += y * y; o[j] = y;
                }
            }
            if (valid) *(u32x2*)(MIX + (size_t)row * MIXW + mixcol + 16 * vb + 4 * fq) = (u32x2){pack2(o[0], o[1]), pack2(o[2], o[3])};
        }
        ss += __shfl_xor(ss, 16); ss += __shfl_xor(ss, 32);
        if (valid && fq == 0) {
            if (ML) { ((float*)(p.ws + WS_SSQM))[(size_t)row * 32 + h * 4 + vq] = ss; if (vq == 0) ((float*)(p.ws + WS_DD))[(size_t)row * 8 + h] = ddv; }
            else ((float*)(p.ws + WS_SSQ))[(size_t)row * 32 + h] = ss;
        }
        const float dec = misc[0];
#pragma unroll
        for (int vb = 0; vb < 4; ++vb) st[vb] *= dec;
#pragma unroll
        for (int kk = 0; kk < 4; ++kk) {
            const int drow = 16 * wid + fr;
            const bf16x8 kf = *(const bf16x8*)(smem + L_KT + drow * RS + (((kk * 4 + fq) ^ ((drow >> 3) & 7)) << 4));
#pragma unroll
            for (int vb = 0; vb < 4; ++vb) {
                const int vrow = 16 * vb + fr;
                const bf16x8 vf = *(const bf16x8*)(smem + L_VT + vrow * RS + (((kk * 4 + fq) ^ ((vrow >> 3) & 7)) << 4));
                st[vb] = __builtin_amdgcn_mfma_f32_16x16x32_bf16(kf, vf, st[vb], 0, 0, 0);
            }
        }
        __syncthreads();
#pragma unroll
        for (int vb = 0; vb < 4; ++vb)
            *(u32x2*)(smem + L_ST + (16 * vb + fr) * RS + (16 * wid + 4 * fq) * 2) = (u32x2){pack2(st[vb][0], st[vb][1]), pack2(st[vb][2], st[vb][3])};
    }
#pragma unroll
    for (int vb = 0; vb < 4; ++vb) {
        const int v = 16 * vb + fr, d0 = 16 * wid + 4 * fq;
        if (!ML) *(f32x4*)(p.out + O_P_SSD + ((size_t)(b * 32 + h) * 64 + v) * 128 + d0) = st[vb];
        else {
#pragma unroll
            for (int j = 0; j < 4; ++j) p.out[O_P_MLC + ((size_t)(b * 8 + h) * 128 + d0 + j) * 256 + vq * 64 + v] = st[vb][j];
        }
    }
    if (ML && vq == 0) {
        if (tid < 128) p.out[O_P_MLN + (size_t)(b * 8 + h) * 128 + tid] = nvec[tid];
        if (tid == 0) p.out[O_P_MLM + b * 8 + h] = mpp[0];
    }
    __syncthreads();
}

__device__ __forceinline__ void sample_ssd(const Params& p, unsigned char* smem, int job) {
    const int tid = opaque_tid(), wid = tid >> 6, lane = tid & 63;
    const int b = job >> 1, g = job & 1, rowb = ROW_SAMPLE + b * 8;
    const bf16_t* U = (const bf16_t*)(p.ws + WS_U);
    const float* SF = (const float*)(p.ws + WS_SF);
    bf16_t* MIX = (bf16_t*)(p.ws + WS_MIX);
    float* Bc = (float*)smem; float* Cc = Bc + 1024; float* xall = Cc + 1024; float* G = xall + 8192; float* dts = G + 64; float* ssqp = dts + 128;
    const float* sconv = p.in[2]; const float* cw = p.in[11]; const float* cb = p.in[12];
#pragma unroll
    for (int q = 0; q < 3; ++q) {
        int ch; float* dst; int dstride = 0;
        if (q < 2) { ch = g * 1024 + tid + q * 512; dst = xall + tid + q * 512; dstride = 1024; }
        else { if (tid >= 256) break; const int which = tid >> 7, n = tid & 127; ch = 2048 + which * 256 + g * 128 + n; dst = (which ? Cc : Bc) + n; dstride = 128; }
        float xm3 = sconv[(size_t)(b * 3 + 0) * 2560 + ch], xm2 = sconv[(size_t)(b * 3 + 1) * 2560 + ch], xm1 = sconv[(size_t)(b * 3 + 2) * 2560 + ch];
        const float w0 = cw[ch], w1 = cw[2560 + ch], w2 = cw[5120 + ch], w3 = cw[7680 + ch], bb = cb[ch];
#pragma unroll
        for (int t = 0; t < 8; ++t) {
            const float x = bf2f(U[(size_t)(rowb + t) * N1P + UC_XBC + ch]);
            dst[t * dstride] = silu_f(bb + w0 * xm3 + w1 * xm2 + w2 * xm1 + w3 * x);
            xm3 = xm2; xm2 = xm1; xm1 = x;
        }
    }
    if (tid < 128) { const int hh = tid >> 3, t = tid & 7; dts[tid] = softplus_f(SF[(size_t)(rowb + t) * 64 + g * 16 + hh] + p.in[13][g * 16 + hh]); }
    __syncthreads();
    {
        const int pair = tid >> 3, part = tid & 7, t = pair >> 3, s = pair & 7;
        float sum = 0.f;
#pragma unroll
        for (int i = 0; i < 4; ++i) {
            const f32x4 c4 = *(const f32x4*)(Cc + t * 128 + part * 16 + i * 4), b4 = *(const f32x4*)(Bc + s * 128 + part * 16 + i * 4);
            sum += c4[0] * b4[0] + c4[1] * b4[1] + c4[2] * b4[2] + c4[3] * b4[3];
        }
        sum += __shfl_xor(sum, 1); sum += __shfl_xor(sum, 2); sum += __shfl_xor(sum, 4);
        if (part == 0) G[pair] = sum;
    }
    __syncthreads();
    const int pp = tid >> 3, nq = tid & 7;
    f32x4 snext[4];
#pragma unroll
    for (int i = 0; i < 4; ++i) snext[i] = *(const f32x4*)(p.in[3] + ((size_t)(b * 32 + g * 16) * 64 + pp) * 128 + nq * 4 + 32 * i);
    for (int hh = 0; hh < 16; ++hh) {
        const int h = g * 16 + hh;
        const float A_h = -__expf(p.in[14][h]), D_h = p.in[15][h];
        float dtv[8], cum[8];
        { float run = 0.f;
#pragma unroll
          for (int t = 0; t < 8; ++t) { dtv[t] = dts[hh * 8 + t]; run += dtv[t] * A_h; cum[t] = run; } }
        const size_t soff = ((size_t)(b * 32 + h) * 64 + pp) * 128 + nq * 4;
        f32x4 s0[4];
#pragma unroll
        for (int i = 0; i < 4; ++i) s0[i] = snext[i];
        if (hh + 1 < 16) {
#pragma unroll
            for (int i = 0; i < 4; ++i) snext[i] = *(const f32x4*)(p.in[3] + soff + 64 * 128 + 32 * i);
        }
        float cs[8];
#pragma unroll
        for (int t = 0; t < 8; ++t) {
            float sum = 0.f;
#pragma unroll
            for (int i = 0; i < 4; ++i) { const f32x4 c4 = *(const f32x4*)(Cc + t * 128 + nq * 4 + 32 * i); sum += c4[0] * s0[i][0] + c4[1] * s0[i][1] + c4[2] * s0[i][2] + c4[3] * s0[i][3]; }
            sum += __shfl_xor(sum, 1); sum += __shfl_xor(sum, 2); sum += __shfl_xor(sum, 4);
            cs[t] = sum;
        }
        float ycs = 0.f, ct = 0.f;
#pragma unroll
        for (int t = 0; t < 8; ++t) { ycs = (nq == t) ? cs[t] : ycs; ct = (nq == t) ? cum[t] : ct; }
        float y = __expf(ct) * ycs, xt = 0.f;
#pragma unroll
        for (int s = 0; s < 8; ++s) {
            const float xs = xall[s * 1024 + hh * 64 + pp];
            const float term = (s <= nq) ? G[nq * 8 + s] * __expf(ct - cum[s]) * dtv[s] * xs : 0.f;
            y += term; xt = (s == nq) ? xs : xt;
        }
        y += D_h * xt;
        const float z = bf2f(U[(size_t)(rowb + nq) * N1P + UC_Z + h * 64 + pp]);
        y *= silu_f(z);
        { const unsigned pk = pack2(y, 0.f); MIX[(size_t)(rowb + nq) * MIXW + h * 64 + pp] = (bf16_t)(pk & 0xffffu); }
        float sq = y * y; sq += __shfl_xor(sq, 8); sq += __shfl_xor(sq, 16); sq += __shfl_xor(sq, 32);
        if (lane < 8) ssqp[(hh * 8 + wid) * 8 + lane] = sq;
        const float cl = cum[7], dec = __expf(cl);
        float xw[8];
#pragma unroll
        for (int s = 0; s < 8; ++s) xw[s] = __expf(cl - cum[s]) * dtv[s] * xall[s * 1024 + hh * 64 + pp];
#pragma unroll
        for (int i = 0; i < 4; ++i) {
            f32x4 acc = s0[i] * dec;
#pragma unroll
            for (int s = 0; s < 8; ++s) acc += xw[s] * *(const f32x4*)(Bc + s * 128 + nq * 4 + 32 * i);
            *(f32x4*)(p.out + O_S_SSD + soff + 32 * i) = acc;
        }
    }
    __syncthreads();
    if (tid < 128) {
        const int hh = tid >> 3, t = tid & 7; float tot = 0.f;
#pragma unroll
        for (int w = 0; w < 8; ++w) tot += ssqp[(hh * 8 + w) * 8 + t];
        ((float*)(p.ws + WS_SSQ))[(size_t)(rowb + t) * 32 + g * 16 + hh] = tot;
    }
    __syncthreads();
}

__device__ __forceinline__ void sample_ml(const Params& p, unsigned char* smem, int job) {
    const int tid = opaque_tid(), wid = __builtin_amdgcn_readfirstlane(tid >> 6), lane = tid & 63;
    const int b = job >> 3, h = job & 7, rowb = ROW_SAMPLE + b * 8;
    const bf16_t* U = (const bf16_t*)(p.ws + WS_U);
    const float* SF = (const float*)(p.ws + WS_SF);
    bf16_t* MIX = (bf16_t*)(p.ws + WS_MIX);
    float* qs = (float*)smem; float* ks = qs + 1024; float* vs = qs + 2048; float* QK = qs + 4096; float* sig = qs + 4160; float* slf = qs + 4168;
    float* qnv = qs + 4176; float* n0v = qs + 4192; float* red = qs + 4352;
    {
        const int t = tid >> 6, c = tid & 63;
        const size_t r = (size_t)(rowb + t) * N1P;
        const unsigned qq = *(const unsigned*)(U + r + UC_Q + h * 128 + 2 * c), kk = *(const unsigned*)(U + r + UC_K + h * 128 + 2 * c);
        const u32x2 vv = *(const u32x2*)(U + r + UC_V + h * 256 + 4 * c);
        qs[t * 128 + 2 * c] = bf_lo(qq); qs[t * 128 + 2 * c + 1] = bf_hi(qq);
        ks[t * 128 + 2 * c] = bf_lo(kk) * 0.08838834764831845f; ks[t * 128 + 2 * c + 1] = bf_hi(kk) * 0.08838834764831845f;
        *(f32x4*)(vs + t * 256 + 4 * c) = (f32x4){bf_lo(vv[0]), bf_hi(vv[0]), bf_lo(vv[1]), bf_hi(vv[1])};
        if (tid < 8) { sig[tid] = SF[(size_t)(rowb + tid) * 64 + 32 + h] + p.in[17][h]; slf[tid] = logsig_f(SF[(size_t)(rowb + tid) * 64 + 40 + h] + p.in[18][h]); }
        if (tid >= 128 && tid < 256) n0v[tid - 128] = p.in[5][(size_t)(b * 8 + h) * 128 + tid - 128];
    }
    const int v4 = lane, dg = wid;
    const size_t coff = ((size_t)(b * 8 + h) * 128 + dg * 16) * 256 + v4 * 4;
    f32x4 c0[16];
#pragma unroll
    for (int i = 0; i < 16; ++i) c0[i] = *(const f32x4*)(p.in[4] + coff + (size_t)i * 256);
    const float mp = p.in[6][b * 8 + h];
    __syncthreads();
    float F[8], gg[8], M[8];
    { float run = 0.f, pm = -INFINITY;
#pragma unroll
      for (int t = 0; t < 8; ++t) { run += slf[t]; F[t] = run; gg[t] = sig[t] - run; pm = fmaxf(pm, gg[t]); M[t] = fmaxf(pm, mp); } }
    const float Ml = M[7], dec = __expf(mp - Ml), m_new = F[7] + Ml;
    {
        const int pair = tid >> 3, part = tid & 7, t = pair >> 3, s = pair & 7;
        float sum = 0.f;
#pragma unroll
        for (int i = 0; i < 4; ++i) {
            const f32x4 a4 = *(const f32x4*)(qs + t * 128 + part * 16 + i * 4), b4 = *(const f32x4*)(ks + s * 128 + part * 16 + i * 4);
            sum += a4[0] * b4[0] + a4[1] * b4[1] + a4[2] * b4[2] + a4[3] * b4[3];
        }
        sum += __shfl_xor(sum, 1); sum += __shfl_xor(sum, 2); sum += __shfl_xor(sum, 4);
        if (part == 0) QK[pair] = sum;
        float qd = qs[wid * 128 + 2 * lane] * n0v[2 * lane] + qs[wid * 128 + 2 * lane + 1] * n0v[2 * lane + 1];
        qd = wave_sum(qd);
        if (lane == 0) qnv[wid] = qd;
    }
#pragma unroll
    for (int t = 0; t < 8; ++t) {
        f32x4 acc = {0.f, 0.f, 0.f, 0.f};
#pragma unroll
        for (int i4 = 0; i4 < 4; ++i4) {
            const f32x4 q4 = *(const f32x4*)(qs + t * 128 + dg * 16 + i4 * 4);
            acc += q4[0] * c0[i4 * 4] + q4[1] * c0[i4 * 4 + 1] + q4[2] * c0[i4 * 4 + 2] + q4[3] * c0[i4 * 4 + 3];
        }
        *(f32x4*)(red + (dg * 8 + t) * 256 + v4 * 4) = acc;
    }
    __syncthreads();
    f32x4 vv[8];
    float scs[8];
#pragma unroll
    for (int s = 0; s < 8; ++s) { vv[s] = *(const f32x4*)(vs + s * 256 + v4 * 4); scs[s] = __expf(gg[s] - Ml); }
#pragma unroll
    for (int i = 0; i < 16; ++i) {
        const int d = dg * 16 + i;
        f32x4 cn = c0[i] * dec;
#pragma unroll
        for (int s = 0; s < 8; ++s) cn += (scs[s] * ks[s * 128 + d]) * vv[s];
        *(f32x4*)(p.out + O_S_MLC + coff + (size_t)i * 256) = cn;
    }
    if (tid < 128) {
        float nn = dec * n0v[tid];
#pragma unroll
        for (int s = 0; s < 8; ++s) nn += scs[s] * ks[s * 128 + tid];
        p.out[O_S_MLN + (size_t)(b * 8 + h) * 128 + tid] = nn;
    }
    if (tid == 0) p.out[O_S_MLM + b * 8 + h] = m_new;
    {
        const int t = wid;
        float Mt = 0.f, Ft = 0.f;
#pragma unroll
        for (int q = 0; q < 8; ++q) { Mt = (t == q) ? M[q] : Mt; Ft = (t == q) ? F[q] : Ft; }
        f32x4 numc = {0.f, 0.f, 0.f, 0.f};
#pragma unroll
        for (int q = 0; q < 8; ++q) numc += *(const f32x4*)(red + (q * 8 + t) * 256 + lane * 4);
        const float et = __expf(mp - Mt);
        float den = et * qnv[t];
        f32x4 intra = {0.f, 0.f, 0.f, 0.f};
#pragma unroll
        for (int s = 0; s < 8; ++s) {
            if (s <= t) { const float w = __expf(gg[s] - Mt) * QK[t * 8 + s]; den += w; intra += w * vv[s]; }
        }
        const float dd = fmaxf(fabsf(den), __expf(-(Ft + Mt)));
        const f32x4 hv = (et * numc + intra) * (1.f / dd);
        float ss = hv[0] * hv[0] + hv[1] * hv[1] + hv[2] * hv[2] + hv[3] * hv[3];
        ss = wave_sum(ss);
        const u32x2 og = *(const u32x2*)(U + (size_t)(rowb + t) * N1P + UC_O + h * 256 + lane * 4);
        *(u32x2*)(MIX + (size_t)(rowb + t) * MIXW + 2048 + h * 256 + lane * 4) =
            (u32x2){pack2(hv[0] * sigm_f(bf_lo(og[0])), hv[1] * sigm_f(bf_hi(og[0]))), pack2(hv[2] * sigm_f(bf_lo(og[1])), hv[3] * sigm_f(bf_hi(og[1])))};
        if (lane < 4) ((float*)(p.ws + WS_SSQM))[(size_t)(rowb + t) * 32 + h * 4 + lane] = lane == 0 ? ss : 0.f;
        if (lane == 0) ((float*)(p.ws + WS_DD))[(size_t)(rowb + t) * 8 + h] = 1.f;
    }
    __syncthreads();
}

__device__ __forceinline__ void phase_scan(const Params& p, unsigned char* smem) {
#ifndef SC_MASK
#define SC_MASK 15
#endif
    for (int j = opaque_bid(); j < 256; j += gridDim.x) { if (j < 128) { if (SC_MASK & 1) prompt_scan<false>(p, smem, j); } else { if (SC_MASK & 2) prompt_scan<true>(p, smem, j - 128); } }
    if (SC_MASK & 4) for (int j = opaque_bid(); j < 256; j += gridDim.x) sample_ssd(p, smem, j);
    if (SC_MASK & 8) for (int j = opaque_bid(); j < 1024; j += gridDim.x) sample_ml(p, smem, j);
}

__device__ __forceinline__ void phase_mixnorm(const Params& p) {
    const int tid = opaque_tid(), wid = tid >> 6, lane = tid & 63;
    bf16_t* MIX = (bf16_t*)(p.ws + WS_MIX);
    const float* SSQ = (const float*)(p.ws + WS_SSQ); const float* SSQM = (const float*)(p.ws + WS_SSQM);
    const float* w1 = p.in[16]; const float* w2 = p.in[19];
    for (int row = opaque_bid() * 8 + wid; row < NVALID; row += gridDim.x * 8) {
        float s = lane < 32 ? SSQ[(size_t)row * 32 + lane] : 0.f;
        s = wave_sum(s);
        const float r1 = rsqrtf(s * (1.f / 2048.f) + EPS);
        float m = lane < 32 ? SSQM[(size_t)row * 32 + lane] : 0.f;
        m += __shfl_xor(m, 1); m += __shfl_xor(m, 2);
        const float ddh = lane < 32 ? ((const float*)(p.ws + WS_DD))[(size_t)row * 8 + (lane >> 2)] : 1.f;
        const float idd = 1.f / ddh;
        const float rh = rsqrtf(m * (1.f / 256.f) * idd * idd + EPS) * idd;
        u32x4 raws[8];
#pragma unroll
        for (int it = 0; it < 8; ++it) raws[it] = *(const u32x4*)(MIX + (size_t)row * MIXW + it * 512 + lane * 8);
#pragma unroll
        for (int it = 0; it < 8; ++it) {
            const int col = it * 512 + lane * 8;
            const u32x4 raw = raws[it];
            float scale; const float* wp;
            if (it < 4) { scale = r1; wp = w1 + col; }
            else { const int head = (it - 4) * 2 + (lane >> 5); scale = __shfl(rh, head * 4); wp = w2 + col - 2048; }
            const f32x4 wa = *(const f32x4*)wp, wb = *(const f32x4*)(wp + 4);
            u32x4 o;
            o[0] = pack2(bf_lo(raw[0]) * scale * wa[0], bf_hi(raw[0]) * scale * wa[1]); o[1] = pack2(bf_lo(raw[1]) * scale * wa[2], bf_hi(raw[1]) * scale * wa[3]);
            o[2] = pack2(bf_lo(raw[2]) * scale * wb[0], bf_hi(raw[2]) * scale * wb[1]); o[3] = pack2(bf_lo(raw[3]) * scale * wb[2], bf_hi(raw[3]) * scale * wb[3]);
            *(u32x4*)(MIX + (size_t)row * MIXW + col) = o;
        }
    }
    const bf16_t* U = (const bf16_t*)(p.ws + WS_U);
    for (int i = opaque_bid() * 512 + tid; i < 132 * 3 * 320; i += gridDim.x * 512) {
        const int cgp = i % 320, j = (i / 320) % 3, q = i / 960;
        int row; float* dst;
        if (q < 4) { row = q * 2048 + 2045 + j; dst = p.out + O_P_SSDCONV + (size_t)(q * 3 + j) * 2560 + cgp * 8; }
        else { row = ROW_SAMPLE + (q - 4) * 8 + 5 + j; dst = p.out + O_S_SSDCONV + (size_t)((q - 4) * 3 + j) * 2560 + cgp * 8; }
        const u32x4 raw = *(const u32x4*)(U + (size_t)row * N1P + UC_XBC + cgp * 8);
        *(f32x4*)dst = (f32x4){bf_lo(raw[0]), bf_hi(raw[0]), bf_lo(raw[1]), bf_hi(raw[1])};
        *(f32x4*)(dst + 4) = (f32x4){bf_lo(raw[2]), bf_hi(raw[2]), bf_lo(raw[3]), bf_hi(raw[3])};
    }
}

__device__ __forceinline__ void unpack8(const u32x4 raw, float (&x)[8]) {
#pragma unroll
    for (int i = 0; i < 4; ++i) { x[2 * i] = bf_lo(raw[i]); x[2 * i + 1] = bf_hi(raw[i]); }
}
__device__ __forceinline__ void phase_act(const Params& p) {
    const bf16_t* UP = (const bf16_t*)(p.ws + WS_UP); bf16_t* ACT = (bf16_t*)(p.ws + WS_ACT);
    const float* cw = p.in[23]; const float* cb = p.in[24]; const float* fst = p.in[7];
    constexpr int CGN = DFF / 8, TOTAL = (NVALID / 8) * CGN;
    const int tid = opaque_tid();
    for (int idx = opaque_bid() * 512 + tid; idx < TOTAL; idx += gridDim.x * 512) {
        const int rb = idx / CGN, cgp = idx % CGN, row0 = rb * 8, c0 = cgp * 8;
        float g2[8], g1[8], v2[8], v1[8];
        int prow = -1; bool from_state = false; int sb = 0, pb = -1;
        if (row0 < ROW_SAMPLE) { const int b = row0 >> 11, t0 = row0 & 2047; prow = t0 > 0 ? row0 - 2 : ROW_META + b * 16 + 14; if (t0 == 2040) pb = b; }
        else if (row0 < ROW_META) { from_state = true; sb = (row0 - ROW_SAMPLE) >> 3; }
        else { if ((row0 - ROW_META) & 15) prow = row0 - 2; }
        if (from_state) {
            const float* s0 = fst + (size_t)(sb * 2) * N3;
#pragma unroll
            for (int i = 0; i < 8; ++i) { g2[i] = s0[c0 + i]; g1[i] = s0[N3 + c0 + i]; v2[i] = s0[DFF + c0 + i]; v1[i] = s0[N3 + DFF + c0 + i]; }
        } else if (prow >= 0) {
            unpack8(*(const u32x4*)(UP + (size_t)prow * N3 + c0), g2); unpack8(*(const u32x4*)(UP + (size_t)(prow + 1) * N3 + c0), g1);
            unpack8(*(const u32x4*)(UP + (size_t)prow * N3 + DFF + c0), v2); unpack8(*(const u32x4*)(UP + (size_t)(prow + 1) * N3 + DFF + c0), v1);
        } else {
#pragma unroll
            for (int i = 0; i < 8; ++i) { g2[i] = 0.f; g1[i] = 0.f; v2[i] = 0.f; v1[i] = 0.f; }
        }
        float wg[3][8], wv[3][8], bg[8], bv[8];
#pragma unroll
        for (int j = 0; j < 3; ++j)
#pragma unroll
            for (int i = 0; i < 8; ++i) { wg[j][i] = cw[j * N3 + c0 + i]; wv[j][i] = cw[j * N3 + DFF + c0 + i]; }
#pragma unroll
        for (int i = 0; i < 8; ++i) { bg[i] = cb[c0 + i]; bv[i] = cb[DFF + c0 + i]; }
        u32x4 rg[8], rv[8];
#pragma unroll
        for (int r = 0; r < 8; ++r) { rg[r] = *(const u32x4*)(UP + (size_t)(row0 + r) * N3 + c0); rv[r] = *(const u32x4*)(UP + (size_t)(row0 + r) * N3 + DFF + c0); }
#pragma unroll
        for (int r = 0; r < 8; ++r) {
            float gx[8], vx[8];
            unpack8(rg[r], gx); unpack8(rv[r], vx);
            float o[8];
#pragma unroll
            for (int i = 0; i < 8; ++i) {
                const float yg = bg[i] + wg[0][i] * g2[i] + wg[1][i] * g1[i] + wg[2][i] * gx[i];
                const float yv = bv[i] + wv[0][i] * v2[i] + wv[1][i] * v1[i] + wv[2][i] * vx[i];
                o[i] = silu_f(yg) * yv;
                g2[i] = g1[i]; g1[i] = gx[i]; v2[i] = v1[i]; v1[i] = vx[i];
            }
            u32x4 ov; ov[0] = pack2(o[0], o[1]); ov[1] = pack2(o[2], o[3]); ov[2] = pack2(o[4], o[5]); ov[3] = pack2(o[6], o[7]);
            *(u32x4*)(ACT + (size_t)(row0 + r) * DFF + c0) = ov;
        }
        if (from_state || pb >= 0) {
            float* dst = from_state ? p.out + O_S_FFN + (size_t)(sb * 2) * N3 : p.out + O_P_FFN + (size_t)(pb * 2) * N3;
            *(f32x4*)(dst + c0) = (f32x4){g2[0], g2[1], g2[2], g2[3]}; *(f32x4*)(dst + c0 + 4) = (f32x4){g2[4], g2[5], g2[6], g2[7]};
            *(f32x4*)(dst + N3 + c0) = (f32x4){g1[0], g1[1], g1[2], g1[3]}; *(f32x4*)(dst + N3 + c0 + 4) = (f32x4){g1[4], g1[5], g1[6], g1[7]};
            *(f32x4*)(dst + DFF + c0) = (f32x4){v2[0], v2[1], v2[2], v2[3]}; *(f32x4*)(dst + DFF + c0 + 4) = (f32x4){v2[4], v2[5], v2[6], v2[7]};
            *(f32x4*)(dst + N3 + DFF + c0) = (f32x4){v1[0], v1[1], v1[2], v1[3]}; *(f32x4*)(dst + N3 + DFF + c0 + 4) = (f32x4){v1[4], v1[5], v1[6], v1[7]};
        }
    }
}

__device__ __forceinline__ void phase_final(const Params& p) {
    const int tid = opaque_tid(), wid = tid >> 6, lane = tid & 63;
    const float* SS3 = (const float*)(p.ws + WS_SS3); const float* nw = p.in[26];
    for (int row = opaque_bid() * 8 + wid; row < NOUTROWS; row += gridDim.x * 8) {
        const float r = rsqrtf(SS3[row] * (1.f / 2048.f) + EPS);
        float* rp = p.out + (size_t)row * DM;
        f32x4 v[8];
#pragma unroll
        for (int it = 0; it < 8; ++it) v[it] = *(const f32x4*)(rp + it * 256 + lane * 4);
#pragma unroll
        for (int it = 0; it < 8; ++it) {
            const int col = it * 256 + lane * 4;
            const f32x4 w = *(const f32x4*)(nw + col);
            *(f32x4*)(rp + col) = v[it] * r * w;
        }
    }
}

__global__ void __launch_bounds__(512, 2) hymba_fwd(Params p0) {
    extern __shared__ __attribute__((aligned(16))) unsigned char smem[];
    cg::grid_group grid = cg::this_grid();
#ifndef DUP_PHASE
#define DUP_PHASE -1
#endif
    for (int phx = p0.ph_lo; phx < p0.ph_hi + (DUP_PHASE >= 0 ? 1 : 0); ++phx) {
        const int ph = (DUP_PHASE >= 0 && phx > DUP_PHASE) ? phx - 1 : phx;
        Params p = p0;
        asm volatile("" : "+s"(p.ws), "+s"(p.out));
        switch (ph) {
        case 0: if (PH_MASK & 1) phase_prep(p, smem); break;
        case 1: if (PH_MASK & 2) { pg8::Gemm g{(const bf16_t*)(p.ws + WS_XN), (const bf16_t*)(p.ws + WS_WIN), MP, N1P, 2048}; pg8::StaticOrder S; S.init(MP, N1P, gridDim.x, opaque_bid());
                  Epi1 E{(bf16_t*)(p.ws + WS_U), (float*)(p.ws + WS_SF)}; pg8::gemm_phase((LAS unsigned char*)smem, g, S, E); } break;
        case 2: if (PH_MASK & 4) phase_scan(p, smem); break;
        case 3: if (PH_MASK & 8) phase_mixnorm(p); break;
        case 4: if (PH_MASK & 16) { pg8::Gemm g{(const bf16_t*)(p.ws + WS_MIX), (const bf16_t*)(p.ws + WS_WOUT), MP, 2048, 4096}; pg8::StaticOrder S; S.init(MP, 2048, gridDim.x, opaque_bid());
                  Epi2 E{p}; pg8::gemm_phase((LAS unsigned char*)smem, g, S, E); } break;
        case 5: if (PH_MASK & 32) { pg8::Gemm g{(const bf16_t*)(p.ws + WS_A2), (const bf16_t*)(p.ws + WS_WUP), MP, N3, 2048}; pg8::StaticOrder S; S.init(MP, N3, gridDim.x, opaque_bid());
                  Epi3 E{(bf16_t*)(p.ws + WS_UP), (const float*)(p.ws + WS_SS2)}; pg8::gemm_phase((LAS unsigned char*)smem, g, S, E); } break;
        case 6: if (PH_MASK & 64) phase_act(p); break;
        case 7: if (PH_MASK & 128) { pg8::Gemm g{(const bf16_t*)(p.ws + WS_ACT), (const bf16_t*)(p.ws + WS_WDOWN), MP, 2048, DFF}; pg8::StaticOrder S; S.init(MP, 2048, gridDim.x, opaque_bid());
                  Epi4 E{(const float*)(p.ws + WS_H1), p.out, (float*)(p.ws + WS_SS3)}; pg8::gemm_phase((LAS unsigned char*)smem, g, S, E); } break;
        default: if (PH_MASK & 256) phase_final(p); break;
        }
        if (phx + 1 < p0.ph_hi + (DUP_PHASE >= 0 ? 1 : 0)) grid.sync();
    }
}

extern "C" void kernel_launch(void* const* d_in, const int* in_sizes, int n_in, void* d_out, int out_size, void* d_ws, size_t ws_size, hipStream_t stream) {
    static int grid_blocks = 0;
    if (grid_blocks == 0) {
        if (n_in != 27 || (size_t)out_size != O_END || ws_size < WS_END) {
            fprintf(stderr, "kernel_launch: unexpected shapes: n_in %d out %d ws %zu (need %zu)\n", n_in, out_size, ws_size, (size_t)WS_END); grid_blocks = -1; return; }
        int dev = 0, cus = 0, per_cu = 0;
        (void)hipGetDevice(&dev);
        (void)hipDeviceGetAttribute(&cus, hipDeviceAttributeMultiprocessorCount, dev);
        (void)hipFuncSetAttribute((const void*)hymba_fwd, hipFuncAttributeMaxDynamicSharedMemorySize, LDS_BYTES);
        (void)hipOccupancyMaxActiveBlocksPerMultiprocessor(&per_cu, (const void*)hymba_fwd, 512, LDS_BYTES);
        if (per_cu < 1) { fprintf(stderr, "kernel_launch: occupancy query says %d blocks per CU\n", per_cu); per_cu = 1; }
        grid_blocks = cus;
    }
    if (grid_blocks < 0) return;
    Params p{};
    for (int i = 0; i < 27; ++i) p.in[i] = (const float*)d_in[i];
    p.out = (float*)d_out; p.ws = (unsigned char*)d_ws; p.ph_lo = 0; p.ph_hi = NPHASE;
    void* args[] = {&p};
    hipError_t e = hipLaunchCooperativeKernel((const void*)hymba_fwd, dim3(grid_blocks), dim3(512), args, LDS_BYTES, stream);
    if (e != hipSuccess) fprintf(stderr, "cooperative launch failed: %s (grid %d)\n", hipGetErrorString(e), grid_blocks);
}
```

```cpp
#include <hip/hip_runtime.h>
#include <hip/hip_cooperative_groups.h>
#include <cstdio>
namespace cg = cooperative_groups;

#define LAS __attribute__((address_space(3)))
typedef unsigned short bf16_t;
typedef short bf16x8 __attribute__((ext_vector_type(8)));
typedef float f32x4 __attribute__((ext_vector_type(4)));
typedef unsigned u32x4 __attribute__((ext_vector_type(4)));
typedef unsigned u32x2 __attribute__((ext_vector_type(2)));

constexpr int DM = 2048, MP = 9472, NVALID = 9280, NOUTROWS = 9216;
constexpr int N1P = 11008, N3 = 11264, DFF = 5632, MIXW = 4096;
constexpr int ROW_SAMPLE = 8192, ROW_META = 9216;
constexpr float EPS = 1e-6f;
constexpr int UC_Z = 0, UC_XBC = 2048, UC_Q = 4640, UC_K = 5664, UC_V = 6688, UC_O = 8752;
constexpr size_t WS_WIN = 0;
constexpr size_t WS_WOUT = WS_WIN + (size_t)N1P * 2048 * 2;
constexpr size_t WS_WUP = WS_WOUT + (size_t)2048 * 4096 * 2;
constexpr size_t WS_WDOWN = WS_WUP + (size_t)N3 * 2048 * 2;
constexpr size_t WS_XN = WS_WDOWN + (size_t)2048 * DFF * 2;
constexpr size_t WS_MIX = WS_XN + (size_t)MP * 2048 * 2;
constexpr size_t WS_ACT = WS_XN;
constexpr size_t WS_U = WS_MIX + (size_t)MP * MIXW * 2;
constexpr size_t WS_UP = WS_U;
constexpr size_t WS_H1 = WS_U + (size_t)MP * N3 * 2;
constexpr size_t WS_A2 = WS_H1 + (size_t)MP * 2048 * 4;
constexpr size_t WS_SF = WS_A2 + (size_t)MP * 2048 * 2;
constexpr size_t WS_SSQ = WS_SF + (size_t)MP * 64 * 4;
constexpr size_t WS_SSQM = WS_SSQ + (size_t)MP * 32 * 4;
constexpr size_t WS_SS2 = WS_SSQM + (size_t)MP * 32 * 4;
constexpr size_t WS_SS3 = WS_SS2 + (size_t)MP * 4;
constexpr size_t WS_DD = WS_SS3 + (size_t)MP * 4;
constexpr size_t WS_END = WS_DD + (size_t)MP * 8 * 4;
constexpr size_t O_Y = 0;
constexpr size_t O_P_SSDCONV = 18874368, O_P_SSD = 18905088, O_P_MLC = 19953664, O_P_MLN = 21002240, O_P_MLM = 21006336, O_P_FFN = 21006368;
constexpr size_t O_S_SSDCONV = 21096480, O_S_SSD = 22079520, O_S_MLC = 55633952, O_S_MLN = 89188384, O_S_MLM = 89319456, O_S_FFN = 89320480;
constexpr size_t O_END = 92204064;
constexpr int LDS_BYTES = 147456;
constexpr int NPHASE = 9;
#ifndef CHL_SSD
#define CHL_SSD 128
#endif
#ifndef CHL_ML
#define CHL_ML 128
#endif
#ifndef PH_MASK
#define PH_MASK 0x1ff
#endif

struct Params {
    const float* in[27];
    float* out;
    unsigned char* ws;
    int ph_lo, ph_hi;
};

__device__ __forceinline__ unsigned pack2(float lo, float hi) { unsigned r; asm("v_cvt_pk_bf16_f32 %0, %1, %2" : "=v"(r) : "v"(lo), "v"(hi)); return r; }
__device__ __forceinline__ float bf_lo(unsigned u) { return __uint_as_float(u << 16); }
__device__ __forceinline__ float bf_hi(unsigned u) { return __uint_as_float(u & 0xffff0000u); }
__device__ __forceinline__ float bf2f(bf16_t h) { return __uint_as_float((unsigned)h << 16); }
__device__ __forceinline__ float sigm_f(float x) { const float d = 1.f + __expf(fminf(-x, 80.f)); float r = __builtin_amdgcn_rcpf(d); return r * (2.f - d * r); }
__device__ __forceinline__ float silu_f(float x) { return x * sigm_f(x); }
__device__ __forceinline__ float softplus_f(float x) { return x > 20.f ? x : log1pf(__expf(x)); }
__device__ __forceinline__ float logsig_f(float x) { return fminf(x, 0.f) - log1pf(__expf(-fabsf(x))); }
__device__ __forceinline__ int opaque_tid() { int t = threadIdx.x; asm volatile("" : "+v"(t)); return t; }
__device__ __forceinline__ int opaque_bid() { int t = blockIdx.x; asm volatile("" : "+s"(t)); return t; }
__device__ __forceinline__ int row_of(int b, int pos) { return pos < 16 ? ROW_META + b * 16 + pos : b * 2048 + pos - 16; }
__device__ __forceinline__ float wave_sum(float v) {
    v += __shfl_xor(v, 32); v += __shfl_xor(v, 16); v += __shfl_xor(v, 8); v += __shfl_xor(v, 4); v += __shfl_xor(v, 2); v += __shfl_xor(v, 1); return v;
}
__device__ __forceinline__ const float* resid_row(const Params& p, int row) {
    if (row < ROW_SAMPLE) return p.in[0] + (size_t)row * DM;
    if (row < ROW_META) return p.in[1] + (size_t)(row - ROW_SAMPLE) * DM;
    if (row < NVALID) return p.in[8] + (size_t)((row - ROW_META) & 15) * DM;
    return nullptr;
}

namespace pg8 {
constexpr int BM = 256, BK = 64, HALF = 128, HTB = HALF * BK * 2, STAGE_BYTES = 8 * HTB, NXCD = 8, WGM = 8;
__device__ __forceinline__ int lds_byte(int r, int c) { const int st = (r >> 4) * 2 + (c >> 5), rr = r & 15, cc = c & 31, ob = rr * 64 + cc * 2; return st * 1024 + (ob ^ (((ob >> 9) & 1) << 5)); }
__device__ __forceinline__ void stage_rc(int b, int& R, int& C) { const int st = b / 1024, sb = b % 1024, swz = sb ^ (((sb >> 9) & 1) << 5); R = (st >> 1) * 16 + swz / 64; C = (st & 1) * 32 + (swz % 64) / 2; }
__device__ __forceinline__ int perm32(int rho) { const int n = rho >> 4, i = rho & 15; return 8 * (i >> 2) + 4 * n + (i & 3); }
struct Unit { int pm, pn; };
struct Gemm { const bf16_t* A; const bf16_t* Bt; int M, N, K; };
struct StaticOrder {
    int nM, nN, nwg, G, c;
    __device__ void init(int M, int N, int G_, int c_) { nM = M / BM; nN = N / BM; nwg = nM * nN; G = G_; c = c_; }
    __device__ bool next(int i, Unit& u) const {
        const long L = (long)i * G + c; if (L >= nwg) return false;
        int wgid = (int)L; { const int q = nwg / NXCD, r = nwg % NXCD, xcd = wgid % NXCD, off = wgid / NXCD; wgid = (xcd < r ? xcd * (q + 1) : r * (q + 1) + (xcd - r) * q) + off; }
        const int nig = WGM * nN, gid = wgid / nig, fm = gid * WGM, gsz = (nM - fm) < WGM ? (nM - fm) : WGM;
        u.pm = fm + ((wgid % nig) % gsz); u.pn = (wgid % nig) / gsz; return true;
    }
};

template <class Epi>
__device__ __forceinline__ void gemm_phase(LAS unsigned char* lds, const Gemm g, const StaticOrder& S, const Epi& E) {
    const int tid = opaque_tid(), wid = __builtin_amdgcn_readfirstlane(tid >> 6), lane = tid & 63, wr = wid >> 2, wc = wid & 3, fr = lane & 15, fq = lane >> 4;
    const int K = g.K, nt = K / BK;
    unsigned voffA[2], voffB[2];
#pragma unroll
    for (int i = 0; i < 2; ++i) { int R, C; stage_rc(tid * 16 + i * 8192, R, C); const int Rb = ((R & ~31) + perm32(R & 31));
        voffA[i] = (unsigned)(R * K + C) * 2u; voffB[i] = (unsigned)(Rb * K + C) * 2u; }
    const size_t kstep = (size_t)(BK * 2);
    const size_t hstep = (size_t)HALF * K * 2;
    const size_t tstep = 2 * hstep;
    const unsigned ldsw = (unsigned)wid * 1024u;
    const int aoff = lds_byte(wr * 64 + fr, fq * 8), boff = lds_byte(wc * 32 + fr, fq * 8);
#define PG8_SA(b, h) (((b) * 2 + (h)) * HTB)
#define PG8_SB(b, h) ((4 + (b) * 2 + (h)) * HTB)
#define PG8_STAGE(bufoff, gbase, voff) do { _Pragma("unroll") for (int _i = 0; _i < 2; ++_i) \
        __builtin_amdgcn_global_load_lds((const unsigned*)((const char*)(gbase) + (voff)[_i]), (LAS unsigned*)(lds + (bufoff) + ldsw + _i * 8192), 16, 0, 0); } while (0)
#define PG8_LDA(dst, b, h) do { _Pragma("unroll") for (int m = 0; m < 4; ++m) _Pragma("unroll") for (int k = 0; k < 2; ++k) dst[m][k] = *(const LAS bf16x8*)(lds + PG8_SA(b, h) + aoff + m * 2048 + k * 1024); } while (0)
#define PG8_LDB(dst, b, h) do { _Pragma("unroll") for (int n = 0; n < 2; ++n) _Pragma("unroll") for (int k = 0; k < 2; ++k) dst[n][k] = *(const LAS bf16x8*)(lds + PG8_SB(b, h) + boff + n * 2048 + k * 1024); } while (0)
#define PG8_MMA(ai, bj, At, Bt) do { __builtin_amdgcn_s_setprio(1); _Pragma("unroll") for (int m = 0; m < 4; ++m) _Pragma("unroll") for (int n = 0; n < 2; ++n) _Pragma("unroll") for (int k = 0; k < 2; ++k) \
        acc[ai][bj][m][n] = __builtin_amdgcn_mfma_f32_16x16x32_bf16(Bt[n][k], At[m][k], acc[ai][bj][m][n], 0, 0, 0); __builtin_amdgcn_s_setprio(0); } while (0)
#define PG8_WAIT_V(n) asm volatile("s_waitcnt vmcnt(" #n ")" ::: "memory")
#define PG8_WAIT_L(n) asm volatile("s_waitcnt lgkmcnt(" #n ")" ::: "memory")
#define PG8_BAR __builtin_amdgcn_s_barrier()
#define PG8_SCHED __builtin_amdgcn_sched_barrier(0)
    Unit cur, nxt; int ui = 0;
    if (!S.next(0, cur)) return;
    f32x4 acc[2][2][4][2];
#pragma unroll
    for (int a = 0; a < 2; ++a)
#pragma unroll
        for (int b = 0; b < 2; ++b)
#pragma unroll
            for (int m = 0; m < 4; ++m)
#pragma unroll
                for (int n = 0; n < 2; ++n) acc[a][b][m][n] = (f32x4){0.f, 0.f, 0.f, 0.f};
    bf16x8 At[4][2], B0[2][2], B1[2][2];
    const char* cA = (const char*)g.A + (size_t)cur.pm * tstep; const char* cB = (const char*)g.Bt + (size_t)cur.pn * tstep;
    PG8_STAGE(PG8_SB(0, 0), cB, voffB); PG8_STAGE(PG8_SA(0, 0), cA, voffA); PG8_STAGE(PG8_SB(0, 1), cB + hstep, voffB); PG8_STAGE(PG8_SA(0, 1), cA + hstep, voffA);
    if (wr == 1) PG8_BAR;
    PG8_WAIT_V(4); PG8_BAR;
    PG8_STAGE(PG8_SB(1, 0), cB + kstep, voffB); PG8_STAGE(PG8_SA(1, 0), cA + kstep, voffA); PG8_STAGE(PG8_SB(1, 1), cB + hstep + kstep, voffB);
    PG8_WAIT_V(6); PG8_BAR;
    for (;;) {
        const bool has_next = S.next(ui + 1, nxt);
        const char* nA = has_next ? (const char*)g.A + (size_t)nxt.pm * tstep : cA; const char* nB = has_next ? (const char*)g.Bt + (size_t)nxt.pn * tstep : cB;
        for (int t = 0; t < nt; t += 2) {
            const bool last = (t == nt - 2);
            const char* a1 = cA + (size_t)(t + 1) * kstep;
            const char* a2 = last ? nA : cA + (size_t)(t + 2) * kstep; const char* b2 = last ? nB : cB + (size_t)(t + 2) * kstep;
            const char* a3 = a2 + kstep; const char* b3 = b2 + kstep;
            PG8_LDB(B0, 0, 0); PG8_SCHED; PG8_LDA(At, 0, 0); PG8_STAGE(PG8_SA(1, 1), a1 + hstep, voffA);
            PG8_WAIT_L(8); PG8_BAR; PG8_WAIT_L(0); PG8_MMA(0, 0, At, B0); PG8_BAR; PG8_SCHED;
            PG8_LDB(B1, 0, 1); PG8_STAGE(PG8_SB(0, 0), b2, voffB);
            PG8_BAR; PG8_WAIT_L(0); PG8_MMA(0, 1, At, B1); PG8_BAR;
            PG8_LDA(At, 0, 1); PG8_STAGE(PG8_SA(0, 0), a2, voffA);
            PG8_BAR; PG8_WAIT_L(0); PG8_MMA(1, 0, At, B0); PG8_BAR; PG8_SCHED;
            PG8_STAGE(PG8_SB(0, 1), b2 + hstep, voffB);
            PG8_WAIT_V(6); PG8_BAR; PG8_MMA(1, 1, At, B1); PG8_BAR;
            PG8_LDB(B0, 1, 0); PG8_SCHED; PG8_LDA(At, 1, 0); PG8_STAGE(PG8_SA(0, 1), a2 + hstep, voffA);
            PG8_WAIT_L(8); PG8_BAR; PG8_WAIT_L(0); PG8_MMA(0, 0, At, B0); PG8_BAR; PG8_SCHED;
            PG8_LDB(B1, 1, 1); PG8_STAGE(PG8_SB(1, 0), b3, voffB);
            PG8_BAR; PG8_WAIT_L(0); PG8_MMA(0, 1, At, B1); PG8_BAR;
            PG8_LDA(At, 1, 1); PG8_STAGE(PG8_SA(1, 0), a3, voffA);
            PG8_BAR; PG8_WAIT_L(0); PG8_MMA(1, 0, At, B0); PG8_BAR; PG8_SCHED;
            PG8_STAGE(PG8_SB(1, 1), b3 + hstep, voffB);
            PG8_WAIT_V(6); PG8_BAR; PG8_MMA(1, 1, At, B1); PG8_BAR;
        }
        { Unit eu = cur; asm volatile("" : "+s"(eu.pm), "+s"(eu.pn)); E(acc, eu, wr, wc, fr, fq); }
        if (!has_next) break;
#pragma unroll
        for (int a = 0; a < 2; ++a)
#pragma unroll
            for (int b = 0; b < 2; ++b)
#pragma unroll
                for (int m = 0; m < 4; ++m)
#pragma unroll
                    for (int n = 0; n < 2; ++n) acc[a][b][m][n] = (f32x4){0.f, 0.f, 0.f, 0.f};
        cur = nxt; cA = nA; cB = nB; ++ui;
    }
    PG8_WAIT_V(0);
    if (wr == 0) PG8_BAR;
    PG8_BAR;
#undef PG8_SA
#undef PG8_SB
#undef PG8_STAGE
#undef PG8_LDA
#undef PG8_LDB
#undef PG8_MMA
#undef PG8_WAIT_V
#undef PG8_WAIT_L
#undef PG8_BAR
#undef PG8_SCHED
}
}

typedef f32x4 AccT[2][2][4][2];
struct Epi1 {
    bf16_t* U; float* sf;
    __device__ __forceinline__ void operator()(const AccT& acc, const pg8::Unit& u, int wr, int wc, int fr, int fq) const {
        const int row0 = u.pm * 256 + wr * 64 + fr, col0 = u.pn * 256 + wc * 32 + 8 * fq;
        const bool side_dt = (u.pn == 18 && wc == 0), side_if = (u.pn == 34 && wc == 1);
#pragma unroll
        for (int ai = 0; ai < 2; ++ai)
#pragma unroll
            for (int m = 0; m < 4; ++m) {
                const int row = row0 + ai * 128 + m * 16;
                bf16_t* rowp = U + (size_t)row * N1P + col0;
#pragma unroll
                for (int bj = 0; bj < 2; ++bj) {
                    const f32x4 v0 = acc[ai][bj][m][0], v1 = acc[ai][bj][m][1];
                    u32x4 o; o[0] = pack2(v0[0], v0[1]); o[1] = pack2(v0[2], v0[3]); o[2] = pack2(v1[0], v1[1]); o[3] = pack2(v1[2], v1[3]);
                    *(u32x4*)(rowp + bj * 128) = o;
                }
                if (side_dt || side_if) {
                    float* sp = sf + (size_t)row * 64 + (side_if ? 32 : 0) + 8 * fq;
                    *(f32x4*)sp = acc[ai][0][m][0]; *(f32x4*)(sp + 4) = acc[ai][0][m][1];
                }
            }
    }
};
struct Epi2 {
    Params p;
    __device__ __forceinline__ void operator()(const AccT& acc, const pg8::Unit& u, int wr, int wc, int fr, int fq) const {
        float* H1 = (float*)(p.ws + WS_H1); bf16_t* A2 = (bf16_t*)(p.ws + WS_A2); float* SS2 = (float*)(p.ws + WS_SS2);
        const float* nw = p.in[21];
        const int row0 = u.pm * 256 + wr * 64 + fr, col0 = u.pn * 256 + wc * 32 + 8 * fq;
        f32x4 w[2][2];
#pragma unroll
        for (int bj = 0; bj < 2; ++bj) { w[bj][0] = *(const f32x4*)(nw + col0 + bj * 128); w[bj][1] = *(const f32x4*)(nw + col0 + bj * 128 + 4); }
#pragma unroll
        for (int ai = 0; ai < 2; ++ai)
#pragma unroll
            for (int m = 0; m < 4; ++m) {
                const int row = row0 + ai * 128 + m * 16;
                const float* rp = resid_row(p, row);
                float ss = 0.f;
#pragma unroll
                for (int bj = 0; bj < 2; ++bj) {
                    f32x4 v0 = acc[ai][bj][m][0], v1 = acc[ai][bj][m][1];
                    if (rp) { v0 += *(const f32x4*)(rp + col0 + bj * 128); v1 += *(const f32x4*)(rp + col0 + bj * 128 + 4); }
                    *(f32x4*)(H1 + (size_t)row * DM + col0 + bj * 128) = v0; *(f32x4*)(H1 + (size_t)row * DM + col0 + bj * 128 + 4) = v1;
                    ss += v0[0] * v0[0] + v0[1] * v0[1] + v0[2] * v0[2] + v0[3] * v0[3] + v1[0] * v1[0] + v1[1] * v1[1] + v1[2] * v1[2] + v1[3] * v1[3];
                    const f32x4 a0 = v0 * w[bj][0], a1 = v1 * w[bj][1];
                    u32x4 o; o[0] = pack2(a0[0], a0[1]); o[1] = pack2(a0[2], a0[3]); o[2] = pack2(a1[0], a1[1]); o[3] = pack2(a1[2], a1[3]);
                    *(u32x4*)(A2 + (size_t)row * DM + col0 + bj * 128) = o;
                }
                ss += __shfl_xor(ss, 16); ss += __shfl_xor(ss, 32);
                if (fq == 0) atomicAdd(SS2 + row, ss);
            }
    }
};
struct Epi3 {
    bf16_t* UP; const float* SS2;
    __device__ __forceinline__ void operator()(const AccT& acc, const pg8::Unit& u, int wr, int wc, int fr, int fq) const {
        const int row0 = u.pm * 256 + wr * 64 + fr, col0 = u.pn * 256 + wc * 32 + 8 * fq;
#pragma unroll
        for (int ai = 0; ai < 2; ++ai)
#pragma unroll
            for (int m = 0; m < 4; ++m) {
                const int row = row0 + ai * 128 + m * 16;
                const float r2 = rsqrtf(SS2[row] * (1.f / 2048.f) + EPS);
                bf16_t* rowp = UP + (size_t)row * N3 + col0;
#pragma unroll
                for (int bj = 0; bj < 2; ++bj) {
                    const f32x4 v0 = acc[ai][bj][m][0] * r2, v1 = acc[ai][bj][m][1] * r2;
                    u32x4 o; o[0] = pack2(v0[0], v0[1]); o[1] = pack2(v0[2], v0[3]); o[2] = pack2(v1[0], v1[1]); o[3] = pack2(v1[2], v1[3]);
                    *(u32x4*)(rowp + bj * 128) = o;
                }
            }
    }
};
struct Epi4 {
    const float* H1; float* out; float* SS3;
    __device__ __forceinline__ void operator()(const AccT& acc, const pg8::Unit& u, int wr, int wc, int fr, int fq) const {
        const int row0 = u.pm * 256 + wr * 64 + fr, col0 = u.pn * 256 + wc * 32 + 8 * fq;
#pragma unroll
        for (int ai = 0; ai < 2; ++ai)
#pragma unroll
            for (int m = 0; m < 4; ++m) {
                const int row = row0 + ai * 128 + m * 16;
                if (row < NOUTROWS) {
                    float ss = 0.f;
#pragma unroll
                    for (int bj = 0; bj < 2; ++bj) {
                        const f32x4 v0 = acc[ai][bj][m][0] + *(const f32x4*)(H1 + (size_t)row * DM + col0 + bj * 128);
                        const f32x4 v1 = acc[ai][bj][m][1] + *(const f32x4*)(H1 + (size_t)row * DM + col0 + bj * 128 + 4);
                        *(f32x4*)(out + (size_t)row * DM + col0 + bj * 128) = v0; *(f32x4*)(out + (size_t)row * DM + col0 + bj * 128 + 4) = v1;
                        ss += v0[0] * v0[0] + v0[1] * v0[1] + v0[2] * v0[2] + v0[3] * v0[3] + v1[0] * v1[0] + v1[1] * v1[1] + v1[2] * v1[2] + v1[3] * v1[3];
                    }
                    ss += __shfl_xor(ss, 16); ss += __shfl_xor(ss, 32);
                    if (fq == 0) atomicAdd(SS3 + row, ss);
                }
            }
    }
};

struct TileRef { const float* W; bf16_t* WT; int K, N, kt, nt; };
__device__ __forceinline__ TileRef tile_ref(const Params& p, int t) {
    constexpr int T_IN = 32 * 43, T_OUT = 64 * 8, T_UP = 32 * 44;
    TileRef r;
    if (t < T_IN) { r.W = p.in[10]; r.WT = (bf16_t*)(p.ws + WS_WIN); r.K = 2048; r.N = 10800; r.kt = t % 32; r.nt = t / 32; }
    else if (t < T_IN + T_OUT) { const int q = t - T_IN; r.W = p.in[20]; r.WT = (bf16_t*)(p.ws + WS_WOUT); r.K = 4096; r.N = 2048; r.kt = q % 64; r.nt = q / 64; }
    else if (t < T_IN + T_OUT + T_UP) { const int q = t - T_IN - T_OUT; r.W = p.in[22]; r.WT = (bf16_t*)(p.ws + WS_WUP); r.K = 2048; r.N = N3; r.kt = q % 32; r.nt = q / 32; }
    else { const int q = t - T_IN - T_OUT - T_UP; r.W = p.in[25]; r.WT = (bf16_t*)(p.ws + WS_WDOWN); r.K = DFF; r.N = 2048; r.kt = q % 88; r.nt = q / 88; }
    return r;
}
__device__ __forceinline__ void tile_load(const TileRef& r, f32x4 (&v)[8], int tid) {
    const int nc = (tid & 63) * 4, n = r.nt * 256 + nc;
#pragma unroll
    for (int i = 0; i < 8; ++i) {
        const int kr = (tid >> 6) + 8 * i;
        v[i] = (f32x4){0.f, 0.f, 0.f, 0.f};
        if (n < r.N) v[i] = *(const f32x4*)(r.W + (size_t)(r.kt * 64 + kr) * r.N + n);
    }
}
__device__ __forceinline__ void tile_lds_write(const f32x4 (&v)[8], int tid, unsigned char* smem) {
    float* tile = (float*)smem;
    const int nc = (tid & 63) * 4;
#pragma unroll
    for (int i = 0; i < 8; ++i) {
        const int kr = (tid >> 6) + 8 * i;
        tile[kr * 257 + nc] = v[i][0]; tile[kr * 257 + nc + 1] = v[i][1]; tile[kr * 257 + nc + 2] = v[i][2]; tile[kr * 257 + nc + 3] = v[i][3];
    }
}
__device__ __forceinline__ void tile_store(const TileRef& r, int tid, unsigned char* smem) {
    const float* tile = (const float*)smem;
    const int kc = (tid & 7) * 8;
#pragma unroll
    for (int q = 0; q < 4; ++q) {
        const int nr = (tid >> 3) + 64 * q;
        u32x4 o;
        o[0] = pack2(tile[(kc + 0) * 257 + nr], tile[(kc + 1) * 257 + nr]); o[1] = pack2(tile[(kc + 2) * 257 + nr], tile[(kc + 3) * 257 + nr]);
        o[2] = pack2(tile[(kc + 4) * 257 + nr], tile[(kc + 5) * 257 + nr]); o[3] = pack2(tile[(kc + 6) * 257 + nr], tile[(kc + 7) * 257 + nr]);
        *(u32x4*)(r.WT + (size_t)(r.nt * 256 + nr) * r.K + r.kt * 64 + kc) = o;
    }
}
__device__ __forceinline__ void phase_prep(const Params& p, unsigned char* smem) {
    const int tid = opaque_tid(), wid = tid >> 6, lane = tid & 63;
    { float* SS2 = (float*)(p.ws + WS_SS2); for (int i = opaque_bid() * 512 + tid; i < 2 * MP; i += gridDim.x * 512) SS2[i] = 0.f; }
    {
        bf16_t* XN = (bf16_t*)(p.ws + WS_XN); const float* nw = p.in[9];
        for (int row = opaque_bid() * 8 + wid; row < MP; row += gridDim.x * 8) {
            const float* src = resid_row(p, row);
            f32x4 v[8];
            float ss = 0.f;
#pragma unroll
            for (int it = 0; it < 4; ++it) {
                const int col = it * 512 + lane * 8;
                if (src) { v[2 * it] = *(const f32x4*)(src + col); v[2 * it + 1] = *(const f32x4*)(src + col + 4); }
                else { v[2 * it] = (f32x4){0.f, 0.f, 0.f, 0.f}; v[2 * it + 1] = (f32x4){0.f, 0.f, 0.f, 0.f}; }
#pragma unroll
                for (int j = 0; j < 4; ++j) ss += v[2 * it][j] * v[2 * it][j] + v[2 * it + 1][j] * v[2 * it + 1][j];
            }
            ss = wave_sum(ss);
            const float r = rsqrtf(ss * (1.f / 2048.f) + EPS);
#pragma unroll
            for (int it = 0; it < 4; ++it) {
                const int col = it * 512 + lane * 8;
                const f32x4 w0 = *(const f32x4*)(nw + col), w1 = *(const f32x4*)(nw + col + 4);
                const f32x4 a = v[2 * it] * r * w0, c = v[2 * it + 1] * r * w1;
                u32x4 o; o[0] = pack2(a[0], a[1]); o[1] = pack2(a[2], a[3]); o[2] = pack2(c[0], c[1]); o[3] = pack2(c[2], c[3]);
                *(u32x4*)(XN + (size_t)row * DM + col) = o;
            }
        }
    }
    constexpr int T_ALL = 32 * 43 + 64 * 8 + 32 * 44 + 88 * 8;
    {
        int t = opaque_bid();
        f32x4 v[8];
        TileRef cur{};
        if (t < T_ALL) { cur = tile_ref(p, t); tile_load(cur, v, tid); }
        while (t < T_ALL) {
            tile_lds_write(v, tid, smem);
            __syncthreads();
            const int tn = t + gridDim.x;
            TileRef nxt{};
            if (tn < T_ALL) { nxt = tile_ref(p, tn); tile_load(nxt, v, tid); }
            tile_store(cur, tid, smem);
            __syncthreads();
            cur = nxt; t = tn;
        }
    }
}

constexpr int RS = 272;
constexpr int L_QS = 0, L_KS = 34816, L_KT = 69632, L_VT = 104448, L_ST = 121856, L_SC = 139264;

template <bool ML>
__device__ __forceinline__ void load_block(const Params& p, float (&val)[8][4], int b, int p0, int Lv, int rb, int cg, int colbase, int chbase, float mlscale) {
    const bf16_t* U = (const bf16_t*)(p.ws + WS_U);
    const int t0 = rb * 8;
    if (t0 >= Lv) {
#pragma unroll
        for (int r = 0; r < 8; ++r)
#pragma unroll
            for (int i = 0; i < 4; ++i) val[r][i] = 0.f;
        return;
    }
    if (ML) {
#pragma unroll
        for (int r = 0; r < 8; ++r) {
            const int row = row_of(b, p0 + t0 + r);
            const u32x2 raw = *(const u32x2*)(U + (size_t)row * N1P + colbase + cg * 4);
            val[r][0] = bf_lo(raw[0]) * mlscale; val[r][1] = bf_hi(raw[0]) * mlscale; val[r][2] = bf_lo(raw[1]) * mlscale; val[r][3] = bf_hi(raw[1]) * mlscale;
        }
    } else {
        u32x2 raw[11];
#pragma unroll
        for (int rr = 0; rr < 11; ++rr) {
            const int pos = p0 + t0 - 3 + rr;
            if (pos >= 0) raw[rr] = *(const u32x2*)(U + (size_t)row_of(b, pos) * N1P + colbase + cg * 4);
            else raw[rr] = (u32x2){0u, 0u};
        }
        const float* cw = p.in[11]; const float* cb = p.in[12];
        const int ch = chbase + cg * 4;
        f32x4 w[4];
#pragma unroll
        for (int j = 0; j < 4; ++j) w[j] = *(const f32x4*)(cw + j * 2560 + ch);
        const f32x4 bi = *(const f32x4*)(cb + ch);
#pragma unroll
        for (int i = 0; i < 4; ++i) {
            float x[11];
#pragma unroll
            for (int rr = 0; rr < 11; ++rr) x[rr] = (i & 1) ? bf_hi(raw[rr][i >> 1]) : bf_lo(raw[rr][i >> 1]);
#pragma unroll
            for (int r = 0; r < 8; ++r) val[r][i] = silu_f(bi[i] + w[0][i] * x[r] + w[1][i] * x[r + 1] + w[2][i] * x[r + 2] + w[3][i] * x[r + 3]);
        }
    }
}
__device__ __forceinline__ void store_rows(unsigned char* base, const float (&val)[8][4], int rb, int cg) {
#pragma unroll
    for (int r = 0; r < 8; ++r) *(u32x2*)(base + (rb * 8 + r) * RS + cg * 8) = (u32x2){pack2(val[r][0], val[r][1]), pack2(val[r][2], val[r][3])};
}
__device__ __forceinline__ void store_cols(unsigned char* base, const float (&val)[8][4], int rb, int cg, const float* scale) {
    float s[8];
#pragma unroll
    for (int r = 0; r < 8; ++r) s[r] = scale ? scale[rb * 8 + r] : 1.f;
#pragma unroll
    for (int i = 0; i < 4; ++i) {
        const int row = cg * 4 + i;
        u32x4 o; o[0] = pack2(val[0][i] * s[0], val[1][i] * s[1]); o[1] = pack2(val[2][i] * s[2], val[3][i] * s[3]);
        o[2] = pack2(val[4][i] * s[4], val[5][i] * s[5]); o[3] = pack2(val[6][i] * s[6], val[7][i] * s[7]);
        *(u32x4*)(base + row * RS + ((rb ^ ((row >> 3) & 7)) << 4)) = o;
    }
}

template <bool ML>
__device__ __forceinline__ void prompt_scan(const Params& p, unsigned char* smem, int job) {
    const int tid = opaque_tid(), wid = __builtin_amdgcn_readfirstlane(tid >> 6), lane = tid & 63, fr = lane & 15, fq = lane >> 4;
    int b, h, vq = 0;
    if (ML) { b = job >> 5; h = (job >> 2) & 7; vq = job & 3; } else { b = job >> 5; h = job & 31; }
    const int g = h >> 4;
    const bf16_t* U = (const bf16_t*)(p.ws + WS_U);
    const float* SF = (const float*)(p.ws + WS_SF);
    bf16_t* MIX = (bf16_t*)(p.ws + WS_MIX);
    float* scb = (float*)(smem + L_SC);
    float *qn = scb + 1600, *nvec = scb + 1728, *mpp = scb + 1856;
    const int qcol = ML ? UC_Q + h * 128 : UC_XBC + 2304 + g * 128;
    const int kcol = ML ? UC_K + h * 128 : UC_XBC + 2048 + g * 128;
    const int vcol = ML ? UC_V + h * 256 + vq * 64 : UC_XBC + h * 64;
    const int gcol = ML ? UC_O + h * 256 + vq * 64 : UC_Z + h * 64;
    const int mixcol = ML ? 2048 + h * 256 + vq * 64 : h * 64;
    float A_h = 0.f, D_h = 0.f, dtb = 0.f, ib = 0.f, fb = 0.f;
    if (ML) { ib = p.in[17][h]; fb = p.in[18][h]; } else { A_h = -__expf(p.in[14][h]); D_h = p.in[15][h]; dtb = p.in[13][h]; }
    f32x4 st[4];
#pragma unroll
    for (int i = 0; i < 4; ++i) st[i] = (f32x4){0.f, 0.f, 0.f, 0.f};
    for (int i = tid; i < 64 * RS / 16; i += 512) *(u32x4*)(smem + L_ST + i * 16) = (u32x4){0u, 0u, 0u, 0u};
    if (tid < 128) nvec[tid] = 0.f;
    if (tid == 0) mpp[0] = 0.f;
    constexpr int CHLs = ML ? CHL_ML : CHL_SSD;
    float sraw[4] = {0.f, 0.f, 0.f, 0.f};
    auto scal_load = [&](int cc) {
        const int p0 = cc == 0 ? 0 : 16 + (cc - 1) * CHLs, Lv = cc == 0 ? 16 : CHLs;
        const int t0 = 2 * lane, t1 = t0 + 1;
        if (!ML) {
            if (t0 < Lv) sraw[0] = SF[(size_t)row_of(b, p0 + t0) * 64 + h];
            if (t1 < Lv) sraw[1] = SF[(size_t)row_of(b, p0 + t1) * 64 + h];
        } else {
            if (t0 < Lv) { const size_t r = (size_t)row_of(b, p0 + t0) * 64; sraw[0] = SF[r + 32 + h]; sraw[2] = SF[r + 40 + h]; }
            if (t1 < Lv) { const size_t r = (size_t)row_of(b, p0 + t1) * 64; sraw[1] = SF[r + 32 + h]; sraw[3] = SF[r + 40 + h]; }
        }
    };
    auto scalars = [&](int cc) {
        const int Lv = cc == 0 ? 16 : CHLs;
        float* sc = scb + (cc & 1) * 800;
        float *rowv = sc, *colv = sc + 128, *colm = sc + 256, *ev = sc + 384, *scv = sc + 512, *dden = sc + 640, *misc = sc + 768;
        const int t0 = 2 * lane, t1 = t0 + 1;
        if (!ML) {
            float d0 = 0.f, d1 = 0.f;
            if (t0 < Lv) d0 = softplus_f(sraw[0] + dtb);
            if (t1 < Lv) d1 = softplus_f(sraw[1] + dtb);
            const float a0 = d0 * A_h, a1 = d1 * A_h;
            float inc = a0 + a1;
#pragma unroll
            for (int o = 1; o < 64; o <<= 1) { const float y = __shfl_up(inc, o); if (lane >= o) inc += y; }
            const float c1 = inc, c0 = inc - a1, cl = __shfl(inc, 63);
            rowv[t0] = c0; rowv[t1] = c1; colv[t0] = -c0; colv[t1] = -c1; colm[t0] = d0; colm[t1] = d1;
            ev[t0] = __expf(c0); ev[t1] = __expf(c1); scv[t0] = __expf(cl - c0) * d0; scv[t1] = __expf(cl - c1) * d1;
            if (lane == 0) misc[0] = __expf(cl);
        } else {
            float i0 = -INFINITY, i1 = -INFINITY, f0 = 0.f, f1 = 0.f;
            if (t0 < Lv) { i0 = sraw[0] + ib; f0 = logsig_f(sraw[2] + fb); }
            if (t1 < Lv) { i1 = sraw[1] + ib; f1 = logsig_f(sraw[3] + fb); }
            float inc = f0 + f1;
#pragma unroll
            for (int o = 1; o < 64; o <<= 1) { const float y = __shfl_up(inc, o); if (lane >= o) inc += y; }
            const float F1 = inc, F0 = inc - f1;
            const float g0 = i0 - F0, g1 = i1 - F1;
            float mx = fmaxf(g0, g1);
#pragma unroll
            for (int o = 1; o < 64; o <<= 1) { const float y = __shfl_up(mx, o); if (lane >= o) mx = fmaxf(mx, y); }
            float ex = __shfl_up(mx, 1); if (lane == 0) ex = -INFINITY;
            const float mp = mpp[0];
            const float M0 = fmaxf(fmaxf(ex, g0), mp), M1 = fmaxf(mx, mp);
            const float Ml = __shfl(M1, 63), Fl = __shfl(F1, 63);
            rowv[t0] = -M0; rowv[t1] = -M1; colv[t0] = g0; colv[t1] = g1; colm[t0] = 1.f; colm[t1] = 1.f;
            ev[t0] = __expf(mp - M0); ev[t1] = __expf(mp - M1); dden[t0] = __expf(-(F0 + M0)); dden[t1] = __expf(-(F1 + M1));
            scv[t0] = __expf(g0 - Ml); scv[t1] = __expf(g1 - Ml);
            if (lane == 0) { misc[0] = __expf(mp - Ml); mpp[0] = Fl + Ml; }
        }
    };
    __syncthreads();
    if (wid == 0) { scal_load(0); scalars(0); }
    __syncthreads();
    constexpr int CHL = ML ? CHL_ML : CHL_SSD, NCH = 1 + 2048 / CHL;
    const int tid_outer = tid;
    for (int c = 0; c < NCH; ++c) {
        int tid = tid_outer; asm volatile("" : "+v"(tid));
        const int lane = tid & 63, fr = lane & 15, fq = lane >> 4;
        const int p0 = c == 0 ? 0 : 16 + (c - 1) * CHL, Lv = c == 0 ? 16 : CHL;
        float* sc = scb + (c & 1) * 800;
        float *rowv = sc, *colv = sc + 128, *colm = sc + 256, *ev = sc + 384, *scv = sc + 512, *dden = sc + 640, *misc = sc + 768;
        if (wid == 0 && c + 1 < NCH) scal_load(c + 1);
        {
            float val[8][4];
            load_block<ML>(p, val, b, p0, Lv, tid >> 5, tid & 31, qcol, 2304 + g * 128, 1.f);
            store_rows(smem + L_QS, val, tid >> 5, tid & 31);
            __builtin_amdgcn_sched_barrier(0);
            load_block<ML>(p, val, b, p0, Lv, tid >> 5, tid & 31, kcol, 2048 + g * 128, 0.08838834764831845f);
            store_rows(smem + L_KS, val, tid >> 5, tid & 31);
            store_cols(smem + L_KT, val, tid >> 5, tid & 31, scv);
            __builtin_amdgcn_sched_barrier(0);
            if (tid < 256) {
                load_block<ML>(p, val, b, p0, Lv, tid >> 4, tid & 15, vcol, h * 64, 1.f);
                store_cols(smem + L_VT, val, tid >> 4, tid & 15, nullptr);
            }
        }
        __syncthreads();
        const int t = 16 * wid + fr;
        const bool valid = t < Lv;
        const int row = row_of(b, p0 + (valid ? t : 0));
        u32x2 gate[4];
#pragma unroll
        for (int vb = 0; vb < 4; ++vb) gate[vb] = *(const u32x2*)(U + (size_t)row * N1P + gcol + 16 * vb + 4 * fq);
        if (ML) {
            const int tt = tid >> 2, part = tid & 3;
            float s = 0.f;
#pragma unroll
            for (int cc = 0; cc < 4; ++cc) {
                const u32x4 raw = *(const u32x4*)(smem + L_QS + tt * RS + (part * 4 + cc) * 16);
                const f32x4 n0 = *(const f32x4*)(nvec + (part * 4 + cc) * 8), n1 = *(const f32x4*)(nvec + (part * 4 + cc) * 8 + 4);
                s += bf_lo(raw[0]) * n0[0] + bf_hi(raw[0]) * n0[1] + bf_lo(raw[1]) * n0[2] + bf_hi(raw[1]) * n0[3]
                   + bf_lo(raw[2]) * n1[0] + bf_hi(raw[2]) * n1[1] + bf_lo(raw[3]) * n1[2] + bf_hi(raw[3]) * n1[3];
            }
            s += __shfl_xor(s, 1); s += __shfl_xor(s, 2);
            if (part == 0) qn[tt] = s;
        }
        bf16x8 qf[4];
#pragma unroll
        for (int kk = 0; kk < 4; ++kk) qf[kk] = *(const bf16x8*)(smem + L_QS + t * RS + (kk * 32 + fq * 8) * 2);
        const float rv = rowv[t];
        float rowsum = 0.f;
        u32x2 pk[8];
#pragma unroll
        for (int sb = 0; sb < 8; ++sb) {
            pk[sb] = (u32x2){0u, 0u};
            if (sb <= wid) {
                f32x4 acc = {0.f, 0.f, 0.f, 0.f};
#pragma unroll
                for (int kk = 0; kk < 4; ++kk) {
                    const bf16x8 kf = *(const bf16x8*)(smem + L_KS + (16 * sb + fr) * RS + (kk * 32 + fq * 8) * 2);
                    acc = __builtin_amdgcn_mfma_f32_16x16x32_bf16(kf, qf[kk], acc, 0, 0, 0);
                }
                const f32x4 cv = *(const f32x4*)(colv + 16 * sb + 4 * fq), cm = *(const f32x4*)(colm + 16 * sb + 4 * fq);
                float pv[4];
#pragma unroll
                for (int j = 0; j < 4; ++j) {
                    const int s = 16 * sb + 4 * fq + j;
                    const float w = (s <= t) ? __expf(rv + cv[j]) * cm[j] : 0.f;
                    pv[j] = acc[j] * w; rowsum += pv[j];
                }
                pk[sb] = (u32x2){pack2(pv[0], pv[1]), pack2(pv[2], pv[3])};
            }
        }
        if (wid == 0 && c + 1 < NCH) scalars(c + 1);
        __syncthreads();
#pragma unroll
        for (int sb = 0; sb < 8; ++sb) *(u32x2*)(smem + L_KS + t * RS + (16 * sb + 4 * fq) * 2) = pk[sb];
        rowsum += __shfl_xor(rowsum, 16); rowsum += __shfl_xor(rowsum, 32);
        if (ML) {
            const int d = tid >> 2, part = tid & 3;
            float s = 0.f;
#pragma unroll
            for (int cc = 0; cc < 4; ++cc) {
                const u32x4 raw = *(const u32x4*)(smem + L_KT + d * RS + (part * 4 + cc) * 16);
                s += bf_lo(raw[0]) + bf_hi(raw[0]) + bf_lo(raw[1]) + bf_hi(raw[1]) + bf_lo(raw[2]) + bf_hi(raw[2]) + bf_lo(raw[3]) + bf_hi(raw[3]);
            }
            s += __shfl_xor(s, 1); s += __shfl_xor(s, 2);
            if (part == 0) nvec[d] = misc[0] * nvec[d] + s;
        }
        __syncthreads();
        bf16x8 pf[4];
#pragma unroll
        for (int kk = 0; kk < 4; ++kk) pf[kk] = *(const bf16x8*)(smem + L_KS + t * RS + (kk * 32 + fq * 8) * 2);
        const float et = ev[t];
        float ddv = 1.f;
        if (ML) ddv = fmaxf(fabsf(rowsum + et * qn[t]), dden[t]);
        float ss = 0.f;
#pragma unroll
        for (int vb = 0; vb < 4; ++vb) {
            f32x4 acc = {0.f, 0.f, 0.f, 0.f};
            const int vrow = 16 * vb + fr;
#pragma unroll
            for (int kk = 0; kk < 4; ++kk) {
                const bf16x8 sf = *(const bf16x8*)(smem + L_ST + vrow * RS + (kk * 32 + fq * 8) * 2);
                acc = __builtin_amdgcn_mfma_f32_16x16x32_bf16(sf, qf[kk], acc, 0, 0, 0);
            }
            acc *= et;
#pragma unroll
            for (int kk = 0; kk < 4; ++kk) {
                const bf16x8 vf = *(const bf16x8*)(smem + L_VT + vrow * RS + (((kk * 4 + fq) ^ ((vrow >> 3) & 7)) << 4));
                acc = __builtin_amdgcn_mfma_f32_16x16x32_bf16(vf, pf[kk], acc, 0, 0, 0);
            }
            const float gz[4] = {bf_lo(gate[vb][0]), bf_hi(gate[vb][0]), bf_lo(gate[vb][1]), bf_hi(gate[vb][1])};
            float o[4];
#pragma unroll
            for (int j = 0; j < 4; ++j) {
                if (ML) { const float hv = acc[j]; ss += hv * hv; o[j] = hv * sigm_f(gz[j]); }
                else {
                    const int v = 16 * vb + 4 * fq + j;
                    const float xv = bf2f(*(const bf16_t*)(smem + L_VT + v * RS + (((t >> 3) ^ ((v >> 3) & 7)) << 4) + (t & 7) * 2));
                    const float y = (acc[j] + D_h * xv) * silu_f(gz[j]); ss += y * y; o[j] = y;
                }
            }
            if (valid) *(u32x2*)(MIX + (size_t)row * MIXW + mixcol + 16 * vb + 4 * fq) = (u32x2){pack2(o[0], o[1]), pack2(o[2], o[3])};
        }
        ss += __shfl_xor(ss, 16); ss += __shfl_xor(ss, 32);
        if (valid && fq == 0) {
            if (ML) { ((float*)(p.ws + WS_SSQM))[(size_t)row * 32 + h * 4 + vq] = ss; if (vq == 0) ((float*)(p.ws + WS_DD))[(size_t)row * 8 + h] = ddv; }
            else ((float*)(p.ws + WS_SSQ))[(size_t)row * 32 + h] = ss;
        }
        const float dec = misc[0];
#pragma unroll
        for (int vb = 0; vb < 4; ++vb) st[vb] *= dec;
#pragma unroll
        for (int kk = 0; kk < 4; ++kk) {
            const int drow = 16 * wid + fr;
            const bf16x8 kf = *(const bf16x8*)(smem + L_KT + drow * RS + (((kk * 4 + fq) ^ ((drow >> 3) & 7)) << 4));
#pragma unroll
            for (int vb = 0; vb < 4; ++vb) {
                const int vrow = 16 * vb + fr;
                const bf16x8 vf = *(const bf16x8*)(smem + L_VT + vrow * RS + (((kk * 4 + fq) ^ ((vrow >> 3) & 7)) << 4));
                st[vb] = __builtin_amdgcn_mfma_f32_16x16x32_bf16(kf, vf, st[vb], 0, 0, 0);
            }
        }
        __syncthreads();
#pragma unroll
        for (int vb = 0; vb < 4; ++vb)
            *(u32x2*)(smem + L_ST + (16 * vb + fr) * RS + (16 * wid + 4 * fq) * 2) = (u32x2){pack2(st[vb][0], st[vb][1]), pack2(st[vb][2], st[vb][3])};
    }
#pragma unroll
    for (int vb = 0; vb < 4; ++vb) {
        const int v = 16 * vb + fr, d0 = 16 * wid + 4 * fq;
        if (!ML) *(f32x4*)(p.out + O_P_SSD + ((size_t)(b * 32 + h) * 64 + v) * 128 + d0) = st[vb];
        else {
#pragma unroll
            for (int j = 0; j < 4; ++j) p.out[O_P_MLC + ((size_t)(b * 8 + h) * 128 + d0 + j) * 256 + vq * 64 + v] = st[vb][j];
        }
    }
    if (ML && vq == 0) {
        if (tid < 128) p.out[O_P_MLN + (size_t)(b * 8 + h) * 128 + tid] = nvec[tid];
        if (tid == 0) p.out[O_P_MLM + b * 8 + h] = mpp[0];
    }
    __syncthreads();
}

__device__ __forceinline__ void sample_ssd(const Params& p, unsigned char* smem, int job) {
    const int tid = opaque_tid(), wid = tid >> 6, lane = tid & 63;
    const int b = job >> 1, g = job & 1, rowb = ROW_SAMPLE + b * 8;
    const bf16_t* U = (const bf16_t*)(p.ws + WS_U);
    const float* SF = (const float*)(p.ws + WS_SF);
    bf16_t* MIX = (bf16_t*)(p.ws + WS_MIX);
    float* Bc = (float*)smem; float* Cc = Bc + 1024; float* xall = Cc + 1024; float* G = xall + 8192; float* dts = G + 64; float* ssqp = dts + 128;
    const float* sconv = p.in[2]; const float* cw = p.in[11]; const float* cb = p.in[12];
#pragma unroll
    for (int q = 0; q < 3; ++q) {
        int ch; float* dst; int dstride = 0;
        if (q < 2) { ch = g * 1024 + tid + q * 512; dst = xall + tid + q * 512; dstride = 1024; }
        else { if (tid >= 256) break; const int which = tid >> 7, n = tid & 127; ch = 2048 + which * 256 + g * 128 + n; dst = (which ? Cc : Bc) + n; dstride = 128; }
        float xm3 = sconv[(size_t)(b * 3 + 0) * 2560 + ch], xm2 = sconv[(size_t)(b * 3 + 1) * 2560 + ch], xm1 = sconv[(size_t)(b * 3 + 2) * 2560 + ch];
        const float w0 = cw[ch], w1 = cw[2560 + ch], w2 = cw[5120 + ch], w3 = cw[7680 + ch], bb = cb[ch];
#pragma unroll
        for (int t = 0; t < 8; ++t) {
            const float x = bf2f(U[(size_t)(rowb + t) * N1P + UC_XBC + ch]);
            dst[t * dstride] = silu_f(bb + w0 * xm3 + w1 * xm2 + w2 * xm1 + w3 * x);
            xm3 = xm2; xm2 = xm1; xm1 = x;
        }
    }
    if (tid < 128) { const int hh = tid >> 3, t = tid & 7; dts[tid] = softplus_f(SF[(size_t)(rowb + t) * 64 + g * 16 + hh] + p.in[13][g * 16 + hh]); }
    __syncthreads();
    {
        const int pair = tid >> 3, part = tid & 7, t = pair >> 3, s = pair & 7;
        float sum = 0.f;
#pragma unroll
        for (int i = 0; i < 4; ++i) {
            const f32x4 c4 = *(const f32x4*)(Cc + t * 128 + part * 16 + i * 4), b4 = *(const f32x4*)(Bc + s * 128 + part * 16 + i * 4);
            sum += c4[0] * b4[0] + c4[1] * b4[1] + c4[2] * b4[2] + c4[3] * b4[3];
        }
        sum += __shfl_xor(sum, 1); sum += __shfl_xor(sum, 2); sum += __shfl_xor(sum, 4);
        if (part == 0) G[pair] = sum;
    }
    __syncthreads();
    const int pp = tid >> 3, nq = tid & 7;
    f32x4 snext[4];
#pragma unroll
    for (int i = 0; i < 4; ++i) snext[i] = *(const f32x4*)(p.in[3] + ((size_t)(b * 32 + g * 16) * 64 + pp) * 128 + nq * 4 + 32 * i);
    for (int hh = 0; hh < 16; ++hh) {
        const int h = g * 16 + hh;
        const float A_h = -__expf(p.in[14][h]), D_h = p.in[15][h];
        float dtv[8], cum[8];
        { float run = 0.f;
#pragma unroll
          for (int t = 0; t < 8; ++t) { dtv[t] = dts[hh * 8 + t]; run += dtv[t] * A_h; cum[t] = run; } }
        const size_t soff = ((size_t)(b * 32 + h) * 64 + pp) * 128 + nq * 4;
        f32x4 s0[4];
#pragma unroll
        for (int i = 0; i < 4; ++i) s0[i] = snext[i];
        if (hh + 1 < 16) {
#pragma unroll
            for (int i = 0; i < 4; ++i) snext[i] = *(const f32x4*)(p.in[3] + soff + 64 * 128 + 32 * i);
        }
        float cs[8];
#pragma unroll
        for (int t = 0; t < 8; ++t) {
            float sum = 0.f;
#pragma unroll
            for (int i = 0; i < 4; ++i) { const f32x4 c4 = *(const f32x4*)(Cc + t * 128 + nq * 4 + 32 * i); sum += c4[0] * s0[i][0] + c4[1] * s0[i][1] + c4[2] * s0[i][2] + c4[3] * s0[i][3]; }
            sum += __shfl_xor(sum, 1); sum += __shfl_xor(sum, 2); sum += __shfl_xor(sum, 4);
            cs[t] = sum;
        }
        float ycs = 0.f, ct = 0.f;
#pragma unroll
        for (int t = 0; t < 8; ++t) { ycs = (nq == t) ? cs[t] : ycs; ct = (nq == t) ? cum[t] : ct; }
        float y = __expf(ct) * ycs, xt = 0.f;
#pragma unroll
        for (int s = 0; s < 8; ++s) {
            const float xs = xall[s * 1024 + hh * 64 + pp];
            const float term = (s <= nq) ? G[nq * 8 + s] * __expf(ct - cum[s]) * dtv[s] * xs : 0.f;
            y += term; xt = (s == nq) ? xs : xt;
        }
        y += D_h * xt;
        const float z = bf2f(U[(size_t)(rowb + nq) * N1P + UC_Z + h * 64 + pp]);
        y *= silu_f(z);
        { const unsigned pk = pack2(y, 0.f); MIX[(size_t)(rowb + nq) * MIXW + h * 64 + pp] = (bf16_t)(pk & 0xffffu); }
        float sq = y * y; sq += __shfl_xor(sq, 8); sq += __shfl_xor(sq, 16); sq += __shfl_xor(sq, 32);
        if (lane < 8) ssqp[(hh * 8 + wid) * 8 + lane] = sq;
        const float cl = cum[7], dec = __expf(cl);
        float xw[8];
#pragma unroll
        for (int s = 0; s < 8; ++s) xw[s] = __expf(cl - cum[s]) * dtv[s] * xall[s * 1024 + hh * 64 + pp];
#pragma unroll
        for (int i = 0; i < 4; ++i) {
            f32x4 acc = s0[i] * dec;
#pragma unroll
            for (int s = 0; s < 8; ++s) acc += xw[s] * *(const f32x4*)(Bc + s * 128 + nq * 4 + 32 * i);
            *(f32x4*)(p.out + O_S_SSD + soff + 32 * i) = acc;
        }
    }
    __syncthreads();
    if (tid < 128) {
        const int hh = tid >> 3, t = tid & 7; float tot = 0.f;
#pragma unroll
        for (int w = 0; w < 8; ++w) tot += ssqp[(hh * 8 + w) * 8 + t];
        ((float*)(p.ws + WS_SSQ))[(size_t)(rowb + t) * 32 + g * 16 + hh] = tot;
    }
    __syncthreads();
}

__device__ __forceinline__ void sample_ml(const Params& p, unsigned char* smem, int job) {
    const int tid = opaque_tid(), wid = __builtin_amdgcn_readfirstlane(tid >> 6), lane = tid & 63;
    const int b = job >> 3, h = job & 7, rowb = ROW_SAMPLE + b * 8;
    const bf16_t* U = (const bf16_t*)(p.ws + WS_U);
    const float* SF = (const float*)(p.ws + WS_SF);
    bf16_t* MIX = (bf16_t*)(p.ws + WS_MIX);
    float* qs = (float*)smem; float* ks = qs + 1024; float* vs = qs + 2048; float* QK = qs + 4096; float* sig = qs + 4160; float* slf = qs + 4168;
    float* qnv = qs + 4176; float* n0v = qs + 4192; float* red = qs + 4352;
    {
        const int t = tid >> 6, c = tid & 63;
        const size_t r = (size_t)(rowb + t) * N1P;
        const unsigned qq = *(const unsigned*)(U + r + UC_Q + h * 128 + 2 * c), kk = *(const unsigned*)(U + r + UC_K + h * 128 + 2 * c);
        const u32x2 vv = *(const u32x2*)(U + r + UC_V + h * 256 + 4 * c);
        qs[t * 128 + 2 * c] = bf_lo(qq); qs[t * 128 + 2 * c + 1] = bf_hi(qq);
        ks[t * 128 + 2 * c] = bf_lo(kk) * 0.08838834764831845f; ks[t * 128 + 2 * c + 1] = bf_hi(kk) * 0.08838834764831845f;
        *(f32x4*)(vs + t * 256 + 4 * c) = (f32x4){bf_lo(vv[0]), bf_hi(vv[0]), bf_lo(vv[1]), bf_hi(vv[1])};
        if (tid < 8) { sig[tid] = SF[(size_t)(rowb + tid) * 64 + 32 + h] + p.in[17][h]; slf[tid] = logsig_f(SF[(size_t)(rowb + tid) * 64 + 40 + h] + p.in[18][h]); }
        if (tid >= 128 && tid < 256) n0v[tid - 128] = p.in[5][(size_t)(b * 8 + h) * 128 + tid - 128];
    }
    const int v4 = lane, dg = wid;
    const size_t coff = ((size_t)(b * 8 + h) * 128 + dg * 16) * 256 + v4 * 4;
    f32x4 c0[16];
#pragma unroll
    for (int i = 0; i < 16; ++i) c0[i] = *(const f32x4*)(p.in[4] + coff + (size_t)i * 256);
    const float mp = p.in[6][b * 8 + h];
    __syncthreads();
    float F[8], gg[8], M[8];
    { float run = 0.f, pm = -INFINITY;
#pragma unroll
      for (int t = 0; t < 8; ++t) { run += slf[t]; F[t] = run; gg[t] = sig[t] - run; pm = fmaxf(pm, gg[t]); M[t] = fmaxf(pm, mp); } }
    const float Ml = M[7], dec = __expf(mp - Ml), m_new = F[7] + Ml;
    {
        const int pair = tid >> 3, part = tid & 7, t = pair >> 3, s = pair & 7;
        float sum = 0.f;
#pragma unroll
        for (int i = 0; i < 4; ++i) {
            const f32x4 a4 = *(const f32x4*)(qs + t * 128 + part * 16 + i * 4), b4 = *(const f32x4*)(ks + s * 128 + part * 16 + i * 4);
            sum += a4[0] * b4[0] + a4[1] * b4[1] + a4[2] * b4[2] + a4[3] * b4[3];
        }
        sum += __shfl_xor(sum, 1); sum += __shfl_xor(sum, 2); sum += __shfl_xor(sum, 4);
        if (part == 0) QK[pair] = sum;
        float qd = qs[wid * 128 + 2 * lane] * n0v[2 * lane] + qs[wid * 128 + 2 * lane + 1] * n0v[2 * lane + 1];
        qd = wave_sum(qd);
        if (lane == 0) qnv[wid] = qd;
    }
#pragma unroll
    for (int t = 0; t < 8; ++t) {
        f32x4 acc = {0.f, 0.f, 0.f, 0.f};
#pragma unroll
        for (int i4 = 0; i4 < 4; ++i4) {
            const f32x4 q4 = *(const f32x4*)(qs + t * 128 + dg * 16 + i4 * 4);
            acc += q4[0] * c0[i4 * 4] + q4[1] * c0[i4 * 4 + 1] + q4[2] * c0[i4 * 4 + 2] + q4[3] * c0[i4 * 4 + 3];
        }
        *(f32x4*)(red + (dg * 8 + t) * 256 + v4 * 4) = acc;
    }
    __syncthreads();
    f32x4 vv[8];
    float scs[8];
#pragma unroll
    for (int s = 0; s < 8; ++s) { vv[s] = *(const f32x4*)(vs + s * 256 + v4 * 4); scs[s] = __expf(gg[s] - Ml); }
#pragma unroll
    for (int i = 0; i < 16; ++i) {
        const int d = dg * 16 + i;
        f32x4 cn = c0[i] * dec;
#pragma unroll
        for (int s = 0; s < 8; ++s) cn += (scs[s] * ks[s * 128 + d]) * vv[s];
        *(f32x4*)(p.out + O_S_MLC + coff + (size_t)i * 256) = cn;
    }
    if (tid < 128) {
        float nn = dec * n0v[tid];
#pragma unroll
        for (int s = 0; s < 8; ++s) nn += scs[s] * ks[s * 128 + tid];
        p.out[O_S_MLN + (size_t)(b * 8 + h) * 128 + tid] = nn;
    }
    if (tid == 0) p.out[O_S_MLM + b * 8 + h] = m_new;
    {
        const int t = wid;
        float Mt = 0.f, Ft = 0.f;
#pragma unroll
        for (int q = 0; q < 8; ++q) { Mt = (t == q) ? M[q] : Mt; Ft = (t == q) ? F[q] : Ft; }
        f32x4 numc = {0.f, 0.f, 0.f, 0.f};
#pragma unroll
        for (int q = 0; q < 8; ++q) numc += *(const f32x4*)(red + (q * 8 + t) * 256 + lane * 4);
        const float et = __expf(mp - Mt);
        float den = et * qnv[t];
        f32x4 intra = {0.f, 0.f, 0.f, 0.f};
#pragma unroll
        for (int s = 0; s < 8; ++s) {
            if (s <= t) { const float w = __expf(gg[s] - Mt) * QK[t * 8 + s]; den += w; intra += w * vv[s]; }
        }
        const float dd = fmaxf(fabsf(den), __expf(-(Ft + Mt)));
        const f32x4 hv = (et * numc + intra) * (1.f / dd);
        float ss = hv[0] * hv[0] + hv[1] * hv[1] + hv[2] * hv[2] + hv[3] * hv[3];
        ss = wave_sum(ss);
        const u32x2 og = *(const u32x2*)(U + (size_t)(rowb + t) * N1P + UC_O + h * 256 + lane * 4);
        *(u32x2*)(MIX + (size_t)(rowb + t) * MIXW + 2048 + h * 256 + lane * 4) =
            (u32x2){pack2(hv[0] * sigm_f(bf_lo(og[0])), hv[1] * sigm_f(bf_hi(og[0]))), pack2(hv[2] * sigm_f(bf_lo(og[1])), hv[3] * sigm_f(bf_hi(og[1])))};
        if (lane < 4) ((float*)(p.ws + WS_SSQM))[(size_t)(rowb + t) * 32 + h * 4 + lane] = lane == 0 ? ss : 0.f;
        if (lane == 0) ((float*)(p.ws + WS_DD))[(size_t)(rowb + t) * 8 + h] = 1.f;
    }
    __syncthreads();
}

__device__ __forceinline__ void phase_scan(const Params& p, unsigned char* smem) {
#ifndef SC_MASK
#define SC_MASK 15
#endif
    for (int j = opaque_bid(); j < 256; j += gridDim.x) { if (j < 128) { if (SC_MASK & 1) prompt_scan<false>(p, smem, j); } else { if (SC_MASK & 2) prompt_scan<true>(p, smem, j - 128); } }
    if (SC_MASK & 4) for (int j = opaque_bid(); j < 256; j += gridDim.x) sample_ssd(p, smem, j);
    if (SC_MASK & 8) for (int j = opaque_bid(); j < 1024; j += gridDim.x) sample_ml(p, smem, j);
}

__device__ __forceinline__ void phase_mixnorm(const Params& p) {
    const int tid = opaque_tid(), wid = tid >> 6, lane = tid & 63;
    bf16_t* MIX = (bf16_t*)(p.ws + WS_MIX);
    const float* SSQ = (const float*)(p.ws + WS_SSQ); const float* SSQM = (const float*)(p.ws + WS_SSQM);
    const float* w1 = p.in[16]; const float* w2 = p.in[19];
    for (int row = opaque_bid() * 8 + wid; row < NVALID; row += gridDim.x * 8) {
        float s = lane < 32 ? SSQ[(size_t)row * 32 + lane] : 0.f;
        s = wave_sum(s);
        const float r1 = rsqrtf(s * (1.f / 2048.f) + EPS);
        float m = lane < 32 ? SSQM[(size_t)row * 32 + lane] : 0.f;
        m += __shfl_xor(m, 1); m += __shfl_xor(m, 2);
        const float ddh = lane < 32 ? ((const float*)(p.ws + WS_DD))[(size_t)row * 8 + (lane >> 2)] : 1.f;
        const float idd = 1.f / ddh;
        const float rh = rsqrtf(m * (1.f / 256.f) * idd * idd + EPS) * idd;
        u32x4 raws[8];
#pragma unroll
        for (int it = 0; it < 8; ++it) raws[it] = *(const u32x4*)(MIX + (size_t)row * MIXW + it * 512 + lane * 8);
#pragma unroll
        for (int it = 0; it < 8; ++it) {
            const int col = it * 512 + lane * 8;
            const u32x4 raw = raws[it];
            float scale; const float* wp;
            if (it < 4) { scale = r1; wp = w1 + col; }
            else { const int head = (it - 4) * 2 + (lane >> 5); scale = __shfl(rh, head * 4); wp = w2 + col - 2048; }
            const f32x4 wa = *(const f32x4*)wp, wb = *(const f32x4*)(wp + 4);
            u32x4 o;
            o[0] = pack2(bf_lo(raw[0]) * scale * wa[0], bf_hi(raw[0]) * scale * wa[1]); o[1] = pack2(bf_lo(raw[1]) * scale * wa[2], bf_hi(raw[1]) * scale * wa[3]);
            o[2] = pack2(bf_lo(raw[2]) * scale * wb[0], bf_hi(raw[2]) * scale * wb[1]); o[3] = pack2(bf_lo(raw[3]) * scale * wb[2], bf_hi(raw[3]) * scale * wb[3]);
            *(u32x4*)(MIX + (size_t)row * MIXW + col) = o;
        }
    }
    const bf16_t* U = (const bf16_t*)(p.ws + WS_U);
    for (int i = opaque_bid() * 512 + tid; i < 132 * 3 * 320; i += gridDim.x * 512) {
        const int cgp = i % 320, j = (i / 320) % 3, q = i / 960;
        int row; float* dst;
        if (q < 4) { row = q * 2048 + 2045 + j; dst = p.out + O_P_SSDCONV + (size_t)(q * 3 + j) * 2560 + cgp * 8; }
        else { row = ROW_SAMPLE + (q - 4) * 8 + 5 + j; dst = p.out + O_S_SSDCONV + (size_t)((q - 4) * 3 + j) * 2560 + cgp * 8; }
        const u32x4 raw = *(const u32x4*)(U + (size_t)row * N1P + UC_XBC + cgp * 8);
        *(f32x4*)dst = (f32x4){bf_lo(raw[0]), bf_hi(raw[0]), bf_lo(raw[1]), bf_hi(raw[1])};
        *(f32x4*)(dst + 4) = (f32x4){bf_lo(raw[2]), bf_hi(raw[2]), bf_lo(raw[3]), bf_hi(raw[3])};
    }
}

__device__ __forceinline__ void unpack8(const u32x4 raw, float (&x)[8]) {
#pragma unroll
    for (int i = 0; i < 4; ++i) { x[2 * i] = bf_lo(raw[i]); x[2 * i + 1] = bf_hi(raw[i]); }
}
__device__ __forceinline__ void phase_act(const Params& p) {
    const bf16_t* UP = (const bf16_t*)(p.ws + WS_UP); bf16_t* ACT = (bf16_t*)(p.ws + WS_ACT);
    const float* cw = p.in[23]; const float* cb = p.in[24]; const float* fst = p.in[7];
    constexpr int CGN = DFF / 8, TOTAL = (NVALID / 8) * CGN;
    const int tid = opaque_tid();
    for (int idx = opaque_bid() * 512 + tid; idx < TOTAL; idx += gridDim.x * 512) {
        const int rb = idx / CGN, cgp = idx % CGN, row0 = rb * 8, c0 = cgp * 8;
        float g2[8], g1[8], v2[8], v1[8];
        int prow = -1; bool from_state = false; int sb = 0, pb = -1;
        if (row0 < ROW_SAMPLE) { const int b = row0 >> 11, t0 = row0 & 2047; prow = t0 > 0 ? row0 - 2 : ROW_META + b * 16 + 14; if (t0 == 2040) pb = b; }
        else if (row0 < ROW_META) { from_state = true; sb = (row0 - ROW_SAMPLE) >> 3; }
        else { if ((row0 - ROW_META) & 15) prow = row0 - 2; }
        if (from_state) {
            const float* s0 = fst + (size_t)(sb * 2) * N3;
#pragma unroll
            for (int i = 0; i < 8; ++i) { g2[i] = s0[c0 + i]; g1[i] = s0[N3 + c0 + i]; v2[i] = s0[DFF + c0 + i]; v1[i] = s0[N3 + DFF + c0 + i]; }
        } else if (prow >= 0) {
            unpack8(*(const u32x4*)(UP + (size_t)prow * N3 + c0), g2); unpack8(*(const u32x4*)(UP + (size_t)(prow + 1) * N3 + c0), g1);
            unpack8(*(const u32x4*)(UP + (size_t)prow * N3 + DFF + c0), v2); unpack8(*(const u32x4*)(UP + (size_t)(prow + 1) * N3 + DFF + c0), v1);
        } else {
#pragma unroll
            for (int i = 0; i < 8; ++i) { g2[i] = 0.f; g1[i] = 0.f; v2[i] = 0.f; v1[i] = 0.f; }
        }
        float wg[3][8], wv[3][8], bg[8], bv[8];
#pragma unroll
        for (int j = 0; j < 3; ++j)
#pragma unroll
            for (int i = 0; i < 8; ++i) { wg[j][i] = cw[j * N3 + c0 + i]; wv[j][i] = cw[j * N3 + DFF + c0 + i]; }
#pragma unroll
        for (int i = 0; i < 8; ++i) { bg[i] = cb[c0 + i]; bv[i] = cb[DFF + c0 + i]; }
        u32x4 rg[8], rv[8];
#pragma unroll
        for (int r = 0; r < 8; ++r) { rg[r] = *(const u32x4*)(UP + (size_t)(row0 + r) * N3 + c0); rv[r] = *(const u32x4*)(UP + (size_t)(row0 + r) * N3 + DFF + c0); }
#pragma unroll
        for (int r = 0; r < 8; ++r) {
            float gx[8], vx[8];
            unpack8(rg[r], gx); unpack8(rv[r], vx);
            float o[8];
#pragma unroll
            for (int i = 0; i < 8; ++i) {
                const float yg = bg[i] + wg[0][i] * g2[i] + wg[1][i] * g1[i] + wg[2][i] * gx[i];
                const float yv = bv[i] + wv[0][i] * v2[i] + wv[1][i] * v1[i] + wv[2][i] * vx[i];
                o[i] = silu_f(yg) * yv;
                g2[i] = g1[i]; g1[i] = gx[i]; v2[i] = v1[i]; v1[i] = vx[i];
            }
            u32x4 ov; ov[0] = pack2(o[0], o[1]); ov[1] = pack2(o[2], o[3]); ov[2] = pack2(o[4], o[5]); ov[3] = pack2(o[6], o[7]);
            *(u32x4*)(ACT + (size_t)(row0 + r) * DFF + c0) = ov;
        }
        if (from_state || pb >= 0) {
            float* dst = from_state ? p.out + O_S_FFN + (size_t)(sb * 2) * N3 : p.out + O_P_FFN + (size_t)(pb * 2) * N3;
            *(f32x4*)(dst + c0) = (f32x4){g2[0], g2[1], g2[2], g2[3]}; *(f32x4*)(dst + c0 + 4) = (f32x4){g2[4], g2[5], g2[6], g2[7]};
            *(f32x4*)(dst + N3 + c0) = (f32x4){g1[0], g1[1], g1[2], g1[3]}; *(f32x4*)(dst + N3 + c0 + 4) = (f32x4){g1[4], g1[5], g1[6], g1[7]};
            *(f32x4*)(dst + DFF + c0) = (f32x4){v2[0], v2[1], v2[2], v2[3]}; *(f32x4*)(dst + DFF + c0 + 4) = (f32x4){v2[4], v2[5], v2[6], v2[7]};
            *(f32x4*)(dst + N3 + DFF + c0) = (f32x4){v1[0], v1[1], v1[2], v1[3]}; *(f32x4*)(dst + N3 + DFF + c0 + 4) = (f32x4){v1[4], v1[5], v1[6], v1[7]};
        }
    }
}

__device__ __forceinline__ void phase_final(const Params& p) {
    const int tid = opaque_tid(), wid = tid >> 6, lane = tid & 63;
    const float* SS3 = (const float*)(p.ws + WS_SS3); const float* nw = p.in[26];
    for (int row = opaque_bid() * 8 + wid; row < NOUTROWS; row += gridDim.x * 8) {
        const float r = rsqrtf(SS3[row] * (1.f / 2048.f) + EPS);
        float* rp = p.out + (size_t)row * DM;
        f32x4 v[8];
#pragma unroll
        for (int it = 0; it < 8; ++it) v[it] = *(const f32x4*)(rp + it * 256 + lane * 4);
#pragma unroll
        for (int it = 0; it < 8; ++it) {
            const int col = it * 256 + lane * 4;
            const f32x4 w = *(const f32x4*)(nw + col);
            *(f32x4*)(rp + col) = v[it] * r * w;
        }
    }
}

__global__ void __launch_bounds__(512, 2) hymba_fwd(Params p0) {
    extern __shared__ __attribute__((aligned(16))) unsigned char smem[];
    cg::grid_group grid = cg::this_grid();
#ifndef DUP_PHASE
#define DUP_PHASE -1
#endif
    for (int phx = p0.ph_lo; phx < p0.ph_hi + (DUP_PHASE >= 0 ? 1 : 0); ++phx) {
        const int ph = (DUP_PHASE >= 0 && phx > DUP_PHASE) ? phx - 1 : phx;
        Params p = p0;
        { size_t z = 0; asm volatile("" : "+s"(z)); p.ws = p0.ws + z; p.out = p0.out + z; }
        switch (ph) {
        case 0: if (PH_MASK & 1) phase_prep(p, smem); break;
        case 1: if (PH_MASK & 2) { pg8::Gemm g{(const bf16_t*)(p.ws + WS_XN), (const bf16_t*)(p.ws + WS_WIN), MP, N1P, 2048}; pg8::StaticOrder S; S.init(MP, N1P, gridDim.x, opaque_bid());
                  Epi1 E{(bf16_t*)(p.ws + WS_U), (float*)(p.ws + WS_SF)}; pg8::gemm_phase((LAS unsigned char*)smem, g, S, E); } break;
        case 2: if (PH_MASK & 4) phase_scan(p, smem); break;
        case 3: if (PH_MASK & 8) phase_mixnorm(p); break;
        case 4: if (PH_MASK & 16) { pg8::Gemm g{(const bf16_t*)(p.ws + WS_MIX), (const bf16_t*)(p.ws + WS_WOUT), MP, 2048, 4096}; pg8::StaticOrder S; S.init(MP, 2048, gridDim.x, opaque_bid());
                  Epi2 E{p}; pg8::gemm_phase((LAS unsigned char*)smem, g, S, E); } break;
        case 5: if (PH_MASK & 32) { pg8::Gemm g{(const bf16_t*)(p.ws + WS_A2), (const bf16_t*)(p.ws + WS_WUP), MP, N3, 2048}; pg8::StaticOrder S; S.init(MP, N3, gridDim.x, opaque_bid());
                  Epi3 E{(bf16_t*)(p.ws + WS_UP), (const float*)(p.ws + WS_SS2)}; pg8::gemm_phase((LAS unsigned char*)smem, g, S, E); } break;
        case 6: if (PH_MASK & 64) phase_act(p); break;
        case 7: if (PH_MASK & 128) { pg8::Gemm g{(const bf16_t*)(p.ws + WS_ACT), (const bf16_t*)(p.ws + WS_WDOWN), MP, 2048, DFF}; pg8::StaticOrder S; S.init(MP, 2048, gridDim.x, opaque_bid());
                  Epi4 E{(const float*)(p.ws + WS_H1), p.out, (float*)(p.ws + WS_SS3)}; pg8::gemm_phase((LAS unsigned char*)smem, g, S, E); } break;
        default: if (PH_MASK & 256) phase_final(p); break;
        }
        if (phx + 1 < p0.ph_hi + (DUP_PHASE >= 0 ? 1 : 0)) grid.sync();
    }
}

extern "C" void kernel_launch(void* const* d_in, const int* in_sizes, int n_in, void* d_out, int out_size, void* d_ws, size_t ws_size, hipStream_t stream) {
    static int grid_blocks = 0;
    if (grid_blocks == 0) {
        if (n_in != 27 || (size_t)out_size != O_END || ws_size < WS_END) {
            fprintf(stderr, "kernel_launch: unexpected shapes: n_in %d out %d ws %zu (need %zu)\n", n_in, out_size, ws_size, (size_t)WS_END); grid_blocks = -1; return; }
        int dev = 0, cus = 0, per_cu = 0;
        (void)hipGetDevice(&dev);
        (void)hipDeviceGetAttribute(&cus, hipDeviceAttributeMultiprocessorCount, dev);
        (void)hipFuncSetAttribute((const void*)hymba_fwd, hipFuncAttributeMaxDynamicSharedMemorySize, LDS_BYTES);
        (void)hipOccupancyMaxActiveBlocksPerMultiprocessor(&per_cu, (const void*)hymba_fwd, 512, LDS_BYTES);
        if (per_cu < 1) { fprintf(stderr, "kernel_launch: occupancy query says %d blocks per CU\n", per_cu); per_cu = 1; }
        grid_blocks = cus;
    }
    if (grid_blocks < 0) return;
    Params p{};
    for (int i = 0; i < 27; ++i) p.in[i] = (const float*)d_in[i];
    p.out = (float*)d_out; p.ws = (unsigned char*)d_ws; p.ph_lo = 0; p.ph_hi = NPHASE;
    void* args[] = {&p};
    hipError_t e = hipLaunchCooperativeKernel((const void*)hymba_fwd, dim3(grid_blocks), dim3(512), args, LDS_BYTES, stream);
    if (e != hipSuccess) fprintf(stderr, "cooperative launch failed: %s (grid %d)\n", hipGetErrorString(e), grid_blocks);
}
```

```cpp
#include <hip/hip_runtime.h>
#include <hip/hip_cooperative_groups.h>
#include <cstdio>
namespace cg = cooperative_groups;

#define LAS __attribute__((address_space(3)))
typedef unsigned short bf16_t;
typedef short bf16x8 __attribute__((ext_vector_type(8)));
typedef float f32x4 __attribute__((ext_vector_type(4)));
typedef unsigned u32x4 __attribute__((ext_vector_type(4)));
typedef unsigned u32x2 __attribute__((ext_vector_type(2)));

constexpr int DM = 2048, MP = 9472, NVALID = 9280, NOUTROWS = 9216;
constexpr int N1P = 11008, N3 = 11264, DFF = 5632, MIXW = 4096;
constexpr int ROW_SAMPLE = 8192, ROW_META = 9216;
constexpr float EPS = 1e-6f;
constexpr int UC_Z = 0, UC_XBC = 2048, UC_Q = 4640, UC_K = 5664, UC_V = 6688, UC_O = 8752;
constexpr size_t WS_WIN = 0;
constexpr size_t WS_WOUT = WS_WIN + (size_t)N1P * 2048 * 2;
constexpr size_t WS_WUP = WS_WOUT + (size_t)2048 * 4096 * 2;
constexpr size_t WS_WDOWN = WS_WUP + (size_t)N3 * 2048 * 2;
constexpr size_t WS_XN = WS_WDOWN + (size_t)2048 * DFF * 2;
constexpr size_t WS_MIX = WS_XN + (size_t)MP * 2048 * 2;
constexpr size_t WS_ACT = WS_XN;
constexpr size_t WS_U = WS_MIX + (size_t)MP * MIXW * 2;
constexpr size_t WS_UP = WS_U;
constexpr size_t WS_H1 = WS_U + (size_t)MP * N3 * 2;
constexpr size_t WS_A2 = WS_H1 + (size_t)MP * 2048 * 4;
constexpr size_t WS_SF = WS_A2 + (size_t)MP * 2048 * 2;
constexpr size_t WS_SSQ = WS_SF + (size_t)MP * 64 * 4;
constexpr size_t WS_SSQM = WS_SSQ + (size_t)MP * 32 * 4;
constexpr size_t WS_SS2 = WS_SSQM + (size_t)MP * 32 * 4;
constexpr size_t WS_SS3 = WS_SS2 + (size_t)MP * 4;
constexpr size_t WS_DD = WS_SS3 + (size_t)MP * 4;
constexpr size_t WS_END = WS_DD + (size_t)MP * 8 * 4;
constexpr size_t O_Y = 0;
constexpr size_t O_P_SSDCONV = 18874368, O_P_SSD = 18905088, O_P_MLC = 19953664, O_P_MLN = 21002240, O_P_MLM = 21006336, O_P_FFN = 21006368;
constexpr size_t O_S_SSDCONV = 21096480, O_S_SSD = 22079520, O_S_MLC = 55633952, O_S_MLN = 89188384, O_S_MLM = 89319456, O_S_FFN = 89320480;
constexpr size_t O_END = 92204064;
constexpr int LDS_BYTES = 147456;
constexpr int NPHASE = 9;
#ifndef CHL_SSD
#define CHL_SSD 128
#endif
#ifndef CHL_ML
#define CHL_ML 128
#endif
#ifndef PH_MASK
#define PH_MASK 0x1ff
#endif

struct Params {
    const float* in[27];
    float* out;
    unsigned char* ws;
    int ph_lo, ph_hi;
};

__device__ __forceinline__ unsigned pack2(float lo, float hi) { unsigned r; asm("v_cvt_pk_bf16_f32 %0, %1, %2" : "=v"(r) : "v"(lo), "v"(hi)); return r; }
__device__ __forceinline__ float bf_lo(unsigned u) { return __uint_as_float(u << 16); }
__device__ __forceinline__ float bf_hi(unsigned u) { return __uint_as_float(u & 0xffff0000u); }
__device__ __forceinline__ float bf2f(bf16_t h) { return __uint_as_float((unsigned)h << 16); }
__device__ __forceinline__ float sigm_f(float x) { const float d = 1.f + __expf(fminf(-x, 80.f)); float r = __builtin_amdgcn_rcpf(d); return r * (2.f - d * r); }
__device__ __forceinline__ float silu_f(float x) { return x * sigm_f(x); }
__device__ __forceinline__ float softplus_f(float x) { return x > 20.f ? x : log1pf(__expf(x)); }
__device__ __forceinline__ float logsig_f(float x) { return fminf(x, 0.f) - log1pf(__expf(-fabsf(x))); }
__device__ __forceinline__ int opaque_tid() { int t = threadIdx.x; asm volatile("" : "+v"(t)); return t; }
__device__ __forceinline__ int opaque_bid() { int t = blockIdx.x; asm volatile("" : "+s"(t)); return t; }
__device__ __forceinline__ int row_of(int b, int pos) { return pos < 16 ? ROW_META + b * 16 + pos : b * 2048 + pos - 16; }
__device__ __forceinline__ float wave_sum(float v) {
    v += __shfl_xor(v, 32); v += __shfl_xor(v, 16); v += __shfl_xor(v, 8); v += __shfl_xor(v, 4); v += __shfl_xor(v, 2); v += __shfl_xor(v, 1); return v;
}
__device__ __forceinline__ const float* resid_row(const Params& p, int row) {
    if (row < ROW_SAMPLE) return p.in[0] + (size_t)row * DM;
    if (row < ROW_META) return p.in[1] + (size_t)(row - ROW_SAMPLE) * DM;
    if (row < NVALID) return p.in[8] + (size_t)((row - ROW_META) & 15) * DM;
    return nullptr;
}

namespace pg8 {
constexpr int BM = 256, BK = 64, HALF = 128, HTB = HALF * BK * 2, STAGE_BYTES = 8 * HTB, NXCD = 8, WGM = 8;
__device__ __forceinline__ int lds_byte(int r, int c) { const int st = (r >> 4) * 2 + (c >> 5), rr = r & 15, cc = c & 31, ob = rr * 64 + cc * 2; return st * 1024 + (ob ^ (((ob >> 9) & 1) << 5)); }
__device__ __forceinline__ void stage_rc(int b, int& R, int& C) { const int st = b / 1024, sb = b % 1024, swz = sb ^ (((sb >> 9) & 1) << 5); R = (st >> 1) * 16 + swz / 64; C = (st & 1) * 32 + (swz % 64) / 2; }
__device__ __forceinline__ int perm32(int rho) { const int n = rho >> 4, i = rho & 15; return 8 * (i >> 2) + 4 * n + (i & 3); }
struct Unit { int pm, pn; };
struct Gemm { const bf16_t* A; const bf16_t* Bt; int M, N, K; };
struct StaticOrder {
    int nM, nN, nwg, G, c;
    __device__ void init(int M, int N, int G_, int c_) { nM = M / BM; nN = N / BM; nwg = nM * nN; G = G_; c = c_; }
    __device__ bool next(int i, Unit& u) const {
        const long L = (long)i * G + c; if (L >= nwg) return false;
        int wgid = (int)L; { const int q = nwg / NXCD, r = nwg % NXCD, xcd = wgid % NXCD, off = wgid / NXCD; wgid = (xcd < r ? xcd * (q + 1) : r * (q + 1) + (xcd - r) * q) + off; }
        const int nig = WGM * nN, gid = wgid / nig, fm = gid * WGM, gsz = (nM - fm) < WGM ? (nM - fm) : WGM;
        u.pm = fm + ((wgid % nig) % gsz); u.pn = (wgid % nig) / gsz; return true;
    }
};

template <class Epi>
__device__ __forceinline__ void gemm_phase(LAS unsigned char* lds, const Gemm g, const StaticOrder& S, const Epi& E) {
    const int tid = opaque_tid(), wid = __builtin_amdgcn_readfirstlane(tid >> 6), lane = tid & 63, wr = wid >> 2, wc = wid & 3, fr = lane & 15, fq = lane >> 4;
    const int K = g.K, nt = K / BK;
    unsigned voffA[2], voffB[2];
#pragma unroll
    for (int i = 0; i < 2; ++i) { int R, C; stage_rc(tid * 16 + i * 8192, R, C); const int Rb = ((R & ~31) + perm32(R & 31));
        voffA[i] = (unsigned)(R * K + C) * 2u; voffB[i] = (unsigned)(Rb * K + C) * 2u; }
    const size_t kstep = (size_t)(BK * 2);
    const size_t hstep = (size_t)HALF * K * 2;
    const size_t tstep = 2 * hstep;
    const unsigned ldsw = (unsigned)wid * 1024u;
    const int aoff = lds_byte(wr * 64 + fr, fq * 8), boff = lds_byte(wc * 32 + fr, fq * 8);
#define PG8_SA(b, h) (((b) * 2 + (h)) * HTB)
#define PG8_SB(b, h) ((4 + (b) * 2 + (h)) * HTB)
#define PG8_STAGE(bufoff, gbase, voff) do { _Pragma("unroll") for (int _i = 0; _i < 2; ++_i) \
        __builtin_amdgcn_global_load_lds((const unsigned*)((const char*)(gbase) + (voff)[_i]), (LAS unsigned*)(lds + (bufoff) + ldsw + _i * 8192), 16, 0, 0); } while (0)
#define PG8_LDA(dst, b, h) do { _Pragma("unroll") for (int m = 0; m < 4; ++m) _Pragma("unroll") for (int k = 0; k < 2; ++k) dst[m][k] = *(const LAS bf16x8*)(lds + PG8_SA(b, h) + aoff + m * 2048 + k * 1024); } while (0)
#define PG8_LDB(dst, b, h) do { _Pragma("unroll") for (int n = 0; n < 2; ++n) _Pragma("unroll") for (int k = 0; k < 2; ++k) dst[n][k] = *(const LAS bf16x8*)(lds + PG8_SB(b, h) + boff + n * 2048 + k * 1024); } while (0)
#define PG8_MMA(ai, bj, At, Bt) do { __builtin_amdgcn_s_setprio(1); _Pragma("unroll") for (int m = 0; m < 4; ++m) _Pragma("unroll") for (int n = 0; n < 2; ++n) _Pragma("unroll") for (int k = 0; k < 2; ++k) \
        acc[ai][bj][m][n] = __builtin_amdgcn_mfma_f32_16x16x32_bf16(Bt[n][k], At[m][k], acc[ai][bj][m][n], 0, 0, 0); __builtin_amdgcn_s_setprio(0); } while (0)
#define PG8_WAIT_V(n) asm volatile("s_waitcnt vmcnt(" #n ")" ::: "memory")
#define PG8_WAIT_L(n) asm volatile("s_waitcnt lgkmcnt(" #n ")" ::: "memory")
#define PG8_BAR __builtin_amdgcn_s_barrier()
#define PG8_SCHED __builtin_amdgcn_sched_barrier(0)
    Unit cur, nxt; int ui = 0;
    if (!S.next(0, cur)) return;
    f32x4 acc[2][2][4][2];
#pragma unroll
    for (int a = 0; a < 2; ++a)
#pragma unroll
        for (int b = 0; b < 2; ++b)
#pragma unroll
            for (int m = 0; m < 4; ++m)
#pragma unroll
                for (int n = 0; n < 2; ++n) acc[a][b][m][n] = (f32x4){0.f, 0.f, 0.f, 0.f};
    bf16x8 At[4][2], B0[2][2], B1[2][2];
    const char* cA = (const char*)g.A + (size_t)cur.pm * tstep; const char* cB = (const char*)g.Bt + (size_t)cur.pn * tstep;
    PG8_STAGE(PG8_SB(0, 0), cB, voffB); PG8_STAGE(PG8_SA(0, 0), cA, voffA); PG8_STAGE(PG8_SB(0, 1), cB + hstep, voffB); PG8_STAGE(PG8_SA(0, 1), cA + hstep, voffA);
    if (wr == 1) PG8_BAR;
    PG8_WAIT_V(4); PG8_BAR;
    PG8_STAGE(PG8_SB(1, 0), cB + kstep, voffB); PG8_STAGE(PG8_SA(1, 0), cA + kstep, voffA); PG8_STAGE(PG8_SB(1, 1), cB + hstep + kstep, voffB);
    PG8_WAIT_V(6); PG8_BAR;
    for (;;) {
        const bool has_next = S.next(ui + 1, nxt);
        const char* nA = has_next ? (const char*)g.A + (size_t)nxt.pm * tstep : cA; const char* nB = has_next ? (const char*)g.Bt + (size_t)nxt.pn * tstep : cB;
        for (int t = 0; t < nt; t += 2) {
            const bool last = (t == nt - 2);
            const char* a1 = cA + (size_t)(t + 1) * kstep;
            const char* a2 = last ? nA : cA + (size_t)(t + 2) * kstep; const char* b2 = last ? nB : cB + (size_t)(t + 2) * kstep;
            const char* a3 = a2 + kstep; const char* b3 = b2 + kstep;
            PG8_LDB(B0, 0, 0); PG8_SCHED; PG8_LDA(At, 0, 0); PG8_STAGE(PG8_SA(1, 1), a1 + hstep, voffA);
            PG8_WAIT_L(8); PG8_BAR; PG8_WAIT_L(0); PG8_MMA(0, 0, At, B0); PG8_BAR; PG8_SCHED;
            PG8_LDB(B1, 0, 1); PG8_STAGE(PG8_SB(0, 0), b2, voffB);
            PG8_BAR; PG8_WAIT_L(0); PG8_MMA(0, 1, At, B1); PG8_BAR;
            PG8_LDA(At, 0, 1); PG8_STAGE(PG8_SA(0, 0), a2, voffA);
            PG8_BAR; PG8_WAIT_L(0); PG8_MMA(1, 0, At, B0); PG8_BAR; PG8_SCHED;
            PG8_STAGE(PG8_SB(0, 1), b2 + hstep, voffB);
            PG8_WAIT_V(6); PG8_BAR; PG8_MMA(1, 1, At, B1); PG8_BAR;
            PG8_LDB(B0, 1, 0); PG8_SCHED; PG8_LDA(At, 1, 0); PG8_STAGE(PG8_SA(0, 1), a2 + hstep, voffA);
            PG8_WAIT_L(8); PG8_BAR; PG8_WAIT_L(0); PG8_MMA(0, 0, At, B0); PG8_BAR; PG8_SCHED;
            PG8_LDB(B1, 1, 1); PG8_STAGE(PG8_SB(1, 0), b3, voffB);
            PG8_BAR; PG8_WAIT_L(0); PG8_MMA(0, 1, At, B1); PG8_BAR;
            PG8_LDA(At, 1, 1); PG8_STAGE(PG8_SA(1, 0), a3, voffA);
            PG8_BAR; PG8_WAIT_L(0); PG8_MMA(1, 0, At, B0); PG8_BAR; PG8_SCHED;
            PG8_STAGE(PG8_SB(1, 1), b3 + hstep, voffB);
            PG8_WAIT_V(6); PG8_BAR; PG8_MMA(1, 1, At, B1); PG8_BAR;
        }
        { Unit eu = cur; asm volatile("" : "+s"(eu.pm), "+s"(eu.pn)); E(acc, eu, wr, wc, fr, fq); }
        if (!has_next) break;
#pragma unroll
        for (int a = 0; a < 2; ++a)
#pragma unroll
            for (int b = 0; b < 2; ++b)
#pragma unroll
                for (int m = 0; m < 4; ++m)
#pragma unroll
                    for (int n = 0; n < 2; ++n) acc[a][b][m][n] = (f32x4){0.f, 0.f, 0.f, 0.f};
        cur = nxt; cA = nA; cB = nB; ++ui;
    }
    PG8_WAIT_V(0);
    if (wr == 0) PG8_BAR;
    PG8_BAR;
#undef PG8_SA
#undef PG8_SB
#undef PG8_STAGE
#undef PG8_LDA
#undef PG8_LDB
#undef PG8_MMA
#undef PG8_WAIT_V
#undef PG8_WAIT_L
#undef PG8_BAR
#undef PG8_SCHED
}
}

typedef f32x4 AccT[2][2][4][2];
struct Epi1 {
    bf16_t* U; float* sf;
    __device__ __forceinline__ void operator()(const AccT& acc, const pg8::Unit& u, int wr, int wc, int fr, int fq) const {
        const int row0 = u.pm * 256 + wr * 64 + fr, col0 = u.pn * 256 + wc * 32 + 8 * fq;
        const bool side_dt = (u.pn == 18 && wc == 0), side_if = (u.pn == 34 && wc == 1);
#pragma unroll
        for (int ai = 0; ai < 2; ++ai)
#pragma unroll
            for (int m = 0; m < 4; ++m) {
                const int row = row0 + ai * 128 + m * 16;
                bf16_t* rowp = U + (size_t)row * N1P + col0;
#pragma unroll
                for (int bj = 0; bj < 2; ++bj) {
                    const f32x4 v0 = acc[ai][bj][m][0], v1 = acc[ai][bj][m][1];
                    u32x4 o; o[0] = pack2(v0[0], v0[1]); o[1] = pack2(v0[2], v0[3]); o[2] = pack2(v1[0], v1[1]); o[3] = pack2(v1[2], v1[3]);
                    *(u32x4*)(rowp + bj * 128) = o;
                }
                if (side_dt || side_if) {
                    float* sp = sf + (size_t)row * 64 + (side_if ? 32 : 0) + 8 * fq;
                    *(f32x4*)sp = acc[ai][0][m][0]; *(f32x4*)(sp + 4) = acc[ai][0][m][1];
                }
            }
    }
};
struct Epi2 {
    Params p;
    __device__ __forceinline__ void operator()(const AccT& acc, const pg8::Unit& u, int wr, int wc, int fr, int fq) const {
        float* H1 = (float*)(p.ws + WS_H1); bf16_t* A2 = (bf16_t*)(p.ws + WS_A2); float* SS2 = (float*)(p.ws + WS_SS2);
        const float* nw = p.in[21];
        const int row0 = u.pm * 256 + wr * 64 + fr, col0 = u.pn * 256 + wc * 32 + 8 * fq;
        f32x4 w[2][2];
#pragma unroll
        for (int bj = 0; bj < 2; ++bj) { w[bj][0] = *(const f32x4*)(nw + col0 + bj * 128); w[bj][1] = *(const f32x4*)(nw + col0 + bj * 128 + 4); }
#pragma unroll
        for (int ai = 0; ai < 2; ++ai)
#pragma unroll
            for (int m = 0; m < 4; ++m) {
                const int row = row0 + ai * 128 + m * 16;
                const float* rp = resid_row(p, row);
                float ss = 0.f;
#pragma unroll
                for (int bj = 0; bj < 2; ++bj) {
                    f32x4 v0 = acc[ai][bj][m][0], v1 = acc[ai][bj][m][1];
                    if (rp) { v0 += *(const f32x4*)(rp + col0 + bj * 128); v1 += *(const f32x4*)(rp + col0 + bj * 128 + 4); }
                    *(f32x4*)(H1 + (size_t)row * DM + col0 + bj * 128) = v0; *(f32x4*)(H1 + (size_t)row * DM + col0 + bj * 128 + 4) = v1;
                    ss += v0[0] * v0[0] + v0[1] * v0[1] + v0[2] * v0[2] + v0[3] * v0[3] + v1[0] * v1[0] + v1[1] * v1[1] + v1[2] * v1[2] + v1[3] * v1[3];
                    const f32x4 a0 = v0 * w[bj][0], a1 = v1 * w[bj][1];
                    u32x4 o; o[0] = pack2(a0[0], a0[1]); o[1] = pack2(a0[2], a0[3]); o[2] = pack2(a1[0], a1[1]); o[3] = pack2(a1[2], a1[3]);
                    *(u32x4*)(A2 + (size_t)row * DM + col0 + bj * 128) = o;
                }
                ss += __shfl_xor(ss, 16); ss += __shfl_xor(ss, 32);
                if (fq == 0) atomicAdd(SS2 + row, ss);
            }
    }
};
struct Epi3 {
    bf16_t* UP; const float* SS2;
    __device__ __forceinline__ void operator()(const AccT& acc, const pg8::Unit& u, int wr, int wc, int fr, int fq) const {
        const int row0 = u.pm * 256 + wr * 64 + fr, col0 = u.pn * 256 + wc * 32 + 8 * fq;
#pragma unroll
        for (int ai = 0; ai < 2; ++ai)
#pragma unroll
            for (int m = 0; m < 4; ++m) {
                const int row = row0 + ai * 128 + m * 16;
                const float r2 = rsqrtf(SS2[row] * (1.f / 2048.f) + EPS);
                bf16_t* rowp = UP + (size_t)row * N3 + col0;
#pragma unroll
                for (int bj = 0; bj < 2; ++bj) {
                    const f32x4 v0 = acc[ai][bj][m][0] * r2, v1 = acc[ai][bj][m][1] * r2;
                    u32x4 o; o[0] = pack2(v0[0], v0[1]); o[1] = pack2(v0[2], v0[3]); o[2] = pack2(v1[0], v1[1]); o[3] = pack2(v1[2], v1[3]);
                    *(u32x4*)(rowp + bj * 128) = o;
                }
            }
    }
};
struct Epi4 {
    const float* H1; float* out; float* SS3;
    __device__ __forceinline__ void operator()(const AccT& acc, const pg8::Unit& u, int wr, int wc, int fr, int fq) const {
        const int row0 = u.pm * 256 + wr * 64 + fr, col0 = u.pn * 256 + wc * 32 + 8 * fq;
#pragma unroll
        for (int ai = 0; ai < 2; ++ai)
#pragma unroll
            for (int m = 0; m < 4; ++m) {
                const int row = row0 + ai * 128 + m * 16;
                if (row < NOUTROWS) {
                    float ss = 0.f;
#pragma unroll
                    for (int bj = 0; bj < 2; ++bj) {
                        const f32x4 v0 = acc[ai][bj][m][0] + *(const f32x4*)(H1 + (size_t)row * DM + col0 + bj * 128);
                        const f32x4 v1 = acc[ai][bj][m][1] + *(const f32x4*)(H1 + (size_t)row * DM + col0 + bj * 128 + 4);
                        *(f32x4*)(out + (size_t)row * DM + col0 + bj * 128) = v0; *(f32x4*)(out + (size_t)row * DM + col0 + bj * 128 + 4) = v1;
                        ss += v0[0] * v0[0] + v0[1] * v0[1] + v0[2] * v0[2] + v0[3] * v0[3] + v1[0] * v1[0] + v1[1] * v1[1] + v1[2] * v1[2] + v1[3] * v1[3];
                    }
                    ss += __shfl_xor(ss, 16); ss += __shfl_xor(ss, 32);
                    if (fq == 0) atomicAdd(SS3 + row, ss);
                }
            }
    }
};

struct TileRef { const float* W; bf16_t* WT; int K, N, kt, nt; };
__device__ __forceinline__ TileRef tile_ref(const Params& p, int t) {
    constexpr int T_IN = 32 * 43, T_OUT = 64 * 8, T_UP = 32 * 44;
    TileRef r;
    if (t < T_IN) { r.W = p.in[10]; r.WT = (bf16_t*)(p.ws + WS_WIN); r.K = 2048; r.N = 10800; r.kt = t % 32; r.nt = t / 32; }
    else if (t < T_IN + T_OUT) { const int q = t - T_IN; r.W = p.in[20]; r.WT = (bf16_t*)(p.ws + WS_WOUT); r.K = 4096; r.N = 2048; r.kt = q % 64; r.nt = q / 64; }
    else if (t < T_IN + T_OUT + T_UP) { const int q = t - T_IN - T_OUT; r.W = p.in[22]; r.WT = (bf16_t*)(p.ws + WS_WUP); r.K = 2048; r.N = N3; r.kt = q % 32; r.nt = q / 32; }
    else { const int q = t - T_IN - T_OUT - T_UP; r.W = p.in[25]; r.WT = (bf16_t*)(p.ws + WS_WDOWN); r.K = DFF; r.N = 2048; r.kt = q % 88; r.nt = q / 88; }
    return r;
}
__device__ __forceinline__ void tile_load(const TileRef& r, f32x4 (&v)[8], int tid) {
    const int nc = (tid & 63) * 4, n = r.nt * 256 + nc;
#pragma unroll
    for (int i = 0; i < 8; ++i) {
        const int kr = (tid >> 6) + 8 * i;
        v[i] = (f32x4){0.f, 0.f, 0.f, 0.f};
        if (n < r.N) v[i] = *(const f32x4*)(r.W + (size_t)(r.kt * 64 + kr) * r.N + n);
    }
}
__device__ __forceinline__ void tile_lds_write(const f32x4 (&v)[8], int tid, unsigned char* smem) {
    float* tile = (float*)smem;
    const int nc = (tid & 63) * 4;
#pragma unroll
    for (int i = 0; i < 8; ++i) {
        const int kr = (tid >> 6) + 8 * i;
        tile[kr * 257 + nc] = v[i][0]; tile[kr * 257 + nc + 1] = v[i][1]; tile[kr * 257 + nc + 2] = v[i][2]; tile[kr * 257 + nc + 3] = v[i][3];
    }
}
__device__ __forceinline__ void tile_store(const TileRef& r, int tid, unsigned char* smem) {
    const float* tile = (const float*)smem;
    const int kc = (tid & 7) * 8;
#pragma unroll
    for (int q = 0; q < 4; ++q) {
        const int nr = (tid >> 3) + 64 * q;
        u32x4 o;
        o[0] = pack2(tile[(kc + 0) * 257 + nr], tile[(kc + 1) * 257 + nr]); o[1] = pack2(tile[(kc + 2) * 257 + nr], tile[(kc + 3) * 257 + nr]);
        o[2] = pack2(tile[(kc + 4) * 257 + nr], tile[(kc + 5) * 257 + nr]); o[3] = pack2(tile[(kc + 6) * 257 + nr], tile[(kc + 7) * 257 + nr]);
        *(u32x4*)(r.WT + (size_t)(r.nt * 256 + nr) * r.K + r.kt * 64 + kc) = o;
    }
}
__device__ __forceinline__ void phase_prep(const Params& p, unsigned char* smem) {
    const int tid = opaque_tid(), wid = tid >> 6, lane = tid & 63;
    { float* SS2 = (float*)(p.ws + WS_SS2); for (int i = opaque_bid() * 512 + tid; i < 2 * MP; i += gridDim.x * 512) SS2[i] = 0.f; }
    {
        bf16_t* XN = (bf16_t*)(p.ws + WS_XN); const float* nw = p.in[9];
        for (int row = opaque_bid() * 8 + wid; row < MP; row += gridDim.x * 8) {
            const float* src = resid_row(p, row);
            f32x4 v[8];
            float ss = 0.f;
#pragma unroll
            for (int it = 0; it < 4; ++it) {
                const int col = it * 512 + lane * 8;
                if (src) { v[2 * it] = *(const f32x4*)(src + col); v[2 * it + 1] = *(const f32x4*)(src + col + 4); }
                else { v[2 * it] = (f32x4){0.f, 0.f, 0.f, 0.f}; v[2 * it + 1] = (f32x4){0.f, 0.f, 0.f, 0.f}; }
#pragma unroll
                for (int j = 0; j < 4; ++j) ss += v[2 * it][j] * v[2 * it][j] + v[2 * it + 1][j] * v[2 * it + 1][j];
            }
            ss = wave_sum(ss);
            const float r = rsqrtf(ss * (1.f / 2048.f) + EPS);
#pragma unroll
            for (int it = 0; it < 4; ++it) {
                const int col = it * 512 + lane * 8;
                const f32x4 w0 = *(const f32x4*)(nw + col), w1 = *(const f32x4*)(nw + col + 4);
                const f32x4 a = v[2 * it] * r * w0, c = v[2 * it + 1] * r * w1;
                u32x4 o; o[0] = pack2(a[0], a[1]); o[1] = pack2(a[2], a[3]); o[2] = pack2(c[0], c[1]); o[3] = pack2(c[2], c[3]);
                *(u32x4*)(XN + (size_t)row * DM + col) = o;
            }
        }
    }
    constexpr int T_ALL = 32 * 43 + 64 * 8 + 32 * 44 + 88 * 8;
    {
        int t = opaque_bid();
        f32x4 v[8];
        TileRef cur{};
        if (t < T_ALL) { cur = tile_ref(p, t); tile_load(cur, v, tid); }
        while (t < T_ALL) {
            tile_lds_write(v, tid, smem);
            __syncthreads();
            const int tn = t + gridDim.x;
            TileRef nxt{};
            if (tn < T_ALL) { nxt = tile_ref(p, tn); tile_load(nxt, v, tid); }
            tile_store(cur, tid, smem);
            __syncthreads();
            cur = nxt; t = tn;
        }
    }
}

constexpr int RS = 272;
constexpr int L_QS = 0, L_KS = 34816, L_KT = 69632, L_VT = 104448, L_ST = 121856, L_SC = 139264;

template <bool ML>
__device__ __forceinline__ void load_block(const Params& p, float (&val)[8][4], int b, int p0, int Lv, int rb, int cg, int colbase, int chbase, float mlscale) {
    const bf16_t* U = (const bf16_t*)(p.ws + WS_U);
    const int t0 = rb * 8;
    if (t0 >= Lv) {
#pragma unroll
        for (int r = 0; r < 8; ++r)
#pragma unroll
            for (int i = 0; i < 4; ++i) val[r][i] = 0.f;
        return;
    }
    if (ML) {
#pragma unroll
        for (int r = 0; r < 8; ++r) {
            const int row = row_of(b, p0 + t0 + r);
            const u32x2 raw = *(const u32x2*)(U + (size_t)row * N1P + colbase + cg * 4);
            val[r][0] = bf_lo(raw[0]) * mlscale; val[r][1] = bf_hi(raw[0]) * mlscale; val[r][2] = bf_lo(raw[1]) * mlscale; val[r][3] = bf_hi(raw[1]) * mlscale;
        }
    } else {
        u32x2 raw[11];
#pragma unroll
        for (int rr = 0; rr < 11; ++rr) {
            const int pos = p0 + t0 - 3 + rr;
            if (pos >= 0) raw[rr] = *(const u32x2*)(U + (size_t)row_of(b, pos) * N1P + colbase + cg * 4);
            else raw[rr] = (u32x2){0u, 0u};
        }
        const float* cw = p.in[11]; const float* cb = p.in[12];
        const int ch = chbase + cg * 4;
        f32x4 w[4];
#pragma unroll
        for (int j = 0; j < 4; ++j) w[j] = *(const f32x4*)(cw + j * 2560 + ch);
        const f32x4 bi = *(const f32x4*)(cb + ch);
#pragma unroll
        for (int i = 0; i < 4; ++i) {
            float x[11];
#pragma unroll
            for (int rr = 0; rr < 11; ++rr) x[rr] = (i & 1) ? bf_hi(raw[rr][i >> 1]) : bf_lo(raw[rr][i >> 1]);
#pragma unroll
            for (int r = 0; r < 8; ++r) val[r][i] = silu_f(bi[i] + w[0][i] * x[r] + w[1][i] * x[r + 1] + w[2][i] * x[r + 2] + w[3][i] * x[r + 3]);
        }
    }
}
__device__ __forceinline__ void store_rows(unsigned char* base, const float (&val)[8][4], int rb, int cg) {
#pragma unroll
    for (int r = 0; r < 8; ++r) *(u32x2*)(base + (rb * 8 + r) * RS + cg * 8) = (u32x2){pack2(val[r][0], val[r][1]), pack2(val[r][2], val[r][3])};
}
__device__ __forceinline__ void store_cols(unsigned char* base, const float (&val)[8][4], int rb, int cg, const float* scale) {
    float s[8];
#pragma unroll
    for (int r = 0; r < 8; ++r) s[r] = scale ? scale[rb * 8 + r] : 1.f;
#pragma unroll
    for (int i = 0; i < 4; ++i) {
        const int row = cg * 4 + i;
        u32x4 o; o[0] = pack2(val[0][i] * s[0], val[1][i] * s[1]); o[1] = pack2(val[2][i] * s[2], val[3][i] * s[3]);
        o[2] = pack2(val[4][i] * s[4], val[5][i] * s[5]); o[3] = pack2(val[6][i] * s[6], val[7][i] * s[7]);
        *(u32x4*)(base + row * RS + ((rb ^ ((row >> 3) & 7)) << 4)) = o;
    }
}

template <bool ML>
__device__ __forceinline__ void prompt_scan(const Params& p, unsigned char* smem, int job) {
    const int tid = opaque_tid(), wid = __builtin_amdgcn_readfirstlane(tid >> 6), lane = tid & 63, fr = lane & 15, fq = lane >> 4;
    int b, h, vq = 0;
    if (ML) { b = job >> 5; h = (job >> 2) & 7; vq = job & 3; } else { b = job >> 5; h = job & 31; }
    const int g = h >> 4;
    const bf16_t* U = (const bf16_t*)(p.ws + WS_U);
    const float* SF = (const float*)(p.ws + WS_SF);
    bf16_t* MIX = (bf16_t*)(p.ws + WS_MIX);
    float* scb = (float*)(smem + L_SC);
    float *qn = scb + 1600, *nvec = scb + 1728, *mpp = scb + 1856;
    const int qcol = ML ? UC_Q + h * 128 : UC_XBC + 2304 + g * 128;
    const int kcol = ML ? UC_K + h * 128 : UC_XBC + 2048 + g * 128;
    const int vcol = ML ? UC_V + h * 256 + vq * 64 : UC_XBC + h * 64;
    const int gcol = ML ? UC_O + h * 256 + vq * 64 : UC_Z + h * 64;
    const int mixcol = ML ? 2048 + h * 256 + vq * 64 : h * 64;
    float A_h = 0.f, D_h = 0.f, dtb = 0.f, ib = 0.f, fb = 0.f;
    if (ML) { ib = p.in[17][h]; fb = p.in[18][h]; } else { A_h = -__expf(p.in[14][h]); D_h = p.in[15][h]; dtb = p.in[13][h]; }
    f32x4 st[4];
#pragma unroll
    for (int i = 0; i < 4; ++i) st[i] = (f32x4){0.f, 0.f, 0.f, 0.f};
    for (int i = tid; i < 64 * RS / 16; i += 512) *(u32x4*)(smem + L_ST + i * 16) = (u32x4){0u, 0u, 0u, 0u};
    if (tid < 128) nvec[tid] = 0.f;
    if (tid == 0) mpp[0] = 0.f;
    constexpr int CHLs = ML ? CHL_ML : CHL_SSD;
    float sraw[4] = {0.f, 0.f, 0.f, 0.f};
    auto scal_load = [&](int cc) {
        const int p0 = cc == 0 ? 0 : 16 + (cc - 1) * CHLs, Lv = cc == 0 ? 16 : CHLs;
        const int t0 = 2 * lane, t1 = t0 + 1;
        if (!ML) {
            if (t0 < Lv) sraw[0] = SF[(size_t)row_of(b, p0 + t0) * 64 + h];
            if (t1 < Lv) sraw[1] = SF[(size_t)row_of(b, p0 + t1) * 64 + h];
        } else {
            if (t0 < Lv) { const size_t r = (size_t)row_of(b, p0 + t0) * 64; sraw[0] = SF[r + 32 + h]; sraw[2] = SF[r + 40 + h]; }
            if (t1 < Lv) { const size_t r = (size_t)row_of(b, p0 + t1) * 64; sraw[1] = SF[r + 32 + h]; sraw[3] = SF[r + 40 + h]; }
        }
    };
    auto scalars = [&](int cc) {
        const int Lv = cc == 0 ? 16 : CHLs;
        float* sc = scb + (cc & 1) * 800;
        float *rowv = sc, *colv = sc + 128, *colm = sc + 256, *ev = sc + 384, *scv = sc + 512, *dden = sc + 640, *misc = sc + 768;
        const int t0 = 2 * lane, t1 = t0 + 1;
        if (!ML) {
            float d0 = 0.f, d1 = 0.f;
            if (t0 < Lv) d0 = softplus_f(sraw[0] + dtb);
            if (t1 < Lv) d1 = softplus_f(sraw[1] + dtb);
            const float a0 = d0 * A_h, a1 = d1 * A_h;
            float inc = a0 + a1;
#pragma unroll
            for (int o = 1; o < 64; o <<= 1) { const float y = __shfl_up(inc, o); if (lane >= o) inc += y; }
            const float c1 = inc, c0 = inc - a1, cl = __shfl(inc, 63);
            rowv[t0] = c0; rowv[t1] = c1; colv[t0] = -c0; colv[t1] = -c1; colm[t0] = d0; colm[t1] = d1;
            ev[t0] = __expf(c0); ev[t1] = __expf(c1); scv[t0] = __expf(cl - c0) * d0; scv[t1] = __expf(cl - c1) * d1;
            if (lane == 0) misc[0] = __expf(cl);
        } else {
            float i0 = -INFINITY, i1 = -INFINITY, f0 = 0.f, f1 = 0.f;
            if (t0 < Lv) { i0 = sraw[0] + ib; f0 = logsig_f(sraw[2] + fb); }
            if (t1 < Lv) { i1 = sraw[1] + ib; f1 = logsig_f(sraw[3] + fb); }
            float inc = f0 + f1;
#pragma unroll
            for (int o = 1; o < 64; o <<= 1) { const float y = __shfl_up(inc, o); if (lane >= o) inc += y; }
            const float F1 = inc, F0 = inc - f1;
            const float g0 = i0 - F0, g1 = i1 - F1;
            float mx = fmaxf(g0, g1);
#pragma unroll
            for (int o = 1; o < 64; o <<= 1) { const float y = __shfl_up(mx, o); if (lane >= o) mx = fmaxf(mx, y); }
            float ex = __shfl_up(mx, 1); if (lane == 0) ex = -INFINITY;
            const float mp = mpp[0];
            const float M0 = fmaxf(fmaxf(ex, g0), mp), M1 = fmaxf(mx, mp);
            const float Ml = __shfl(M1, 63), Fl = __shfl(F1, 63);
            rowv[t0] = -M0; rowv[t1] = -M1; colv[t0] = g0; colv[t1] = g1; colm[t0] = 1.f; colm[t1] = 1.f;
            ev[t0] = __expf(mp - M0); ev[t1] = __expf(mp - M1); dden[t0] = __expf(-(F0 + M0)); dden[t1] = __expf(-(F1 + M1));
            scv[t0] = __expf(g0 - Ml); scv[t1] = __expf(g1 - Ml);
            if (lane == 0) { misc[0] = __expf(mp - Ml); mpp[0] = Fl + Ml; }
        }
    };
    __syncthreads();
    if (wid == 0) { scal_load(0); scalars(0); }
    __syncthreads();
    constexpr int CHL = ML ? CHL_ML : CHL_SSD, NCH = 1 + 2048 / CHL;
    const int tid_outer = tid;
    for (int c = 0; c < NCH; ++c) {
        int tid = tid_outer; asm volatile("" : "+v"(tid));
        const int lane = tid & 63, fr = lane & 15, fq = lane >> 4;
        const int p0 = c == 0 ? 0 : 16 + (c - 1) * CHL, Lv = c == 0 ? 16 : CHL;
        float* sc = scb + (c & 1) * 800;
        float *rowv = sc, *colv = sc + 128, *colm = sc + 256, *ev = sc + 384, *scv = sc + 512, *dden = sc + 640, *misc = sc + 768;
        if (wid == 0 && c + 1 < NCH) scal_load(c + 1);
        {
            float val[8][4];
            load_block<ML>(p, val, b, p0, Lv, tid >> 5, tid & 31, qcol, 2304 + g * 128, 1.f);
            store_rows(smem + L_QS, val, tid >> 5, tid & 31);
            __builtin_amdgcn_sched_barrier(0);
            load_block<ML>(p, val, b, p0, Lv, tid >> 5, tid & 31, kcol, 2048 + g * 128, 0.08838834764831845f);
            store_rows(smem + L_KS, val, tid >> 5, tid & 31);
            store_cols(smem + L_KT, val, tid >> 5, tid & 31, scv);
            __builtin_amdgcn_sched_barrier(0);
            if (tid < 256) {
                load_block<ML>(p, val, b, p0, Lv, tid >> 4, tid & 15, vcol, h * 64, 1.f);
                store_cols(smem + L_VT, val, tid >> 4, tid & 15, nullptr);
            }
        }
        __syncthreads();
        const int t = 16 * wid + fr;
        const bool valid = t < Lv;
        const int row = row_of(b, p0 + (valid ? t : 0));
        u32x2 gate[4];
#pragma unroll
        for (int vb = 0; vb < 4; ++vb) gate[vb] = *(const u32x2*)(U + (size_t)row * N1P + gcol + 16 * vb + 4 * fq);
        if (ML) {
            const int tt = tid >> 2, part = tid & 3;
            float s = 0.f;
#pragma unroll
            for (int cc = 0; cc < 4; ++cc) {
                const u32x4 raw = *(const u32x4*)(smem + L_QS + tt * RS + (part * 4 + cc) * 16);
                const f32x4 n0 = *(const f32x4*)(nvec + (part * 4 + cc) * 8), n1 = *(const f32x4*)(nvec + (part * 4 + cc) * 8 + 4);
                s += bf_lo(raw[0]) * n0[0] + bf_hi(raw[0]) * n0[1] + bf_lo(raw[1]) * n0[2] + bf_hi(raw[1]) * n0[3]
                   + bf_lo(raw[2]) * n1[0] + bf_hi(raw[2]) * n1[1] + bf_lo(raw[3]) * n1[2] + bf_hi(raw[3]) * n1[3];
            }
            s += __shfl_xor(s, 1); s += __shfl_xor(s, 2);
            if (part == 0) qn[tt] = s;
        }
        bf16x8 qf[4];
#pragma unroll
        for (int kk = 0; kk < 4; ++kk) qf[kk] = *(const bf16x8*)(smem + L_QS + t * RS + (kk * 32 + fq * 8) * 2);
        const float rv = rowv[t];
        float rowsum = 0.f;
        u32x2 pk[8];
#pragma unroll
        for (int sb = 0; sb < 8; ++sb) {
            pk[sb] = (u32x2){0u, 0u};
            if (sb <= wid) {
                f32x4 acc = {0.f, 0.f, 0.f, 0.f};
#pragma unroll
                for (int kk = 0; kk < 4; ++kk) {
                    const bf16x8 kf = *(const bf16x8*)(smem + L_KS + (16 * sb + fr) * RS + (kk * 32 + fq * 8) * 2);
                    acc = __builtin_amdgcn_mfma_f32_16x16x32_bf16(kf, qf[kk], acc, 0, 0, 0);
                }
                const f32x4 cv = *(const f32x4*)(colv + 16 * sb + 4 * fq), cm = *(const f32x4*)(colm + 16 * sb + 4 * fq);
                float pv[4];
#pragma unroll
                for (int j = 0; j < 4; ++j) {
                    const int s = 16 * sb + 4 * fq + j;
                    const float w = (s <= t) ? __expf(rv + cv[j]) * cm[j] : 0.f;
                    pv[j] = acc[j] * w; rowsum += pv[j];
                }
                pk[sb] = (u32x2){pack2(pv[0], pv[1]), pack2(pv[2], pv[3])};
            }
        }
        if (wid == 0 && c + 1 < NCH) scalars(c + 1);
        __syncthreads();
#pragma unroll
        for (int sb = 0; sb < 8; ++sb) *(u32x2*)(smem + L_KS + t * RS + (16 * sb + 4 * fq) * 2) = pk[sb];
        rowsum += __shfl_xor(rowsum, 16); rowsum += __shfl_xor(rowsum, 32);
        if (ML) {
            const int d = tid >> 2, part = tid & 3;
            float s = 0.f;
#pragma unroll
            for (int cc = 0; cc < 4; ++cc) {
                const u32x4 raw = *(const u32x4*)(smem + L_KT + d * RS + (part * 4 + cc) * 16);
                s += bf_lo(raw[0]) + bf_hi(raw[0]) + bf_lo(raw[1]) + bf_hi(raw[1]) + bf_lo(raw[2]) + bf_hi(raw[2]) + bf_lo(raw[3]) + bf_hi(raw[3]);
            }
            s += __shfl_xor(s, 1); s += __shfl_xor(s, 2);
            if (part == 0) nvec[d] = misc[0] * nvec[d] + s;
        }
        __syncthreads();
        bf16x8 pf[4];
#pragma unroll
        for (int kk = 0; kk < 4; ++kk) pf[kk] = *(const bf16x8*)(smem + L_KS + t * RS + (kk * 32 + fq * 8) * 2);
        const float et = ev[t];
        float ddv = 1.f;
        if (ML) ddv = fmaxf(fabsf(rowsum + et * qn[t]), dden[t]);
        float ss = 0.f;
#pragma unroll
        for (int vb = 0; vb < 4; ++vb) {
            f32x4 acc = {0.f, 0.f, 0.f, 0.f};
            const int vrow = 16 * vb + fr;
#pragma unroll
            for (int kk = 0; kk < 4; ++kk) {
                const bf16x8 sf = *(const bf16x8*)(smem + L_ST + vrow * RS + (kk * 32 + fq * 8) * 2);
                acc = __builtin_amdgcn_mfma_f32_16x16x32_bf16(sf, qf[kk], acc, 0, 0, 0);
            }
            acc *= et;
#pragma unroll
            for (int kk = 0; kk < 4; ++kk) {
                const bf16x8 vf = *(const bf16x8*)(smem + L_VT + vrow * RS + (((kk * 4 + fq) ^ ((vrow >> 3) & 7)) << 4));
                acc = __builtin_amdgcn_mfma_f32_16x16x32_bf16(vf, pf[kk], acc, 0, 0, 0);
            }
            const float gz[4] = {bf_lo(gate[vb][0]), bf_hi(gate[vb][0]), bf_lo(gate[vb][1]), bf_hi(gate[vb][1])};
            float o[4];
#pragma unroll
            for (int j = 0; j < 4; ++j) {
                if (ML) { const float hv = acc[j]; ss += hv * hv; o[j] = hv * sigm_f(gz[j]); }
                else {
                    const int v = 16 * vb + 4 * fq + j;
                    const float xv = bf2f(*(const bf16_t*)(smem + L_VT + v * RS + (((t >> 3) ^ ((v >> 3) & 7)) << 4) + (t & 7) * 2));
                    const float y = (acc[j] + D_h * xv) * silu_f(gz[j]); ss += y * y; o[j] = y;
                }
            }
            if (valid) *(u32x2*)(MIX + (size_t)row * MIXW + mixcol + 16 * vb + 4 * fq) = (u32x2){pack2(o[0], o[1]), pack2(o[2], o[3])};
        }
        ss += __shfl_xor(ss, 16); ss += __shfl_xor(ss, 32);
        if (valid && fq == 0) {
            if (ML) { ((float*)(p.ws + WS_SSQM))[(size_t)row * 32 + h * 4 + vq] = ss; if (vq == 0) ((float*)(p.ws + WS_DD))[(size_t)row * 8 + h] = ddv; }
            else ((float*)(p.ws + WS_SSQ))[(size_t)row * 32 + h] = ss;
        }
        const float dec = misc[0];
#pragma unroll
        for (int vb = 0; vb < 4; ++vb) st[vb] *= dec;
#pragma unroll
        for (int kk = 0; kk < 4; ++kk) {
            const int drow = 16 * wid + fr;
            const bf16x8 kf = *(const bf16x8*)(smem + L_KT + drow * RS + (((kk * 4 + fq) ^ ((drow >> 3) & 7)) << 4));
#pragma unroll
            for (int vb = 0; vb < 4; ++vb) {
                const int vrow = 16 * vb + fr;
                const bf16x8 vf = *(const bf16x8*)(smem + L_VT + vrow * RS + (((kk * 4 + fq) ^ ((vrow >> 3) & 7)) << 4));
                st[vb] = __builtin_amdgcn_mfma_f32_16x16x32_bf16(kf, vf, st[vb], 0, 0, 0);
            }
        }
        __syncthreads();
#pragma unroll
        for (int vb = 0; vb < 4; ++vb)
            *(u32x2*)(smem + L_ST + (16 * vb + fr) * RS + (16 * wid + 4 * fq) * 2) = (u32x2){pack2(st[vb][0], st[vb][1]), pack2(st[vb][2], st[vb][3])};
    }
#pragma unroll
    for (int vb = 0; vb < 4; ++vb) {
        const int v = 16 * vb + fr, d0 = 16 * wid + 4 * fq;
        if (!ML) *(f32x4*)(p.out + O_P_SSD + ((size_t)(b * 32 + h) * 64 + v) * 128 + d0) = st[vb];
        else {
#pragma unroll
            for (int j = 0; j < 4; ++j) p.out[O_P_MLC + ((size_t)(b * 8 + h) * 128 + d0 + j) * 256 + vq * 64 + v] = st[vb][j];
        }
    }
    if (ML && vq == 0) {
        if (tid < 128) p.out[O_P_MLN + (size_t)(b * 8 + h) * 128 + tid] = nvec[tid];
        if (tid == 0) p.out[O_P_MLM + b * 8 + h] = mpp[0];
    }
    __syncthreads();
}

__device__ __forceinline__ void sample_ssd(const Params& p, unsigned char* smem, int job) {
    const int tid = opaque_tid(), wid = tid >> 6, lane = tid & 63;
    const int b = job >> 1, g = job & 1, rowb = ROW_SAMPLE + b * 8;
    const bf16_t* U = (const bf16_t*)(p.ws + WS_U);
    const float* SF = (const float*)(p.ws + WS_SF);
    bf16_t* MIX = (bf16_t*)(p.ws + WS_MIX);
    float* Bc = (float*)smem; float* Cc = Bc + 1024; float* xall = Cc + 1024; float* G = xall + 8192; float* dts = G + 64; float* ssqp = dts + 128;
    const float* sconv = p.in[2]; const float* cw = p.in[11]; const float* cb = p.in[12];
#pragma unroll
    for (int q = 0; q < 3; ++q) {
        int ch; float* dst; int dstride = 0;
        if (q < 2) { ch = g * 1024 + tid + q * 512; dst = xall + tid + q * 512; dstride = 1024; }
        else { if (tid >= 256) break; const int which = tid >> 7, n = tid & 127; ch = 2048 + which * 256 + g * 128 + n; dst = (which ? Cc : Bc) + n; dstride = 128; }
        float xm3 = sconv[(size_t)(b * 3 + 0) * 2560 + ch], xm2 = sconv[(size_t)(b * 3 + 1) * 2560 + ch], xm1 = sconv[(size_t)(b * 3 + 2) * 2560 + ch];
        const float w0 = cw[ch], w1 = cw[2560 + ch], w2 = cw[5120 + ch], w3 = cw[7680 + ch], bb = cb[ch];
#pragma unroll
        for (int t = 0; t < 8; ++t) {
            const float x = bf2f(U[(size_t)(rowb + t) * N1P + UC_XBC + ch]);
            dst[t * dstride] = silu_f(bb + w0 * xm3 + w1 * xm2 + w2 * xm1 + w3 * x);
            xm3 = xm2; xm2 = xm1; xm1 = x;
        }
    }
    if (tid < 128) { const int hh = tid >> 3, t = tid & 7; dts[tid] = softplus_f(SF[(size_t)(rowb + t) * 64 + g * 16 + hh] + p.in[13][g * 16 + hh]); }
    __syncthreads();
    {
        const int pair = tid >> 3, part = tid & 7, t = pair >> 3, s = pair & 7;
        float sum = 0.f;
#pragma unroll
        for (int i = 0; i < 4; ++i) {
            const f32x4 c4 = *(const f32x4*)(Cc + t * 128 + part * 16 + i * 4), b4 = *(const f32x4*)(Bc + s * 128 + part * 16 + i * 4);
            sum += c4[0] * b4[0] + c4[1] * b4[1] + c4[2] * b4[2] + c4[3] * b4[3];
        }
        sum += __shfl_xor(sum, 1); sum += __shfl_xor(sum, 2); sum += __shfl_xor(sum, 4);
        if (part == 0) G[pair] = sum;
    }
    __syncthreads();
    const int pp = tid >> 3, nq = tid & 7;
    f32x4 snext[4];
#pragma unroll
    for (int i = 0; i < 4; ++i) snext[i] = __builtin_nontemporal_load((const f32x4*)(p.in[3] + ((size_t)(b * 32 + g * 16) * 64 + pp) * 128 + nq * 4 + 32 * i));
    for (int hh = 0; hh < 16; ++hh) {
        const int h = g * 16 + hh;
        const float A_h = -__expf(p.in[14][h]), D_h = p.in[15][h];
        float dtv[8], cum[8];
        { float run = 0.f;
#pragma unroll
          for (int t = 0; t < 8; ++t) { dtv[t] = dts[hh * 8 + t]; run += dtv[t] * A_h; cum[t] = run; } }
        const size_t soff = ((size_t)(b * 32 + h) * 64 + pp) * 128 + nq * 4;
        f32x4 s0[4];
#pragma unroll
        for (int i = 0; i < 4; ++i) s0[i] = snext[i];
        if (hh + 1 < 16) {
#pragma unroll
            for (int i = 0; i < 4; ++i) snext[i] = __builtin_nontemporal_load((const f32x4*)(p.in[3] + soff + 64 * 128 + 32 * i));
        }
        float cs[8];
#pragma unroll
        for (int t = 0; t < 8; ++t) {
            float sum = 0.f;
#pragma unroll
            for (int i = 0; i < 4; ++i) { const f32x4 c4 = *(const f32x4*)(Cc + t * 128 + nq * 4 + 32 * i); sum += c4[0] * s0[i][0] + c4[1] * s0[i][1] + c4[2] * s0[i][2] + c4[3] * s0[i][3]; }
            sum += __shfl_xor(sum, 1); sum += __shfl_xor(sum, 2); sum += __shfl_xor(sum, 4);
            cs[t] = sum;
        }
        float ycs = 0.f, ct = 0.f;
#pragma unroll
        for (int t = 0; t < 8; ++t) { ycs = (nq == t) ? cs[t] : ycs; ct = (nq == t) ? cum[t] : ct; }
        float y = __expf(ct) * ycs, xt = 0.f;
#pragma unroll
        for (int s = 0; s < 8; ++s) {
            const float xs = xall[s * 1024 + hh * 64 + pp];
            const float term = (s <= nq) ? G[nq * 8 + s] * __expf(ct - cum[s]) * dtv[s] * xs : 0.f;
            y += term; xt = (s == nq) ? xs : xt;
        }
        y += D_h * xt;
        const float z = bf2f(U[(size_t)(rowb + nq) * N1P + UC_Z + h * 64 + pp]);
        y *= silu_f(z);
        { const unsigned pk = pack2(y, 0.f); MIX[(size_t)(rowb + nq) * MIXW + h * 64 + pp] = (bf16_t)(pk & 0xffffu); }
        float sq = y * y; sq += __shfl_xor(sq, 8); sq += __shfl_xor(sq, 16); sq += __shfl_xor(sq, 32);
        if (lane < 8) ssqp[(hh * 8 + wid) * 8 + lane] = sq;
        const float cl = cum[7], dec = __expf(cl);
        float xw[8];
#pragma unroll
        for (int s = 0; s < 8; ++s) xw[s] = __expf(cl - cum[s]) * dtv[s] * xall[s * 1024 + hh * 64 + pp];
#pragma unroll
        for (int i = 0; i < 4; ++i) {
            f32x4 acc = s0[i] * dec;
#pragma unroll
            for (int s = 0; s < 8; ++s) acc += xw[s] * *(const f32x4*)(Bc + s * 128 + nq * 4 + 32 * i);
            __builtin_nontemporal_store(acc, (f32x4*)(p.out + O_S_SSD + soff + 32 * i));
        }
    }
    __syncthreads();
    if (tid < 128) {
        const int hh = tid >> 3, t = tid & 7; float tot = 0.f;
#pragma unroll
        for (int w = 0; w < 8; ++w) tot += ssqp[(hh * 8 + w) * 8 + t];
        ((float*)(p.ws + WS_SSQ))[(size_t)(rowb + t) * 32 + g * 16 + hh] = tot;
    }
    __syncthreads();
}

__device__ __forceinline__ void sample_ml(const Params& p, unsigned char* smem, int job) {
    const int tid = opaque_tid(), wid = __builtin_amdgcn_readfirstlane(tid >> 6), lane = tid & 63;
    const int b = job >> 3, h = job & 7, rowb = ROW_SAMPLE + b * 8;
    const bf16_t* U = (const bf16_t*)(p.ws + WS_U);
    const float* SF = (const float*)(p.ws + WS_SF);
    bf16_t* MIX = (bf16_t*)(p.ws + WS_MIX);
    float* qs = (float*)smem; float* ks = qs + 1024; float* vs = qs + 2048; float* QK = qs + 4096; float* sig = qs + 4160; float* slf = qs + 4168;
    float* qnv = qs + 4176; float* n0v = qs + 4192; float* red = qs + 4352;
    {
        const int t = tid >> 6, c = tid & 63;
        const size_t r = (size_t)(rowb + t) * N1P;
        const unsigned qq = *(const unsigned*)(U + r + UC_Q + h * 128 + 2 * c), kk = *(const unsigned*)(U + r + UC_K + h * 128 + 2 * c);
        const u32x2 vv = *(const u32x2*)(U + r + UC_V + h * 256 + 4 * c);
        qs[t * 128 + 2 * c] = bf_lo(qq); qs[t * 128 + 2 * c + 1] = bf_hi(qq);
        ks[t * 128 + 2 * c] = bf_lo(kk) * 0.08838834764831845f; ks[t * 128 + 2 * c + 1] = bf_hi(kk) * 0.08838834764831845f;
        *(f32x4*)(vs + t * 256 + 4 * c) = (f32x4){bf_lo(vv[0]), bf_hi(vv[0]), bf_lo(vv[1]), bf_hi(vv[1])};
        if (tid < 8) { sig[tid] = SF[(size_t)(rowb + tid) * 64 + 32 + h] + p.in[17][h]; slf[tid] = logsig_f(SF[(size_t)(rowb + tid) * 64 + 40 + h] + p.in[18][h]); }
        if (tid >= 128 && tid < 256) n0v[tid - 128] = p.in[5][(size_t)(b * 8 + h) * 128 + tid - 128];
    }
    const int v4 = lane, dg = wid;
    const size_t coff = ((size_t)(b * 8 + h) * 128 + dg * 16) * 256 + v4 * 4;
    f32x4 c0[16];
#pragma unroll
    for (int i = 0; i < 16; ++i) c0[i] = __builtin_nontemporal_load((const f32x4*)(p.in[4] + coff + (size_t)i * 256));
    const float mp = p.in[6][b * 8 + h];
    __syncthreads();
    float F[8], gg[8], M[8];
    { float run = 0.f, pm = -INFINITY;
#pragma unroll
      for (int t = 0; t < 8; ++t) { run += slf[t]; F[t] = run; gg[t] = sig[t] - run; pm = fmaxf(pm, gg[t]); M[t] = fmaxf(pm, mp); } }
    const float Ml = M[7], dec = __expf(mp - Ml), m_new = F[7] + Ml;
    {
        const int pair = tid >> 3, part = tid & 7, t = pair >> 3, s = pair & 7;
        float sum = 0.f;
#pragma unroll
        for (int i = 0; i < 4; ++i) {
            const f32x4 a4 = *(const f32x4*)(qs + t * 128 + part * 16 + i * 4), b4 = *(const f32x4*)(ks + s * 128 + part * 16 + i * 4);
            sum += a4[0] * b4[0] + a4[1] * b4[1] + a4[2] * b4[2] + a4[3] * b4[3];
        }
        sum += __shfl_xor(sum, 1); sum += __shfl_xor(sum, 2); sum += __shfl_xor(sum, 4);
        if (part == 0) QK[pair] = sum;
        float qd = qs[wid * 128 + 2 * lane] * n0v[2 * lane] + qs[wid * 128 + 2 * lane + 1] * n0v[2 * lane + 1];
        qd = wave_sum(qd);
        if (lane == 0) qnv[wid] = qd;
    }
#pragma unroll
    for (int t = 0; t < 8; ++t) {
        f32x4 acc = {0.f, 0.f, 0.f, 0.f};
#pragma unroll
        for (int i4 = 0; i4 < 4; ++i4) {
            const f32x4 q4 = *(const f32x4*)(qs + t * 128 + dg * 16 + i4 * 4);
            acc += q4[0] * c0[i4 * 4] + q4[1] * c0[i4 * 4 + 1] + q4[2] * c0[i4 * 4 + 2] + q4[3] * c0[i4 * 4 + 3];
        }
        *(f32x4*)(red + (dg * 8 + t) * 256 + v4 * 4) = acc;
    }
    __syncthreads();
    f32x4 vv[8];
    float scs[8];
#pragma unroll
    for (int s = 0; s < 8; ++s) { vv[s] = *(const f32x4*)(vs + s * 256 + v4 * 4); scs[s] = __expf(gg[s] - Ml); }
#pragma unroll
    for (int i = 0; i < 16; ++i) {
        const int d = dg * 16 + i;
        f32x4 cn = c0[i] * dec;
#pragma unroll
        for (int s = 0; s < 8; ++s) cn += (scs[s] * ks[s * 128 + d]) * vv[s];
        __builtin_nontemporal_store(cn, (f32x4*)(p.out + O_S_MLC + coff + (size_t)i * 256));
    }
    if (tid < 128) {
        float nn = dec * n0v[tid];
#pragma unroll
        for (int s = 0; s < 8; ++s) nn += scs[s] * ks[s * 128 + tid];
        p.out[O_S_MLN + (size_t)(b * 8 + h) * 128 + tid] = nn;
    }
    if (tid == 0) p.out[O_S_MLM + b * 8 + h] = m_new;
    {
        const int t = wid;
        float Mt = 0.f, Ft = 0.f;
#pragma unroll
        for (int q = 0; q < 8; ++q) { Mt = (t == q) ? M[q] : Mt; Ft = (t == q) ? F[q] : Ft; }
        f32x4 numc = {0.f, 0.f, 0.f, 0.f};
#pragma unroll
        for (int q = 0; q < 8; ++q) numc += *(const f32x4*)(red + (q * 8 + t) * 256 + lane * 4);
        const float et = __expf(mp - Mt);
        float den = et * qnv[t];
        f32x4 intra = {0.f, 0.f, 0.f, 0.f};
#pragma unroll
        for (int s = 0; s < 8; ++s) {
            if (s <= t) { const float w = __expf(gg[s] - Mt) * QK[t * 8 + s]; den += w; intra += w * vv[s]; }
        }
        const float dd = fmaxf(fabsf(den), __expf(-(Ft + Mt)));
        const f32x4 hv = (et * numc + intra) * (1.f / dd);
        float ss = hv[0] * hv[0] + hv[1] * hv[1] + hv[2] * hv[2] + hv[3] * hv[3];
        ss = wave_sum(ss);
        const u32x2 og = *(const u32x2*)(U + (size_t)(rowb + t) * N1P + UC_O + h * 256 + lane * 4);
        *(u32x2*)(MIX + (size_t)(rowb + t) * MIXW + 2048 + h * 256 + lane * 4) =
            (u32x2){pack2(hv[0] * sigm_f(bf_lo(og[0])), hv[1] * sigm_f(bf_hi(og[0]))), pack2(hv[2] * sigm_f(bf_lo(og[1])), hv[3] * sigm_f(bf_hi(og[1])))};
        if (lane < 4) ((float*)(p.ws + WS_SSQM))[(size_t)(rowb + t) * 32 + h * 4 + lane] = lane == 0 ? ss : 0.f;
        if (lane == 0) ((float*)(p.ws + WS_DD))[(size_t)(rowb + t) * 8 + h] = 1.f;
    }
    __syncthreads();
}

__device__ __forceinline__ void phase_scan(const Params& p, unsigned char* smem) {
#ifndef SC_MASK
#define SC_MASK 15
#endif
    for (int j = opaque_bid(); j < 256; j += gridDim.x) { if (j < 128) { if (SC_MASK & 1) prompt_scan<false>(p, smem, j); } else { if (SC_MASK & 2) prompt_scan<true>(p, smem, j - 128); } }
    if (SC_MASK & 4) for (int j = opaque_bid(); j < 256; j += gridDim.x) sample_ssd(p, smem, j);
    if (SC_MASK & 8) for (int j = opaque_bid(); j < 1024; j += gridDim.x) sample_ml(p, smem, j);
}

__device__ __forceinline__ void phase_mixnorm(const Params& p) {
    const int tid = opaque_tid(), wid = tid >> 6, lane = tid & 63;
    bf16_t* MIX = (bf16_t*)(p.ws + WS_MIX);
    const float* SSQ = (const float*)(p.ws + WS_SSQ); const float* SSQM = (const float*)(p.ws + WS_SSQM);
    const float* w1 = p.in[16]; const float* w2 = p.in[19];
    for (int row = opaque_bid() * 8 + wid; row < NVALID; row += gridDim.x * 8) {
        float s = lane < 32 ? SSQ[(size_t)row * 32 + lane] : 0.f;
        s = wave_sum(s);
        const float r1 = rsqrtf(s * (1.f / 2048.f) + EPS);
        float m = lane < 32 ? SSQM[(size_t)row * 32 + lane] : 0.f;
        m += __shfl_xor(m, 1); m += __shfl_xor(m, 2);
        const float ddh = lane < 32 ? ((const float*)(p.ws + WS_DD))[(size_t)row * 8 + (lane >> 2)] : 1.f;
        const float idd = 1.f / ddh;
        const float rh = rsqrtf(m * (1.f / 256.f) * idd * idd + EPS) * idd;
        u32x4 raws[8];
#pragma unroll
        for (int it = 0; it < 8; ++it) raws[it] = *(const u32x4*)(MIX + (size_t)row * MIXW + it * 512 + lane * 8);
#pragma unroll
        for (int it = 0; it < 8; ++it) {
            const int col = it * 512 + lane * 8;
            const u32x4 raw = raws[it];
            float scale; const float* wp;
            if (it < 4) { scale = r1; wp = w1 + col; }
            else { const int head = (it - 4) * 2 + (lane >> 5); scale = __shfl(rh, head * 4); wp = w2 + col - 2048; }
            const f32x4 wa = *(const f32x4*)wp, wb = *(const f32x4*)(wp + 4);
            u32x4 o;
            o[0] = pack2(bf_lo(raw[0]) * scale * wa[0], bf_hi(raw[0]) * scale * wa[1]); o[1] = pack2(bf_lo(raw[1]) * scale * wa[2], bf_hi(raw[1]) * scale * wa[3]);
            o[2] = pack2(bf_lo(raw[2]) * scale * wb[0], bf_hi(raw[2]) * scale * wb[1]); o[3] = pack2(bf_lo(raw[3]) * scale * wb[2], bf_hi(raw[3]) * scale * wb[3]);
            *(u32x4*)(MIX + (size_t)row * MIXW + col) = o;
        }
    }
    const bf16_t* U = (const bf16_t*)(p.ws + WS_U);
    for (int i = opaque_bid() * 512 + tid; i < 132 * 3 * 320; i += gridDim.x * 512) {
        const int cgp = i % 320, j = (i / 320) % 3, q = i / 960;
        int row; float* dst;
        if (q < 4) { row = q * 2048 + 2045 + j; dst = p.out + O_P_SSDCONV + (size_t)(q * 3 + j) * 2560 + cgp * 8; }
        else { row = ROW_SAMPLE + (q - 4) * 8 + 5 + j; dst = p.out + O_S_SSDCONV + (size_t)((q - 4) * 3 + j) * 2560 + cgp * 8; }
        const u32x4 raw = *(const u32x4*)(U + (size_t)row * N1P + UC_XBC + cgp * 8);
        *(f32x4*)dst = (f32x4){bf_lo(raw[0]), bf_hi(raw[0]), bf_lo(raw[1]), bf_hi(raw[1])};
        *(f32x4*)(dst + 4) = (f32x4){bf_lo(raw[2]), bf_hi(raw[2]), bf_lo(raw[3]), bf_hi(raw[3])};
    }
}

__device__ __forceinline__ void unpack8(const u32x4 raw, float (&x)[8]) {
#pragma unroll
    for (int i = 0; i < 4; ++i) { x[2 * i] = bf_lo(raw[i]); x[2 * i + 1] = bf_hi(raw[i]); }
}
__device__ __forceinline__ void phase_act(const Params& p) {
    const bf16_t* UP = (const bf16_t*)(p.ws + WS_UP); bf16_t* ACT = (bf16_t*)(p.ws + WS_ACT);
    const float* cw = p.in[23]; const float* cb = p.in[24]; const float* fst = p.in[7];
    constexpr int CGN = DFF / 8, TOTAL = (NVALID / 8) * CGN;
    const int tid = opaque_tid();
    for (int idx = opaque_bid() * 512 + tid; idx < TOTAL; idx += gridDim.x * 512) {
        const int rb = idx / CGN, cgp = idx % CGN, row0 = rb * 8, c0 = cgp * 8;
        float g2[8], g1[8], v2[8], v1[8];
        int prow = -1; bool from_state = false; int sb = 0, pb = -1;
        if (row0 < ROW_SAMPLE) { const int b = row0 >> 11, t0 = row0 & 2047; prow = t0 > 0 ? row0 - 2 : ROW_META + b * 16 + 14; if (t0 == 2040) pb = b; }
        else if (row0 < ROW_META) { from_state = true; sb = (row0 - ROW_SAMPLE) >> 3; }
        else { if ((row0 - ROW_META) & 15) prow = row0 - 2; }
        if (from_state) {
            const float* s0 = fst + (size_t)(sb * 2) * N3;
#pragma unroll
            for (int i = 0; i < 8; ++i) { g2[i] = s0[c0 + i]; g1[i] = s0[N3 + c0 + i]; v2[i] = s0[DFF + c0 + i]; v1[i] = s0[N3 + DFF + c0 + i]; }
        } else if (prow >= 0) {
            unpack8(*(const u32x4*)(UP + (size_t)prow * N3 + c0), g2); unpack8(*(const u32x4*)(UP + (size_t)(prow + 1) * N3 + c0), g1);
            unpack8(*(const u32x4*)(UP + (size_t)prow * N3 + DFF + c0), v2); unpack8(*(const u32x4*)(UP + (size_t)(prow + 1) * N3 + DFF + c0), v1);
        } else {
#pragma unroll
            for (int i = 0; i < 8; ++i) { g2[i] = 0.f; g1[i] = 0.f; v2[i] = 0.f; v1[i] = 0.f; }
        }
        float wg[3][8], wv[3][8], bg[8], bv[8];
#pragma unroll
        for (int j = 0; j < 3; ++j)
#pragma unroll
            for (int i = 0; i < 8; ++i) { wg[j][i] = cw[j * N3 + c0 + i]; wv[j][i] = cw[j * N3 + DFF + c0 + i]; }
#pragma unroll
        for (int i = 0; i < 8; ++i) { bg[i] = cb[c0 + i]; bv[i] = cb[DFF + c0 + i]; }
        u32x4 rg[8], rv[8];
#pragma unroll
        for (int r = 0; r < 8; ++r) { rg[r] = *(const u32x4*)(UP + (size_t)(row0 + r) * N3 + c0); rv[r] = *(const u32x4*)(UP + (size_t)(row0 + r) * N3 + DFF + c0); }
#pragma unroll
        for (int r = 0; r < 8; ++r) {
            float gx[8], vx[8];
            unpack8(rg[r], gx); unpack8(rv[r], vx);
            float o[8];
#pragma unroll
            for (int i = 0; i < 8; ++i) {
                const float yg = bg[i] + wg[0][i] * g2[i] + wg[1][i] * g1[i] + wg[2][i] * gx[i];
                const float yv = bv[i] + wv[0][i] * v2[i] + wv[1][i] * v1[i] + wv[2][i] * vx[i];
                o[i] = silu_f(yg) * yv;
                g2[i] = g1[i]; g1[i] = gx[i]; v2[i] = v1[i]; v1[i] = vx[i];
            }
            u32x4 ov; ov[0] = pack2(o[0], o[1]); ov[1] = pack2(o[2], o[3]); ov[2] = pack2(o[4], o[5]); ov[3] = pack2(o[6], o[7]);
            *(u32x4*)(ACT + (size_t)(row0 + r) * DFF + c0) = ov;
        }
        if (from_state || pb >= 0) {
            float* dst = from_state ? p.out + O_S_FFN + (size_t)(sb * 2) * N3 : p.out + O_P_FFN + (size_t)(pb * 2) * N3;
            *(f32x4*)(dst + c0) = (f32x4){g2[0], g2[1], g2[2], g2[3]}; *(f32x4*)(dst + c0 + 4) = (f32x4){g2[4], g2[5], g2[6], g2[7]};
            *(f32x4*)(dst + N3 + c0) = (f32x4){g1[0], g1[1], g1[2], g1[3]}; *(f32x4*)(dst + N3 + c0 + 4) = (f32x4){g1[4], g1[5], g1[6], g1[7]};
            *(f32x4*)(dst + DFF + c0) = (f32x4){v2[0], v2[1], v2[2], v2[3]}; *(f32x4*)(dst + DFF + c0 + 4) = (f32x4){v2[4], v2[5], v2[6], v2[7]};
            *(f32x4*)(dst + N3 + DFF + c0) = (f32x4){v1[0], v1[1], v1[2], v1[3]}; *(f32x4*)(dst + N3 + DFF + c0 + 4) = (f32x4){v1[4], v1[5], v1[6], v1[7]};
        }
    }
}

__device__ __forceinline__ void phase_final(const Params& p) {
    const int tid = opaque_tid(), wid = tid >> 6, lane = tid & 63;
    const float* SS3 = (const float*)(p.ws + WS_SS3); const float* nw = p.in[26];
    for (int row = opaque_bid() * 8 + wid; row < NOUTROWS; row += gridDim.x * 8) {
        const float r = rsqrtf(SS3[row] * (1.f / 2048.f) + EPS);
        float* rp = p.out + (size_t)row * DM;
        f32x4 v[8];
#pragma unroll
        for (int it = 0; it < 8; ++it) v[it] = *(const f32x4*)(rp + it * 256 + lane * 4);
#pragma unroll
        for (int it = 0; it < 8; ++it) {
            const int col = it * 256 + lane * 4;
            const f32x4 w = *(const f32x4*)(nw + col);
            *(f32x4*)(rp + col) = v[it] * r * w;
        }
    }
}

__global__ void __launch_bounds__(512, 2) hymba_fwd(Params p0) {
    extern __shared__ __attribute__((aligned(16))) unsigned char smem[];
    cg::grid_group grid = cg::this_grid();
#ifndef DUP_PHASE
#define DUP_PHASE -1
#endif
    for (int phx = p0.ph_lo; phx < p0.ph_hi + (DUP_PHASE >= 0 ? 1 : 0); ++phx) {
        const int ph = (DUP_PHASE >= 0 && phx > DUP_PHASE) ? phx - 1 : phx;
        Params p = p0;
        { size_t z = 0; asm volatile("" : "+s"(z)); p.ws = p0.ws + z; p.out = p0.out + z; }
        switch (ph) {
        case 0: if (PH_MASK & 1) phase_prep(p, smem); break;
        case 1: if (PH_MASK & 2) { pg8::Gemm g{(const bf16_t*)(p.ws + WS_XN), (const bf16_t*)(p.ws + WS_WIN), MP, N1P, 2048}; pg8::StaticOrder S; S.init(MP, N1P, gridDim.x, opaque_bid());
                  Epi1 E{(bf16_t*)(p.ws + WS_U), (float*)(p.ws + WS_SF)}; pg8::gemm_phase((LAS unsigned char*)smem, g, S, E); } break;
        case 2: if (PH_MASK & 4) phase_scan(p, smem); break;
        case 3: if (PH_MASK & 8) phase_mixnorm(p); break;
        case 4: if (PH_MASK & 16) { pg8::Gemm g{(const bf16_t*)(p.ws + WS_MIX), (const bf16_t*)(p.ws + WS_WOUT), MP, 2048, 4096}; pg8::StaticOrder S; S.init(MP, 2048, gridDim.x, opaque_bid());
                  Epi2 E{p}; pg8::gemm_phase((LAS unsigned char*)smem, g, S, E); } break;
        case 5: if (PH_MASK & 32) { pg8::Gemm g{(const bf16_t*)(p.ws + WS_A2), (const bf16_t*)(p.ws + WS_WUP), MP, N3, 2048}; pg8::StaticOrder S; S.init(MP, N3, gridDim.x, opaque_bid());
                  Epi3 E{(bf16_t*)(p.ws + WS_UP), (const float*)(p.ws + WS_SS2)}; pg8::gemm_phase((LAS unsigned char*)smem, g, S, E); } break;
        case 6: if (PH_MASK & 64) phase_act(p); break;
        case 7: if (PH_MASK & 128) { pg8::Gemm g{(const bf16_t*)(p.ws + WS_ACT), (const bf16_t*)(p.ws + WS_WDOWN), MP, 2048, DFF}; pg8::StaticOrder S; S.init(MP, 2048, gridDim.x, opaque_bid());
                  Epi4 E{(const float*)(p.ws + WS_H1), p.out, (float*)(p.ws + WS_SS3)}; pg8::gemm_phase((LAS unsigned char*)smem, g, S, E); } break;
        default: if (PH_MASK & 256) phase_final(p); break;
        }
        if (phx + 1 < p0.ph_hi + (DUP_PHASE >= 0 ? 1 : 0)) grid.sync();
    }
}

extern "C" void kernel_launch(void* const* d_in, const int* in_sizes, int n_in, void* d_out, int out_size, void* d_ws, size_t ws_size, hipStream_t stream) {
    static int grid_blocks = 0;
    if (grid_blocks == 0) {
        if (n_in != 27 || (size_t)out_size != O_END || ws_size < WS_END) {
            fprintf(stderr, "kernel_launch: unexpected shapes: n_in %d out %d ws %zu (need %zu)\n", n_in, out_size, ws_size, (size_t)WS_END); grid_blocks = -1; return; }
        int dev = 0, cus = 0, per_cu = 0;
        (void)hipGetDevice(&dev);
        (void)hipDeviceGetAttribute(&cus, hipDeviceAttributeMultiprocessorCount, dev);
        (void)hipFuncSetAttribute((const void*)hymba_fwd, hipFuncAttributeMaxDynamicSharedMemorySize, LDS_BYTES);
        (void)hipOccupancyMaxActiveBlocksPerMultiprocessor(&per_cu, (const void*)hymba_fwd, 512, LDS_BYTES);
        if (per_cu < 1) { fprintf(stderr, "kernel_launch: occupancy query says %d blocks per CU\n", per_cu); per_cu = 1; }
        grid_blocks = cus;
    }
    if (grid_blocks < 0) return;
    Params p{};
    for (int i = 0; i < 27; ++i) p.in[i] = (const float*)d_in[i];
    p.out = (float*)d_out; p.ws = (unsigned char*)d_ws; p.ph_lo = 0; p.ph_hi = NPHASE;
    void* args[] = {&p};
    hipError_t e = hipLaunchCooperativeKernel((const void*)hymba_fwd, dim3(grid_blocks), dim3(512), args, LDS_BYTES, stream);
    if (e != hipSuccess) fprintf(stderr, "cooperative launch failed: %s (grid %d)\n", hipGetErrorString(e), grid_blocks);
}
```

```cpp
#include <hip/hip_runtime.h>
#include <hip/hip_cooperative_groups.h>
#include <cstdio>
namespace cg = cooperative_groups;

#define LAS __attribute__((address_space(3)))
typedef unsigned short bf16_t;
typedef short bf16x8 __attribute__((ext_vector_type(8)));
typedef float f32x4 __attribute__((ext_vector_type(4)));
typedef unsigned u32x4 __attribute__((ext_vector_type(4)));
typedef unsigned u32x2 __attribute__((ext_vector_type(2)));

constexpr int DM = 2048, MP = 9472, NVALID = 9280, NOUTROWS = 9216;
constexpr int N1P = 11008, N3 = 11264, DFF = 5632, MIXW = 4096;
constexpr int ROW_SAMPLE = 8192, ROW_META = 9216;
constexpr float EPS = 1e-6f;
constexpr int UC_Z = 0, UC_XBC = 2048, UC_Q = 4640, UC_K = 5664, UC_V = 6688, UC_O = 8752;
constexpr size_t WS_WIN = 0;
constexpr size_t WS_WOUT = WS_WIN + (size_t)N1P * 2048 * 2;
constexpr size_t WS_WUP = WS_WOUT + (size_t)2048 * 4096 * 2;
constexpr size_t WS_WDOWN = WS_WUP + (size_t)N3 * 2048 * 2;
constexpr size_t WS_XN = WS_WDOWN + (size_t)2048 * DFF * 2;
constexpr size_t WS_MIX = WS_XN + (size_t)MP * 2048 * 2;
constexpr size_t WS_ACT = WS_XN;
constexpr size_t WS_U = WS_MIX + (size_t)MP * MIXW * 2;
constexpr size_t WS_UP = WS_U;
constexpr size_t WS_H1 = WS_U + (size_t)MP * N3 * 2;
constexpr size_t WS_A2 = WS_H1 + (size_t)MP * 2048 * 4;
constexpr size_t WS_SF = WS_A2 + (size_t)MP * 2048 * 2;
constexpr size_t WS_SSQ = WS_SF + (size_t)MP * 64 * 4;
constexpr size_t WS_SSQM = WS_SSQ + (size_t)MP * 32 * 4;
constexpr size_t WS_SS2 = WS_SSQM + (size_t)MP * 32 * 4;
constexpr size_t WS_SS3 = WS_SS2 + (size_t)MP * 4;
constexpr size_t WS_DD = WS_SS3 + (size_t)MP * 4;
constexpr size_t WS_END = WS_DD + (size_t)MP * 8 * 4;
constexpr size_t O_Y = 0;
constexpr size_t O_P_SSDCONV = 18874368, O_P_SSD = 18905088, O_P_MLC = 19953664, O_P_MLN = 21002240, O_P_MLM = 21006336, O_P_FFN = 21006368;
constexpr size_t O_S_SSDCONV = 21096480, O_S_SSD = 22079520, O_S_MLC = 55633952, O_S_MLN = 89188384, O_S_MLM = 89319456, O_S_FFN = 89320480;
constexpr size_t O_END = 92204064;
constexpr int LDS_BYTES = 147456;
constexpr int NPHASE = 9;
#ifndef CHL_SSD
#define CHL_SSD 128
#endif
#ifndef CHL_ML
#define CHL_ML 128
#endif
#ifndef PH_MASK
#define PH_MASK 0x1ff
#endif

struct Params {
    const float* in[27];
    float* out;
    unsigned char* ws;
    int ph_lo, ph_hi;
};

__device__ __forceinline__ unsigned pack2(float lo, float hi) { unsigned r; asm("v_cvt_pk_bf16_f32 %0, %1, %2" : "=v"(r) : "v"(lo), "v"(hi)); return r; }
__device__ __forceinline__ float bf_lo(unsigned u) { return __uint_as_float(u << 16); }
__device__ __forceinline__ float bf_hi(unsigned u) { return __uint_as_float(u & 0xffff0000u); }
__device__ __forceinline__ float bf2f(bf16_t h) { return __uint_as_float((unsigned)h << 16); }
__device__ __forceinline__ float sigm_f(float x) { const float d = 1.f + __expf(fminf(-x, 80.f)); float r = __builtin_amdgcn_rcpf(d); return r * (2.f - d * r); }
__device__ __forceinline__ float silu_f(float x) { return x * sigm_f(x); }
__device__ __forceinline__ float softplus_f(float x) { return x > 20.f ? x : log1pf(__expf(x)); }
__device__ __forceinline__ float logsig_f(float x) { return fminf(x, 0.f) - log1pf(__expf(-fabsf(x))); }
__device__ __forceinline__ int opaque_tid() { int t = threadIdx.x; asm volatile("" : "+v"(t)); return t; }
__device__ __forceinline__ int opaque_bid() { int t = blockIdx.x; asm volatile("" : "+s"(t)); return t; }
__device__ __forceinline__ int row_of(int b, int pos) { return pos < 16 ? ROW_META + b * 16 + pos : b * 2048 + pos - 16; }
__device__ __forceinline__ float wave_sum(float v) {
    v += __shfl_xor(v, 32); v += __shfl_xor(v, 16); v += __shfl_xor(v, 8); v += __shfl_xor(v, 4); v += __shfl_xor(v, 2); v += __shfl_xor(v, 1); return v;
}
__device__ __forceinline__ const float* resid_row(const Params& p, int row) {
    if (row < ROW_SAMPLE) return p.in[0] + (size_t)row * DM;
    if (row < ROW_META) return p.in[1] + (size_t)(row - ROW_SAMPLE) * DM;
    if (row < NVALID) return p.in[8] + (size_t)((row - ROW_META) & 15) * DM;
    return nullptr;
}

namespace pg8 {
constexpr int BM = 256, BK = 64, HALF = 128, HTB = HALF * BK * 2, STAGE_BYTES = 8 * HTB, NXCD = 8, WGM = 8;
__device__ __forceinline__ int lds_byte(int r, int c) { const int st = (r >> 4) * 2 + (c >> 5), rr = r & 15, cc = c & 31, ob = rr * 64 + cc * 2; return st * 1024 + (ob ^ (((ob >> 9) & 1) << 5)); }
__device__ __forceinline__ void stage_rc(int b, int& R, int& C) { const int st = b / 1024, sb = b % 1024, swz = sb ^ (((sb >> 9) & 1) << 5); R = (st >> 1) * 16 + swz / 64; C = (st & 1) * 32 + (swz % 64) / 2; }
__device__ __forceinline__ int perm32(int rho) { const int n = rho >> 4, i = rho & 15; return 8 * (i >> 2) + 4 * n + (i & 3); }
struct Unit { int pm, pn; };
struct Gemm { const bf16_t* A; const bf16_t* Bt; int M, N, K; };
struct StaticOrder {
    int nM, nN, nwg, G, c;
    __device__ void init(int M, int N, int G_, int c_) { nM = M / BM; nN = N / BM; nwg = nM * nN; G = G_; c = c_; }
    __device__ bool next(int i, Unit& u) const {
        const long L = (long)i * G + c; if (L >= nwg) return false;
        int wgid = (int)L; { const int q = nwg / NXCD, r = nwg % NXCD, xcd = wgid % NXCD, off = wgid / NXCD; wgid = (xcd < r ? xcd * (q + 1) : r * (q + 1) + (xcd - r) * q) + off; }
        const int nig = WGM * nN, gid = wgid / nig, fm = gid * WGM, gsz = (nM - fm) < WGM ? (nM - fm) : WGM;
        u.pm = fm + ((wgid % nig) % gsz); u.pn = (wgid % nig) / gsz; return true;
    }
};

template <class Epi>
__device__ __forceinline__ void gemm_phase(LAS unsigned char* lds, const Gemm g, const StaticOrder& S, const Epi& E) {
    const int tid = opaque_tid(), wid = __builtin_amdgcn_readfirstlane(tid >> 6), lane = tid & 63, wr = wid >> 2, wc = wid & 3, fr = lane & 15, fq = lane >> 4;
    const int K = g.K, nt = K / BK;
    unsigned voffA[2], voffB[2];
#pragma unroll
    for (int i = 0; i < 2; ++i) { int R, C; stage_rc(tid * 16 + i * 8192, R, C); const int Rb = ((R & ~31) + perm32(R & 31));
        voffA[i] = (unsigned)(R * K + C) * 2u; voffB[i] = (unsigned)(Rb * K + C) * 2u; }
    const size_t kstep = (size_t)(BK * 2);
    const size_t hstep = (size_t)HALF * K * 2;
    const size_t tstep = 2 * hstep;
    const unsigned ldsw = (unsigned)wid * 1024u;
    const int aoff = lds_byte(wr * 64 + fr, fq * 8), boff = lds_byte(wc * 32 + fr, fq * 8);
#define PG8_SA(b, h) (((b) * 2 + (h)) * HTB)
#define PG8_SB(b, h) ((4 + (b) * 2 + (h)) * HTB)
#define PG8_STAGE(bufoff, gbase, voff) do { _Pragma("unroll") for (int _i = 0; _i < 2; ++_i) \
        __builtin_amdgcn_global_load_lds((const unsigned*)((const char*)(gbase) + (voff)[_i]), (LAS unsigned*)(lds + (bufoff) + ldsw + _i * 8192), 16, 0, 0); } while (0)
#define PG8_LDA(dst, b, h) do { _Pragma("unroll") for (int m = 0; m < 4; ++m) _Pragma("unroll") for (int k = 0; k < 2; ++k) dst[m][k] = *(const LAS bf16x8*)(lds + PG8_SA(b, h) + aoff + m * 2048 + k * 1024); } while (0)
#define PG8_LDB(dst, b, h) do { _Pragma("unroll") for (int n = 0; n < 2; ++n) _Pragma("unroll") for (int k = 0; k < 2; ++k) dst[n][k] = *(const LAS bf16x8*)(lds + PG8_SB(b, h) + boff + n * 2048 + k * 1024); } while (0)
#define PG8_MMA(ai, bj, At, Bt) do { __builtin_amdgcn_s_setprio(1); _Pragma("unroll") for (int m = 0; m < 4; ++m) _Pragma("unroll") for (int n = 0; n < 2; ++n) _Pragma("unroll") for (int k = 0; k < 2; ++k) \
        acc[ai][bj][m][n] = __builtin_amdgcn_mfma_f32_16x16x32_bf16(Bt[n][k], At[m][k], acc[ai][bj][m][n], 0, 0, 0); __builtin_amdgcn_s_setprio(0); } while (0)
#define PG8_WAIT_V(n) asm volatile("s_waitcnt vmcnt(" #n ")" ::: "memory")
#define PG8_WAIT_L(n) asm volatile("s_waitcnt lgkmcnt(" #n ")" ::: "memory")
#define PG8_BAR __builtin_amdgcn_s_barrier()
#define PG8_SCHED __builtin_amdgcn_sched_barrier(0)
    Unit cur, nxt; int ui = 0;
    if (!S.next(0, cur)) return;
    f32x4 acc[2][2][4][2];
#pragma unroll
    for (int a = 0; a < 2; ++a)
#pragma unroll
        for (int b = 0; b < 2; ++b)
#pragma unroll
            for (int m = 0; m < 4; ++m)
#pragma unroll
                for (int n = 0; n < 2; ++n) acc[a][b][m][n] = (f32x4){0.f, 0.f, 0.f, 0.f};
    bf16x8 At[4][2], B0[2][2], B1[2][2];
    const char* cA = (const char*)g.A + (size_t)cur.pm * tstep; const char* cB = (const char*)g.Bt + (size_t)cur.pn * tstep;
    PG8_STAGE(PG8_SB(0, 0), cB, voffB); PG8_STAGE(PG8_SA(0, 0), cA, voffA); PG8_STAGE(PG8_SB(0, 1), cB + hstep, voffB); PG8_STAGE(PG8_SA(0, 1), cA + hstep, voffA);
    if (wr == 1) PG8_BAR;
    PG8_WAIT_V(4); PG8_BAR;
    PG8_STAGE(PG8_SB(1, 0), cB + kstep, voffB); PG8_STAGE(PG8_SA(1, 0), cA + kstep, voffA); PG8_STAGE(PG8_SB(1, 1), cB + hstep + kstep, voffB);
    PG8_WAIT_V(6); PG8_BAR;
    for (;;) {
        const bool has_next = S.next(ui + 1, nxt);
        const char* nA = has_next ? (const char*)g.A + (size_t)nxt.pm * tstep : cA; const char* nB = has_next ? (const char*)g.Bt + (size_t)nxt.pn * tstep : cB;
        for (int t = 0; t < nt; t += 2) {
            const bool last = (t == nt - 2);
            const char* a1 = cA + (size_t)(t + 1) * kstep;
            const char* a2 = last ? nA : cA + (size_t)(t + 2) * kstep; const char* b2 = last ? nB : cB + (size_t)(t + 2) * kstep;
            const char* a3 = a2 + kstep; const char* b3 = b2 + kstep;
            PG8_LDB(B0, 0, 0); PG8_SCHED; PG8_LDA(At, 0, 0); PG8_STAGE(PG8_SA(1, 1), a1 + hstep, voffA);
            PG8_WAIT_L(8); PG8_BAR; PG8_WAIT_L(0); PG8_MMA(0, 0, At, B0); PG8_BAR; PG8_SCHED;
            PG8_LDB(B1, 0, 1); PG8_STAGE(PG8_SB(0, 0), b2, voffB);
            PG8_BAR; PG8_WAIT_L(0); PG8_MMA(0, 1, At, B1); PG8_BAR;
            PG8_LDA(At, 0, 1); PG8_STAGE(PG8_SA(0, 0), a2, voffA);
            PG8_BAR; PG8_WAIT_L(0); PG8_MMA(1, 0, At, B0); PG8_BAR; PG8_SCHED;
            PG8_STAGE(PG8_SB(0, 1), b2 + hstep, voffB);
            PG8_WAIT_V(6); PG8_BAR; PG8_MMA(1, 1, At, B1); PG8_BAR;
            PG8_LDB(B0, 1, 0); PG8_SCHED; PG8_LDA(At, 1, 0); PG8_STAGE(PG8_SA(0, 1), a2 + hstep, voffA);
            PG8_WAIT_L(8); PG8_BAR; PG8_WAIT_L(0); PG8_MMA(0, 0, At, B0); PG8_BAR; PG8_SCHED;
            PG8_LDB(B1, 1, 1); PG8_STAGE(PG8_SB(1, 0), b3, voffB);
            PG8_BAR; PG8_WAIT_L(0); PG8_MMA(0, 1, At, B1); PG8_BAR;
            PG8_LDA(At, 1, 1); PG8_STAGE(PG8_SA(1, 0), a3, voffA);
            PG8_BAR; PG8_WAIT_L(0); PG8_MMA(1, 0, At, B0); PG8_BAR; PG8_SCHED;
            PG8_STAGE(PG8_SB(1, 1), b3 + hstep, voffB);
            PG8_WAIT_V(6); PG8_BAR; PG8_MMA(1, 1, At, B1); PG8_BAR;
        }
        { Unit eu = cur; asm volatile("" : "+s"(eu.pm), "+s"(eu.pn)); E(acc, eu, wr, wc, fr, fq); }
        if (!has_next) break;
#pragma unroll
        for (int a = 0; a < 2; ++a)
#pragma unroll
            for (int b = 0; b < 2; ++b)
#pragma unroll
                for (int m = 0; m < 4; ++m)
#pragma unroll
                    for (int n = 0; n < 2; ++n) acc[a][b][m][n] = (f32x4){0.f, 0.f, 0.f, 0.f};
        cur = nxt; cA = nA; cB = nB; ++ui;
    }
    PG8_WAIT_V(0);
    if (wr == 0) PG8_BAR;
    PG8_BAR;
#undef PG8_SA
#undef PG8_SB
#undef PG8_STAGE
#undef PG8_LDA
#undef PG8_LDB
#undef PG8_MMA
#undef PG8_WAIT_V
#undef PG8_WAIT_L
#undef PG8_BAR
#undef PG8_SCHED
}
}

typedef f32x4 AccT[2][2][4][2];
struct Epi1 {
    bf16_t* U; float* sf;
    __device__ __forceinline__ void operator()(const AccT& acc, const pg8::Unit& u, int wr, int wc, int fr, int fq) const {
        const int row0 = u.pm * 256 + wr * 64 + fr, col0 = u.pn * 256 + wc * 32 + 8 * fq;
        const bool side_dt = (u.pn == 18 && wc == 0), side_if = (u.pn == 34 && wc == 1);
#pragma unroll
        for (int ai = 0; ai < 2; ++ai)
#pragma unroll
            for (int m = 0; m < 4; ++m) {
                const int row = row0 + ai * 128 + m * 16;
                bf16_t* rowp = U + (size_t)row * N1P + col0;
#pragma unroll
                for (int bj = 0; bj < 2; ++bj) {
                    const f32x4 v0 = acc[ai][bj][m][0], v1 = acc[ai][bj][m][1];
                    u32x4 o; o[0] = pack2(v0[0], v0[1]); o[1] = pack2(v0[2], v0[3]); o[2] = pack2(v1[0], v1[1]); o[3] = pack2(v1[2], v1[3]);
                    *(u32x4*)(rowp + bj * 128) = o;
                }
                if (side_dt || side_if) {
                    float* sp = sf + (size_t)row * 64 + (side_if ? 32 : 0) + 8 * fq;
                    *(f32x4*)sp = acc[ai][0][m][0]; *(f32x4*)(sp + 4) = acc[ai][0][m][1];
                }
            }
    }
};
struct Epi2 {
    Params p;
    __device__ __forceinline__ void operator()(const AccT& acc, const pg8::Unit& u, int wr, int wc, int fr, int fq) const {
        float* H1 = (float*)(p.ws + WS_H1); bf16_t* A2 = (bf16_t*)(p.ws + WS_A2); float* SS2 = (float*)(p.ws + WS_SS2);
        const float* nw = p.in[21];
        const int row0 = u.pm * 256 + wr * 64 + fr, col0 = u.pn * 256 + wc * 32 + 8 * fq;
        f32x4 w[2][2];
#pragma unroll
        for (int bj = 0; bj < 2; ++bj) { w[bj][0] = *(const f32x4*)(nw + col0 + bj * 128); w[bj][1] = *(const f32x4*)(nw + col0 + bj * 128 + 4); }
#pragma unroll
        for (int ai = 0; ai < 2; ++ai)
#pragma unroll
            for (int m = 0; m < 4; ++m) {
                const int row = row0 + ai * 128 + m * 16;
                const float* rp = resid_row(p, row);
                float ss = 0.f;
#pragma unroll
                for (int bj = 0; bj < 2; ++bj) {
                    f32x4 v0 = acc[ai][bj][m][0], v1 = acc[ai][bj][m][1];
                    if (rp) { v0 += *(const f32x4*)(rp + col0 + bj * 128); v1 += *(const f32x4*)(rp + col0 + bj * 128 + 4); }
                    *(f32x4*)(H1 + (size_t)row * DM + col0 + bj * 128) = v0; *(f32x4*)(H1 + (size_t)row * DM + col0 + bj * 128 + 4) = v1;
                    ss += v0[0] * v0[0] + v0[1] * v0[1] + v0[2] * v0[2] + v0[3] * v0[3] + v1[0] * v1[0] + v1[1] * v1[1] + v1[2] * v1[2] + v1[3] * v1[3];
                    const f32x4 a0 = v0 * w[bj][0], a1 = v1 * w[bj][1];
                    u32x4 o; o[0] = pack2(a0[0], a0[1]); o[1] = pack2(a0[2], a0[3]); o[2] = pack2(a1[0], a1[1]); o[3] = pack2(a1[2], a1[3]);
                    *(u32x4*)(A2 + (size_t)row * DM + col0 + bj * 128) = o;
                }
                ss += __shfl_xor(ss, 16); ss += __shfl_xor(ss, 32);
                if (fq == 0) atomicAdd(SS2 + row, ss);
            }
    }
};
struct Epi3 {
    bf16_t* UP; const float* SS2;
    __device__ __forceinline__ void operator()(const AccT& acc, const pg8::Unit& u, int wr, int wc, int fr, int fq) const {
        const int row0 = u.pm * 256 + wr * 64 + fr, col0 = u.pn * 256 + wc * 32 + 8 * fq;
#pragma unroll
        for (int ai = 0; ai < 2; ++ai)
#pragma unroll
            for (int m = 0; m < 4; ++m) {
                const int row = row0 + ai * 128 + m * 16;
                const float r2 = rsqrtf(SS2[row] * (1.f / 2048.f) + EPS);
                bf16_t* rowp = UP + (size_t)row * N3 + col0;
#pragma unroll
                for (int bj = 0; bj < 2; ++bj) {
                    const f32x4 v0 = acc[ai][bj][m][0] * r2, v1 = acc[ai][bj][m][1] * r2;
                    u32x4 o; o[0] = pack2(v0[0], v0[1]); o[1] = pack2(v0[2], v0[3]); o[2] = pack2(v1[0], v1[1]); o[3] = pack2(v1[2], v1[3]);
                    *(u32x4*)(rowp + bj * 128) = o;
                }
            }
    }
};
struct Epi4 {
    const float* H1; float* out; float* SS3;
    __device__ __forceinline__ void operator()(const AccT& acc, const pg8::Unit& u, int wr, int wc, int fr, int fq) const {
        const int row0 = u.pm * 256 + wr * 64 + fr, col0 = u.pn * 256 + wc * 32 + 8 * fq;
#pragma unroll
        for (int ai = 0; ai < 2; ++ai)
#pragma unroll
            for (int m = 0; m < 4; ++m) {
                const int row = row0 + ai * 128 + m * 16;
                if (row < NOUTROWS) {
                    float ss = 0.f;
#pragma unroll
                    for (int bj = 0; bj < 2; ++bj) {
                        const f32x4 v0 = acc[ai][bj][m][0] + *(const f32x4*)(H1 + (size_t)row * DM + col0 + bj * 128);
                        const f32x4 v1 = acc[ai][bj][m][1] + *(const f32x4*)(H1 + (size_t)row * DM + col0 + bj * 128 + 4);
                        *(f32x4*)(out + (size_t)row * DM + col0 + bj * 128) = v0; *(f32x4*)(out + (size_t)row * DM + col0 + bj * 128 + 4) = v1;
                        ss += v0[0] * v0[0] + v0[1] * v0[1] + v0[2] * v0[2] + v0[3] * v0[3] + v1[0] * v1[0] + v1[1] * v1[1] + v1[2] * v1[2] + v1[3] * v1[3];
                    }
                    ss += __shfl_xor(ss, 16); ss += __shfl_xor(ss, 32);
                    if (fq == 0) atomicAdd(SS3 + row, ss);
                }
            }
    }
};

constexpr int T_IN = 32 * 43, T_OUT = 64 * 8, T_UP = 32 * 44, T_DOWN = 88 * 8, T_ALL = T_IN + T_OUT + T_UP + T_DOWN;
struct TileRef { const float* W; bf16_t* WT; int K, N, kt, nt; };
__device__ __forceinline__ TileRef tile_ref(const Params& p, int t) {
    TileRef r;
    if (t < T_IN) { r.W = p.in[10]; r.WT = (bf16_t*)(p.ws + WS_WIN); r.K = 2048; r.N = 10800; r.kt = t % 32; r.nt = t / 32; }
    else if (t < T_IN + T_OUT) { const int q = t - T_IN; r.W = p.in[20]; r.WT = (bf16_t*)(p.ws + WS_WOUT); r.K = 4096; r.N = 2048; r.kt = q % 64; r.nt = q / 64; }
    else if (t < T_IN + T_OUT + T_UP) { const int q = t - T_IN - T_OUT; r.W = p.in[22]; r.WT = (bf16_t*)(p.ws + WS_WUP); r.K = 2048; r.N = N3; r.kt = q % 32; r.nt = q / 32; }
    else { const int q = t - T_IN - T_OUT - T_UP; r.W = p.in[25]; r.WT = (bf16_t*)(p.ws + WS_WDOWN); r.K = DFF; r.N = 2048; r.kt = q % 88; r.nt = q / 88; }
    return r;
}
__device__ __forceinline__ void tile_load(const TileRef& r, f32x4 (&v)[8], int tid) {
    const int nc = (tid & 63) * 4, n = r.nt * 256 + nc;
#pragma unroll
    for (int i = 0; i < 8; ++i) {
        const int kr = (tid >> 6) + 8 * i;
        v[i] = (f32x4){0.f, 0.f, 0.f, 0.f};
        if (n < r.N) v[i] = *(const f32x4*)(r.W + (size_t)(r.kt * 64 + kr) * r.N + n);
    }
}
__device__ __forceinline__ void tile_lds_write(const f32x4 (&v)[8], int tid, unsigned char* smem) {
    float* tile = (float*)smem;
    const int nc = (tid & 63) * 4;
#pragma unroll
    for (int i = 0; i < 8; ++i) {
        const int kr = (tid >> 6) + 8 * i;
        tile[kr * 257 + nc] = v[i][0]; tile[kr * 257 + nc + 1] = v[i][1]; tile[kr * 257 + nc + 2] = v[i][2]; tile[kr * 257 + nc + 3] = v[i][3];
    }
}
__device__ __forceinline__ void tile_store(const TileRef& r, int tid, unsigned char* smem) {
    const float* tile = (const float*)smem;
    const int kc = (tid & 7) * 8;
#pragma unroll
    for (int q = 0; q < 4; ++q) {
        const int nr = (tid >> 3) + 64 * q;
        u32x4 o;
        o[0] = pack2(tile[(kc + 0) * 257 + nr], tile[(kc + 1) * 257 + nr]); o[1] = pack2(tile[(kc + 2) * 257 + nr], tile[(kc + 3) * 257 + nr]);
        o[2] = pack2(tile[(kc + 4) * 257 + nr], tile[(kc + 5) * 257 + nr]); o[3] = pack2(tile[(kc + 6) * 257 + nr], tile[(kc + 7) * 257 + nr]);
        *(u32x4*)(r.WT + (size_t)(r.nt * 256 + nr) * r.K + r.kt * 64 + kc) = o;
    }
}
__device__ __forceinline__ void convert_tiles(const Params& p, unsigned char* smem, int t_begin, int t_end, int worker, int nworkers) {
    const int tid = opaque_tid();
    int t = t_begin + worker;
    f32x4 v[8];
    TileRef cur{};
    if (t < t_end) { cur = tile_ref(p, t); tile_load(cur, v, tid); }
    while (t < t_end) {
        tile_lds_write(v, tid, smem);
        __syncthreads();
        const int tn = t + nworkers;
        TileRef nxt{};
        if (tn < t_end) { nxt = tile_ref(p, tn); tile_load(nxt, v, tid); }
        tile_store(cur, tid, smem);
        __syncthreads();
        cur = nxt; t = tn;
    }
}
__device__ __forceinline__ void convert_in_tail(const Params& p, unsigned char* smem, int n_units, int t_begin, int t_end) {
    const int G = gridDim.x, rem = n_units % G, bid = opaque_bid();
    if (rem == 0) convert_tiles(p, smem, t_begin, t_end, bid, G);
    else if (bid >= rem) convert_tiles(p, smem, t_begin, t_end, bid - rem, G - rem);
}
__device__ __forceinline__ void phase_prep(const Params& p, unsigned char* smem) {
    const int tid = opaque_tid(), wid = tid >> 6, lane = tid & 63;
    { float* SS2 = (float*)(p.ws + WS_SS2); for (int i = opaque_bid() * 512 + tid; i < 2 * MP; i += gridDim.x * 512) SS2[i] = 0.f; }
    {
        bf16_t* XN = (bf16_t*)(p.ws + WS_XN); const float* nw = p.in[9];
        for (int row = opaque_bid() * 8 + wid; row < MP; row += gridDim.x * 8) {
            const float* src = resid_row(p, row);
            f32x4 v[8];
            float ss = 0.f;
#pragma unroll
            for (int it = 0; it < 4; ++it) {
                const int col = it * 512 + lane * 8;
                if (src) { v[2 * it] = *(const f32x4*)(src + col); v[2 * it + 1] = *(const f32x4*)(src + col + 4); }
                else { v[2 * it] = (f32x4){0.f, 0.f, 0.f, 0.f}; v[2 * it + 1] = (f32x4){0.f, 0.f, 0.f, 0.f}; }
#pragma unroll
                for (int j = 0; j < 4; ++j) ss += v[2 * it][j] * v[2 * it][j] + v[2 * it + 1][j] * v[2 * it + 1][j];
            }
            ss = wave_sum(ss);
            const float r = rsqrtf(ss * (1.f / 2048.f) + EPS);
#pragma unroll
            for (int it = 0; it < 4; ++it) {
                const int col = it * 512 + lane * 8;
                const f32x4 w0 = *(const f32x4*)(nw + col), w1 = *(const f32x4*)(nw + col + 4);
                const f32x4 a = v[2 * it] * r * w0, c = v[2 * it + 1] * r * w1;
                u32x4 o; o[0] = pack2(a[0], a[1]); o[1] = pack2(a[2], a[3]); o[2] = pack2(c[0], c[1]); o[3] = pack2(c[2], c[3]);
                *(u32x4*)(XN + (size_t)row * DM + col) = o;
            }
        }
    }
    convert_tiles(p, smem, 0, T_IN, opaque_bid(), gridDim.x);
}

constexpr int RS = 272;
constexpr int L_QS = 0, L_KS = 34816, L_KT = 69632, L_VT = 104448, L_ST = 121856, L_SC = 139264;

template <bool ML>
__device__ __forceinline__ void load_block(const Params& p, float (&val)[8][4], int b, int p0, int Lv, int rb, int cg, int colbase, int chbase, float mlscale) {
    const bf16_t* U = (const bf16_t*)(p.ws + WS_U);
    const int t0 = rb * 8;
    if (t0 >= Lv) {
#pragma unroll
        for (int r = 0; r < 8; ++r)
#pragma unroll
            for (int i = 0; i < 4; ++i) val[r][i] = 0.f;
        return;
    }
    if (ML) {
#pragma unroll
        for (int r = 0; r < 8; ++r) {
            const int row = row_of(b, p0 + t0 + r);
            const u32x2 raw = *(const u32x2*)(U + (size_t)row * N1P + colbase + cg * 4);
            val[r][0] = bf_lo(raw[0]) * mlscale; val[r][1] = bf_hi(raw[0]) * mlscale; val[r][2] = bf_lo(raw[1]) * mlscale; val[r][3] = bf_hi(raw[1]) * mlscale;
        }
    } else {
        u32x2 raw[11];
#pragma unroll
        for (int rr = 0; rr < 11; ++rr) {
            const int pos = p0 + t0 - 3 + rr;
            if (pos >= 0) raw[rr] = *(const u32x2*)(U + (size_t)row_of(b, pos) * N1P + colbase + cg * 4);
            else raw[rr] = (u32x2){0u, 0u};
        }
        const float* cw = p.in[11]; const float* cb = p.in[12];
        const int ch = chbase + cg * 4;
        f32x4 w[4];
#pragma unroll
        for (int j = 0; j < 4; ++j) w[j] = *(const f32x4*)(cw + j * 2560 + ch);
        const f32x4 bi = *(const f32x4*)(cb + ch);
#pragma unroll
        for (int i = 0; i < 4; ++i) {
            float x[11];
#pragma unroll
            for (int rr = 0; rr < 11; ++rr) x[rr] = (i & 1) ? bf_hi(raw[rr][i >> 1]) : bf_lo(raw[rr][i >> 1]);
#pragma unroll
            for (int r = 0; r < 8; ++r) val[r][i] = silu_f(bi[i] + w[0][i] * x[r] + w[1][i] * x[r + 1] + w[2][i] * x[r + 2] + w[3][i] * x[r + 3]);
        }
    }
}
__device__ __forceinline__ void store_rows(unsigned char* base, const float (&val)[8][4], int rb, int cg) {
#pragma unroll
    for (int r = 0; r < 8; ++r) *(u32x2*)(base + (rb * 8 + r) * RS + cg * 8) = (u32x2){pack2(val[r][0], val[r][1]), pack2(val[r][2], val[r][3])};
}
__device__ __forceinline__ void store_cols(unsigned char* base, const float (&val)[8][4], int rb, int cg, const float* scale) {
    float s[8];
#pragma unroll
    for (int r = 0; r < 8; ++r) s[r] = scale ? scale[rb * 8 + r] : 1.f;
#pragma unroll
    for (int i = 0; i < 4; ++i) {
        const int row = cg * 4 + i;
        u32x4 o; o[0] = pack2(val[0][i] * s[0], val[1][i] * s[1]); o[1] = pack2(val[2][i] * s[2], val[3][i] * s[3]);
        o[2] = pack2(val[4][i] * s[4], val[5][i] * s[5]); o[3] = pack2(val[6][i] * s[6], val[7][i] * s[7]);
        *(u32x4*)(base + row * RS + ((rb ^ ((row >> 3) & 7)) << 4)) = o;
    }
}

template <bool ML>
__device__ __forceinline__ void prompt_scan(const Params& p, unsigned char* smem, int job) {
    const int tid = opaque_tid(), wid = __builtin_amdgcn_readfirstlane(tid >> 6), lane = tid & 63, fr = lane & 15, fq = lane >> 4;
    int b, h, vq = 0;
    if (ML) { b = job >> 5; h = (job >> 2) & 7; vq = job & 3; } else { b = job >> 5; h = job & 31; }
    const int g = h >> 4;
    const bf16_t* U = (const bf16_t*)(p.ws + WS_U);
    const float* SF = (const float*)(p.ws + WS_SF);
    bf16_t* MIX = (bf16_t*)(p.ws + WS_MIX);
    float* scb = (float*)(smem + L_SC);
    float *qn = scb + 1600, *nvec = scb + 1728, *mpp = scb + 1856;
    const int qcol = ML ? UC_Q + h * 128 : UC_XBC + 2304 + g * 128;
    const int kcol = ML ? UC_K + h * 128 : UC_XBC + 2048 + g * 128;
    const int vcol = ML ? UC_V + h * 256 + vq * 64 : UC_XBC + h * 64;
    const int gcol = ML ? UC_O + h * 256 + vq * 64 : UC_Z + h * 64;
    const int mixcol = ML ? 2048 + h * 256 + vq * 64 : h * 64;
    float A_h = 0.f, D_h = 0.f, dtb = 0.f, ib = 0.f, fb = 0.f;
    if (ML) { ib = p.in[17][h]; fb = p.in[18][h]; } else { A_h = -__expf(p.in[14][h]); D_h = p.in[15][h]; dtb = p.in[13][h]; }
    f32x4 st[4];
#pragma unroll
    for (int i = 0; i < 4; ++i) st[i] = (f32x4){0.f, 0.f, 0.f, 0.f};
    for (int i = tid; i < 64 * RS / 16; i += 512) *(u32x4*)(smem + L_ST + i * 16) = (u32x4){0u, 0u, 0u, 0u};
    if (tid < 128) nvec[tid] = 0.f;
    if (tid == 0) mpp[0] = 0.f;
    constexpr int CHLs = ML ? CHL_ML : CHL_SSD;
    float sraw[4] = {0.f, 0.f, 0.f, 0.f};
    auto scal_load = [&](int cc) {
        const int p0 = cc == 0 ? 0 : 16 + (cc - 1) * CHLs, Lv = cc == 0 ? 16 : CHLs;
        const int t0 = 2 * lane, t1 = t0 + 1;
        if (!ML) {
            if (t0 < Lv) sraw[0] = SF[(size_t)row_of(b, p0 + t0) * 64 + h];
            if (t1 < Lv) sraw[1] = SF[(size_t)row_of(b, p0 + t1) * 64 + h];
        } else {
            if (t0 < Lv) { const size_t r = (size_t)row_of(b, p0 + t0) * 64; sraw[0] = SF[r + 32 + h]; sraw[2] = SF[r + 40 + h]; }
            if (t1 < Lv) { const size_t r = (size_t)row_of(b, p0 + t1) * 64; sraw[1] = SF[r + 32 + h]; sraw[3] = SF[r + 40 + h]; }
        }
    };
    auto scalars = [&](int cc) {
        const int Lv = cc == 0 ? 16 : CHLs;
        float* sc = scb + (cc & 1) * 800;
        float *rowv = sc, *colv = sc + 128, *colm = sc + 256, *ev = sc + 384, *scv = sc + 512, *dden = sc + 640, *misc = sc + 768;
        const int t0 = 2 * lane, t1 = t0 + 1;
        if (!ML) {
            float d0 = 0.f, d1 = 0.f;
            if (t0 < Lv) d0 = softplus_f(sraw[0] + dtb);
            if (t1 < Lv) d1 = softplus_f(sraw[1] + dtb);
            const float a0 = d0 * A_h, a1 = d1 * A_h;
            float inc = a0 + a1;
#pragma unroll
            for (int o = 1; o < 64; o <<= 1) { const float y = __shfl_up(inc, o); if (lane >= o) inc += y; }
            const float c1 = inc, c0 = inc - a1, cl = __shfl(inc, 63);
            rowv[t0] = c0; rowv[t1] = c1; colv[t0] = -c0; colv[t1] = -c1; colm[t0] = d0; colm[t1] = d1;
            ev[t0] = __expf(c0); ev[t1] = __expf(c1); scv[t0] = __expf(cl - c0) * d0; scv[t1] = __expf(cl - c1) * d1;
            if (lane == 0) misc[0] = __expf(cl);
        } else {
            float i0 = -INFINITY, i1 = -INFINITY, f0 = 0.f, f1 = 0.f;
            if (t0 < Lv) { i0 = sraw[0] + ib; f0 = logsig_f(sraw[2] + fb); }
            if (t1 < Lv) { i1 = sraw[1] + ib; f1 = logsig_f(sraw[3] + fb); }
            float inc = f0 + f1;
#pragma unroll
            for (int o = 1; o < 64; o <<= 1) { const float y = __shfl_up(inc, o); if (lane >= o) inc += y; }
            const float F1 = inc, F0 = inc - f1;
            const float g0 = i0 - F0, g1 = i1 - F1;
            float mx = fmaxf(g0, g1);
#pragma unroll
            for (int o = 1; o < 64; o <<= 1) { const float y = __shfl_up(mx, o); if (lane >= o) mx = fmaxf(mx, y); }
            float ex = __shfl_up(mx, 1); if (lane == 0) ex = -INFINITY;
            const float mp = mpp[0];
            const float M0 = fmaxf(fmaxf(ex, g0), mp), M1 = fmaxf(mx, mp);
            const float Ml = __shfl(M1, 63), Fl = __shfl(F1, 63);
            rowv[t0] = -M0; rowv[t1] = -M1; colv[t0] = g0; colv[t1] = g1; colm[t0] = 1.f; colm[t1] = 1.f;
            ev[t0] = __expf(mp - M0); ev[t1] = __expf(mp - M1); dden[t0] = __expf(-(F0 + M0)); dden[t1] = __expf(-(F1 + M1));
            scv[t0] = __expf(g0 - Ml); scv[t1] = __expf(g1 - Ml);
            if (lane == 0) { misc[0] = __expf(mp - Ml); mpp[0] = Fl + Ml; }
        }
    };
    __syncthreads();
    if (wid == 0) { scal_load(0); scalars(0); }
    __syncthreads();
    constexpr int CHL = ML ? CHL_ML : CHL_SSD, NCH = 1 + 2048 / CHL;
    const int tid_outer = tid;
    for (int c = 0; c < NCH; ++c) {
        int tid = tid_outer; asm volatile("" : "+v"(tid));
        const int lane = tid & 63, fr = lane & 15, fq = lane >> 4;
        const int p0 = c == 0 ? 0 : 16 + (c - 1) * CHL, Lv = c == 0 ? 16 : CHL;
        float* sc = scb + (c & 1) * 800;
        float *rowv = sc, *colv = sc + 128, *colm = sc + 256, *ev = sc + 384, *scv = sc + 512, *dden = sc + 640, *misc = sc + 768;
        if (wid == 0 && c + 1 < NCH) scal_load(c + 1);
        {
            float val[8][4];
            load_block<ML>(p, val, b, p0, Lv, tid >> 5, tid & 31, qcol, 2304 + g * 128, 1.f);
            store_rows(smem + L_QS, val, tid >> 5, tid & 31);
            __builtin_amdgcn_sched_barrier(0);
            load_block<ML>(p, val, b, p0, Lv, tid >> 5, tid & 31, kcol, 2048 + g * 128, 0.08838834764831845f);
            store_rows(smem + L_KS, val, tid >> 5, tid & 31);
            store_cols(smem + L_KT, val, tid >> 5, tid & 31, scv);
            __builtin_amdgcn_sched_barrier(0);
            if (tid < 256) {
                load_block<ML>(p, val, b, p0, Lv, tid >> 4, tid & 15, vcol, h * 64, 1.f);
                store_cols(smem + L_VT, val, tid >> 4, tid & 15, nullptr);
            }
        }
        __syncthreads();
        const int t = 16 * wid + fr;
        const bool valid = t < Lv;
        const int row = row_of(b, p0 + (valid ? t : 0));
        u32x2 gate[4];
#pragma unroll
        for (int vb = 0; vb < 4; ++vb) gate[vb] = *(const u32x2*)(U + (size_t)row * N1P + gcol + 16 * vb + 4 * fq);
        if (ML) {
            const int tt = tid >> 2, part = tid & 3;
            float s = 0.f;
#pragma unroll
            for (int cc = 0; cc < 4; ++cc) {
                const u32x4 raw = *(const u32x4*)(smem + L_QS + tt * RS + (part * 4 + cc) * 16);
                const f32x4 n0 = *(const f32x4*)(nvec + (part * 4 + cc) * 8), n1 = *(const f32x4*)(nvec + (part * 4 + cc) * 8 + 4);
                s += bf_lo(raw[0]) * n0[0] + bf_hi(raw[0]) * n0[1] + bf_lo(raw[1]) * n0[2] + bf_hi(raw[1]) * n0[3]
                   + bf_lo(raw[2]) * n1[0] + bf_hi(raw[2]) * n1[1] + bf_lo(raw[3]) * n1[2] + bf_hi(raw[3]) * n1[3];
            }
            s += __shfl_xor(s, 1); s += __shfl_xor(s, 2);
            if (part == 0) qn[tt] = s;
        }
        bf16x8 qf[4];
#pragma unroll
        for (int kk = 0; kk < 4; ++kk) qf[kk] = *(const bf16x8*)(smem + L_QS + t * RS + (kk * 32 + fq * 8) * 2);
        const float rv = rowv[t];
        float rowsum = 0.f;
        u32x2 pk[8];
#pragma unroll
        for (int sb = 0; sb < 8; ++sb) {
            pk[sb] = (u32x2){0u, 0u};
            if (sb <= wid) {
                f32x4 acc = {0.f, 0.f, 0.f, 0.f};
#pragma unroll
                for (int kk = 0; kk < 4; ++kk) {
                    const bf16x8 kf = *(const bf16x8*)(smem + L_KS + (16 * sb + fr) * RS + (kk * 32 + fq * 8) * 2);
                    acc = __builtin_amdgcn_mfma_f32_16x16x32_bf16(kf, qf[kk], acc, 0, 0, 0);
                }
                const f32x4 cv = *(const f32x4*)(colv + 16 * sb + 4 * fq), cm = *(const f32x4*)(colm + 16 * sb + 4 * fq);
                float pv[4];
#pragma unroll
                for (int j = 0; j < 4; ++j) {
                    const int s = 16 * sb + 4 * fq + j;
                    const float w = (s <= t) ? __expf(rv + cv[j]) * cm[j] : 0.f;
                    pv[j] = acc[j] * w; rowsum += pv[j];
                }
                pk[sb] = (u32x2){pack2(pv[0], pv[1]), pack2(pv[2], pv[3])};
            }
        }
        if (wid == 0 && c + 1 < NCH) scalars(c + 1);
        __syncthreads();
#pragma unroll
        for (int sb = 0; sb < 8; ++sb) *(u32x2*)(smem + L_KS + t * RS + (16 * sb + 4 * fq) * 2) = pk[sb];
        rowsum += __shfl_xor(rowsum, 16); rowsum += __shfl_xor(rowsum, 32);
        if (ML) {
            const int d = tid >> 2, part = tid & 3;
            float s = 0.f;
#pragma unroll
            for (int cc = 0; cc < 4; ++cc) {
                const u32x4 raw = *(const u32x4*)(smem + L_KT + d * RS + (part * 4 + cc) * 16);
                s += bf_lo(raw[0]) + bf_hi(raw[0]) + bf_lo(raw[1]) + bf_hi(raw[1]) + bf_lo(raw[2]) + bf_hi(raw[2]) + bf_lo(raw[3]) + bf_hi(raw[3]);
            }
            s += __shfl_xor(s, 1); s += __shfl_xor(s, 2);
            if (part == 0) nvec[d] = misc[0] * nvec[d] + s;
        }
        __syncthreads();
        bf16x8 pf[4];
#pragma unroll
        for (int kk = 0; kk < 4; ++kk) pf[kk] = *(const bf16x8*)(smem + L_KS + t * RS + (kk * 32 + fq * 8) * 2);
        const float et = ev[t];
        float ddv = 1.f;
        if (ML) ddv = fmaxf(fabsf(rowsum + et * qn[t]), dden[t]);
        float ss = 0.f;
#pragma unroll
        for (int vb = 0; vb < 4; ++vb) {
            f32x4 acc = {0.f, 0.f, 0.f, 0.f};
            const int vrow = 16 * vb + fr;
#pragma unroll
            for (int kk = 0; kk < 4; ++kk) {
                const bf16x8 sf = *(const bf16x8*)(smem + L_ST + vrow * RS + (kk * 32 + fq * 8) * 2);
                acc = __builtin_amdgcn_mfma_f32_16x16x32_bf16(sf, qf[kk], acc, 0, 0, 0);
            }
            acc *= et;
#pragma unroll
            for (int kk = 0; kk < 4; ++kk) {
                const bf16x8 vf = *(const bf16x8*)(smem + L_VT + vrow * RS + (((kk * 4 + fq) ^ ((vrow >> 3) & 7)) << 4));
                acc = __builtin_amdgcn_mfma_f32_16x16x32_bf16(vf, pf[kk], acc, 0, 0, 0);
            }
            const float gz[4] = {bf_lo(gate[vb][0]), bf_hi(gate[vb][0]), bf_lo(gate[vb][1]), bf_hi(gate[vb][1])};
            float o[4];
#pragma unroll
            for (int j = 0; j < 4; ++j) {
                if (ML) { const float hv = acc[j]; ss += hv * hv; o[j] = hv * sigm_f(gz[j]); }
                else {
                    const int v = 16 * vb + 4 * fq + j;
                    const float xv = bf2f(*(const bf16_t*)(smem + L_VT + v * RS + (((t >> 3) ^ ((v >> 3) & 7)) << 4) + (t & 7) * 2));
                    const float y = (acc[j] + D_h * xv) * silu_f(gz[j]); ss += y * y; o[j] = y;
                }
            }
            if (valid) *(u32x2*)(MIX + (size_t)row * MIXW + mixcol + 16 * vb + 4 * fq) = (u32x2){pack2(o[0], o[1]), pack2(o[2], o[3])};
        }
        ss += __shfl_xor(ss, 16); ss += __shfl_xor(ss, 32);
        if (valid && fq == 0) {
            if (ML) { ((float*)(p.ws + WS_SSQM))[(size_t)row * 32 + h * 4 + vq] = ss; if (vq == 0) ((float*)(p.ws + WS_DD))[(size_t)row * 8 + h] = ddv; }
            else ((float*)(p.ws + WS_SSQ))[(size_t)row * 32 + h] = ss;
        }
        const float dec = misc[0];
#pragma unroll
        for (int vb = 0; vb < 4; ++vb) st[vb] *= dec;
#pragma unroll
        for (int kk = 0; kk < 4; ++kk) {
            const int drow = 16 * wid + fr;
            const bf16x8 kf = *(const bf16x8*)(smem + L_KT + drow * RS + (((kk * 4 + fq) ^ ((drow >> 3) & 7)) << 4));
#pragma unroll
            for (int vb = 0; vb < 4; ++vb) {
                const int vrow = 16 * vb + fr;
                const bf16x8 vf = *(const bf16x8*)(smem + L_VT + vrow * RS + (((kk * 4 + fq) ^ ((vrow >> 3) & 7)) << 4));
                st[vb] = __builtin_amdgcn_mfma_f32_16x16x32_bf16(kf, vf, st[vb], 0, 0, 0);
            }
        }
        __syncthreads();
#pragma unroll
        for (int vb = 0; vb < 4; ++vb)
            *(u32x2*)(smem + L_ST + (16 * vb + fr) * RS + (16 * wid + 4 * fq) * 2) = (u32x2){pack2(st[vb][0], st[vb][1]), pack2(st[vb][2], st[vb][3])};
    }
#pragma unroll
    for (int vb = 0; vb < 4; ++vb) {
        const int v = 16 * vb + fr, d0 = 16 * wid + 4 * fq;
        if (!ML) *(f32x4*)(p.out + O_P_SSD + ((size_t)(b * 32 + h) * 64 + v) * 128 + d0) = st[vb];
        else {
#pragma unroll
            for (int j = 0; j < 4; ++j) p.out[O_P_MLC + ((size_t)(b * 8 + h) * 128 + d0 + j) * 256 + vq * 64 + v] = st[vb][j];
        }
    }
    if (ML && vq == 0) {
        if (tid < 128) p.out[O_P_MLN + (size_t)(b * 8 + h) * 128 + tid] = nvec[tid];
        if (tid == 0) p.out[O_P_MLM + b * 8 + h] = mpp[0];
    }
    __syncthreads();
}

__device__ __forceinline__ void sample_ssd(const Params& p, unsigned char* smem, int job) {
    const int tid = opaque_tid(), wid = tid >> 6, lane = tid & 63;
    const int b = job >> 1, g = job & 1, rowb = ROW_SAMPLE + b * 8;
    const bf16_t* U = (const bf16_t*)(p.ws + WS_U);
    const float* SF = (const float*)(p.ws + WS_SF);
    bf16_t* MIX = (bf16_t*)(p.ws + WS_MIX);
    float* Bc = (float*)smem; float* Cc = Bc + 1024; float* xall = Cc + 1024; float* G = xall + 8192; float* dts = G + 64; float* ssqp = dts + 128;
    const float* sconv = p.in[2]; const float* cw = p.in[11]; const float* cb = p.in[12];
#pragma unroll
    for (int q = 0; q < 3; ++q) {
        int ch; float* dst; int dstride = 0;
        if (q < 2) { ch = g * 1024 + tid + q * 512; dst = xall + tid + q * 512; dstride = 1024; }
        else { if (tid >= 256) break; const int which = tid >> 7, n = tid & 127; ch = 2048 + which * 256 + g * 128 + n; dst = (which ? Cc : Bc) + n; dstride = 128; }
        float xm3 = sconv[(size_t)(b * 3 + 0) * 2560 + ch], xm2 = sconv[(size_t)(b * 3 + 1) * 2560 + ch], xm1 = sconv[(size_t)(b * 3 + 2) * 2560 + ch];
        const float w0 = cw[ch], w1 = cw[2560 + ch], w2 = cw[5120 + ch], w3 = cw[7680 + ch], bb = cb[ch];
#pragma unroll
        for (int t = 0; t < 8; ++t) {
            const float x = bf2f(U[(size_t)(rowb + t) * N1P + UC_XBC + ch]);
            dst[t * dstride] = silu_f(bb + w0 * xm3 + w1 * xm2 + w2 * xm1 + w3 * x);
            xm3 = xm2; xm2 = xm1; xm1 = x;
        }
    }
    if (tid < 128) { const int hh = tid >> 3, t = tid & 7; dts[tid] = softplus_f(SF[(size_t)(rowb + t) * 64 + g * 16 + hh] + p.in[13][g * 16 + hh]); }
    __syncthreads();
    {
        const int pair = tid >> 3, part = tid & 7, t = pair >> 3, s = pair & 7;
        float sum = 0.f;
#pragma unroll
        for (int i = 0; i < 4; ++i) {
            const f32x4 c4 = *(const f32x4*)(Cc + t * 128 + part * 16 + i * 4), b4 = *(const f32x4*)(Bc + s * 128 + part * 16 + i * 4);
            sum += c4[0] * b4[0] + c4[1] * b4[1] + c4[2] * b4[2] + c4[3] * b4[3];
        }
        sum += __shfl_xor(sum, 1); sum += __shfl_xor(sum, 2); sum += __shfl_xor(sum, 4);
        if (part == 0) G[pair] = sum;
    }
    __syncthreads();
    const int pp = tid >> 3, nq = tid & 7;
    f32x4 snext[4];
#pragma unroll
    for (int i = 0; i < 4; ++i) snext[i] = __builtin_nontemporal_load((const f32x4*)(p.in[3] + ((size_t)(b * 32 + g * 16) * 64 + pp) * 128 + nq * 4 + 32 * i));
    for (int hh = 0; hh < 16; ++hh) {
        const int h = g * 16 + hh;
        const float A_h = -__expf(p.in[14][h]), D_h = p.in[15][h];
        float dtv[8], cum[8];
        { float run = 0.f;
#pragma unroll
          for (int t = 0; t < 8; ++t) { dtv[t] = dts[hh * 8 + t]; run += dtv[t] * A_h; cum[t] = run; } }
        const size_t soff = ((size_t)(b * 32 + h) * 64 + pp) * 128 + nq * 4;
        f32x4 s0[4];
#pragma unroll
        for (int i = 0; i < 4; ++i) s0[i] = snext[i];
        if (hh + 1 < 16) {
#pragma unroll
            for (int i = 0; i < 4; ++i) snext[i] = __builtin_nontemporal_load((const f32x4*)(p.in[3] + soff + 64 * 128 + 32 * i));
        }
        float cs[8];
#pragma unroll
        for (int t = 0; t < 8; ++t) {
            float sum = 0.f;
#pragma unroll
            for (int i = 0; i < 4; ++i) { const f32x4 c4 = *(const f32x4*)(Cc + t * 128 + nq * 4 + 32 * i); sum += c4[0] * s0[i][0] + c4[1] * s0[i][1] + c4[2] * s0[i][2] + c4[3] * s0[i][3]; }
            sum += __shfl_xor(sum, 1); sum += __shfl_xor(sum, 2); sum += __shfl_xor(sum, 4);
            cs[t] = sum;
        }
        float ycs = 0.f, ct = 0.f;
#pragma unroll
        for (int t = 0; t < 8; ++t) { ycs = (nq == t) ? cs[t] : ycs; ct = (nq == t) ? cum[t] : ct; }
        float y = __expf(ct) * ycs, xt = 0.f;
#pragma unroll
        for (int s = 0; s < 8; ++s) {
            const float xs = xall[s * 1024 + hh * 64 + pp];
            const float term = (s <= nq) ? G[nq * 8 + s] * __expf(ct - cum[s]) * dtv[s] * xs : 0.f;
            y += term; xt = (s == nq) ? xs : xt;
        }
        y += D_h * xt;
        const float z = bf2f(U[(size_t)(rowb + nq) * N1P + UC_Z + h * 64 + pp]);
        y *= silu_f(z);
        { const unsigned pk = pack2(y, 0.f); MIX[(size_t)(rowb + nq) * MIXW + h * 64 + pp] = (bf16_t)(pk & 0xffffu); }
        float sq = y * y; sq += __shfl_xor(sq, 8); sq += __shfl_xor(sq, 16); sq += __shfl_xor(sq, 32);
        if (lane < 8) ssqp[(hh * 8 + wid) * 8 + lane] = sq;
        const float cl = cum[7], dec = __expf(cl);
        float xw[8];
#pragma unroll
        for (int s = 0; s < 8; ++s) xw[s] = __expf(cl - cum[s]) * dtv[s] * xall[s * 1024 + hh * 64 + pp];
#pragma unroll
        for (int i = 0; i < 4; ++i) {
            f32x4 acc = s0[i] * dec;
#pragma unroll
            for (int s = 0; s < 8; ++s) acc += xw[s] * *(const f32x4*)(Bc + s * 128 + nq * 4 + 32 * i);
            __builtin_nontemporal_store(acc, (f32x4*)(p.out + O_S_SSD + soff + 32 * i));
        }
    }
    __syncthreads();
    if (tid < 128) {
        const int hh = tid >> 3, t = tid & 7; float tot = 0.f;
#pragma unroll
        for (int w = 0; w < 8; ++w) tot += ssqp[(hh * 8 + w) * 8 + t];
        ((float*)(p.ws + WS_SSQ))[(size_t)(rowb + t) * 32 + g * 16 + hh] = tot;
    }
    __syncthreads();
}

__device__ __forceinline__ void sample_ml(const Params& p, unsigned char* smem, int job) {
    const int tid = opaque_tid(), wid = __builtin_amdgcn_readfirstlane(tid >> 6), lane = tid & 63;
    const int b = job >> 3, h = job & 7, rowb = ROW_SAMPLE + b * 8;
    const bf16_t* U = (const bf16_t*)(p.ws + WS_U);
    const float* SF = (const float*)(p.ws + WS_SF);
    bf16_t* MIX = (bf16_t*)(p.ws + WS_MIX);
    float* qs = (float*)smem; float* ks = qs + 1024; float* vs = qs + 2048; float* QK = qs + 4096; float* sig = qs + 4160; float* slf = qs + 4168;
    float* qnv = qs + 4176; float* n0v = qs + 4192; float* red = qs + 4352;
    {
        const int t = tid >> 6, c = tid & 63;
        const size_t r = (size_t)(rowb + t) * N1P;
        const unsigned qq = *(const unsigned*)(U + r + UC_Q + h * 128 + 2 * c), kk = *(const unsigned*)(U + r + UC_K + h * 128 + 2 * c);
        const u32x2 vv = *(const u32x2*)(U + r + UC_V + h * 256 + 4 * c);
        qs[t * 128 + 2 * c] = bf_lo(qq); qs[t * 128 + 2 * c + 1] = bf_hi(qq);
        ks[t * 128 + 2 * c] = bf_lo(kk) * 0.08838834764831845f; ks[t * 128 + 2 * c + 1] = bf_hi(kk) * 0.08838834764831845f;
        *(f32x4*)(vs + t * 256 + 4 * c) = (f32x4){bf_lo(vv[0]), bf_hi(vv[0]), bf_lo(vv[1]), bf_hi(vv[1])};
        if (tid < 8) { sig[tid] = SF[(size_t)(rowb + tid) * 64 + 32 + h] + p.in[17][h]; slf[tid] = logsig_f(SF[(size_t)(rowb + tid) * 64 + 40 + h] + p.in[18][h]); }
        if (tid >= 128 && tid < 256) n0v[tid - 128] = p.in[5][(size_t)(b * 8 + h) * 128 + tid - 128];
    }
    const int v4 = lane, dg = wid;
    const size_t coff = ((size_t)(b * 8 + h) * 128 + dg * 16) * 256 + v4 * 4;
    f32x4 c0[16];
#pragma unroll
    for (int i = 0; i < 16; ++i) c0[i] = __builtin_nontemporal_load((const f32x4*)(p.in[4] + coff + (size_t)i * 256));
    const float mp = p.in[6][b * 8 + h];
    __syncthreads();
    float F[8], gg[8], M[8];
    { float run = 0.f, pm = -INFINITY;
#pragma unroll
      for (int t = 0; t < 8; ++t) { run += slf[t]; F[t] = run; gg[t] = sig[t] - run; pm = fmaxf(pm, gg[t]); M[t] = fmaxf(pm, mp); } }
    const float Ml = M[7], dec = __expf(mp - Ml), m_new = F[7] + Ml;
    {
        const int pair = tid >> 3, part = tid & 7, t = pair >> 3, s = pair & 7;
        float sum = 0.f;
#pragma unroll
        for (int i = 0; i < 4; ++i) {
            const f32x4 a4 = *(const f32x4*)(qs + t * 128 + part * 16 + i * 4), b4 = *(const f32x4*)(ks + s * 128 + part * 16 + i * 4);
            sum += a4[0] * b4[0] + a4[1] * b4[1] + a4[2] * b4[2] + a4[3] * b4[3];
        }
        sum += __shfl_xor(sum, 1); sum += __shfl_xor(sum, 2); sum += __shfl_xor(sum, 4);
        if (part == 0) QK[pair] = sum;
        float qd = qs[wid * 128 + 2 * lane] * n0v[2 * lane] + qs[wid * 128 + 2 * lane + 1] * n0v[2 * lane + 1];
        qd = wave_sum(qd);
        if (lane == 0) qnv[wid] = qd;
    }
#pragma unroll
    for (int t = 0; t < 8; ++t) {
        f32x4 acc = {0.f, 0.f, 0.f, 0.f};
#pragma unroll
        for (int i4 = 0; i4 < 4; ++i4) {
            const f32x4 q4 = *(const f32x4*)(qs + t * 128 + dg * 16 + i4 * 4);
            acc += q4[0] * c0[i4 * 4] + q4[1] * c0[i4 * 4 + 1] + q4[2] * c0[i4 * 4 + 2] + q4[3] * c0[i4 * 4 + 3];
        }
        *(f32x4*)(red + (dg * 8 + t) * 256 + v4 * 4) = acc;
    }
    __syncthreads();
    f32x4 vv[8];
    float scs[8];
#pragma unroll
    for (int s = 0; s < 8; ++s) { vv[s] = *(const f32x4*)(vs + s * 256 + v4 * 4); scs[s] = __expf(gg[s] - Ml); }
#pragma unroll
    for (int i = 0; i < 16; ++i) {
        const int d = dg * 16 + i;
        f32x4 cn = c0[i] * dec;
#pragma unroll
        for (int s = 0; s < 8; ++s) cn += (scs[s] * ks[s * 128 + d]) * vv[s];
        __builtin_nontemporal_store(cn, (f32x4*)(p.out + O_S_MLC + coff + (size_t)i * 256));
    }
    if (tid < 128) {
        float nn = dec * n0v[tid];
#pragma unroll
        for (int s = 0; s < 8; ++s) nn += scs[s] * ks[s * 128 + tid];
        p.out[O_S_MLN + (size_t)(b * 8 + h) * 128 + tid] = nn;
    }
    if (tid == 0) p.out[O_S_MLM + b * 8 + h] = m_new;
    {
        const int t = wid;
        float Mt = 0.f, Ft = 0.f;
#pragma unroll
        for (int q = 0; q < 8; ++q) { Mt = (t == q) ? M[q] : Mt; Ft = (t == q) ? F[q] : Ft; }
        f32x4 numc = {0.f, 0.f, 0.f, 0.f};
#pragma unroll
        for (int q = 0; q < 8; ++q) numc += *(const f32x4*)(red + (q * 8 + t) * 256 + lane * 4);
        const float et = __expf(mp - Mt);
        float den = et * qnv[t];
        f32x4 intra = {0.f, 0.f, 0.f, 0.f};
#pragma unroll
        for (int s = 0; s < 8; ++s) {
            if (s <= t) { const float w = __expf(gg[s] - Mt) * QK[t * 8 + s]; den += w; intra += w * vv[s]; }
        }
        const float dd = fmaxf(fabsf(den), __expf(-(Ft + Mt)));
        const f32x4 hv = (et * numc + intra) * (1.f / dd);
        float ss = hv[0] * hv[0] + hv[1] * hv[1] + hv[2] * hv[2] + hv[3] * hv[3];
        ss = wave_sum(ss);
        const u32x2 og = *(const u32x2*)(U + (size_t)(rowb + t) * N1P + UC_O + h * 256 + lane * 4);
        *(u32x2*)(MIX + (size_t)(rowb + t) * MIXW + 2048 + h * 256 + lane * 4) =
            (u32x2){pack2(hv[0] * sigm_f(bf_lo(og[0])), hv[1] * sigm_f(bf_hi(og[0]))), pack2(hv[2] * sigm_f(bf_lo(og[1])), hv[3] * sigm_f(bf_hi(og[1])))};
        if (lane < 4) ((float*)(p.ws + WS_SSQM))[(size_t)(rowb + t) * 32 + h * 4 + lane] = lane == 0 ? ss : 0.f;
        if (lane == 0) ((float*)(p.ws + WS_DD))[(size_t)(rowb + t) * 8 + h] = 1.f;
    }
    __syncthreads();
}

__device__ __forceinline__ void phase_scan(const Params& p, unsigned char* smem) {
#ifndef SC_MASK
#define SC_MASK 15
#endif
    for (int j = opaque_bid(); j < 256; j += gridDim.x) { if (j < 128) { if (SC_MASK & 1) prompt_scan<false>(p, smem, j); } else { if (SC_MASK & 2) prompt_scan<true>(p, smem, j - 128); } }
    if (SC_MASK & 4) for (int j = opaque_bid(); j < 256; j += gridDim.x) sample_ssd(p, smem, j);
    if (SC_MASK & 8) for (int j = opaque_bid(); j < 1024; j += gridDim.x) sample_ml(p, smem, j);
}

__device__ __forceinline__ void phase_mixnorm(const Params& p) {
    const int tid = opaque_tid(), wid = tid >> 6, lane = tid & 63;
    bf16_t* MIX = (bf16_t*)(p.ws + WS_MIX);
    const float* SSQ = (const float*)(p.ws + WS_SSQ); const float* SSQM = (const float*)(p.ws + WS_SSQM);
    const float* w1 = p.in[16]; const float* w2 = p.in[19];
    for (int row = opaque_bid() * 8 + wid; row < NVALID; row += gridDim.x * 8) {
        float s = lane < 32 ? SSQ[(size_t)row * 32 + lane] : 0.f;
        s = wave_sum(s);
        const float r1 = rsqrtf(s * (1.f / 2048.f) + EPS);
        float m = lane < 32 ? SSQM[(size_t)row * 32 + lane] : 0.f;
        m += __shfl_xor(m, 1); m += __shfl_xor(m, 2);
        const float ddh = lane < 32 ? ((const float*)(p.ws + WS_DD))[(size_t)row * 8 + (lane >> 2)] : 1.f;
        const float idd = 1.f / ddh;
        const float rh = rsqrtf(m * (1.f / 256.f) * idd * idd + EPS) * idd;
        u32x4 raws[8];
#pragma unroll
        for (int it = 0; it < 8; ++it) raws[it] = *(const u32x4*)(MIX + (size_t)row * MIXW + it * 512 + lane * 8);
#pragma unroll
        for (int it = 0; it < 8; ++it) {
            const int col = it * 512 + lane * 8;
            const u32x4 raw = raws[it];
            float scale; const float* wp;
            if (it < 4) { scale = r1; wp = w1 + col; }
            else { const int head = (it - 4) * 2 + (lane >> 5); scale = __shfl(rh, head * 4); wp = w2 + col - 2048; }
            const f32x4 wa = *(const f32x4*)wp, wb = *(const f32x4*)(wp + 4);
            u32x4 o;
            o[0] = pack2(bf_lo(raw[0]) * scale * wa[0], bf_hi(raw[0]) * scale * wa[1]); o[1] = pack2(bf_lo(raw[1]) * scale * wa[2], bf_hi(raw[1]) * scale * wa[3]);
            o[2] = pack2(bf_lo(raw[2]) * scale * wb[0], bf_hi(raw[2]) * scale * wb[1]); o[3] = pack2(bf_lo(raw[3]) * scale * wb[2], bf_hi(raw[3]) * scale * wb[3]);
            *(u32x4*)(MIX + (size_t)row * MIXW + col) = o;
        }
    }
    const bf16_t* U = (const bf16_t*)(p.ws + WS_U);
    for (int i = opaque_bid() * 512 + tid; i < 132 * 3 * 320; i += gridDim.x * 512) {
        const int cgp = i % 320, j = (i / 320) % 3, q = i / 960;
        int row; float* dst;
        if (q < 4) { row = q * 2048 + 2045 + j; dst = p.out + O_P_SSDCONV + (size_t)(q * 3 + j) * 2560 + cgp * 8; }
        else { row = ROW_SAMPLE + (q - 4) * 8 + 5 + j; dst = p.out + O_S_SSDCONV + (size_t)((q - 4) * 3 + j) * 2560 + cgp * 8; }
        const u32x4 raw = *(const u32x4*)(U + (size_t)row * N1P + UC_XBC + cgp * 8);
        *(f32x4*)dst = (f32x4){bf_lo(raw[0]), bf_hi(raw[0]), bf_lo(raw[1]), bf_hi(raw[1])};
        *(f32x4*)(dst + 4) = (f32x4){bf_lo(raw[2]), bf_hi(raw[2]), bf_lo(raw[3]), bf_hi(raw[3])};
    }
}

__device__ __forceinline__ void unpack8(const u32x4 raw, float (&x)[8]) {
#pragma unroll
    for (int i = 0; i < 4; ++i) { x[2 * i] = bf_lo(raw[i]); x[2 * i + 1] = bf_hi(raw[i]); }
}
__device__ __forceinline__ void phase_act(const Params& p) {
    const bf16_t* UP = (const bf16_t*)(p.ws + WS_UP); bf16_t* ACT = (bf16_t*)(p.ws + WS_ACT);
    const float* cw = p.in[23]; const float* cb = p.in[24]; const float* fst = p.in[7];
    constexpr int CGN = DFF / 8, TOTAL = (NVALID / 8) * CGN;
    const int tid = opaque_tid();
    for (int idx = opaque_bid() * 512 + tid; idx < TOTAL; idx += gridDim.x * 512) {
        const int rb = idx / CGN, cgp = idx % CGN, row0 = rb * 8, c0 = cgp * 8;
        float g2[8], g1[8], v2[8], v1[8];
        int prow = -1; bool from_state = false; int sb = 0, pb = -1;
        if (row0 < ROW_SAMPLE) { const int b = row0 >> 11, t0 = row0 & 2047; prow = t0 > 0 ? row0 - 2 : ROW_META + b * 16 + 14; if (t0 == 2040) pb = b; }
        else if (row0 < ROW_META) { from_state = true; sb = (row0 - ROW_SAMPLE) >> 3; }
        else { if ((row0 - ROW_META) & 15) prow = row0 - 2; }
        if (from_state) {
            const float* s0 = fst + (size_t)(sb * 2) * N3;
#pragma unroll
            for (int i = 0; i < 8; ++i) { g2[i] = s0[c0 + i]; g1[i] = s0[N3 + c0 + i]; v2[i] = s0[DFF + c0 + i]; v1[i] = s0[N3 + DFF + c0 + i]; }
        } else if (prow >= 0) {
            unpack8(*(const u32x4*)(UP + (size_t)prow * N3 + c0), g2); unpack8(*(const u32x4*)(UP + (size_t)(prow + 1) * N3 + c0), g1);
            unpack8(*(const u32x4*)(UP + (size_t)prow * N3 + DFF + c0), v2); unpack8(*(const u32x4*)(UP + (size_t)(prow + 1) * N3 + DFF + c0), v1);
        } else {
#pragma unroll
            for (int i = 0; i < 8; ++i) { g2[i] = 0.f; g1[i] = 0.f; v2[i] = 0.f; v1[i] = 0.f; }
        }
        float wg[3][8], wv[3][8], bg[8], bv[8];
#pragma unroll
        for (int j = 0; j < 3; ++j)
#pragma unroll
            for (int i = 0; i < 8; ++i) { wg[j][i] = cw[j * N3 + c0 + i]; wv[j][i] = cw[j * N3 + DFF + c0 + i]; }
#pragma unroll
        for (int i = 0; i < 8; ++i) { bg[i] = cb[c0 + i]; bv[i] = cb[DFF + c0 + i]; }
        u32x4 rg[8], rv[8];
#pragma unroll
        for (int r = 0; r < 8; ++r) { rg[r] = *(const u32x4*)(UP + (size_t)(row0 + r) * N3 + c0); rv[r] = *(const u32x4*)(UP + (size_t)(row0 + r) * N3 + DFF + c0); }
#pragma unroll
        for (int r = 0; r < 8; ++r) {
            float gx[8], vx[8];
            unpack8(rg[r], gx); unpack8(rv[r], vx);
            float o[8];
#pragma unroll
            for (int i = 0; i < 8; ++i) {
                const float yg = bg[i] + wg[0][i] * g2[i] + wg[1][i] * g1[i] + wg[2][i] * gx[i];
                const float yv = bv[i] + wv[0][i] * v2[i] + wv[1][i] * v1[i] + wv[2][i] * vx[i];
                o[i] = silu_f(yg) * yv;
                g2[i] = g1[i]; g1[i] = gx[i]; v2[i] = v1[i]; v1[i] = vx[i];
            }
            u32x4 ov; ov[0] = pack2(o[0], o[1]); ov[1] = pack2(o[2], o[3]); ov[2] = pack2(o[4], o[5]); ov[3] = pack2(o[6], o[7]);
            *(u32x4*)(ACT + (size_t)(row0 + r) * DFF + c0) = ov;
        }
        if (from_state || pb >= 0) {
            float* dst = from_state ? p.out + O_S_FFN + (size_t)(sb * 2) * N3 : p.out + O_P_FFN + (size_t)(pb * 2) * N3;
            *(f32x4*)(dst + c0) = (f32x4){g2[0], g2[1], g2[2], g2[3]}; *(f32x4*)(dst + c0 + 4) = (f32x4){g2[4], g2[5], g2[6], g2[7]};
            *(f32x4*)(dst + N3 + c0) = (f32x4){g1[0], g1[1], g1[2], g1[3]}; *(f32x4*)(dst + N3 + c0 + 4) = (f32x4){g1[4], g1[5], g1[6], g1[7]};
            *(f32x4*)(dst + DFF + c0) = (f32x4){v2[0], v2[1], v2[2], v2[3]}; *(f32x4*)(dst + DFF + c0 + 4) = (f32x4){v2[4], v2[5], v2[6], v2[7]};
            *(f32x4*)(dst + N3 + DFF + c0) = (f32x4){v1[0], v1[1], v1[2], v1[3]}; *(f32x4*)(dst + N3 + DFF + c0 + 4) = (f32x4){v1[4], v1[5], v1[6], v1[7]};
        }
    }
}

__device__ __forceinline__ void phase_final(const Params& p) {
    const int tid = opaque_tid(), wid = tid >> 6, lane = tid & 63;
    const float* SS3 = (const float*)(p.ws + WS_SS3); const float* nw = p.in[26];
    for (int row = opaque_bid() * 8 + wid; row < NOUTROWS; row += gridDim.x * 8) {
        const float r = rsqrtf(SS3[row] * (1.f / 2048.f) + EPS);
        float* rp = p.out + (size_t)row * DM;
        f32x4 v[8];
#pragma unroll
        for (int it = 0; it < 8; ++it) v[it] = *(const f32x4*)(rp + it * 256 + lane * 4);
#pragma unroll
        for (int it = 0; it < 8; ++it) {
            const int col = it * 256 + lane * 4;
            const f32x4 w = *(const f32x4*)(nw + col);
            *(f32x4*)(rp + col) = v[it] * r * w;
        }
    }
}

__global__ void __launch_bounds__(512, 2) hymba_fwd(Params p0) {
    extern __shared__ __attribute__((aligned(16))) unsigned char smem[];
    cg::grid_group grid = cg::this_grid();
#ifndef DUP_PHASE
#define DUP_PHASE -1
#endif
    for (int phx = p0.ph_lo; phx < p0.ph_hi + (DUP_PHASE >= 0 ? 1 : 0); ++phx) {
        const int ph = (DUP_PHASE >= 0 && phx > DUP_PHASE) ? phx - 1 : phx;
        Params p = p0;
        { size_t z = 0; asm volatile("" : "+s"(z)); p.ws = p0.ws + z; p.out = p0.out + z; }
        switch (ph) {
        case 0: if (PH_MASK & 1) phase_prep(p, smem); break;
        case 1: if (PH_MASK & 2) { pg8::Gemm g{(const bf16_t*)(p.ws + WS_XN), (const bf16_t*)(p.ws + WS_WIN), MP, N1P, 2048}; pg8::StaticOrder S; S.init(MP, N1P, gridDim.x, opaque_bid());
                  Epi1 E{(bf16_t*)(p.ws + WS_U), (float*)(p.ws + WS_SF)}; pg8::gemm_phase((LAS unsigned char*)smem, g, S, E);
                  convert_in_tail(p, smem, (MP / 256) * (N1P / 256), T_IN, T_IN + T_OUT + T_UP); } break;
        case 2: if (PH_MASK & 4) phase_scan(p, smem); break;
        case 3: if (PH_MASK & 8) phase_mixnorm(p); break;
        case 4: if (PH_MASK & 16) { pg8::Gemm g{(const bf16_t*)(p.ws + WS_MIX), (const bf16_t*)(p.ws + WS_WOUT), MP, 2048, 4096}; pg8::StaticOrder S; S.init(MP, 2048, gridDim.x, opaque_bid());
                  Epi2 E{p}; pg8::gemm_phase((LAS unsigned char*)smem, g, S, E); } break;
        case 5: if (PH_MASK & 32) { pg8::Gemm g{(const bf16_t*)(p.ws + WS_A2), (const bf16_t*)(p.ws + WS_WUP), MP, N3, 2048}; pg8::StaticOrder S; S.init(MP, N3, gridDim.x, opaque_bid());
                  Epi3 E{(bf16_t*)(p.ws + WS_UP), (const float*)(p.ws + WS_SS2)}; pg8::gemm_phase((LAS unsigned char*)smem, g, S, E);
                  convert_in_tail(p, smem, (MP / 256) * (N3 / 256), T_IN + T_OUT + T_UP, T_ALL); } break;
        case 6: if (PH_MASK & 64) phase_act(p); break;
        case 7: if (PH_MASK & 128) { pg8::Gemm g{(const bf16_t*)(p.ws + WS_ACT), (const bf16_t*)(p.ws + WS_WDOWN), MP, 2048, DFF}; pg8::StaticOrder S; S.init(MP, 2048, gridDim.x, opaque_bid());
                  Epi4 E{(const float*)(p.ws + WS_H1), p.out, (float*)(p.ws + WS_SS3)}; pg8::gemm_phase((LAS unsigned char*)smem, g, S, E); } break;
        default: if (PH_MASK & 256) phase_final(p); break;
        }
        if (phx + 1 < p0.ph_hi + (DUP_PHASE >= 0 ? 1 : 0)) grid.sync();
    }
}

extern "C" void kernel_launch(void* const* d_in, const int* in_sizes, int n_in, void* d_out, int out_size, void* d_ws, size_t ws_size, hipStream_t stream) {
    static int grid_blocks = 0;
    if (grid_blocks == 0) {
        if (n_in != 27 || (size_t)out_size != O_END || ws_size < WS_END) {
            fprintf(stderr, "kernel_launch: unexpected shapes: n_in %d out %d ws %zu (need %zu)\n", n_in, out_size, ws_size, (size_t)WS_END); grid_blocks = -1; return; }
        int dev = 0, cus = 0, per_cu = 0;
        (void)hipGetDevice(&dev);
        (void)hipDeviceGetAttribute(&cus, hipDeviceAttributeMultiprocessorCount, dev);
        (void)hipFuncSetAttribute((const void*)hymba_fwd, hipFuncAttributeMaxDynamicSharedMemorySize, LDS_BYTES);
        (void)hipOccupancyMaxActiveBlocksPerMultiprocessor(&per_cu, (const void*)hymba_fwd, 512, LDS_BYTES);
        if (per_cu < 1) { fprintf(stderr, "kernel_launch: occupancy query says %d blocks per CU\n", per_cu); per_cu = 1; }
        grid_blocks = cus;
    }
    if (grid_blocks < 0) return;
    Params p{};
    for (int i = 0; i < 27; ++i) p.in[i] = (const float*)d_in[i];
    p.out = (float*)d_out; p.ws = (unsigned char*)d_ws; p.ph_lo = 0; p.ph_hi = NPHASE;
    void* args[] = {&p};
    hipError_t e = hipLaunchCooperativeKernel((const void*)hymba_fwd, dim3(grid_blocks), dim3(512), args, LDS_BYTES, stream);
    if (e != hipSuccess) fprintf(stderr, "cooperative launch failed: %s (grid %d)\n", hipGetErrorString(e), grid_blocks);
}
```

```cpp
#include <hip/hip_runtime.h>
#include <hip/hip_cooperative_groups.h>
#include <cstdio>
namespace cg = cooperative_groups;

#define LAS __attribute__((address_space(3)))
typedef unsigned short bf16_t;
typedef short bf16x8 __attribute__((ext_vector_type(8)));
typedef float f32x4 __attribute__((ext_vector_type(4)));
typedef unsigned u32x4 __attribute__((ext_vector_type(4)));
typedef unsigned u32x2 __attribute__((ext_vector_type(2)));

constexpr int DM = 2048, MP = 9472, NVALID = 9280, NOUTROWS = 9216;
constexpr int N1P = 11008, N3 = 11264, DFF = 5632, MIXW = 4096;
constexpr int ROW_SAMPLE = 8192, ROW_META = 9216;
constexpr float EPS = 1e-6f;
constexpr int UC_Z = 0, UC_XBC = 2048, UC_Q = 4640, UC_K = 5664, UC_V = 6688, UC_O = 8752;
constexpr size_t WS_WIN = 0;
constexpr size_t WS_WOUT = WS_WIN + (size_t)N1P * 2048 * 2;
constexpr size_t WS_WUP = WS_WOUT + (size_t)2048 * 4096 * 2;
constexpr size_t WS_WDOWN = WS_WUP + (size_t)N3 * 2048 * 2;
constexpr size_t WS_XN = WS_WDOWN + (size_t)2048 * DFF * 2;
constexpr size_t WS_MIX = WS_XN + (size_t)MP * 2048 * 2;
constexpr size_t WS_ACT = WS_XN;
constexpr size_t WS_U = WS_MIX + (size_t)MP * MIXW * 2;
constexpr size_t WS_UP = WS_U;
constexpr size_t WS_H1 = WS_U + (size_t)MP * N3 * 2;
constexpr size_t WS_A2 = WS_H1 + (size_t)MP * 2048 * 4;
constexpr size_t WS_SF = WS_A2 + (size_t)MP * 2048 * 2;
constexpr size_t WS_SSQ = WS_SF + (size_t)MP * 64 * 4;
constexpr size_t WS_SSQM = WS_SSQ + (size_t)MP * 32 * 4;
constexpr size_t WS_SS2 = WS_SSQM + (size_t)MP * 32 * 4;
constexpr size_t WS_SS3 = WS_SS2 + (size_t)MP * 4;
constexpr size_t WS_DD = WS_SS3 + (size_t)MP * 4;
constexpr size_t WS_END = WS_DD + (size_t)MP * 8 * 4;
constexpr size_t O_Y = 0;
constexpr size_t O_P_SSDCONV = 18874368, O_P_SSD = 18905088, O_P_MLC = 19953664, O_P_MLN = 21002240, O_P_MLM = 21006336, O_P_FFN = 21006368;
constexpr size_t O_S_SSDCONV = 21096480, O_S_SSD = 22079520, O_S_MLC = 55633952, O_S_MLN = 89188384, O_S_MLM = 89319456, O_S_FFN = 89320480;
constexpr size_t O_END = 92204064;
constexpr int LDS_BYTES = 147456;
constexpr int NPHASE = 9;
#ifndef CHL_SSD
#define CHL_SSD 128
#endif
#ifndef CHL_ML
#define CHL_ML 128
#endif
#ifndef PH_MASK
#define PH_MASK 0x1ff
#endif

struct Params {
    const float* in[27];
    float* out;
    unsigned char* ws;
    int ph_lo, ph_hi;
};

__device__ __forceinline__ unsigned pack2(float lo, float hi) { unsigned r; asm("v_cvt_pk_bf16_f32 %0, %1, %2" : "=v"(r) : "v"(lo), "v"(hi)); return r; }
__device__ __forceinline__ float bf_lo(unsigned u) { return __uint_as_float(u << 16); }
__device__ __forceinline__ float bf_hi(unsigned u) { return __uint_as_float(u & 0xffff0000u); }
__device__ __forceinline__ float bf2f(bf16_t h) { return __uint_as_float((unsigned)h << 16); }
__device__ __forceinline__ float sigm_f(float x) { const float d = 1.f + __expf(fminf(-x, 80.f)); float r = __builtin_amdgcn_rcpf(d); return r * (2.f - d * r); }
__device__ __forceinline__ float silu_f(float x) { return x * sigm_f(x); }
__device__ __forceinline__ float softplus_f(float x) { return x > 20.f ? x : log1pf(__expf(x)); }
__device__ __forceinline__ float logsig_f(float x) { return fminf(x, 0.f) - log1pf(__expf(-fabsf(x))); }
__device__ __forceinline__ int opaque_tid() { int t = threadIdx.x; asm volatile("" : "+v"(t)); return t; }
__device__ __forceinline__ int opaque_bid() { int t = blockIdx.x; asm volatile("" : "+s"(t)); return t; }
__device__ __forceinline__ int row_of(int b, int pos) { return pos < 16 ? ROW_META + b * 16 + pos : b * 2048 + pos - 16; }
__device__ __forceinline__ float wave_sum(float v) {
    v += __shfl_xor(v, 32); v += __shfl_xor(v, 16); v += __shfl_xor(v, 8); v += __shfl_xor(v, 4); v += __shfl_xor(v, 2); v += __shfl_xor(v, 1); return v;
}
__device__ __forceinline__ const float* resid_row(const Params& p, int row) {
    if (row < ROW_SAMPLE) return p.in[0] + (size_t)row * DM;
    if (row < ROW_META) return p.in[1] + (size_t)(row - ROW_SAMPLE) * DM;
    if (row < NVALID) return p.in[8] + (size_t)((row - ROW_META) & 15) * DM;
    return nullptr;
}

namespace pg8 {
constexpr int BM = 256, BK = 64, HALF = 128, HTB = HALF * BK * 2, STAGE_BYTES = 8 * HTB, NXCD = 8, WGM = 8;
__device__ __forceinline__ int lds_byte(int r, int c) { const int st = (r >> 4) * 2 + (c >> 5), rr = r & 15, cc = c & 31, ob = rr * 64 + cc * 2; return st * 1024 + (ob ^ (((ob >> 9) & 1) << 5)); }
__device__ __forceinline__ void stage_rc(int b, int& R, int& C) { const int st = b / 1024, sb = b % 1024, swz = sb ^ (((sb >> 9) & 1) << 5); R = (st >> 1) * 16 + swz / 64; C = (st & 1) * 32 + (swz % 64) / 2; }
__device__ __forceinline__ int perm32(int rho) { const int n = rho >> 4, i = rho & 15; return 8 * (i >> 2) + 4 * n + (i & 3); }
struct Unit { int pm, pn; };
struct Gemm { const bf16_t* A; const bf16_t* Bt; int M, N, K; };
struct StaticOrder {
    int nM, nN, nwg, G, c;
    __device__ void init(int M, int N, int G_, int c_) { nM = M / BM; nN = N / BM; nwg = nM * nN; G = G_; c = c_; }
    __device__ bool next(int i, Unit& u) const {
        const long L = (long)i * G + c; if (L >= nwg) return false;
        int wgid = (int)L; { const int q = nwg / NXCD, r = nwg % NXCD, xcd = wgid % NXCD, off = wgid / NXCD; wgid = (xcd < r ? xcd * (q + 1) : r * (q + 1) + (xcd - r) * q) + off; }
        const int nig = WGM * nN, gid = wgid / nig, fm = gid * WGM, gsz = (nM - fm) < WGM ? (nM - fm) : WGM;
        u.pm = fm + ((wgid % nig) % gsz); u.pn = (wgid % nig) / gsz; return true;
    }
};

template <class Epi>
__device__ __forceinline__ void gemm_phase(LAS unsigned char* lds, const Gemm g, const StaticOrder& S, const Epi& E) {
    const int tid = opaque_tid(), wid = __builtin_amdgcn_readfirstlane(tid >> 6), lane = tid & 63, wr = wid >> 2, wc = wid & 3, fr = lane & 15, fq = lane >> 4;
    const int K = g.K, nt = K / BK;
    unsigned voffA[2], voffB[2];
#pragma unroll
    for (int i = 0; i < 2; ++i) { int R, C; stage_rc(tid * 16 + i * 8192, R, C); const int Rb = ((R & ~31) + perm32(R & 31));
        voffA[i] = (unsigned)(R * K + C) * 2u; voffB[i] = (unsigned)(Rb * K + C) * 2u; }
    const size_t kstep = (size_t)(BK * 2);
    const size_t hstep = (size_t)HALF * K * 2;
    const size_t tstep = 2 * hstep;
    const unsigned ldsw = (unsigned)wid * 1024u;
    const int aoff = lds_byte(wr * 64 + fr, fq * 8), boff = lds_byte(wc * 32 + fr, fq * 8);
#define PG8_SA(b, h) (((b) * 2 + (h)) * HTB)
#define PG8_SB(b, h) ((4 + (b) * 2 + (h)) * HTB)
#define PG8_STAGE(bufoff, gbase, voff) do { _Pragma("unroll") for (int _i = 0; _i < 2; ++_i) \
        __builtin_amdgcn_global_load_lds((const unsigned*)((const char*)(gbase) + (voff)[_i]), (LAS unsigned*)(lds + (bufoff) + ldsw + _i * 8192), 16, 0, 0); } while (0)
#define PG8_LDA(dst, b, h) do { _Pragma("unroll") for (int m = 0; m < 4; ++m) _Pragma("unroll") for (int k = 0; k < 2; ++k) dst[m][k] = *(const LAS bf16x8*)(lds + PG8_SA(b, h) + aoff + m * 2048 + k * 1024); } while (0)
#define PG8_LDB(dst, b, h) do { _Pragma("unroll") for (int n = 0; n < 2; ++n) _Pragma("unroll") for (int k = 0; k < 2; ++k) dst[n][k] = *(const LAS bf16x8*)(lds + PG8_SB(b, h) + boff + n * 2048 + k * 1024); } while (0)
#define PG8_MMA(ai, bj, At, Bt) do { __builtin_amdgcn_s_setprio(1); _Pragma("unroll") for (int m = 0; m < 4; ++m) _Pragma("unroll") for (int n = 0; n < 2; ++n) _Pragma("unroll") for (int k = 0; k < 2; ++k) \
        acc[ai][bj][m][n] = __builtin_amdgcn_mfma_f32_16x16x32_bf16(Bt[n][k], At[m][k], acc[ai][bj][m][n], 0, 0, 0); __builtin_amdgcn_s_setprio(0); } while (0)
#define PG8_WAIT_V(n) asm volatile("s_waitcnt vmcnt(" #n ")" ::: "memory")
#define PG8_WAIT_L(n) asm volatile("s_waitcnt lgkmcnt(" #n ")" ::: "memory")
#define PG8_BAR __builtin_amdgcn_s_barrier()
#define PG8_SCHED __builtin_amdgcn_sched_barrier(0)
    Unit cur, nxt; int ui = 0;
    if (!S.next(0, cur)) return;
    f32x4 acc[2][2][4][2];
#pragma unroll
    for (int a = 0; a < 2; ++a)
#pragma unroll
        for (int b = 0; b < 2; ++b)
#pragma unroll
            for (int m = 0; m < 4; ++m)
#pragma unroll
                for (int n = 0; n < 2; ++n) acc[a][b][m][n] = (f32x4){0.f, 0.f, 0.f, 0.f};
    bf16x8 At[4][2], B0[2][2], B1[2][2];
    const char* cA = (const char*)g.A + (size_t)cur.pm * tstep; const char* cB = (const char*)g.Bt + (size_t)cur.pn * tstep;
    PG8_STAGE(PG8_SB(0, 0), cB, voffB); PG8_STAGE(PG8_SA(0, 0), cA, voffA); PG8_STAGE(PG8_SB(0, 1), cB + hstep, voffB); PG8_STAGE(PG8_SA(0, 1), cA + hstep, voffA);
    if (wr == 1) PG8_BAR;
    PG8_WAIT_V(4); PG8_BAR;
    PG8_STAGE(PG8_SB(1, 0), cB + kstep, voffB); PG8_STAGE(PG8_SA(1, 0), cA + kstep, voffA); PG8_STAGE(PG8_SB(1, 1), cB + hstep + kstep, voffB);
    PG8_WAIT_V(6); PG8_BAR;
    for (;;) {
        const bool has_next = S.next(ui + 1, nxt);
        const char* nA = has_next ? (const char*)g.A + (size_t)nxt.pm * tstep : cA; const char* nB = has_next ? (const char*)g.Bt + (size_t)nxt.pn * tstep : cB;
        for (int t = 0; t < nt; t += 2) {
            const bool last = (t == nt - 2);
            const char* a1 = cA + (size_t)(t + 1) * kstep;
            const char* a2 = last ? nA : cA + (size_t)(t + 2) * kstep; const char* b2 = last ? nB : cB + (size_t)(t + 2) * kstep;
            const char* a3 = a2 + kstep; const char* b3 = b2 + kstep;
            PG8_LDB(B0, 0, 0); PG8_SCHED; PG8_LDA(At, 0, 0); PG8_STAGE(PG8_SA(1, 1), a1 + hstep, voffA);
            PG8_WAIT_L(8); PG8_BAR; PG8_WAIT_L(0); PG8_MMA(0, 0, At, B0); PG8_BAR; PG8_SCHED;
            PG8_LDB(B1, 0, 1); PG8_STAGE(PG8_SB(0, 0), b2, voffB);
            PG8_BAR; PG8_WAIT_L(0); PG8_MMA(0, 1, At, B1); PG8_BAR;
            PG8_LDA(At, 0, 1); PG8_STAGE(PG8_SA(0, 0), a2, voffA);
            PG8_BAR; PG8_WAIT_L(0); PG8_MMA(1, 0, At, B0); PG8_BAR; PG8_SCHED;
            PG8_STAGE(PG8_SB(0, 1), b2 + hstep, voffB);
            PG8_WAIT_V(6); PG8_BAR; PG8_MMA(1, 1, At, B1); PG8_BAR;
            PG8_LDB(B0, 1, 0); PG8_SCHED; PG8_LDA(At, 1, 0); PG8_STAGE(PG8_SA(0, 1), a2 + hstep, voffA);
            PG8_WAIT_L(8); PG8_BAR; PG8_WAIT_L(0); PG8_MMA(0, 0, At, B0); PG8_BAR; PG8_SCHED;
            PG8_LDB(B1, 1, 1); PG8_STAGE(PG8_SB(1, 0), b3, voffB);
            PG8_BAR; PG8_WAIT_L(0); PG8_MMA(0, 1, At, B1); PG8_BAR;
            PG8_LDA(At, 1, 1); PG8_STAGE(PG8_SA(1, 0), a3, voffA);
            PG8_BAR; PG8_WAIT_L(0); PG8_MMA(1, 0, At, B0); PG8_BAR; PG8_SCHED;
            PG8_STAGE(PG8_SB(1, 1), b3 + hstep, voffB);
            PG8_WAIT_V(6); PG8_BAR; PG8_MMA(1, 1, At, B1); PG8_BAR;
        }
        { Unit eu = cur; asm volatile("" : "+s"(eu.pm), "+s"(eu.pn)); E(acc, eu, wr, wc, fr, fq); }
        if (!has_next) break;
#pragma unroll
        for (int a = 0; a < 2; ++a)
#pragma unroll
            for (int b = 0; b < 2; ++b)
#pragma unroll
                for (int m = 0; m < 4; ++m)
#pragma unroll
                    for (int n = 0; n < 2; ++n) acc[a][b][m][n] = (f32x4){0.f, 0.f, 0.f, 0.f};
        cur = nxt; cA = nA; cB = nB; ++ui;
    }
    PG8_WAIT_V(0);
    if (wr == 0) PG8_BAR;
    PG8_BAR;
#undef PG8_SA
#undef PG8_SB
#undef PG8_STAGE
#undef PG8_LDA
#undef PG8_LDB
#undef PG8_MMA
#undef PG8_WAIT_V
#undef PG8_WAIT_L
#undef PG8_BAR
#undef PG8_SCHED
}
}

typedef f32x4 AccT[2][2][4][2];
struct Epi1 {
    bf16_t* U; float* sf;
    __device__ __forceinline__ void operator()(const AccT& acc, const pg8::Unit& u, int wr, int wc, int fr, int fq) const {
        const int row0 = u.pm * 256 + wr * 64 + fr, col0 = u.pn * 256 + wc * 32 + 8 * fq;
        const bool side_dt = (u.pn == 18 && wc == 0), side_if = (u.pn == 34 && wc == 1);
#pragma unroll
        for (int ai = 0; ai < 2; ++ai)
#pragma unroll
            for (int m = 0; m < 4; ++m) {
                const int row = row0 + ai * 128 + m * 16;
                bf16_t* rowp = U + (size_t)row * N1P + col0;
#pragma unroll
                for (int bj = 0; bj < 2; ++bj) {
                    const f32x4 v0 = acc[ai][bj][m][0], v1 = acc[ai][bj][m][1];
                    u32x4 o; o[0] = pack2(v0[0], v0[1]); o[1] = pack2(v0[2], v0[3]); o[2] = pack2(v1[0], v1[1]); o[3] = pack2(v1[2], v1[3]);
                    *(u32x4*)(rowp + bj * 128) = o;
                }
                if (side_dt || side_if) {
                    float* sp = sf + (size_t)row * 64 + (side_if ? 32 : 0) + 8 * fq;
                    *(f32x4*)sp = acc[ai][0][m][0]; *(f32x4*)(sp + 4) = acc[ai][0][m][1];
                }
            }
    }
};
struct Epi2 {
    Params p;
    __device__ __forceinline__ void operator()(const AccT& acc, const pg8::Unit& u, int wr, int wc, int fr, int fq) const {
        float* H1 = (float*)(p.ws + WS_H1); bf16_t* A2 = (bf16_t*)(p.ws + WS_A2); float* SS2 = (float*)(p.ws + WS_SS2);
        const float* nw = p.in[21];
        const int row0 = u.pm * 256 + wr * 64 + fr, col0 = u.pn * 256 + wc * 32 + 8 * fq;
        f32x4 w[2][2];
#pragma unroll
        for (int bj = 0; bj < 2; ++bj) { w[bj][0] = *(const f32x4*)(nw + col0 + bj * 128); w[bj][1] = *(const f32x4*)(nw + col0 + bj * 128 + 4); }
#pragma unroll
        for (int ai = 0; ai < 2; ++ai)
#pragma unroll
            for (int m = 0; m < 4; ++m) {
                const int row = row0 + ai * 128 + m * 16;
                const float* rp = resid_row(p, row);
                float ss = 0.f;
#pragma unroll
                for (int bj = 0; bj < 2; ++bj) {
                    f32x4 v0 = acc[ai][bj][m][0], v1 = acc[ai][bj][m][1];
                    if (rp) { v0 += *(const f32x4*)(rp + col0 + bj * 128); v1 += *(const f32x4*)(rp + col0 + bj * 128 + 4); }
                    *(f32x4*)(H1 + (size_t)row * DM + col0 + bj * 128) = v0; *(f32x4*)(H1 + (size_t)row * DM + col0 + bj * 128 + 4) = v1;
                    ss += v0[0] * v0[0] + v0[1] * v0[1] + v0[2] * v0[2] + v0[3] * v0[3] + v1[0] * v1[0] + v1[1] * v1[1] + v1[2] * v1[2] + v1[3] * v1[3];
                    const f32x4 a0 = v0 * w[bj][0], a1 = v1 * w[bj][1];
                    u32x4 o; o[0] = pack2(a0[0], a0[1]); o[1] = pack2(a0[2], a0[3]); o[2] = pack2(a1[0], a1[1]); o[3] = pack2(a1[2], a1[3]);
                    *(u32x4*)(A2 + (size_t)row * DM + col0 + bj * 128) = o;
                }
                ss += __shfl_xor(ss, 16); ss += __shfl_xor(ss, 32);
                if (fq == 0) atomicAdd(SS2 + row, ss);
            }
    }
};
struct Epi3 {
    bf16_t* UP; const float* SS2;
    __device__ __forceinline__ void operator()(const AccT& acc, const pg8::Unit& u, int wr, int wc, int fr, int fq) const {
        const int row0 = u.pm * 256 + wr * 64 + fr, col0 = u.pn * 256 + wc * 32 + 8 * fq;
#pragma unroll
        for (int ai = 0; ai < 2; ++ai)
#pragma unroll
            for (int m = 0; m < 4; ++m) {
                const int row = row0 + ai * 128 + m * 16;
                const float r2 = rsqrtf(SS2[row] * (1.f / 2048.f) + EPS);
                bf16_t* rowp = UP + (size_t)row * N3 + col0;
#pragma unroll
                for (int bj = 0; bj < 2; ++bj) {
                    const f32x4 v0 = acc[ai][bj][m][0] * r2, v1 = acc[ai][bj][m][1] * r2;
                    u32x4 o; o[0] = pack2(v0[0], v0[1]); o[1] = pack2(v0[2], v0[3]); o[2] = pack2(v1[0], v1[1]); o[3] = pack2(v1[2], v1[3]);
                    *(u32x4*)(rowp + bj * 128) = o;
                }
            }
    }
};
struct Epi4 {
    const float* H1; float* out; float* SS3;
    __device__ __forceinline__ void operator()(const AccT& acc, const pg8::Unit& u, int wr, int wc, int fr, int fq) const {
        const int row0 = u.pm * 256 + wr * 64 + fr, col0 = u.pn * 256 + wc * 32 + 8 * fq;
#pragma unroll
        for (int ai = 0; ai < 2; ++ai)
#pragma unroll
            for (int m = 0; m < 4; ++m) {
                const int row = row0 + ai * 128 + m * 16;
                if (row < NOUTROWS) {
                    float ss = 0.f;
#pragma unroll
                    for (int bj = 0; bj < 2; ++bj) {
                        const f32x4 v0 = acc[ai][bj][m][0] + *(const f32x4*)(H1 + (size_t)row * DM + col0 + bj * 128);
                        const f32x4 v1 = acc[ai][bj][m][1] + *(const f32x4*)(H1 + (size_t)row * DM + col0 + bj * 128 + 4);
                        *(f32x4*)(out + (size_t)row * DM + col0 + bj * 128) = v0; *(f32x4*)(out + (size_t)row * DM + col0 + bj * 128 + 4) = v1;
                        ss += v0[0] * v0[0] + v0[1] * v0[1] + v0[2] * v0[2] + v0[3] * v0[3] + v1[0] * v1[0] + v1[1] * v1[1] + v1[2] * v1[2] + v1[3] * v1[3];
                    }
                    ss += __shfl_xor(ss, 16); ss += __shfl_xor(ss, 32);
                    if (fq == 0) atomicAdd(SS3 + row, ss);
                }
            }
    }
};

constexpr int T_IN = 32 * 43, T_OUT = 64 * 8, T_UP = 32 * 44, T_DOWN = 88 * 8, T_ALL = T_IN + T_OUT + T_UP + T_DOWN;
struct TileRef { const float* W; bf16_t* WT; int K, N, kt, nt; };
__device__ __forceinline__ TileRef tile_ref(const Params& p, int t) {
    TileRef r;
    if (t < T_IN) { r.W = p.in[10]; r.WT = (bf16_t*)(p.ws + WS_WIN); r.K = 2048; r.N = 10800; r.kt = t % 32; r.nt = t / 32; }
    else if (t < T_IN + T_OUT) { const int q = t - T_IN; r.W = p.in[20]; r.WT = (bf16_t*)(p.ws + WS_WOUT); r.K = 4096; r.N = 2048; r.kt = q % 64; r.nt = q / 64; }
    else if (t < T_IN + T_OUT + T_UP) { const int q = t - T_IN - T_OUT; r.W = p.in[22]; r.WT = (bf16_t*)(p.ws + WS_WUP); r.K = 2048; r.N = N3; r.kt = q % 32; r.nt = q / 32; }
    else { const int q = t - T_IN - T_OUT - T_UP; r.W = p.in[25]; r.WT = (bf16_t*)(p.ws + WS_WDOWN); r.K = DFF; r.N = 2048; r.kt = q % 88; r.nt = q / 88; }
    return r;
}
__device__ __forceinline__ void tile_load(const TileRef& r, f32x4 (&v)[8], int tid) {
    const int nc = (tid & 63) * 4, n = r.nt * 256 + nc;
#pragma unroll
    for (int i = 0; i < 8; ++i) {
        const int kr = (tid >> 6) + 8 * i;
        v[i] = (f32x4){0.f, 0.f, 0.f, 0.f};
        if (n < r.N) v[i] = __builtin_nontemporal_load((const f32x4*)(r.W + (size_t)(r.kt * 64 + kr) * r.N + n));
    }
}
__device__ __forceinline__ void tile_lds_write(const f32x4 (&v)[8], int tid, unsigned char* smem) {
    float* tile = (float*)smem;
    const int nc = (tid & 63) * 4;
#pragma unroll
    for (int i = 0; i < 8; ++i) {
        const int kr = (tid >> 6) + 8 * i;
        tile[kr * 257 + nc] = v[i][0]; tile[kr * 257 + nc + 1] = v[i][1]; tile[kr * 257 + nc + 2] = v[i][2]; tile[kr * 257 + nc + 3] = v[i][3];
    }
}
__device__ __forceinline__ void tile_store(const TileRef& r, int tid, unsigned char* smem) {
    const float* tile = (const float*)smem;
    const int kc = (tid & 7) * 8;
#pragma unroll
    for (int q = 0; q < 4; ++q) {
        const int nr = (tid >> 3) + 64 * q;
        u32x4 o;
        o[0] = pack2(tile[(kc + 0) * 257 + nr], tile[(kc + 1) * 257 + nr]); o[1] = pack2(tile[(kc + 2) * 257 + nr], tile[(kc + 3) * 257 + nr]);
        o[2] = pack2(tile[(kc + 4) * 257 + nr], tile[(kc + 5) * 257 + nr]); o[3] = pack2(tile[(kc + 6) * 257 + nr], tile[(kc + 7) * 257 + nr]);
        *(u32x4*)(r.WT + (size_t)(r.nt * 256 + nr) * r.K + r.kt * 64 + kc) = o;
    }
}
__device__ __forceinline__ void convert_tiles(const Params& p, unsigned char* smem, int t_begin, int t_end, int worker, int nworkers) {
    const int tid = opaque_tid();
    int t = t_begin + worker;
    f32x4 v[8];
    TileRef cur{};
    if (t < t_end) { cur = tile_ref(p, t); tile_load(cur, v, tid); }
    while (t < t_end) {
        tile_lds_write(v, tid, smem);
        __syncthreads();
        const int tn = t + nworkers;
        TileRef nxt{};
        if (tn < t_end) { nxt = tile_ref(p, tn); tile_load(nxt, v, tid); }
        tile_store(cur, tid, smem);
        __syncthreads();
        cur = nxt; t = tn;
    }
}
__device__ __forceinline__ void convert_in_tail(const Params& p, unsigned char* smem, int n_units, int t_begin, int t_end) {
    const int G = gridDim.x, rem = n_units % G, bid = opaque_bid();
    if (rem == 0) convert_tiles(p, smem, t_begin, t_end, bid, G);
    else if (bid >= rem) convert_tiles(p, smem, t_begin, t_end, bid - rem, G - rem);
}
__device__ __forceinline__ void phase_prep(const Params& p, unsigned char* smem) {
    const int tid = opaque_tid(), wid = tid >> 6, lane = tid & 63;
    { float* SS2 = (float*)(p.ws + WS_SS2); for (int i = opaque_bid() * 512 + tid; i < 2 * MP; i += gridDim.x * 512) SS2[i] = 0.f; }
    {
        bf16_t* XN = (bf16_t*)(p.ws + WS_XN); const float* nw = p.in[9];
        for (int row = opaque_bid() * 8 + wid; row < MP; row += gridDim.x * 8) {
            const float* src = resid_row(p, row);
            f32x4 v[8];
            float ss = 0.f;
#pragma unroll
            for (int it = 0; it < 4; ++it) {
                const int col = it * 512 + lane * 8;
                if (src) { v[2 * it] = *(const f32x4*)(src + col); v[2 * it + 1] = *(const f32x4*)(src + col + 4); }
                else { v[2 * it] = (f32x4){0.f, 0.f, 0.f, 0.f}; v[2 * it + 1] = (f32x4){0.f, 0.f, 0.f, 0.f}; }
#pragma unroll
                for (int j = 0; j < 4; ++j) ss += v[2 * it][j] * v[2 * it][j] + v[2 * it + 1][j] * v[2 * it + 1][j];
            }
            ss = wave_sum(ss);
            const float r = rsqrtf(ss * (1.f / 2048.f) + EPS);
#pragma unroll
            for (int it = 0; it < 4; ++it) {
                const int col = it * 512 + lane * 8;
                const f32x4 w0 = *(const f32x4*)(nw + col), w1 = *(const f32x4*)(nw + col + 4);
                const f32x4 a = v[2 * it] * r * w0, c = v[2 * it + 1] * r * w1;
                u32x4 o; o[0] = pack2(a[0], a[1]); o[1] = pack2(a[2], a[3]); o[2] = pack2(c[0], c[1]); o[3] = pack2(c[2], c[3]);
                *(u32x4*)(XN + (size_t)row * DM + col) = o;
            }
        }
    }
    convert_tiles(p, smem, 0, T_IN, opaque_bid(), gridDim.x);
}

constexpr int RS = 272;
constexpr int L_QS = 0, L_KS = 34816, L_KT = 69632, L_VT = 104448, L_ST = 121856, L_SC = 139264;

template <bool ML>
__device__ __forceinline__ void load_block(const Params& p, float (&val)[8][4], int b, int p0, int Lv, int rb, int cg, int colbase, int chbase, float mlscale) {
    const bf16_t* U = (const bf16_t*)(p.ws + WS_U);
    const int t0 = rb * 8;
    if (t0 >= Lv) {
#pragma unroll
        for (int r = 0; r < 8; ++r)
#pragma unroll
            for (int i = 0; i < 4; ++i) val[r][i] = 0.f;
        return;
    }
    if (ML) {
#pragma unroll
        for (int r = 0; r < 8; ++r) {
            const int row = row_of(b, p0 + t0 + r);
            const u32x2 raw = *(const u32x2*)(U + (size_t)row * N1P + colbase + cg * 4);
            val[r][0] = bf_lo(raw[0]) * mlscale; val[r][1] = bf_hi(raw[0]) * mlscale; val[r][2] = bf_lo(raw[1]) * mlscale; val[r][3] = bf_hi(raw[1]) * mlscale;
        }
    } else {
        u32x2 raw[11];
#pragma unroll
        for (int rr = 0; rr < 11; ++rr) {
            const int pos = p0 + t0 - 3 + rr;
            if (pos >= 0) raw[rr] = *(const u32x2*)(U + (size_t)row_of(b, pos) * N1P + colbase + cg * 4);
            else raw[rr] = (u32x2){0u, 0u};
        }
        const float* cw = p.in[11]; const float* cb = p.in[12];
        const int ch = chbase + cg * 4;
        f32x4 w[4];
#pragma unroll
        for (int j = 0; j < 4; ++j) w[j] = *(const f32x4*)(cw + j * 2560 + ch);
        const f32x4 bi = *(const f32x4*)(cb + ch);
#pragma unroll
        for (int i = 0; i < 4; ++i) {
            float x[11];
#pragma unroll
            for (int rr = 0; rr < 11; ++rr) x[rr] = (i & 1) ? bf_hi(raw[rr][i >> 1]) : bf_lo(raw[rr][i >> 1]);
#pragma unroll
            for (int r = 0; r < 8; ++r) val[r][i] = silu_f(bi[i] + w[0][i] * x[r] + w[1][i] * x[r + 1] + w[2][i] * x[r + 2] + w[3][i] * x[r + 3]);
        }
    }
}
__device__ __forceinline__ void store_rows(unsigned char* base, const float (&val)[8][4], int rb, int cg) {
#pragma unroll
    for (int r = 0; r < 8; ++r) *(u32x2*)(base + (rb * 8 + r) * RS + cg * 8) = (u32x2){pack2(val[r][0], val[r][1]), pack2(val[r][2], val[r][3])};
}
__device__ __forceinline__ void store_cols(unsigned char* base, const float (&val)[8][4], int rb, int cg, const float* scale) {
    float s[8];
#pragma unroll
    for (int r = 0; r < 8; ++r) s[r] = scale ? scale[rb * 8 + r] : 1.f;
#pragma unroll
    for (int i = 0; i < 4; ++i) {
        const int row = cg * 4 + i;
        u32x4 o; o[0] = pack2(val[0][i] * s[0], val[1][i] * s[1]); o[1] = pack2(val[2][i] * s[2], val[3][i] * s[3]);
        o[2] = pack2(val[4][i] * s[4], val[5][i] * s[5]); o[3] = pack2(val[6][i] * s[6], val[7][i] * s[7]);
        *(u32x4*)(base + row * RS + ((rb ^ ((row >> 3) & 7)) << 4)) = o;
    }
}

template <bool ML>
__device__ __forceinline__ void prompt_scan(const Params& p, unsigned char* smem, int job) {
    const int tid = opaque_tid(), wid = __builtin_amdgcn_readfirstlane(tid >> 6), lane = tid & 63, fr = lane & 15, fq = lane >> 4;
    int b, h, vq = 0;
    if (ML) { b = job >> 5; h = (job >> 2) & 7; vq = job & 3; } else { b = job >> 5; h = job & 31; }
    const int g = h >> 4;
    const bf16_t* U = (const bf16_t*)(p.ws + WS_U);
    const float* SF = (const float*)(p.ws + WS_SF);
    bf16_t* MIX = (bf16_t*)(p.ws + WS_MIX);
    float* scb = (float*)(smem + L_SC);
    float *qn = scb + 1600, *nvec = scb + 1728, *mpp = scb + 1856;
    const int qcol = ML ? UC_Q + h * 128 : UC_XBC + 2304 + g * 128;
    const int kcol = ML ? UC_K + h * 128 : UC_XBC + 2048 + g * 128;
    const int vcol = ML ? UC_V + h * 256 + vq * 64 : UC_XBC + h * 64;
    const int gcol = ML ? UC_O + h * 256 + vq * 64 : UC_Z + h * 64;
    const int mixcol = ML ? 2048 + h * 256 + vq * 64 : h * 64;
    float A_h = 0.f, D_h = 0.f, dtb = 0.f, ib = 0.f, fb = 0.f;
    if (ML) { ib = p.in[17][h]; fb = p.in[18][h]; } else { A_h = -__expf(p.in[14][h]); D_h = p.in[15][h]; dtb = p.in[13][h]; }
    f32x4 st[4];
#pragma unroll
    for (int i = 0; i < 4; ++i) st[i] = (f32x4){0.f, 0.f, 0.f, 0.f};
    for (int i = tid; i < 64 * RS / 16; i += 512) *(u32x4*)(smem + L_ST + i * 16) = (u32x4){0u, 0u, 0u, 0u};
    if (tid < 128) nvec[tid] = 0.f;
    if (tid == 0) mpp[0] = 0.f;
    constexpr int CHLs = ML ? CHL_ML : CHL_SSD;
    float sraw[4] = {0.f, 0.f, 0.f, 0.f};
    auto scal_load = [&](int cc) {
        const int p0 = cc == 0 ? 0 : 16 + (cc - 1) * CHLs, Lv = cc == 0 ? 16 : CHLs;
        const int t0 = 2 * lane, t1 = t0 + 1;
        if (!ML) {
            if (t0 < Lv) sraw[0] = SF[(size_t)row_of(b, p0 + t0) * 64 + h];
            if (t1 < Lv) sraw[1] = SF[(size_t)row_of(b, p0 + t1) * 64 + h];
        } else {
            if (t0 < Lv) { const size_t r = (size_t)row_of(b, p0 + t0) * 64; sraw[0] = SF[r + 32 + h]; sraw[2] = SF[r + 40 + h]; }
            if (t1 < Lv) { const size_t r = (size_t)row_of(b, p0 + t1) * 64; sraw[1] = SF[r + 32 + h]; sraw[3] = SF[r + 40 + h]; }
        }
    };
    auto scalars = [&](int cc) {
        const int Lv = cc == 0 ? 16 : CHLs;
        float* sc = scb + (cc & 1) * 800;
        float *rowv = sc, *colv = sc + 128, *colm = sc + 256, *ev = sc + 384, *scv = sc + 512, *dden = sc + 640, *misc = sc + 768;
        const int t0 = 2 * lane, t1 = t0 + 1;
        if (!ML) {
            float d0 = 0.f, d1 = 0.f;
            if (t0 < Lv) d0 = softplus_f(sraw[0] + dtb);
            if (t1 < Lv) d1 = softplus_f(sraw[1] + dtb);
            const float a0 = d0 * A_h, a1 = d1 * A_h;
            float inc = a0 + a1;
#pragma unroll
            for (int o = 1; o < 64; o <<= 1) { const float y = __shfl_up(inc, o); if (lane >= o) inc += y; }
            const float c1 = inc, c0 = inc - a1, cl = __shfl(inc, 63);
            rowv[t0] = c0; rowv[t1] = c1; colv[t0] = -c0; colv[t1] = -c1; colm[t0] = d0; colm[t1] = d1;
            ev[t0] = __expf(c0); ev[t1] = __expf(c1); scv[t0] = __expf(cl - c0) * d0; scv[t1] = __expf(cl - c1) * d1;
            if (lane == 0) misc[0] = __expf(cl);
        } else {
            float i0 = -INFINITY, i1 = -INFINITY, f0 = 0.f, f1 = 0.f;
            if (t0 < Lv) { i0 = sraw[0] + ib; f0 = logsig_f(sraw[2] + fb); }
            if (t1 < Lv) { i1 = sraw[1] + ib; f1 = logsig_f(sraw[3] + fb); }
            float inc = f0 + f1;
#pragma unroll
            for (int o = 1; o < 64; o <<= 1) { const float y = __shfl_up(inc, o); if (lane >= o) inc += y; }
            const float F1 = inc, F0 = inc - f1;
            const float g0 = i0 - F0, g1 = i1 - F1;
            float mx = fmaxf(g0, g1);
#pragma unroll
            for (int o = 1; o < 64; o <<= 1) { const float y = __shfl_up(mx, o); if (lane >= o) mx = fmaxf(mx, y); }
            float ex = __shfl_up(mx, 1); if (lane == 0) ex = -INFINITY;
            const float mp = mpp[0];
            const float M0 = fmaxf(fmaxf(ex, g0), mp), M1 = fmaxf(mx, mp);
            const float Ml = __shfl(M1, 63), Fl = __shfl(F1, 63);
            rowv[t0] = -M0; rowv[t1] = -M1; colv[t0] = g0; colv[t1] = g1; colm[t0] = 1.f; colm[t1] = 1.f;
            ev[t0] = __expf(mp - M0); ev[t1] = __expf(mp - M1); dden[t0] = __expf(-(F0 + M0)); dden[t1] = __expf(-(F1 + M1));
            scv[t0] = __expf(g0 - Ml); scv[t1] = __expf(g1 - Ml);
            if (lane == 0) { misc[0] = __expf(mp - Ml); mpp[0] = Fl + Ml; }
        }
    };
    __syncthreads();
    if (wid == 0) { scal_load(0); scalars(0); }
    __syncthreads();
    constexpr int CHL = ML ? CHL_ML : CHL_SSD, NCH = 1 + 2048 / CHL;
    const int tid_outer = tid;
    for (int c = 0; c < NCH; ++c) {
        int tid = tid_outer; asm volatile("" : "+v"(tid));
        const int lane = tid & 63, fr = lane & 15, fq = lane >> 4;
        const int p0 = c == 0 ? 0 : 16 + (c - 1) * CHL, Lv = c == 0 ? 16 : CHL;
        float* sc = scb + (c & 1) * 800;
        float *rowv = sc, *colv = sc + 128, *colm = sc + 256, *ev = sc + 384, *scv = sc + 512, *dden = sc + 640, *misc = sc + 768;
        if (wid == 0 && c + 1 < NCH) scal_load(c + 1);
        {
            float val[8][4];
            load_block<ML>(p, val, b, p0, Lv, tid >> 5, tid & 31, qcol, 2304 + g * 128, 1.f);
            store_rows(smem + L_QS, val, tid >> 5, tid & 31);
            __builtin_amdgcn_sched_barrier(0);
            load_block<ML>(p, val, b, p0, Lv, tid >> 5, tid & 31, kcol, 2048 + g * 128, 0.08838834764831845f);
            store_rows(smem + L_KS, val, tid >> 5, tid & 31);
            store_cols(smem + L_KT, val, tid >> 5, tid & 31, scv);
            __builtin_amdgcn_sched_barrier(0);
            if (tid < 256) {
                load_block<ML>(p, val, b, p0, Lv, tid >> 4, tid & 15, vcol, h * 64, 1.f);
                store_cols(smem + L_VT, val, tid >> 4, tid & 15, nullptr);
            }
        }
        __syncthreads();
        const int t = 16 * wid + fr;
        const bool valid = t < Lv;
        const int row = row_of(b, p0 + (valid ? t : 0));
        u32x2 gate[4];
#pragma unroll
        for (int vb = 0; vb < 4; ++vb) gate[vb] = *(const u32x2*)(U + (size_t)row * N1P + gcol + 16 * vb + 4 * fq);
        if (ML) {
            const int tt = tid >> 2, part = tid & 3;
            float s = 0.f;
#pragma unroll
            for (int cc = 0; cc < 4; ++cc) {
                const u32x4 raw = *(const u32x4*)(smem + L_QS + tt * RS + (part * 4 + cc) * 16);
                const f32x4 n0 = *(const f32x4*)(nvec + (part * 4 + cc) * 8), n1 = *(const f32x4*)(nvec + (part * 4 + cc) * 8 + 4);
                s += bf_lo(raw[0]) * n0[0] + bf_hi(raw[0]) * n0[1] + bf_lo(raw[1]) * n0[2] + bf_hi(raw[1]) * n0[3]
                   + bf_lo(raw[2]) * n1[0] + bf_hi(raw[2]) * n1[1] + bf_lo(raw[3]) * n1[2] + bf_hi(raw[3]) * n1[3];
            }
            s += __shfl_xor(s, 1); s += __shfl_xor(s, 2);
            if (part == 0) qn[tt] = s;
        }
        bf16x8 qf[4];
#pragma unroll
        for (int kk = 0; kk < 4; ++kk) qf[kk] = *(const bf16x8*)(smem + L_QS + t * RS + (kk * 32 + fq * 8) * 2);
        const float rv = rowv[t];
        float rowsum = 0.f;
        u32x2 pk[8];
#pragma unroll
        for (int sb = 0; sb < 8; ++sb) {
            pk[sb] = (u32x2){0u, 0u};
            if (sb <= wid) {
                f32x4 acc = {0.f, 0.f, 0.f, 0.f};
#pragma unroll
                for (int kk = 0; kk < 4; ++kk) {
                    const bf16x8 kf = *(const bf16x8*)(smem + L_KS + (16 * sb + fr) * RS + (kk * 32 + fq * 8) * 2);
                    acc = __builtin_amdgcn_mfma_f32_16x16x32_bf16(kf, qf[kk], acc, 0, 0, 0);
                }
                const f32x4 cv = *(const f32x4*)(colv + 16 * sb + 4 * fq), cm = *(const f32x4*)(colm + 16 * sb + 4 * fq);
                float pv[4];
#pragma unroll
                for (int j = 0; j < 4; ++j) {
                    const int s = 16 * sb + 4 * fq + j;
                    const float w = (s <= t) ? __expf(rv + cv[j]) * cm[j] : 0.f;
                    pv[j] = acc[j] * w; rowsum += pv[j];
                }
                pk[sb] = (u32x2){pack2(pv[0], pv[1]), pack2(pv[2], pv[3])};
            }
        }
        if (wid == 0 && c + 1 < NCH) scalars(c + 1);
        __syncthreads();
#pragma unroll
        for (int sb = 0; sb < 8; ++sb) *(u32x2*)(smem + L_KS + t * RS + (16 * sb + 4 * fq) * 2) = pk[sb];
        rowsum += __shfl_xor(rowsum, 16); rowsum += __shfl_xor(rowsum, 32);
        if (ML) {
            const int d = tid >> 2, part = tid & 3;
            float s = 0.f;
#pragma unroll
            for (int cc = 0; cc < 4; ++cc) {
                const u32x4 raw = *(const u32x4*)(smem + L_KT + d * RS + (part * 4 + cc) * 16);
                s += bf_lo(raw[0]) + bf_hi(raw[0]) + bf_lo(raw[1]) + bf_hi(raw[1]) + bf_lo(raw[2]) + bf_hi(raw[2]) + bf_lo(raw[3]) + bf_hi(raw[3]);
            }
            s += __shfl_xor(s, 1); s += __shfl_xor(s, 2);
            if (part == 0) nvec[d] = misc[0] * nvec[d] + s;
        }
        __syncthreads();
        bf16x8 pf[4];
#pragma unroll
        for (int kk = 0; kk < 4; ++kk) pf[kk] = *(const bf16x8*)(smem + L_KS + t * RS + (kk * 32 + fq * 8) * 2);
        const float et = ev[t];
        float ddv = 1.f;
        if (ML) ddv = fmaxf(fabsf(rowsum + et * qn[t]), dden[t]);
        float ss = 0.f;
#pragma unroll
        for (int vb = 0; vb < 4; ++vb) {
            f32x4 acc = {0.f, 0.f, 0.f, 0.f};
            const int vrow = 16 * vb + fr;
#pragma unroll
            for (int kk = 0; kk < 4; ++kk) {
                const bf16x8 sf = *(const bf16x8*)(smem + L_ST + vrow * RS + (kk * 32 + fq * 8) * 2);
                acc = __builtin_amdgcn_mfma_f32_16x16x32_bf16(sf, qf[kk], acc, 0, 0, 0);
            }
            acc *= et;
#pragma unroll
            for (int kk = 0; kk < 4; ++kk) {
                const bf16x8 vf = *(const bf16x8*)(smem + L_VT + vrow * RS + (((kk * 4 + fq) ^ ((vrow >> 3) & 7)) << 4));
                acc = __builtin_amdgcn_mfma_f32_16x16x32_bf16(vf, pf[kk], acc, 0, 0, 0);
            }
            const float gz[4] = {bf_lo(gate[vb][0]), bf_hi(gate[vb][0]), bf_lo(gate[vb][1]), bf_hi(gate[vb][1])};
            float o[4];
#pragma unroll
            for (int j = 0; j < 4; ++j) {
                if (ML) { const float hv = acc[j]; ss += hv * hv; o[j] = hv * sigm_f(gz[j]); }
                else {
                    const int v = 16 * vb + 4 * fq + j;
                    const float xv = bf2f(*(const bf16_t*)(smem + L_VT + v * RS + (((t >> 3) ^ ((v >> 3) & 7)) << 4) + (t & 7) * 2));
                    const float y = (acc[j] + D_h * xv) * silu_f(gz[j]); ss += y * y; o[j] = y;
                }
            }
            if (valid) *(u32x2*)(MIX + (size_t)row * MIXW + mixcol + 16 * vb + 4 * fq) = (u32x2){pack2(o[0], o[1]), pack2(o[2], o[3])};
        }
        ss += __shfl_xor(ss, 16); ss += __shfl_xor(ss, 32);
        if (valid && fq == 0) {
            if (ML) { ((float*)(p.ws + WS_SSQM))[(size_t)row * 32 + h * 4 + vq] = ss; if (vq == 0) ((float*)(p.ws + WS_DD))[(size_t)row * 8 + h] = ddv; }
            else ((float*)(p.ws + WS_SSQ))[(size_t)row * 32 + h] = ss;
        }
        const float dec = misc[0];
#pragma unroll
        for (int vb = 0; vb < 4; ++vb) st[vb] *= dec;
#pragma unroll
        for (int kk = 0; kk < 4; ++kk) {
            const int drow = 16 * wid + fr;
            const bf16x8 kf = *(const bf16x8*)(smem + L_KT + drow * RS + (((kk * 4 + fq) ^ ((drow >> 3) & 7)) << 4));
#pragma unroll
            for (int vb = 0; vb < 4; ++vb) {
                const int vrow = 16 * vb + fr;
                const bf16x8 vf = *(const bf16x8*)(smem + L_VT + vrow * RS + (((kk * 4 + fq) ^ ((vrow >> 3) & 7)) << 4));
                st[vb] = __builtin_amdgcn_mfma_f32_16x16x32_bf16(kf, vf, st[vb], 0, 0, 0);
            }
        }
        __syncthreads();
#pragma unroll
        for (int vb = 0; vb < 4; ++vb)
            *(u32x2*)(smem + L_ST + (16 * vb + fr) * RS + (16 * wid + 4 * fq) * 2) = (u32x2){pack2(st[vb][0], st[vb][1]), pack2(st[vb][2], st[vb][3])};
    }
#pragma unroll
    for (int vb = 0; vb < 4; ++vb) {
        const int v = 16 * vb + fr, d0 = 16 * wid + 4 * fq;
        if (!ML) *(f32x4*)(p.out + O_P_SSD + ((size_t)(b * 32 + h) * 64 + v) * 128 + d0) = st[vb];
        else {
#pragma unroll
            for (int j = 0; j < 4; ++j) p.out[O_P_MLC + ((size_t)(b * 8 + h) * 128 + d0 + j) * 256 + vq * 64 + v] = st[vb][j];
        }
    }
    if (ML && vq == 0) {
        if (tid < 128) p.out[O_P_MLN + (size_t)(b * 8 + h) * 128 + tid] = nvec[tid];
        if (tid == 0) p.out[O_P_MLM + b * 8 + h] = mpp[0];
    }
    __syncthreads();
}

__device__ __forceinline__ void sample_ssd(const Params& p, unsigned char* smem, int job) {
    const int tid = opaque_tid(), wid = tid >> 6, lane = tid & 63;
    const int b = job >> 1, g = job & 1, rowb = ROW_SAMPLE + b * 8;
    const bf16_t* U = (const bf16_t*)(p.ws + WS_U);
    const float* SF = (const float*)(p.ws + WS_SF);
    bf16_t* MIX = (bf16_t*)(p.ws + WS_MIX);
    float* Bc = (float*)smem; float* Cc = Bc + 1024; float* xall = Cc + 1024; float* G = xall + 8192; float* dts = G + 64; float* ssqp = dts + 128;
    const float* sconv = p.in[2]; const float* cw = p.in[11]; const float* cb = p.in[12];
#pragma unroll
    for (int q = 0; q < 3; ++q) {
        int ch; float* dst; int dstride = 0;
        if (q < 2) { ch = g * 1024 + tid + q * 512; dst = xall + tid + q * 512; dstride = 1024; }
        else { if (tid >= 256) break; const int which = tid >> 7, n = tid & 127; ch = 2048 + which * 256 + g * 128 + n; dst = (which ? Cc : Bc) + n; dstride = 128; }
        float xm3 = sconv[(size_t)(b * 3 + 0) * 2560 + ch], xm2 = sconv[(size_t)(b * 3 + 1) * 2560 + ch], xm1 = sconv[(size_t)(b * 3 + 2) * 2560 + ch];
        const float w0 = cw[ch], w1 = cw[2560 + ch], w2 = cw[5120 + ch], w3 = cw[7680 + ch], bb = cb[ch];
#pragma unroll
        for (int t = 0; t < 8; ++t) {
            const float x = bf2f(U[(size_t)(rowb + t) * N1P + UC_XBC + ch]);
            dst[t * dstride] = silu_f(bb + w0 * xm3 + w1 * xm2 + w2 * xm1 + w3 * x);
            xm3 = xm2; xm2 = xm1; xm1 = x;
        }
    }
    if (tid < 128) { const int hh = tid >> 3, t = tid & 7; dts[tid] = softplus_f(SF[(size_t)(rowb + t) * 64 + g * 16 + hh] + p.in[13][g * 16 + hh]); }
    __syncthreads();
    {
        const int pair = tid >> 3, part = tid & 7, t = pair >> 3, s = pair & 7;
        float sum = 0.f;
#pragma unroll
        for (int i = 0; i < 4; ++i) {
            const f32x4 c4 = *(const f32x4*)(Cc + t * 128 + part * 16 + i * 4), b4 = *(const f32x4*)(Bc + s * 128 + part * 16 + i * 4);
            sum += c4[0] * b4[0] + c4[1] * b4[1] + c4[2] * b4[2] + c4[3] * b4[3];
        }
        sum += __shfl_xor(sum, 1); sum += __shfl_xor(sum, 2); sum += __shfl_xor(sum, 4);
        if (part == 0) G[pair] = sum;
    }
    __syncthreads();
    const int pp = tid >> 3, nq = tid & 7;
    f32x4 snext[4];
#pragma unroll
    for (int i = 0; i < 4; ++i) snext[i] = __builtin_nontemporal_load((const f32x4*)(p.in[3] + ((size_t)(b * 32 + g * 16) * 64 + pp) * 128 + nq * 4 + 32 * i));
    for (int hh = 0; hh < 16; ++hh) {
        const int h = g * 16 + hh;
        const float A_h = -__expf(p.in[14][h]), D_h = p.in[15][h];
        float dtv[8], cum[8];
        { float run = 0.f;
#pragma unroll
          for (int t = 0; t < 8; ++t) { dtv[t] = dts[hh * 8 + t]; run += dtv[t] * A_h; cum[t] = run; } }
        const size_t soff = ((size_t)(b * 32 + h) * 64 + pp) * 128 + nq * 4;
        f32x4 s0[4];
#pragma unroll
        for (int i = 0; i < 4; ++i) s0[i] = snext[i];
        if (hh + 1 < 16) {
#pragma unroll
            for (int i = 0; i < 4; ++i) snext[i] = __builtin_nontemporal_load((const f32x4*)(p.in[3] + soff + 64 * 128 + 32 * i));
        }
        float cs[8];
#pragma unroll
        for (int t = 0; t < 8; ++t) {
            float sum = 0.f;
#pragma unroll
            for (int i = 0; i < 4; ++i) { const f32x4 c4 = *(const f32x4*)(Cc + t * 128 + nq * 4 + 32 * i); sum += c4[0] * s0[i][0] + c4[1] * s0[i][1] + c4[2] * s0[i][2] + c4[3] * s0[i][3]; }
            sum += __shfl_xor(sum, 1); sum += __shfl_xor(sum, 2); sum += __shfl_xor(sum, 4);
            cs[t] = sum;
        }
        float ycs = 0.f, ct = 0.f;
#pragma unroll
        for (int t = 0; t < 8; ++t) { ycs = (nq == t) ? cs[t] : ycs; ct = (nq == t) ? cum[t] : ct; }
        float y = __expf(ct) * ycs, xt = 0.f;
#pragma unroll
        for (int s = 0; s < 8; ++s) {
            const float xs = xall[s * 1024 + hh * 64 + pp];
            const float term = (s <= nq) ? G[nq * 8 + s] * __expf(ct - cum[s]) * dtv[s] * xs : 0.f;
            y += term; xt = (s == nq) ? xs : xt;
        }
        y += D_h * xt;
        const float z = bf2f(U[(size_t)(rowb + nq) * N1P + UC_Z + h * 64 + pp]);
        y *= silu_f(z);
        { const unsigned pk = pack2(y, 0.f); MIX[(size_t)(rowb + nq) * MIXW + h * 64 + pp] = (bf16_t)(pk & 0xffffu); }
        float sq = y * y; sq += __shfl_xor(sq, 8); sq += __shfl_xor(sq, 16); sq += __shfl_xor(sq, 32);
        if (lane < 8) ssqp[(hh * 8 + wid) * 8 + lane] = sq;
        const float cl = cum[7], dec = __expf(cl);
        float xw[8];
#pragma unroll
        for (int s = 0; s < 8; ++s) xw[s] = __expf(cl - cum[s]) * dtv[s] * xall[s * 1024 + hh * 64 + pp];
#pragma unroll
        for (int i = 0; i < 4; ++i) {
            f32x4 acc = s0[i] * dec;
#pragma unroll
            for (int s = 0; s < 8; ++s) acc += xw[s] * *(const f32x4*)(Bc + s * 128 + nq * 4 + 32 * i);
            __builtin_nontemporal_store(acc, (f32x4*)(p.out + O_S_SSD + soff + 32 * i));
        }
    }
    __syncthreads();
    if (tid < 128) {
        const int hh = tid >> 3, t = tid & 7; float tot = 0.f;
#pragma unroll
        for (int w = 0; w < 8; ++w) tot += ssqp[(hh * 8 + w) * 8 + t];
        ((float*)(p.ws + WS_SSQ))[(size_t)(rowb + t) * 32 + g * 16 + hh] = tot;
    }
    __syncthreads();
}

__device__ __forceinline__ void sample_ml(const Params& p, unsigned char* smem, int job) {
    const int tid = opaque_tid(), wid = __builtin_amdgcn_readfirstlane(tid >> 6), lane = tid & 63;
    const int b = job >> 3, h = job & 7, rowb = ROW_SAMPLE + b * 8;
    const bf16_t* U = (const bf16_t*)(p.ws + WS_U);
    const float* SF = (const float*)(p.ws + WS_SF);
    bf16_t* MIX = (bf16_t*)(p.ws + WS_MIX);
    float* qs = (float*)smem; float* ks = qs + 1024; float* vs = qs + 2048; float* QK = qs + 4096; float* sig = qs + 4160; float* slf = qs + 4168;
    float* qnv = qs + 4176; float* n0v = qs + 4192; float* red = qs + 4352;
    {
        const int t = tid >> 6, c = tid & 63;
        const size_t r = (size_t)(rowb + t) * N1P;
        const unsigned qq = *(const unsigned*)(U + r + UC_Q + h * 128 + 2 * c), kk = *(const unsigned*)(U + r + UC_K + h * 128 + 2 * c);
        const u32x2 vv = *(const u32x2*)(U + r + UC_V + h * 256 + 4 * c);
        qs[t * 128 + 2 * c] = bf_lo(qq); qs[t * 128 + 2 * c + 1] = bf_hi(qq);
        ks[t * 128 + 2 * c] = bf_lo(kk) * 0.08838834764831845f; ks[t * 128 + 2 * c + 1] = bf_hi(kk) * 0.08838834764831845f;
        *(f32x4*)(vs + t * 256 + 4 * c) = (f32x4){bf_lo(vv[0]), bf_hi(vv[0]), bf_lo(vv[1]), bf_hi(vv[1])};
        if (tid < 8) { sig[tid] = SF[(size_t)(rowb + tid) * 64 + 32 + h] + p.in[17][h]; slf[tid] = logsig_f(SF[(size_t)(rowb + tid) * 64 + 40 + h] + p.in[18][h]); }
        if (tid >= 128 && tid < 256) n0v[tid - 128] = p.in[5][(size_t)(b * 8 + h) * 128 + tid - 128];
    }
    const int v4 = lane, dg = wid;
    const size_t coff = ((size_t)(b * 8 + h) * 128 + dg * 16) * 256 + v4 * 4;
    f32x4 c0[16];
#pragma unroll
    for (int i = 0; i < 16; ++i) c0[i] = __builtin_nontemporal_load((const f32x4*)(p.in[4] + coff + (size_t)i * 256));
    const float mp = p.in[6][b * 8 + h];
    __syncthreads();
    float F[8], gg[8], M[8];
    { float run = 0.f, pm = -INFINITY;
#pragma unroll
      for (int t = 0; t < 8; ++t) { run += slf[t]; F[t] = run; gg[t] = sig[t] - run; pm = fmaxf(pm, gg[t]); M[t] = fmaxf(pm, mp); } }
    const float Ml = M[7], dec = __expf(mp - Ml), m_new = F[7] + Ml;
    {
        const int pair = tid >> 3, part = tid & 7, t = pair >> 3, s = pair & 7;
        float sum = 0.f;
#pragma unroll
        for (int i = 0; i < 4; ++i) {
            const f32x4 a4 = *(const f32x4*)(qs + t * 128 + part * 16 + i * 4), b4 = *(const f32x4*)(ks + s * 128 + part * 16 + i * 4);
            sum += a4[0] * b4[0] + a4[1] * b4[1] + a4[2] * b4[2] + a4[3] * b4[3];
        }
        sum += __shfl_xor(sum, 1); sum += __shfl_xor(sum, 2); sum += __shfl_xor(sum, 4);
        if (part == 0) QK[pair] = sum;
        float qd = qs[wid * 128 + 2 * lane] * n0v[2 * lane] + qs[wid * 128 + 2 * lane + 1] * n0v[2 * lane + 1];
        qd = wave_sum(qd);
        if (lane == 0) qnv[wid] = qd;
    }
#pragma unroll
    for (int t = 0; t < 8; ++t) {
        f32x4 acc = {0.f, 0.f, 0.f, 0.f};
#pragma unroll
        for (int i4 = 0; i4 < 4; ++i4) {
            const f32x4 q4 = *(const f32x4*)(qs + t * 128 + dg * 16 + i4 * 4);
            acc += q4[0] * c0[i4 * 4] + q4[1] * c0[i4 * 4 + 1] + q4[2] * c0[i4 * 4 + 2] + q4[3] * c0[i4 * 4 + 3];
        }
        *(f32x4*)(red + (dg * 8 + t) * 256 + v4 * 4) = acc;
    }
    __syncthreads();
    f32x4 vv[8];
    float scs[8];
#pragma unroll
    for (int s = 0; s < 8; ++s) { vv[s] = *(const f32x4*)(vs + s * 256 + v4 * 4); scs[s] = __expf(gg[s] - Ml); }
#pragma unroll
    for (int i = 0; i < 16; ++i) {
        const int d = dg * 16 + i;
        f32x4 cn = c0[i] * dec;
#pragma unroll
        for (int s = 0; s < 8; ++s) cn += (scs[s] * ks[s * 128 + d]) * vv[s];
        __builtin_nontemporal_store(cn, (f32x4*)(p.out + O_S_MLC + coff + (size_t)i * 256));
    }
    if (tid < 128) {
        float nn = dec * n0v[tid];
#pragma unroll
        for (int s = 0; s < 8; ++s) nn += scs[s] * ks[s * 128 + tid];
        p.out[O_S_MLN + (size_t)(b * 8 + h) * 128 + tid] = nn;
    }
    if (tid == 0) p.out[O_S_MLM + b * 8 + h] = m_new;
    {
        const int t = wid;
        float Mt = 0.f, Ft = 0.f;
#pragma unroll
        for (int q = 0; q < 8; ++q) { Mt = (t == q) ? M[q] : Mt; Ft = (t == q) ? F[q] : Ft; }
        f32x4 numc = {0.f, 0.f, 0.f, 0.f};
#pragma unroll
        for (int q = 0; q < 8; ++q) numc += *(const f32x4*)(red + (q * 8 + t) * 256 + lane * 4);
        const float et = __expf(mp - Mt);
        float den = et * qnv[t];
        f32x4 intra = {0.f, 0.f, 0.f, 0.f};
#pragma unroll
        for (int s = 0; s < 8; ++s) {
            if (s <= t) { const float w = __expf(gg[s] - Mt) * QK[t * 8 + s]; den += w; intra += w * vv[s]; }
        }
        const float dd = fmaxf(fabsf(den), __expf(-(Ft + Mt)));
        const f32x4 hv = (et * numc + intra) * (1.f / dd);
        float ss = hv[0] * hv[0] + hv[1] * hv[1] + hv[2] * hv[2] + hv[3] * hv[3];
        ss = wave_sum(ss);
        const u32x2 og = *(const u32x2*)(U + (size_t)(rowb + t) * N1P + UC_O + h * 256 + lane * 4);
        *(u32x2*)(MIX + (size_t)(rowb + t) * MIXW + 2048 + h * 256 + lane * 4) =
            (u32x2){pack2(hv[0] * sigm_f(bf_lo(og[0])), hv[1] * sigm_f(bf_hi(og[0]))), pack2(hv[2] * sigm_f(bf_lo(og[1])), hv[3] * sigm_f(bf_hi(og[1])))};
        if (lane < 4) ((float*)(p.ws + WS_SSQM))[(size_t)(rowb + t) * 32 + h * 4 + lane] = lane == 0 ? ss : 0.f;
        if (lane == 0) ((float*)(p.ws + WS_DD))[(size_t)(rowb + t) * 8 + h] = 1.f;
    }
    __syncthreads();
}

__device__ __forceinline__ void phase_scan(const Params& p, unsigned char* smem) {
#ifndef SC_MASK
#define SC_MASK 15
#endif
    for (int j = opaque_bid(); j < 256; j += gridDim.x) { if (j < 128) { if (SC_MASK & 1) prompt_scan<false>(p, smem, j); } else { if (SC_MASK & 2) prompt_scan<true>(p, smem, j - 128); } }
    if (SC_MASK & 4) for (int j = opaque_bid(); j < 256; j += gridDim.x) sample_ssd(p, smem, j);
    if (SC_MASK & 8) for (int j = opaque_bid(); j < 1024; j += gridDim.x) sample_ml(p, smem, j);
}

__device__ __forceinline__ void phase_mixnorm(const Params& p) {
    const int tid = opaque_tid(), wid = tid >> 6, lane = tid & 63;
    bf16_t* MIX = (bf16_t*)(p.ws + WS_MIX);
    const float* SSQ = (const float*)(p.ws + WS_SSQ); const float* SSQM = (const float*)(p.ws + WS_SSQM);
    const float* w1 = p.in[16]; const float* w2 = p.in[19];
    for (int row = opaque_bid() * 8 + wid; row < NVALID; row += gridDim.x * 8) {
        float s = lane < 32 ? SSQ[(size_t)row * 32 + lane] : 0.f;
        s = wave_sum(s);
        const float r1 = rsqrtf(s * (1.f / 2048.f) + EPS);
        float m = lane < 32 ? SSQM[(size_t)row * 32 + lane] : 0.f;
        m += __shfl_xor(m, 1); m += __shfl_xor(m, 2);
        const float ddh = lane < 32 ? ((const float*)(p.ws + WS_DD))[(size_t)row * 8 + (lane >> 2)] : 1.f;
        const float idd = 1.f / ddh;
        const float rh = rsqrtf(m * (1.f / 256.f) * idd * idd + EPS) * idd;
        u32x4 raws[8];
#pragma unroll
        for (int it = 0; it < 8; ++it) raws[it] = *(const u32x4*)(MIX + (size_t)row * MIXW + it * 512 + lane * 8);
#pragma unroll
        for (int it = 0; it < 8; ++it) {
            const int col = it * 512 + lane * 8;
            const u32x4 raw = raws[it];
            float scale; const float* wp;
            if (it < 4) { scale = r1; wp = w1 + col; }
            else { const int head = (it - 4) * 2 + (lane >> 5); scale = __shfl(rh, head * 4); wp = w2 + col - 2048; }
            const f32x4 wa = *(const f32x4*)wp, wb = *(const f32x4*)(wp + 4);
            u32x4 o;
            o[0] = pack2(bf_lo(raw[0]) * scale * wa[0], bf_hi(raw[0]) * scale * wa[1]); o[1] = pack2(bf_lo(raw[1]) * scale * wa[2], bf_hi(raw[1]) * scale * wa[3]);
            o[2] = pack2(bf_lo(raw[2]) * scale * wb[0], bf_hi(raw[2]) * scale * wb[1]); o[3] = pack2(bf_lo(raw[3]) * scale * wb[2], bf_hi(raw[3]) * scale * wb[3]);
            *(u32x4*)(MIX + (size_t)row * MIXW + col) = o;
        }
    }
    const bf16_t* U = (const bf16_t*)(p.ws + WS_U);
    for (int i = opaque_bid() * 512 + tid; i < 132 * 3 * 320; i += gridDim.x * 512) {
        const int cgp = i % 320, j = (i / 320) % 3, q = i / 960;
        int row; float* dst;
        if (q < 4) { row = q * 2048 + 2045 + j; dst = p.out + O_P_SSDCONV + (size_t)(q * 3 + j) * 2560 + cgp * 8; }
        else { row = ROW_SAMPLE + (q - 4) * 8 + 5 + j; dst = p.out + O_S_SSDCONV + (size_t)((q - 4) * 3 + j) * 2560 + cgp * 8; }
        const u32x4 raw = *(const u32x4*)(U + (size_t)row * N1P + UC_XBC + cgp * 8);
        *(f32x4*)dst = (f32x4){bf_lo(raw[0]), bf_hi(raw[0]), bf_lo(raw[1]), bf_hi(raw[1])};
        *(f32x4*)(dst + 4) = (f32x4){bf_lo(raw[2]), bf_hi(raw[2]), bf_lo(raw[3]), bf_hi(raw[3])};
    }
}

__device__ __forceinline__ void unpack8(const u32x4 raw, float (&x)[8]) {
#pragma unroll
    for (int i = 0; i < 4; ++i) { x[2 * i] = bf_lo(raw[i]); x[2 * i + 1] = bf_hi(raw[i]); }
}
__device__ __forceinline__ void phase_act(const Params& p) {
    const bf16_t* UP = (const bf16_t*)(p.ws + WS_UP); bf16_t* ACT = (bf16_t*)(p.ws + WS_ACT);
    const float* cw = p.in[23]; const float* cb = p.in[24]; const float* fst = p.in[7];
    constexpr int CGN = DFF / 8, TOTAL = (NVALID / 8) * CGN;
    const int tid = opaque_tid();
    for (int idx = opaque_bid() * 512 + tid; idx < TOTAL; idx += gridDim.x * 512) {
        const int rb = idx / CGN, cgp = idx % CGN, row0 = rb * 8, c0 = cgp * 8;
        float g2[8], g1[8], v2[8], v1[8];
        int prow = -1; bool from_state = false; int sb = 0, pb = -1;
        if (row0 < ROW_SAMPLE) { const int b = row0 >> 11, t0 = row0 & 2047; prow = t0 > 0 ? row0 - 2 : ROW_META + b * 16 + 14; if (t0 == 2040) pb = b; }
        else if (row0 < ROW_META) { from_state = true; sb = (row0 - ROW_SAMPLE) >> 3; }
        else { if ((row0 - ROW_META) & 15) prow = row0 - 2; }
        if (from_state) {
            const float* s0 = fst + (size_t)(sb * 2) * N3;
#pragma unroll
            for (int i = 0; i < 8; ++i) { g2[i] = s0[c0 + i]; g1[i] = s0[N3 + c0 + i]; v2[i] = s0[DFF + c0 + i]; v1[i] = s0[N3 + DFF + c0 + i]; }
        } else if (prow >= 0) {
            unpack8(*(const u32x4*)(UP + (size_t)prow * N3 + c0), g2); unpack8(*(const u32x4*)(UP + (size_t)(prow + 1) * N3 + c0), g1);
            unpack8(*(const u32x4*)(UP + (size_t)prow * N3 + DFF + c0), v2); unpack8(*(const u32x4*)(UP + (size_t)(prow + 1) * N3 + DFF + c0), v1);
        } else {
#pragma unroll
            for (int i = 0; i < 8; ++i) { g2[i] = 0.f; g1[i] = 0.f; v2[i] = 0.f; v1[i] = 0.f; }
        }
        float wg[3][8], wv[3][8], bg[8], bv[8];
#pragma unroll
        for (int j = 0; j < 3; ++j)
#pragma unroll
            for (int i = 0; i < 8; ++i) { wg[j][i] = cw[j * N3 + c0 + i]; wv[j][i] = cw[j * N3 + DFF + c0 + i]; }
#pragma unroll
        for (int i = 0; i < 8; ++i) { bg[i] = cb[c0 + i]; bv[i] = cb[DFF + c0 + i]; }
        u32x4 rg[8], rv[8];
#pragma unroll
        for (int r = 0; r < 8; ++r) { rg[r] = *(const u32x4*)(UP + (size_t)(row0 + r) * N3 + c0); rv[r] = *(const u32x4*)(UP + (size_t)(row0 + r) * N3 + DFF + c0); }
#pragma unroll
        for (int r = 0; r < 8; ++r) {
            float gx[8], vx[8];
            unpack8(rg[r], gx); unpack8(rv[r], vx);
            float o[8];
#pragma unroll
            for (int i = 0; i < 8; ++i) {
                const float yg = bg[i] + wg[0][i] * g2[i] + wg[1][i] * g1[i] + wg[2][i] * gx[i];
                const float yv = bv[i] + wv[0][i] * v2[i] + wv[1][i] * v1[i] + wv[2][i] * vx[i];
                o[i] = silu_f(yg) * yv;
                g2[i] = g1[i]; g1[i] = gx[i]; v2[i] = v1[i]; v1[i] = vx[i];
            }
            u32x4 ov; ov[0] = pack2(o[0], o[1]); ov[1] = pack2(o[2], o[3]); ov[2] = pack2(o[4], o[5]); ov[3] = pack2(o[6], o[7]);
            *(u32x4*)(ACT + (size_t)(row0 + r) * DFF + c0) = ov;
        }
        if (from_state || pb >= 0) {
            float* dst = from_state ? p.out + O_S_FFN + (size_t)(sb * 2) * N3 : p.out + O_P_FFN + (size_t)(pb * 2) * N3;
            *(f32x4*)(dst + c0) = (f32x4){g2[0], g2[1], g2[2], g2[3]}; *(f32x4*)(dst + c0 + 4) = (f32x4){g2[4], g2[5], g2[6], g2[7]};
            *(f32x4*)(dst + N3 + c0) = (f32x4){g1[0], g1[1], g1[2], g1[3]}; *(f32x4*)(dst + N3 + c0 + 4) = (f32x4){g1[4], g1[5], g1[6], g1[7]};
            *(f32x4*)(dst + DFF + c0) = (f32x4){v2[0], v2[1], v2[2], v2[3]}; *(f32x4*)(dst + DFF + c0 + 4) = (f32x4){v2[4], v2[5], v2[6], v2[7]};
            *(f32x4*)(dst + N3 + DFF + c0) = (f32x4){v1[0], v1[1], v1[2], v1[3]}; *(f32x4*)(dst + N3 + DFF + c0 + 4) = (f32x4){v1[4], v1[5], v1[6], v1[7]};
        }
    }
}

__device__ __forceinline__ void phase_final(const Params& p) {
    const int tid = opaque_tid(), wid = tid >> 6, lane = tid & 63;
    const float* SS3 = (const float*)(p.ws + WS_SS3); const float* nw = p.in[26];
    for (int row = opaque_bid() * 8 + wid; row < NOUTROWS; row += gridDim.x * 8) {
        const float r = rsqrtf(SS3[row] * (1.f / 2048.f) + EPS);
        float* rp = p.out + (size_t)row * DM;
        f32x4 v[8];
#pragma unroll
        for (int it = 0; it < 8; ++it) v[it] = *(const f32x4*)(rp + it * 256 + lane * 4);
#pragma unroll
        for (int it = 0; it < 8; ++it) {
            const int col = it * 256 + lane * 4;
            const f32x4 w = *(const f32x4*)(nw + col);
            *(f32x4*)(rp + col) = v[it] * r * w;
        }
    }
}

__global__ void __launch_bounds__(512, 2) hymba_fwd(Params p0) {
    extern __shared__ __attribute__((aligned(16))) unsigned char smem[];
    cg::grid_group grid = cg::this_grid();
#ifndef DUP_PHASE
#define DUP_PHASE -1
#endif
    for (int phx = p0.ph_lo; phx < p0.ph_hi + (DUP_PHASE >= 0 ? 1 : 0); ++phx) {
        const int ph = (DUP_PHASE >= 0 && phx > DUP_PHASE) ? phx - 1 : phx;
        Params p = p0;
        { size_t z = 0; asm volatile("" : "+s"(z)); p.ws = p0.ws + z; p.out = p0.out + z; }
        switch (ph) {
        case 0: if (PH_MASK & 1) phase_prep(p, smem); break;
        case 1: if (PH_MASK & 2) { pg8::Gemm g{(const bf16_t*)(p.ws + WS_XN), (const bf16_t*)(p.ws + WS_WIN), MP, N1P, 2048}; pg8::StaticOrder S; S.init(MP, N1P, gridDim.x, opaque_bid());
                  Epi1 E{(bf16_t*)(p.ws + WS_U), (float*)(p.ws + WS_SF)}; pg8::gemm_phase((LAS unsigned char*)smem, g, S, E);
                  convert_in_tail(p, smem, (MP / 256) * (N1P / 256), T_IN, T_IN + T_OUT + T_UP); } break;
        case 2: if (PH_MASK & 4) phase_scan(p, smem); break;
        case 3: if (PH_MASK & 8) phase_mixnorm(p); break;
        case 4: if (PH_MASK & 16) { pg8::Gemm g{(const bf16_t*)(p.ws + WS_MIX), (const bf16_t*)(p.ws + WS_WOUT), MP, 2048, 4096}; pg8::StaticOrder S; S.init(MP, 2048, gridDim.x, opaque_bid());
                  Epi2 E{p}; pg8::gemm_phase((LAS unsigned char*)smem, g, S, E); } break;
        case 5: if (PH_MASK & 32) { pg8::Gemm g{(const bf16_t*)(p.ws + WS_A2), (const bf16_t*)(p.ws + WS_WUP), MP, N3, 2048}; pg8::StaticOrder S; S.init(MP, N3, gridDim.x, opaque_bid());
                  Epi3 E{(bf16_t*)(p.ws + WS_UP), (const float*)(p.ws + WS_SS2)}; pg8::gemm_phase((LAS unsigned char*)smem, g, S, E);
                  convert_in_tail(p, smem, (MP / 256) * (N3 / 256), T_IN + T_OUT + T_UP, T_ALL); } break;
        case 6: if (PH_MASK & 64) phase_act(p); break;
        case 7: if (PH_MASK & 128) { pg8::Gemm g{(const bf16_t*)(p.ws + WS_ACT), (const bf16_t*)(p.ws + WS_WDOWN), MP, 2048, DFF}; pg8::StaticOrder S; S.init(MP, 2048, gridDim.x, opaque_bid());
                  Epi4 E{(const float*)(p.ws + WS_H1), p.out, (float*)(p.ws + WS_SS3)}; pg8::gemm_phase((LAS unsigned char*)smem, g, S, E); } break;
        default: if (PH_MASK & 256) phase_final(p); break;
        }
        if (phx + 1 < p0.ph_hi + (DUP_PHASE >= 0 ? 1 : 0)) grid.sync();
    }
}

extern "C" void kernel_launch(void* const* d_in, const int* in_sizes, int n_in, void* d_out, int out_size, void* d_ws, size_t ws_size, hipStream_t stream) {
    static int grid_blocks = 0;
    if (grid_blocks == 0) {
        if (n_in != 27 || (size_t)out_size != O_END || ws_size < WS_END) {
            fprintf(stderr, "kernel_launch: unexpected shapes: n_in %d out %d ws %zu (need %zu)\n", n_in, out_size, ws_size, (size_t)WS_END); grid_blocks = -1; return; }
        int dev = 0, cus = 0, per_cu = 0;
        (void)hipGetDevice(&dev);
        (void)hipDeviceGetAttribute(&cus, hipDeviceAttributeMultiprocessorCount, dev);
        (void)hipFuncSetAttribute((const void*)hymba_fwd, hipFuncAttributeMaxDynamicSharedMemorySize, LDS_BYTES);
        (void)hipOccupancyMaxActiveBlocksPerMultiprocessor(&per_cu, (const void*)hymba_fwd, 512, LDS_BYTES);
        if (per_cu < 1) { fprintf(stderr, "kernel_launch: occupancy query says %d blocks per CU\n", per_cu); per_cu = 1; }
        grid_blocks = cus;
    }
    if (grid_blocks < 0) return;
    Params p{};
    for (int i = 0; i < 27; ++i) p.in[i] = (const float*)d_in[i];
    p.out = (float*)d_out; p.ws = (unsigned char*)d_ws; p.ph_lo = 0; p.ph_hi = NPHASE;
    void* args[] = {&p};
    hipError_t e = hipLaunchCooperativeKernel((const void*)hymba_fwd, dim3(grid_blocks), dim3(512), args, LDS_BYTES, stream);
    if (e != hipSuccess) fprintf(stderr, "cooperative launch failed: %s (grid %d)\n", hipGetErrorString(e), grid_blocks);
}
```

```cpp
#include <hip/hip_runtime.h>
#include <hip/hip_cooperative_groups.h>
#include <cstdio>
namespace cg = cooperative_groups;

#define LAS __attribute__((address_space(3)))
typedef unsigned short bf16_t;
typedef short bf16x8 __attribute__((ext_vector_type(8)));
typedef float f32x4 __attribute__((ext_vector_type(4)));
typedef unsigned u32x4 __attribute__((ext_vector_type(4)));
typedef unsigned u32x2 __attribute__((ext_vector_type(2)));

constexpr int DM = 2048, MP = 9472, NVALID = 9280, NOUTROWS = 9216;
constexpr int N1P = 11008, N3 = 11264, DFF = 5632, MIXW = 4096;
constexpr int ROW_SAMPLE = 8192, ROW_META = 9216;
constexpr float EPS = 1e-6f;
constexpr int UC_Z = 0, UC_XBC = 2048, UC_Q = 4640, UC_K = 5664, UC_V = 6688, UC_O = 8752;
constexpr size_t WS_WIN = 0;
constexpr size_t WS_WOUT = WS_WIN + (size_t)N1P * 2048 * 2;
constexpr size_t WS_WUP = WS_WOUT + (size_t)2048 * 4096 * 2;
constexpr size_t WS_WDOWN = WS_WUP + (size_t)N3 * 2048 * 2;
constexpr size_t WS_XN = WS_WDOWN + (size_t)2048 * DFF * 2;
constexpr size_t WS_MIX = WS_XN + (size_t)MP * 2048 * 2;
constexpr size_t WS_ACT = WS_XN;
constexpr size_t WS_U = WS_MIX + (size_t)MP * MIXW * 2;
constexpr size_t WS_UP = WS_U;
constexpr size_t WS_H1 = WS_U + (size_t)MP * N3 * 2;
constexpr size_t WS_A2 = WS_H1 + (size_t)MP * 2048 * 4;
constexpr size_t WS_SF = WS_A2 + (size_t)MP * 2048 * 2;
constexpr size_t WS_SSQ = WS_SF + (size_t)MP * 64 * 4;
constexpr size_t WS_SSQM = WS_SSQ + (size_t)MP * 32 * 4;
constexpr size_t WS_SS2 = WS_SSQM + (size_t)MP * 32 * 4;
constexpr size_t WS_SS3 = WS_SS2 + (size_t)MP * 4;
constexpr size_t WS_DD = WS_SS3 + (size_t)MP * 4;
constexpr size_t WS_END = WS_DD + (size_t)MP * 8 * 4;
constexpr size_t O_Y = 0;
constexpr size_t O_P_SSDCONV = 18874368, O_P_SSD = 18905088, O_P_MLC = 19953664, O_P_MLN = 21002240, O_P_MLM = 21006336, O_P_FFN = 21006368;
constexpr size_t O_S_SSDCONV = 21096480, O_S_SSD = 22079520, O_S_MLC = 55633952, O_S_MLN = 89188384, O_S_MLM = 89319456, O_S_FFN = 89320480;
constexpr size_t O_END = 92204064;
constexpr int LDS_BYTES = 147456;
constexpr int NPHASE = 9;
#ifndef CHL_SSD
#define CHL_SSD 128
#endif
#ifndef CHL_ML
#define CHL_ML 128
#endif
#ifndef PH_MASK
#define PH_MASK 0x1ff
#endif

struct Params {
    const float* in[27];
    float* out;
    unsigned char* ws;
    int ph_lo, ph_hi;
};

__device__ __forceinline__ unsigned pack2(float lo, float hi) { unsigned r; asm("v_cvt_pk_bf16_f32 %0, %1, %2" : "=v"(r) : "v"(lo), "v"(hi)); return r; }
__device__ __forceinline__ float bf_lo(unsigned u) { return __uint_as_float(u << 16); }
__device__ __forceinline__ float bf_hi(unsigned u) { return __uint_as_float(u & 0xffff0000u); }
__device__ __forceinline__ float bf2f(bf16_t h) { return __uint_as_float((unsigned)h << 16); }
__device__ __forceinline__ float sigm_f(float x) { const float d = 1.f + __expf(fminf(-x, 80.f)); float r = __builtin_amdgcn_rcpf(d); return r * (2.f - d * r); }
__device__ __forceinline__ float silu_f(float x) { return x * sigm_f(x); }
__device__ __forceinline__ float softplus_f(float x) { return x > 20.f ? x : log1pf(__expf(x)); }
__device__ __forceinline__ float logsig_f(float x) { return fminf(x, 0.f) - log1pf(__expf(-fabsf(x))); }
__device__ __forceinline__ int opaque_tid() { int t = threadIdx.x; asm volatile("" : "+v"(t)); return t; }
__device__ __forceinline__ int opaque_bid() { int t = blockIdx.x; asm volatile("" : "+s"(t)); return t; }
__device__ __forceinline__ int row_of(int b, int pos) { return pos < 16 ? ROW_META + b * 16 + pos : b * 2048 + pos - 16; }
__device__ __forceinline__ float wave_sum(float v) {
    v += __shfl_xor(v, 32); v += __shfl_xor(v, 16); v += __shfl_xor(v, 8); v += __shfl_xor(v, 4); v += __shfl_xor(v, 2); v += __shfl_xor(v, 1); return v;
}
__device__ __forceinline__ const float* resid_row(const Params& p, int row) {
    if (row < ROW_SAMPLE) return p.in[0] + (size_t)row * DM;
    if (row < ROW_META) return p.in[1] + (size_t)(row - ROW_SAMPLE) * DM;
    if (row < NVALID) return p.in[8] + (size_t)((row - ROW_META) & 15) * DM;
    return nullptr;
}

namespace pg8 {
constexpr int BM = 256, BK = 64, HALF = 128, HTB = HALF * BK * 2, STAGE_BYTES = 8 * HTB, NXCD = 8, WGM = 8;
__device__ __forceinline__ int lds_byte(int r, int c) { const int st = (r >> 4) * 2 + (c >> 5), rr = r & 15, cc = c & 31, ob = rr * 64 + cc * 2; return st * 1024 + (ob ^ (((ob >> 9) & 1) << 5)); }
__device__ __forceinline__ void stage_rc(int b, int& R, int& C) { const int st = b / 1024, sb = b % 1024, swz = sb ^ (((sb >> 9) & 1) << 5); R = (st >> 1) * 16 + swz / 64; C = (st & 1) * 32 + (swz % 64) / 2; }
__device__ __forceinline__ int perm32(int rho) { const int n = rho >> 4, i = rho & 15; return 8 * (i >> 2) + 4 * n + (i & 3); }
struct Unit { int pm, pn; };
struct Gemm { const bf16_t* A; const bf16_t* Bt; int M, N, K; };
struct StaticOrder {
    int nM, nN, nwg, G, c;
    __device__ void init(int M, int N, int G_, int c_) { nM = M / BM; nN = N / BM; nwg = nM * nN; G = G_; c = c_; }
    __device__ bool next(int i, Unit& u) const {
        const long L = (long)i * G + c; if (L >= nwg) return false;
        int wgid = (int)L; { const int q = nwg / NXCD, r = nwg % NXCD, xcd = wgid % NXCD, off = wgid / NXCD; wgid = (xcd < r ? xcd * (q + 1) : r * (q + 1) + (xcd - r) * q) + off; }
        const int nig = WGM * nN, gid = wgid / nig, fm = gid * WGM, gsz = (nM - fm) < WGM ? (nM - fm) : WGM;
        u.pm = fm + ((wgid % nig) % gsz); u.pn = (wgid % nig) / gsz; return true;
    }
};

template <class Epi>
__device__ __forceinline__ void gemm_phase(LAS unsigned char* lds, const Gemm g, const StaticOrder& S, const Epi& E) {
    const int tid = opaque_tid(), wid = __builtin_amdgcn_readfirstlane(tid >> 6), lane = tid & 63, wr = wid >> 2, wc = wid & 3, fr = lane & 15, fq = lane >> 4;
    const int K = g.K, nt = K / BK;
    unsigned voffA[2], voffB[2];
#pragma unroll
    for (int i = 0; i < 2; ++i) { int R, C; stage_rc(tid * 16 + i * 8192, R, C); const int Rb = ((R & ~31) + perm32(R & 31));
        voffA[i] = (unsigned)(R * K + C) * 2u; voffB[i] = (unsigned)(Rb * K + C) * 2u; }
    const size_t kstep = (size_t)(BK * 2);
    const size_t hstep = (size_t)HALF * K * 2;
    const size_t tstep = 2 * hstep;
    const unsigned ldsw = (unsigned)wid * 1024u;
    const int aoff = lds_byte(wr * 64 + fr, fq * 8), boff = lds_byte(wc * 32 + fr, fq * 8);
#define PG8_SA(b, h) (((b) * 2 + (h)) * HTB)
#define PG8_SB(b, h) ((4 + (b) * 2 + (h)) * HTB)
#define PG8_STAGE(bufoff, gbase, voff) do { _Pragma("unroll") for (int _i = 0; _i < 2; ++_i) \
        __builtin_amdgcn_global_load_lds((const unsigned*)((const char*)(gbase) + (voff)[_i]), (LAS unsigned*)(lds + (bufoff) + ldsw + _i * 8192), 16, 0, 0); } while (0)
#define PG8_LDA(dst, b, h) do { _Pragma("unroll") for (int m = 0; m < 4; ++m) _Pragma("unroll") for (int k = 0; k < 2; ++k) dst[m][k] = *(const LAS bf16x8*)(lds + PG8_SA(b, h) + aoff + m * 2048 + k * 1024); } while (0)
#define PG8_LDB(dst, b, h) do { _Pragma("unroll") for (int n = 0; n < 2; ++n) _Pragma("unroll") for (int k = 0; k < 2; ++k) dst[n][k] = *(const LAS bf16x8*)(lds + PG8_SB(b, h) + boff + n * 2048 + k * 1024); } while (0)
#define PG8_MMA(ai, bj, At, Bt) do { __builtin_amdgcn_s_setprio(1); _Pragma("unroll") for (int m = 0; m < 4; ++m) _Pragma("unroll") for (int n = 0; n < 2; ++n) _Pragma("unroll") for (int k = 0; k < 2; ++k) \
        acc[ai][bj][m][n] = __builtin_amdgcn_mfma_f32_16x16x32_bf16(Bt[n][k], At[m][k], acc[ai][bj][m][n], 0, 0, 0); __builtin_amdgcn_s_setprio(0); } while (0)
#define PG8_WAIT_V(n) asm volatile("s_waitcnt vmcnt(" #n ")" ::: "memory")
#define PG8_WAIT_L(n) asm volatile("s_waitcnt lgkmcnt(" #n ")" ::: "memory")
#define PG8_BAR __builtin_amdgcn_s_barrier()
#define PG8_SCHED __builtin_amdgcn_sched_barrier(0)
    Unit cur, nxt; int ui = 0;
    if (!S.next(0, cur)) return;
    f32x4 acc[2][2][4][2];
#pragma unroll
    for (int a = 0; a < 2; ++a)
#pragma unroll
        for (int b = 0; b < 2; ++b)
#pragma unroll
            for (int m = 0; m < 4; ++m)
#pragma unroll
                for (int n = 0; n < 2; ++n) acc[a][b][m][n] = (f32x4){0.f, 0.f, 0.f, 0.f};
    bf16x8 At[4][2], B0[2][2], B1[2][2];
    const char* cA = (const char*)g.A + (size_t)cur.pm * tstep; const char* cB = (const char*)g.Bt + (size_t)cur.pn * tstep;
    PG8_STAGE(PG8_SB(0, 0), cB, voffB); PG8_STAGE(PG8_SA(0, 0), cA, voffA); PG8_STAGE(PG8_SB(0, 1), cB + hstep, voffB); PG8_STAGE(PG8_SA(0, 1), cA + hstep, voffA);
    if (wr == 1) PG8_BAR;
    PG8_WAIT_V(4); PG8_BAR;
    PG8_STAGE(PG8_SB(1, 0), cB + kstep, voffB); PG8_STAGE(PG8_SA(1, 0), cA + kstep, voffA); PG8_STAGE(PG8_SB(1, 1), cB + hstep + kstep, voffB);
    PG8_WAIT_V(6); PG8_BAR;
    for (;;) {
        const bool has_next = S.next(ui + 1, nxt);
        const char* nA = has_next ? (const char*)g.A + (size_t)nxt.pm * tstep : cA; const char* nB = has_next ? (const char*)g.Bt + (size_t)nxt.pn * tstep : cB;
        for (int t = 0; t < nt; t += 2) {
            const bool last = (t == nt - 2);
            const char* a1 = cA + (size_t)(t + 1) * kstep;
            const char* a2 = last ? nA : cA + (size_t)(t + 2) * kstep; const char* b2 = last ? nB : cB + (size_t)(t + 2) * kstep;
            const char* a3 = a2 + kstep; const char* b3 = b2 + kstep;
            PG8_LDB(B0, 0, 0); PG8_SCHED; PG8_LDA(At, 0, 0); PG8_STAGE(PG8_SA(1, 1), a1 + hstep, voffA);
            PG8_WAIT_L(8); PG8_BAR; PG8_WAIT_L(0); PG8_MMA(0, 0, At, B0); PG8_BAR; PG8_SCHED;
            PG8_LDB(B1, 0, 1); PG8_STAGE(PG8_SB(0, 0), b2, voffB);
            PG8_BAR; PG8_WAIT_L(0); PG8_MMA(0, 1, At, B1); PG8_BAR;
            PG8_LDA(At, 0, 1); PG8_STAGE(PG8_SA(0, 0), a2, voffA);
            PG8_BAR; PG8_WAIT_L(0); PG8_MMA(1, 0, At, B0); PG8_BAR; PG8_SCHED;
            PG8_STAGE(PG8_SB(0, 1), b2 + hstep, voffB);
            PG8_WAIT_V(6); PG8_BAR; PG8_MMA(1, 1, At, B1); PG8_BAR;
            PG8_LDB(B0, 1, 0); PG8_SCHED; PG8_LDA(At, 1, 0); PG8_STAGE(PG8_SA(0, 1), a2 + hstep, voffA);
            PG8_WAIT_L(8); PG8_BAR; PG8_WAIT_L(0); PG8_MMA(0, 0, At, B0); PG8_BAR; PG8_SCHED;
            PG8_LDB(B1, 1, 1); PG8_STAGE(PG8_SB(1, 0), b3, voffB);
            PG8_BAR; PG8_WAIT_L(0); PG8_MMA(0, 1, At, B1); PG8_BAR;
            PG8_LDA(At, 1, 1); PG8_STAGE(PG8_SA(1, 0), a3, voffA);
            PG8_BAR; PG8_WAIT_L(0); PG8_MMA(1, 0, At, B0); PG8_BAR; PG8_SCHED;
            PG8_STAGE(PG8_SB(1, 1), b3 + hstep, voffB);
            PG8_WAIT_V(6); PG8_BAR; PG8_MMA(1, 1, At, B1); PG8_BAR;
        }
        { Unit eu = cur; asm volatile("" : "+s"(eu.pm), "+s"(eu.pn)); E(acc, eu, wr, wc, fr, fq); }
        if (!has_next) break;
#pragma unroll
        for (int a = 0; a < 2; ++a)
#pragma unroll
            for (int b = 0; b < 2; ++b)
#pragma unroll
                for (int m = 0; m < 4; ++m)
#pragma unroll
                    for (int n = 0; n < 2; ++n) acc[a][b][m][n] = (f32x4){0.f, 0.f, 0.f, 0.f};
        cur = nxt; cA = nA; cB = nB; ++ui;
    }
    PG8_WAIT_V(0);
    if (wr == 0) PG8_BAR;
    PG8_BAR;
#undef PG8_SA
#undef PG8_SB
#undef PG8_STAGE
#undef PG8_LDA
#undef PG8_LDB
#undef PG8_MMA
#undef PG8_WAIT_V
#undef PG8_WAIT_L
#undef PG8_BAR
#undef PG8_SCHED
}
}

typedef f32x4 AccT[2][2][4][2];
struct Epi1 {
    bf16_t* U; float* sf;
    __device__ __forceinline__ void operator()(const AccT& acc, const pg8::Unit& u, int wr, int wc, int fr, int fq) const {
        const int row0 = u.pm * 256 + wr * 64 + fr, col0 = u.pn * 256 + wc * 32 + 8 * fq;
        const bool side_dt = (u.pn == 18 && wc == 0), side_if = (u.pn == 34 && wc == 1);
#pragma unroll
        for (int ai = 0; ai < 2; ++ai)
#pragma unroll
            for (int m = 0; m < 4; ++m) {
                const int row = row0 + ai * 128 + m * 16;
                bf16_t* rowp = U + (size_t)row * N1P + col0;
#pragma unroll
                for (int bj = 0; bj < 2; ++bj) {
                    const f32x4 v0 = acc[ai][bj][m][0], v1 = acc[ai][bj][m][1];
                    u32x4 o; o[0] = pack2(v0[0], v0[1]); o[1] = pack2(v0[2], v0[3]); o[2] = pack2(v1[0], v1[1]); o[3] = pack2(v1[2], v1[3]);
                    *(u32x4*)(rowp + bj * 128) = o;
                }
                if (side_dt || side_if) {
                    float* sp = sf + (size_t)row * 64 + (side_if ? 32 : 0) + 8 * fq;
                    *(f32x4*)sp = acc[ai][0][m][0]; *(f32x4*)(sp + 4) = acc[ai][0][m][1];
                }
            }
    }
};
struct Epi2 {
    Params p;
    __device__ __forceinline__ void operator()(const AccT& acc, const pg8::Unit& u, int wr, int wc, int fr, int fq) const {
        float* H1 = (float*)(p.ws + WS_H1); bf16_t* A2 = (bf16_t*)(p.ws + WS_A2); float* SS2 = (float*)(p.ws + WS_SS2);
        const float* nw = p.in[21];
        const int row0 = u.pm * 256 + wr * 64 + fr, col0 = u.pn * 256 + wc * 32 + 8 * fq;
        f32x4 w[2][2];
#pragma unroll
        for (int bj = 0; bj < 2; ++bj) { w[bj][0] = *(const f32x4*)(nw + col0 + bj * 128); w[bj][1] = *(const f32x4*)(nw + col0 + bj * 128 + 4); }
#pragma unroll
        for (int ai = 0; ai < 2; ++ai)
#pragma unroll
            for (int m = 0; m < 4; ++m) {
                const int row = row0 + ai * 128 + m * 16;
                const float* rp = resid_row(p, row);
                float ss = 0.f;
#pragma unroll
                for (int bj = 0; bj < 2; ++bj) {
                    f32x4 v0 = acc[ai][bj][m][0], v1 = acc[ai][bj][m][1];
                    if (rp) { v0 += __builtin_nontemporal_load((const f32x4*)(rp + col0 + bj * 128)); v1 += __builtin_nontemporal_load((const f32x4*)(rp + col0 + bj * 128 + 4)); }
                    *(f32x4*)(H1 + (size_t)row * DM + col0 + bj * 128) = v0; *(f32x4*)(H1 + (size_t)row * DM + col0 + bj * 128 + 4) = v1;
                    ss += v0[0] * v0[0] + v0[1] * v0[1] + v0[2] * v0[2] + v0[3] * v0[3] + v1[0] * v1[0] + v1[1] * v1[1] + v1[2] * v1[2] + v1[3] * v1[3];
                    const f32x4 a0 = v0 * w[bj][0], a1 = v1 * w[bj][1];
                    u32x4 o; o[0] = pack2(a0[0], a0[1]); o[1] = pack2(a0[2], a0[3]); o[2] = pack2(a1[0], a1[1]); o[3] = pack2(a1[2], a1[3]);
                    *(u32x4*)(A2 + (size_t)row * DM + col0 + bj * 128) = o;
                }
                ss += __shfl_xor(ss, 16); ss += __shfl_xor(ss, 32);
                if (fq == 0) atomicAdd(SS2 + row, ss);
            }
    }
};
struct Epi3 {
    bf16_t* UP; const float* SS2;
    __device__ __forceinline__ void operator()(const AccT& acc, const pg8::Unit& u, int wr, int wc, int fr, int fq) const {
        const int row0 = u.pm * 256 + wr * 64 + fr, col0 = u.pn * 256 + wc * 32 + 8 * fq;
#pragma unroll
        for (int ai = 0; ai < 2; ++ai)
#pragma unroll
            for (int m = 0; m < 4; ++m) {
                const int row = row0 + ai * 128 + m * 16;
                const float r2 = rsqrtf(SS2[row] * (1.f / 2048.f) + EPS);
                bf16_t* rowp = UP + (size_t)row * N3 + col0;
#pragma unroll
                for (int bj = 0; bj < 2; ++bj) {
                    const f32x4 v0 = acc[ai][bj][m][0] * r2, v1 = acc[ai][bj][m][1] * r2;
                    u32x4 o; o[0] = pack2(v0[0], v0[1]); o[1] = pack2(v0[2], v0[3]); o[2] = pack2(v1[0], v1[1]); o[3] = pack2(v1[2], v1[3]);
                    *(u32x4*)(rowp + bj * 128) = o;
                }
            }
    }
};
struct Epi4 {
    const float* H1; float* out; float* SS3;
    __device__ __forceinline__ void operator()(const AccT& acc, const pg8::Unit& u, int wr, int wc, int fr, int fq) const {
        const int row0 = u.pm * 256 + wr * 64 + fr, col0 = u.pn * 256 + wc * 32 + 8 * fq;
#pragma unroll
        for (int ai = 0; ai < 2; ++ai)
#pragma unroll
            for (int m = 0; m < 4; ++m) {
                const int row = row0 + ai * 128 + m * 16;
                if (row < NOUTROWS) {
                    float ss = 0.f;
#pragma unroll
                    for (int bj = 0; bj < 2; ++bj) {
                        const f32x4 v0 = acc[ai][bj][m][0] + __builtin_nontemporal_load((const f32x4*)(H1 + (size_t)row * DM + col0 + bj * 128));
                        const f32x4 v1 = acc[ai][bj][m][1] + __builtin_nontemporal_load((const f32x4*)(H1 + (size_t)row * DM + col0 + bj * 128 + 4));
                        *(f32x4*)(out + (size_t)row * DM + col0 + bj * 128) = v0; *(f32x4*)(out + (size_t)row * DM + col0 + bj * 128 + 4) = v1;
                        ss += v0[0] * v0[0] + v0[1] * v0[1] + v0[2] * v0[2] + v0[3] * v0[3] + v1[0] * v1[0] + v1[1] * v1[1] + v1[2] * v1[2] + v1[3] * v1[3];
                    }
                    ss += __shfl_xor(ss, 16); ss += __shfl_xor(ss, 32);
                    if (fq == 0) atomicAdd(SS3 + row, ss);
                }
            }
    }
};

constexpr int T_IN = 32 * 43, T_OUT = 64 * 8, T_UP = 32 * 44, T_DOWN = 88 * 8, T_ALL = T_IN + T_OUT + T_UP + T_DOWN;
struct TileRef { const float* W; bf16_t* WT; int K, N, kt, nt; };
__device__ __forceinline__ TileRef tile_ref(const Params& p, int t) {
    TileRef r;
    if (t < T_IN) { r.W = p.in[10]; r.WT = (bf16_t*)(p.ws + WS_WIN); r.K = 2048; r.N = 10800; r.kt = t % 32; r.nt = t / 32; }
    else if (t < T_IN + T_OUT) { const int q = t - T_IN; r.W = p.in[20]; r.WT = (bf16_t*)(p.ws + WS_WOUT); r.K = 4096; r.N = 2048; r.kt = q % 64; r.nt = q / 64; }
    else if (t < T_IN + T_OUT + T_UP) { const int q = t - T_IN - T_OUT; r.W = p.in[22]; r.WT = (bf16_t*)(p.ws + WS_WUP); r.K = 2048; r.N = N3; r.kt = q % 32; r.nt = q / 32; }
    else { const int q = t - T_IN - T_OUT - T_UP; r.W = p.in[25]; r.WT = (bf16_t*)(p.ws + WS_WDOWN); r.K = DFF; r.N = 2048; r.kt = q % 88; r.nt = q / 88; }
    return r;
}
__device__ __forceinline__ void tile_load(const TileRef& r, f32x4 (&v)[8], int tid) {
    const int nc = (tid & 63) * 4, n = r.nt * 256 + nc;
#pragma unroll
    for (int i = 0; i < 8; ++i) {
        const int kr = (tid >> 6) + 8 * i;
        v[i] = (f32x4){0.f, 0.f, 0.f, 0.f};
        if (n < r.N) v[i] = __builtin_nontemporal_load((const f32x4*)(r.W + (size_t)(r.kt * 64 + kr) * r.N + n));
    }
}
__device__ __forceinline__ void tile_lds_write(const f32x4 (&v)[8], int tid, unsigned char* smem) {
    float* tile = (float*)smem;
    const int nc = (tid & 63) * 4;
#pragma unroll
    for (int i = 0; i < 8; ++i) {
        const int kr = (tid >> 6) + 8 * i;
        tile[kr * 257 + nc] = v[i][0]; tile[kr * 257 + nc + 1] = v[i][1]; tile[kr * 257 + nc + 2] = v[i][2]; tile[kr * 257 + nc + 3] = v[i][3];
    }
}
__device__ __forceinline__ void tile_store(const TileRef& r, int tid, unsigned char* smem) {
    const float* tile = (const float*)smem;
    const int kc = (tid & 7) * 8;
#pragma unroll
    for (int q = 0; q < 4; ++q) {
        const int nr = (tid >> 3) + 64 * q;
        u32x4 o;
        o[0] = pack2(tile[(kc + 0) * 257 + nr], tile[(kc + 1) * 257 + nr]); o[1] = pack2(tile[(kc + 2) * 257 + nr], tile[(kc + 3) * 257 + nr]);
        o[2] = pack2(tile[(kc + 4) * 257 + nr], tile[(kc + 5) * 257 + nr]); o[3] = pack2(tile[(kc + 6) * 257 + nr], tile[(kc + 7) * 257 + nr]);
        *(u32x4*)(r.WT + (size_t)(r.nt * 256 + nr) * r.K + r.kt * 64 + kc) = o;
    }
}
__device__ __forceinline__ void convert_tiles(const Params& p, unsigned char* smem, int t_begin, int t_end, int worker, int nworkers) {
    const int tid = opaque_tid();
    int t = t_begin + worker;
    f32x4 v[8];
    TileRef cur{};
    if (t < t_end) { cur = tile_ref(p, t); tile_load(cur, v, tid); }
    while (t < t_end) {
        tile_lds_write(v, tid, smem);
        __syncthreads();
        const int tn = t + nworkers;
        TileRef nxt{};
        if (tn < t_end) { nxt = tile_ref(p, tn); tile_load(nxt, v, tid); }
        tile_store(cur, tid, smem);
        __syncthreads();
        cur = nxt; t = tn;
    }
}
__device__ __forceinline__ void convert_in_tail(const Params& p, unsigned char* smem, int n_units, int t_begin, int t_end) {
    const int G = gridDim.x, rem = n_units % G, bid = opaque_bid();
    if (rem == 0) convert_tiles(p, smem, t_begin, t_end, bid, G);
    else if (bid >= rem) convert_tiles(p, smem, t_begin, t_end, bid - rem, G - rem);
}
__device__ __forceinline__ void phase_prep(const Params& p, unsigned char* smem) {
    const int tid = opaque_tid(), wid = tid >> 6, lane = tid & 63;
    { float* SS2 = (float*)(p.ws + WS_SS2); for (int i = opaque_bid() * 512 + tid; i < 2 * MP; i += gridDim.x * 512) SS2[i] = 0.f; }
    {
        bf16_t* XN = (bf16_t*)(p.ws + WS_XN); const float* nw = p.in[9];
        for (int row = opaque_bid() * 8 + wid; row < MP; row += gridDim.x * 8) {
            const float* src = resid_row(p, row);
            f32x4 v[8];
            float ss = 0.f;
#pragma unroll
            for (int it = 0; it < 4; ++it) {
                const int col = it * 512 + lane * 8;
                if (src) { v[2 * it] = __builtin_nontemporal_load((const f32x4*)(src + col)); v[2 * it + 1] = __builtin_nontemporal_load((const f32x4*)(src + col + 4)); }
                else { v[2 * it] = (f32x4){0.f, 0.f, 0.f, 0.f}; v[2 * it + 1] = (f32x4){0.f, 0.f, 0.f, 0.f}; }
#pragma unroll
                for (int j = 0; j < 4; ++j) ss += v[2 * it][j] * v[2 * it][j] + v[2 * it + 1][j] * v[2 * it + 1][j];
            }
            ss = wave_sum(ss);
            const float r = rsqrtf(ss * (1.f / 2048.f) + EPS);
#pragma unroll
            for (int it = 0; it < 4; ++it) {
                const int col = it * 512 + lane * 8;
                const f32x4 w0 = *(const f32x4*)(nw + col), w1 = *(const f32x4*)(nw + col + 4);
                const f32x4 a = v[2 * it] * r * w0, c = v[2 * it + 1] * r * w1;
                u32x4 o; o[0] = pack2(a[0], a[1]); o[1] = pack2(a[2], a[3]); o[2] = pack2(c[0], c[1]); o[3] = pack2(c[2], c[3]);
                *(u32x4*)(XN + (size_t)row * DM + col) = o;
            }
        }
    }
    convert_tiles(p, smem, 0, T_IN, opaque_bid(), gridDim.x);
}

constexpr int RS = 272;
constexpr int L_QS = 0, L_KS = 34816, L_KT = 69632, L_VT = 104448, L_ST = 121856, L_SC = 139264;

template <bool ML>
__device__ __forceinline__ void load_block(const Params& p, float (&val)[8][4], int b, int p0, int Lv, int rb, int cg, int colbase, int chbase, float mlscale) {
    const bf16_t* U = (const bf16_t*)(p.ws + WS_U);
    const int t0 = rb * 8;
    if (t0 >= Lv) {
#pragma unroll
        for (int r = 0; r < 8; ++r)
#pragma unroll
            for (int i = 0; i < 4; ++i) val[r][i] = 0.f;
        return;
    }
    if (ML) {
#pragma unroll
        for (int r = 0; r < 8; ++r) {
            const int row = row_of(b, p0 + t0 + r);
            const u32x2 raw = *(const u32x2*)(U + (size_t)row * N1P + colbase + cg * 4);
            val[r][0] = bf_lo(raw[0]) * mlscale; val[r][1] = bf_hi(raw[0]) * mlscale; val[r][2] = bf_lo(raw[1]) * mlscale; val[r][3] = bf_hi(raw[1]) * mlscale;
        }
    } else {
        u32x2 raw[11];
#pragma unroll
        for (int rr = 0; rr < 11; ++rr) {
            const int pos = p0 + t0 - 3 + rr;
            if (pos >= 0) raw[rr] = *(const u32x2*)(U + (size_t)row_of(b, pos) * N1P + colbase + cg * 4);
            else raw[rr] = (u32x2){0u, 0u};
        }
        const float* cw = p.in[11]; const float* cb = p.in[12];
        const int ch = chbase + cg * 4;
        f32x4 w[4];
#pragma unroll
        for (int j = 0; j < 4; ++j) w[j] = *(const f32x4*)(cw + j * 2560 + ch);
        const f32x4 bi = *(const f32x4*)(cb + ch);
#pragma unroll
        for (int i = 0; i < 4; ++i) {
            float x[11];
#pragma unroll
            for (int rr = 0; rr < 11; ++rr) x[rr] = (i & 1) ? bf_hi(raw[rr][i >> 1]) : bf_lo(raw[rr][i >> 1]);
#pragma unroll
            for (int r = 0; r < 8; ++r) val[r][i] = silu_f(bi[i] + w[0][i] * x[r] + w[1][i] * x[r + 1] + w[2][i] * x[r + 2] + w[3][i] * x[r + 3]);
        }
    }
}
__device__ __forceinline__ void store_rows(unsigned char* base, const float (&val)[8][4], int rb, int cg) {
#pragma unroll
    for (int r = 0; r < 8; ++r) *(u32x2*)(base + (rb * 8 + r) * RS + cg * 8) = (u32x2){pack2(val[r][0], val[r][1]), pack2(val[r][2], val[r][3])};
}
__device__ __forceinline__ void store_cols(unsigned char* base, const float (&val)[8][4], int rb, int cg, const float* scale) {
    float s[8];
#pragma unroll
    for (int r = 0; r < 8; ++r) s[r] = scale ? scale[rb * 8 + r] : 1.f;
#pragma unroll
    for (int i = 0; i < 4; ++i) {
        const int row = cg * 4 + i;
        u32x4 o; o[0] = pack2(val[0][i] * s[0], val[1][i] * s[1]); o[1] = pack2(val[2][i] * s[2], val[3][i] * s[3]);
        o[2] = pack2(val[4][i] * s[4], val[5][i] * s[5]); o[3] = pack2(val[6][i] * s[6], val[7][i] * s[7]);
        *(u32x4*)(base + row * RS + ((rb ^ ((row >> 3) & 7)) << 4)) = o;
    }
}

template <bool ML>
__device__ __forceinline__ void prompt_scan(const Params& p, unsigned char* smem, int job) {
    const int tid = opaque_tid(), wid = __builtin_amdgcn_readfirstlane(tid >> 6), lane = tid & 63, fr = lane & 15, fq = lane >> 4;
    int b, h, vq = 0;
    if (ML) { b = job >> 5; h = (job >> 2) & 7; vq = job & 3; } else { b = job >> 5; h = job & 31; }
    const int g = h >> 4;
    const bf16_t* U = (const bf16_t*)(p.ws + WS_U);
    const float* SF = (const float*)(p.ws + WS_SF);
    bf16_t* MIX = (bf16_t*)(p.ws + WS_MIX);
    float* scb = (float*)(smem + L_SC);
    float *qn = scb + 1600, *nvec = scb + 1728, *mpp = scb + 1856;
    const int qcol = ML ? UC_Q + h * 128 : UC_XBC + 2304 + g * 128;
    const int kcol = ML ? UC_K + h * 128 : UC_XBC + 2048 + g * 128;
    const int vcol = ML ? UC_V + h * 256 + vq * 64 : UC_XBC + h * 64;
    const int gcol = ML ? UC_O + h * 256 + vq * 64 : UC_Z + h * 64;
    const int mixcol = ML ? 2048 + h * 256 + vq * 64 : h * 64;
    float A_h = 0.f, D_h = 0.f, dtb = 0.f, ib = 0.f, fb = 0.f;
    if (ML) { ib = p.in[17][h]; fb = p.in[18][h]; } else { A_h = -__expf(p.in[14][h]); D_h = p.in[15][h]; dtb = p.in[13][h]; }
    f32x4 st[4];
#pragma unroll
    for (int i = 0; i < 4; ++i) st[i] = (f32x4){0.f, 0.f, 0.f, 0.f};
    for (int i = tid; i < 64 * RS / 16; i += 512) *(u32x4*)(smem + L_ST + i * 16) = (u32x4){0u, 0u, 0u, 0u};
    if (tid < 128) nvec[tid] = 0.f;
    if (tid == 0) mpp[0] = 0.f;
    constexpr int CHLs = ML ? CHL_ML : CHL_SSD;
    float sraw[4] = {0.f, 0.f, 0.f, 0.f};
    auto scal_load = [&](int cc) {
        const int p0 = cc == 0 ? 0 : 16 + (cc - 1) * CHLs, Lv = cc == 0 ? 16 : CHLs;
        const int t0 = 2 * lane, t1 = t0 + 1;
        if (!ML) {
            if (t0 < Lv) sraw[0] = SF[(size_t)row_of(b, p0 + t0) * 64 + h];
            if (t1 < Lv) sraw[1] = SF[(size_t)row_of(b, p0 + t1) * 64 + h];
        } else {
            if (t0 < Lv) { const size_t r = (size_t)row_of(b, p0 + t0) * 64; sraw[0] = SF[r + 32 + h]; sraw[2] = SF[r + 40 + h]; }
            if (t1 < Lv) { const size_t r = (size_t)row_of(b, p0 + t1) * 64; sraw[1] = SF[r + 32 + h]; sraw[3] = SF[r + 40 + h]; }
        }
    };
    auto scalars = [&](int cc) {
        const int Lv = cc == 0 ? 16 : CHLs;
        float* sc = scb + (cc & 1) * 800;
        float *rowv = sc, *colv = sc + 128, *colm = sc + 256, *ev = sc + 384, *scv = sc + 512, *dden = sc + 640, *misc = sc + 768;
        const int t0 = 2 * lane, t1 = t0 + 1;
        if (!ML) {
            float d0 = 0.f, d1 = 0.f;
            if (t0 < Lv) d0 = softplus_f(sraw[0] + dtb);
            if (t1 < Lv) d1 = softplus_f(sraw[1] + dtb);
            const float a0 = d0 * A_h, a1 = d1 * A_h;
            float inc = a0 + a1;
#pragma unroll
            for (int o = 1; o < 64; o <<= 1) { const float y = __shfl_up(inc, o); if (lane >= o) inc += y; }
            const float c1 = inc, c0 = inc - a1, cl = __shfl(inc, 63);
            rowv[t0] = c0; rowv[t1] = c1; colv[t0] = -c0; colv[t1] = -c1; colm[t0] = d0; colm[t1] = d1;
            ev[t0] = __expf(c0); ev[t1] = __expf(c1); scv[t0] = __expf(cl - c0) * d0; scv[t1] = __expf(cl - c1) * d1;
            if (lane == 0) misc[0] = __expf(cl);
        } else {
            float i0 = -INFINITY, i1 = -INFINITY, f0 = 0.f, f1 = 0.f;
            if (t0 < Lv) { i0 = sraw[0] + ib; f0 = logsig_f(sraw[2] + fb); }
            if (t1 < Lv) { i1 = sraw[1] + ib; f1 = logsig_f(sraw[3] + fb); }
            float inc = f0 + f1;
#pragma unroll
            for (int o = 1; o < 64; o <<= 1) { const float y = __shfl_up(inc, o); if (lane >= o) inc += y; }
            const float F1 = inc, F0 = inc - f1;
            const float g0 = i0 - F0, g1 = i1 - F1;
            float mx = fmaxf(g0, g1);
#pragma unroll
            for (int o = 1; o < 64; o <<= 1) { const float y = __shfl_up(mx, o); if (lane >= o) mx = fmaxf(mx, y); }
            float ex = __shfl_up(mx, 1); if (lane == 0) ex = -INFINITY;
            const float mp = mpp[0];
            const float M0 = fmaxf(fmaxf(ex, g0), mp), M1 = fmaxf(mx, mp);
            const float Ml = __shfl(M1, 63), Fl = __shfl(F1, 63);
            rowv[t0] = -M0; rowv[t1] = -M1; colv[t0] = g0; colv[t1] = g1; colm[t0] = 1.f; colm[t1] = 1.f;
            ev[t0] = __expf(mp - M0); ev[t1] = __expf(mp - M1); dden[t0] = __expf(-(F0 + M0)); dden[t1] = __expf(-(F1 + M1));
            scv[t0] = __expf(g0 - Ml); scv[t1] = __expf(g1 - Ml);
            if (lane == 0) { misc[0] = __expf(mp - Ml); mpp[0] = Fl + Ml; }
        }
    };
    __syncthreads();
    if (wid == 0) { scal_load(0); scalars(0); }
    __syncthreads();
    constexpr int CHL = ML ? CHL_ML : CHL_SSD, NCH = 1 + 2048 / CHL;
    const int tid_outer = tid;
    for (int c = 0; c < NCH; ++c) {
        int tid = tid_outer; asm volatile("" : "+v"(tid));
        const int lane = tid & 63, fr = lane & 15, fq = lane >> 4;
        const int p0 = c == 0 ? 0 : 16 + (c - 1) * CHL, Lv = c == 0 ? 16 : CHL;
        float* sc = scb + (c & 1) * 800;
        float *rowv = sc, *colv = sc + 128, *colm = sc + 256, *ev = sc + 384, *scv = sc + 512, *dden = sc + 640, *misc = sc + 768;
        if (wid == 0 && c + 1 < NCH) scal_load(c + 1);
        {
            float val[8][4];
            load_block<ML>(p, val, b, p0, Lv, tid >> 5, tid & 31, qcol, 2304 + g * 128, 1.f);
            store_rows(smem + L_QS, val, tid >> 5, tid & 31);
            __builtin_amdgcn_sched_barrier(0);
            load_block<ML>(p, val, b, p0, Lv, tid >> 5, tid & 31, kcol, 2048 + g * 128, 0.08838834764831845f);
            store_rows(smem + L_KS, val, tid >> 5, tid & 31);
            store_cols(smem + L_KT, val, tid >> 5, tid & 31, scv);
            __builtin_amdgcn_sched_barrier(0);
            if (tid < 256) {
                load_block<ML>(p, val, b, p0, Lv, tid >> 4, tid & 15, vcol, h * 64, 1.f);
                store_cols(smem + L_VT, val, tid >> 4, tid & 15, nullptr);
            }
        }
        __syncthreads();
        const int t = 16 * wid + fr;
        const bool valid = t < Lv;
        const int row = row_of(b, p0 + (valid ? t : 0));
        u32x2 gate[4];
#pragma unroll
        for (int vb = 0; vb < 4; ++vb) gate[vb] = *(const u32x2*)(U + (size_t)row * N1P + gcol + 16 * vb + 4 * fq);
        if (ML) {
            const int tt = tid >> 2, part = tid & 3;
            float s = 0.f;
#pragma unroll
            for (int cc = 0; cc < 4; ++cc) {
                const u32x4 raw = *(const u32x4*)(smem + L_QS + tt * RS + (part * 4 + cc) * 16);
                const f32x4 n0 = *(const f32x4*)(nvec + (part * 4 + cc) * 8), n1 = *(const f32x4*)(nvec + (part * 4 + cc) * 8 + 4);
                s += bf_lo(raw[0]) * n0[0] + bf_hi(raw[0]) * n0[1] + bf_lo(raw[1]) * n0[2] + bf_hi(raw[1]) * n0[3]
                   + bf_lo(raw[2]) * n1[0] + bf_hi(raw[2]) * n1[1] + bf_lo(raw[3]) * n1[2] + bf_hi(raw[3]) * n1[3];
            }
            s += __shfl_xor(s, 1); s += __shfl_xor(s, 2);
            if (part == 0) qn[tt] = s;
        }
        bf16x8 qf[4];
#pragma unroll
        for (int kk = 0; kk < 4; ++kk) qf[kk] = *(const bf16x8*)(smem + L_QS + t * RS + (kk * 32 + fq * 8) * 2);
        const float rv = rowv[t];
        float rowsum = 0.f;
        u32x2 pk[8];
#pragma unroll
        for (int sb = 0; sb < 8; ++sb) {
            pk[sb] = (u32x2){0u, 0u};
            if (sb <= wid) {
                f32x4 acc = {0.f, 0.f, 0.f, 0.f};
#pragma unroll
                for (int kk = 0; kk < 4; ++kk) {
                    const bf16x8 kf = *(const bf16x8*)(smem + L_KS + (16 * sb + fr) * RS + (kk * 32 + fq * 8) * 2);
                    acc = __builtin_amdgcn_mfma_f32_16x16x32_bf16(kf, qf[kk], acc, 0, 0, 0);
                }
                const f32x4 cv = *(const f32x4*)(colv + 16 * sb + 4 * fq), cm = *(const f32x4*)(colm + 16 * sb + 4 * fq);
                float pv[4];
#pragma unroll
                for (int j = 0; j < 4; ++j) {
                    const int s = 16 * sb + 4 * fq + j;
                    const float w = (s <= t) ? __expf(rv + cv[j]) * cm[j] : 0.f;
                    pv[j] = acc[j] * w; rowsum += pv[j];
                }
                pk[sb] = (u32x2){pack2(pv[0], pv[1]), pack2(pv[2], pv[3])};
            }
        }
        if (wid == 0 && c + 1 < NCH) scalars(c + 1);
        __syncthreads();
#pragma unroll
        for (int sb = 0; sb < 8; ++sb) *(u32x2*)(smem + L_KS + t * RS + (16 * sb + 4 * fq) * 2) = pk[sb];
        rowsum += __shfl_xor(rowsum, 16); rowsum += __shfl_xor(rowsum, 32);
        if (ML) {
            const int d = tid >> 2, part = tid & 3;
            float s = 0.f;
#pragma unroll
            for (int cc = 0; cc < 4; ++cc) {
                const u32x4 raw = *(const u32x4*)(smem + L_KT + d * RS + (part * 4 + cc) * 16);
                s += bf_lo(raw[0]) + bf_hi(raw[0]) + bf_lo(raw[1]) + bf_hi(raw[1]) + bf_lo(raw[2]) + bf_hi(raw[2]) + bf_lo(raw[3]) + bf_hi(raw[3]);
            }
            s += __shfl_xor(s, 1); s += __shfl_xor(s, 2);
            if (part == 0) nvec[d] = misc[0] * nvec[d] + s;
        }
        __syncthreads();
        bf16x8 pf[4];
#pragma unroll
        for (int kk = 0; kk < 4; ++kk) pf[kk] = *(const bf16x8*)(smem + L_KS + t * RS + (kk * 32 + fq * 8) * 2);
        const float et = ev[t];
        float ddv = 1.f;
        if (ML) ddv = fmaxf(fabsf(rowsum + et * qn[t]), dden[t]);
        float ss = 0.f;
#pragma unroll
        for (int vb = 0; vb < 4; ++vb) {
            f32x4 acc = {0.f, 0.f, 0.f, 0.f};
            const int vrow = 16 * vb + fr;
#pragma unroll
            for (int kk = 0; kk < 4; ++kk) {
                const bf16x8 sf = *(const bf16x8*)(smem + L_ST + vrow * RS + (kk * 32 + fq * 8) * 2);
                acc = __builtin_amdgcn_mfma_f32_16x16x32_bf16(sf, qf[kk], acc, 0, 0, 0);
            }
            acc *= et;
#pragma unroll
            for (int kk = 0; kk < 4; ++kk) {
                const bf16x8 vf = *(const bf16x8*)(smem + L_VT + vrow * RS + (((kk * 4 + fq) ^ ((vrow >> 3) & 7)) << 4));
                acc = __builtin_amdgcn_mfma_f32_16x16x32_bf16(vf, pf[kk], acc, 0, 0, 0);
            }
            const float gz[4] = {bf_lo(gate[vb][0]), bf_hi(gate[vb][0]), bf_lo(gate[vb][1]), bf_hi(gate[vb][1])};
            float o[4];
#pragma unroll
            for (int j = 0; j < 4; ++j) {
                if (ML) { const float hv = acc[j]; ss += hv * hv; o[j] = hv * sigm_f(gz[j]); }
                else {
                    const int v = 16 * vb + 4 * fq + j;
                    const float xv = bf2f(*(const bf16_t*)(smem + L_VT + v * RS + (((t >> 3) ^ ((v >> 3) & 7)) << 4) + (t & 7) * 2));
                    const float y = (acc[j] + D_h * xv) * silu_f(gz[j]); ss += y * y; o[j] = y;
                }
            }
            if (valid) *(u32x2*)(MIX + (size_t)row * MIXW + mixcol + 16 * vb + 4 * fq) = (u32x2){pack2(o[0], o[1]), pack2(o[2], o[3])};
        }
        ss += __shfl_xor(ss, 16); ss += __shfl_xor(ss, 32);
        if (valid && fq == 0) {
            if (ML) { ((float*)(p.ws + WS_SSQM))[(size_t)row * 32 + h * 4 + vq] = ss; if (vq == 0) ((float*)(p.ws + WS_DD))[(size_t)row * 8 + h] = ddv; }
            else ((float*)(p.ws + WS_SSQ))[(size_t)row * 32 + h] = ss;
        }
        const float dec = misc[0];
#pragma unroll
        for (int vb = 0; vb < 4; ++vb) st[vb] *= dec;
#pragma unroll
        for (int kk = 0; kk < 4; ++kk) {
            const int drow = 16 * wid + fr;
            const bf16x8 kf = *(const bf16x8*)(smem + L_KT + drow * RS + (((kk * 4 + fq) ^ ((drow >> 3) & 7)) << 4));
#pragma unroll
            for (int vb = 0; vb < 4; ++vb) {
                const int vrow = 16 * vb + fr;
                const bf16x8 vf = *(const bf16x8*)(smem + L_VT + vrow * RS + (((kk * 4 + fq) ^ ((vrow >> 3) & 7)) << 4));
                st[vb] = __builtin_amdgcn_mfma_f32_16x16x32_bf16(kf, vf, st[vb], 0, 0, 0);
            }
        }
        __syncthreads();
#pragma unroll
        for (int vb = 0; vb < 4; ++vb)
            *(u32x2*)(smem + L_ST + (16 * vb + fr) * RS + (16 * wid + 4 * fq) * 2) = (u32x2){pack2(st[vb][0], st[vb][1]), pack2(st[vb][2], st[vb][3])};
    }
#pragma unroll
    for (int vb = 0; vb < 4; ++vb) {
        const int v = 16 * vb + fr, d0 = 16 * wid + 4 * fq;
        if (!ML) *(f32x4*)(p.out + O_P_SSD + ((size_t)(b * 32 + h) * 64 + v) * 128 + d0) = st[vb];
        else {
#pragma unroll
            for (int j = 0; j < 4; ++j) p.out[O_P_MLC + ((size_t)(b * 8 + h) * 128 + d0 + j) * 256 + vq * 64 + v] = st[vb][j];
        }
    }
    if (ML && vq == 0) {
        if (tid < 128) p.out[O_P_MLN + (size_t)(b * 8 + h) * 128 + tid] = nvec[tid];
        if (tid == 0) p.out[O_P_MLM + b * 8 + h] = mpp[0];
    }
    __syncthreads();
}

__device__ __forceinline__ void sample_ssd(const Params& p, unsigned char* smem, int job) {
    const int tid = opaque_tid(), wid = tid >> 6, lane = tid & 63;
    const int b = job >> 1, g = job & 1, rowb = ROW_SAMPLE + b * 8;
    const bf16_t* U = (const bf16_t*)(p.ws + WS_U);
    const float* SF = (const float*)(p.ws + WS_SF);
    bf16_t* MIX = (bf16_t*)(p.ws + WS_MIX);
    float* Bc = (float*)smem; float* Cc = Bc + 1024; float* xall = Cc + 1024; float* G = xall + 8192; float* dts = G + 64; float* ssqp = dts + 128;
    const float* sconv = p.in[2]; const float* cw = p.in[11]; const float* cb = p.in[12];
#pragma unroll
    for (int q = 0; q < 3; ++q) {
        int ch; float* dst; int dstride = 0;
        if (q < 2) { ch = g * 1024 + tid + q * 512; dst = xall + tid + q * 512; dstride = 1024; }
        else { if (tid >= 256) break; const int which = tid >> 7, n = tid & 127; ch = 2048 + which * 256 + g * 128 + n; dst = (which ? Cc : Bc) + n; dstride = 128; }
        float xm3 = sconv[(size_t)(b * 3 + 0) * 2560 + ch], xm2 = sconv[(size_t)(b * 3 + 1) * 2560 + ch], xm1 = sconv[(size_t)(b * 3 + 2) * 2560 + ch];
        const float w0 = cw[ch], w1 = cw[2560 + ch], w2 = cw[5120 + ch], w3 = cw[7680 + ch], bb = cb[ch];
#pragma unroll
        for (int t = 0; t < 8; ++t) {
            const float x = bf2f(U[(size_t)(rowb + t) * N1P + UC_XBC + ch]);
            dst[t * dstride] = silu_f(bb + w0 * xm3 + w1 * xm2 + w2 * xm1 + w3 * x);
            xm3 = xm2; xm2 = xm1; xm1 = x;
        }
    }
    if (tid < 128) { const int hh = tid >> 3, t = tid & 7; dts[tid] = softplus_f(SF[(size_t)(rowb + t) * 64 + g * 16 + hh] + p.in[13][g * 16 + hh]); }
    __syncthreads();
    {
        const int pair = tid >> 3, part = tid & 7, t = pair >> 3, s = pair & 7;
        float sum = 0.f;
#pragma unroll
        for (int i = 0; i < 4; ++i) {
            const f32x4 c4 = *(const f32x4*)(Cc + t * 128 + part * 16 + i * 4), b4 = *(const f32x4*)(Bc + s * 128 + part * 16 + i * 4);
            sum += c4[0] * b4[0] + c4[1] * b4[1] + c4[2] * b4[2] + c4[3] * b4[3];
        }
        sum += __shfl_xor(sum, 1); sum += __shfl_xor(sum, 2); sum += __shfl_xor(sum, 4);
        if (part == 0) G[pair] = sum;
    }
    __syncthreads();
    const int pp = tid >> 3, nq = tid & 7;
    f32x4 snext[4];
#pragma unroll
    for (int i = 0; i < 4; ++i) snext[i] = __builtin_nontemporal_load((const f32x4*)(p.in[3] + ((size_t)(b * 32 + g * 16) * 64 + pp) * 128 + nq * 4 + 32 * i));
    for (int hh = 0; hh < 16; ++hh) {
        const int h = g * 16 + hh;
        const float A_h = -__expf(p.in[14][h]), D_h = p.in[15][h];
        float dtv[8], cum[8];
        { float run = 0.f;
#pragma unroll
          for (int t = 0; t < 8; ++t) { dtv[t] = dts[hh * 8 + t]; run += dtv[t] * A_h; cum[t] = run; } }
        const size_t soff = ((size_t)(b * 32 + h) * 64 + pp) * 128 + nq * 4;
        f32x4 s0[4];
#pragma unroll
        for (int i = 0; i < 4; ++i) s0[i] = snext[i];
        if (hh + 1 < 16) {
#pragma unroll
            for (int i = 0; i < 4; ++i) snext[i] = __builtin_nontemporal_load((const f32x4*)(p.in[3] + soff + 64 * 128 + 32 * i));
        }
        float cs[8];
#pragma unroll
        for (int t = 0; t < 8; ++t) {
            float sum = 0.f;
#pragma unroll
            for (int i = 0; i < 4; ++i) { const f32x4 c4 = *(const f32x4*)(Cc + t * 128 + nq * 4 + 32 * i); sum += c4[0] * s0[i][0] + c4[1] * s0[i][1] + c4[2] * s0[i][2] + c4[3] * s0[i][3]; }
            sum += __shfl_xor(sum, 1); sum += __shfl_xor(sum, 2); sum += __shfl_xor(sum, 4);
            cs[t] = sum;
        }
        float ycs = 0.f, ct = 0.f;
#pragma unroll
        for (int t = 0; t < 8; ++t) { ycs = (nq == t) ? cs[t] : ycs; ct = (nq == t) ? cum[t] : ct; }
        float y = __expf(ct) * ycs, xt = 0.f;
#pragma unroll
        for (int s = 0; s < 8; ++s) {
            const float xs = xall[s * 1024 + hh * 64 + pp];
            const float term = (s <= nq) ? G[nq * 8 + s] * __expf(ct - cum[s]) * dtv[s] * xs : 0.f;
            y += term; xt = (s == nq) ? xs : xt;
        }
        y += D_h * xt;
        const float z = bf2f(U[(size_t)(rowb + nq) * N1P + UC_Z + h * 64 + pp]);
        y *= silu_f(z);
        { const unsigned pk = pack2(y, 0.f); MIX[(size_t)(rowb + nq) * MIXW + h * 64 + pp] = (bf16_t)(pk & 0xffffu); }
        float sq = y * y; sq += __shfl_xor(sq, 8); sq += __shfl_xor(sq, 16); sq += __shfl_xor(sq, 32);
        if (lane < 8) ssqp[(hh * 8 + wid) * 8 + lane] = sq;
        const float cl = cum[7], dec = __expf(cl);
        float xw[8];
#pragma unroll
        for (int s = 0; s < 8; ++s) xw[s] = __expf(cl - cum[s]) * dtv[s] * xall[s * 1024 + hh * 64 + pp];
#pragma unroll
        for (int i = 0; i < 4; ++i) {
            f32x4 acc = s0[i] * dec;
#pragma unroll
            for (int s = 0; s < 8; ++s) acc += xw[s] * *(const f32x4*)(Bc + s * 128 + nq * 4 + 32 * i);
            __builtin_nontemporal_store(acc, (f32x4*)(p.out + O_S_SSD + soff + 32 * i));
        }
    }
    __syncthreads();
    if (tid < 128) {
        const int hh = tid >> 3, t = tid & 7; float tot = 0.f;
#pragma unroll
        for (int w = 0; w < 8; ++w) tot += ssqp[(hh * 8 + w) * 8 + t];
        ((float*)(p.ws + WS_SSQ))[(size_t)(rowb + t) * 32 + g * 16 + hh] = tot;
    }
    __syncthreads();
}

__device__ __forceinline__ void sample_ml(const Params& p, unsigned char* smem, int job) {
    const int tid = opaque_tid(), wid = __builtin_amdgcn_readfirstlane(tid >> 6), lane = tid & 63;
    const int b = job >> 3, h = job & 7, rowb = ROW_SAMPLE + b * 8;
    const bf16_t* U = (const bf16_t*)(p.ws + WS_U);
    const float* SF = (const float*)(p.ws + WS_SF);
    bf16_t* MIX = (bf16_t*)(p.ws + WS_MIX);
    float* qs = (float*)smem; float* ks = qs + 1024; float* vs = qs + 2048; float* QK = qs + 4096; float* sig = qs + 4160; float* slf = qs + 4168;
    float* qnv = qs + 4176; float* n0v = qs + 4192; float* red = qs + 4352;
    {
        const int t = tid >> 6, c = tid & 63;
        const size_t r = (size_t)(rowb + t) * N1P;
        const unsigned qq = *(const unsigned*)(U + r + UC_Q + h * 128 + 2 * c), kk = *(const unsigned*)(U + r + UC_K + h * 128 + 2 * c);
        const u32x2 vv = *(const u32x2*)(U + r + UC_V + h * 256 + 4 * c);
        qs[t * 128 + 2 * c] = bf_lo(qq); qs[t * 128 + 2 * c + 1] = bf_hi(qq);
        ks[t * 128 + 2 * c] = bf_lo(kk) * 0.08838834764831845f; ks[t * 128 + 2 * c + 1] = bf_hi(kk) * 0.08838834764831845f;
        *(f32x4*)(vs + t * 256 + 4 * c) = (f32x4){bf_lo(vv[0]), bf_hi(vv[0]), bf_lo(vv[1]), bf_hi(vv[1])};
        if (tid < 8) { sig[tid] = SF[(size_t)(rowb + tid) * 64 + 32 + h] + p.in[17][h]; slf[tid] = logsig_f(SF[(size_t)(rowb + tid) * 64 + 40 + h] + p.in[18][h]); }
        if (tid >= 128 && tid < 256) n0v[tid - 128] = p.in[5][(size_t)(b * 8 + h) * 128 + tid - 128];
    }
    const int v4 = lane, dg = wid;
    const size_t coff = ((size_t)(b * 8 + h) * 128 + dg * 16) * 256 + v4 * 4;
    f32x4 c0[16];
#pragma unroll
    for (int i = 0; i < 16; ++i) c0[i] = __builtin_nontemporal_load((const f32x4*)(p.in[4] + coff + (size_t)i * 256));
    const float mp = p.in[6][b * 8 + h];
    __syncthreads();
    float F[8], gg[8], M[8];
    { float run = 0.f, pm = -INFINITY;
#pragma unroll
      for (int t = 0; t < 8; ++t) { run += slf[t]; F[t] = run; gg[t] = sig[t] - run; pm = fmaxf(pm, gg[t]); M[t] = fmaxf(pm, mp); } }
    const float Ml = M[7], dec = __expf(mp - Ml), m_new = F[7] + Ml;
    {
        const int pair = tid >> 3, part = tid & 7, t = pair >> 3, s = pair & 7;
        float sum = 0.f;
#pragma unroll
        for (int i = 0; i < 4; ++i) {
            const f32x4 a4 = *(const f32x4*)(qs + t * 128 + part * 16 + i * 4), b4 = *(const f32x4*)(ks + s * 128 + part * 16 + i * 4);
            sum += a4[0] * b4[0] + a4[1] * b4[1] + a4[2] * b4[2] + a4[3] * b4[3];
        }
        sum += __shfl_xor(sum, 1); sum += __shfl_xor(sum, 2); sum += __shfl_xor(sum, 4);
        if (part == 0) QK[pair] = sum;
        float qd = qs[wid * 128 + 2 * lane] * n0v[2 * lane] + qs[wid * 128 + 2 * lane + 1] * n0v[2 * lane + 1];
        qd = wave_sum(qd);
        if (lane == 0) qnv[wid] = qd;
    }
#pragma unroll
    for (int t = 0; t < 8; ++t) {
        f32x4 acc = {0.f, 0.f, 0.f, 0.f};
#pragma unroll
        for (int i4 = 0; i4 < 4; ++i4) {
            const f32x4 q4 = *(const f32x4*)(qs + t * 128 + dg * 16 + i4 * 4);
            acc += q4[0] * c0[i4 * 4] + q4[1] * c0[i4 * 4 + 1] + q4[2] * c0[i4 * 4 + 2] + q4[3] * c0[i4 * 4 + 3];
        }
        *(f32x4*)(red + (dg * 8 + t) * 256 + v4 * 4) = acc;
    }
    __syncthreads();
    f32x4 vv[8];
    float scs[8];
#pragma unroll
    for (int s = 0; s < 8; ++s) { vv[s] = *(const f32x4*)(vs + s * 256 + v4 * 4); scs[s] = __expf(gg[s] - Ml); }
#pragma unroll
    for (int i = 0; i < 16; ++i) {
        const int d = dg * 16 + i;
        f32x4 cn = c0[i] * dec;
#pragma unroll
        for (int s = 0; s < 8; ++s) cn += (scs[s] * ks[s * 128 + d]) * vv[s];
        __builtin_nontemporal_store(cn, (f32x4*)(p.out + O_S_MLC + coff + (size_t)i * 256));
    }
    if (tid < 128) {
        float nn = dec * n0v[tid];
#pragma unroll
        for (int s = 0; s < 8; ++s) nn += scs[s] * ks[s * 128 + tid];
        p.out[O_S_MLN + (size_t)(b * 8 + h) * 128 + tid] = nn;
    }
    if (tid == 0) p.out[O_S_MLM + b * 8 + h] = m_new;
    {
        const int t = wid;
        float Mt = 0.f, Ft = 0.f;
#pragma unroll
        for (int q = 0; q < 8; ++q) { Mt = (t == q) ? M[q] : Mt; Ft = (t == q) ? F[q] : Ft; }
        f32x4 numc = {0.f, 0.f, 0.f, 0.f};
#pragma unroll
        for (int q = 0; q < 8; ++q) numc += *(const f32x4*)(red + (q * 8 + t) * 256 + lane * 4);
        const float et = __expf(mp - Mt);
        float den = et * qnv[t];
        f32x4 intra = {0.f, 0.f, 0.f, 0.f};
#pragma unroll
        for (int s = 0; s < 8; ++s) {
            if (s <= t) { const float w = __expf(gg[s] - Mt) * QK[t * 8 + s]; den += w; intra += w * vv[s]; }
        }
        const float dd = fmaxf(fabsf(den), __expf(-(Ft + Mt)));
        const f32x4 hv = (et * numc + intra) * (1.f / dd);
        float ss = hv[0] * hv[0] + hv[1] * hv[1] + hv[2] * hv[2] + hv[3] * hv[3];
        ss = wave_sum(ss);
        const u32x2 og = *(const u32x2*)(U + (size_t)(rowb + t) * N1P + UC_O + h * 256 + lane * 4);
        *(u32x2*)(MIX + (size_t)(rowb + t) * MIXW + 2048 + h * 256 + lane * 4) =
            (u32x2){pack2(hv[0] * sigm_f(bf_lo(og[0])), hv[1] * sigm_f(bf_hi(og[0]))), pack2(hv[2] * sigm_f(bf_lo(og[1])), hv[3] * sigm_f(bf_hi(og[1])))};
        if (lane < 4) ((float*)(p.ws + WS_SSQM))[(size_t)(rowb + t) * 32 + h * 4 + lane] = lane == 0 ? ss : 0.f;
        if (lane == 0) ((float*)(p.ws + WS_DD))[(size_t)(rowb + t) * 8 + h] = 1.f;
    }
    __syncthreads();
}

__device__ __forceinline__ void phase_scan(const Params& p, unsigned char* smem) {
#ifndef SC_MASK
#define SC_MASK 15
#endif
    for (int j = opaque_bid(); j < 256; j += gridDim.x) { if (j < 128) { if (SC_MASK & 1) prompt_scan<false>(p, smem, j); } else { if (SC_MASK & 2) prompt_scan<true>(p, smem, j - 128); } }
    if (SC_MASK & 4) for (int j = opaque_bid(); j < 256; j += gridDim.x) sample_ssd(p, smem, j);
    if (SC_MASK & 8) for (int j = opaque_bid(); j < 1024; j += gridDim.x) sample_ml(p, smem, j);
}

__device__ __forceinline__ void phase_mixnorm(const Params& p) {
    const int tid = opaque_tid(), wid = tid >> 6, lane = tid & 63;
    bf16_t* MIX = (bf16_t*)(p.ws + WS_MIX);
    const float* SSQ = (const float*)(p.ws + WS_SSQ); const float* SSQM = (const float*)(p.ws + WS_SSQM);
    const float* w1 = p.in[16]; const float* w2 = p.in[19];
    for (int row = opaque_bid() * 8 + wid; row < NVALID; row += gridDim.x * 8) {
        float s = lane < 32 ? SSQ[(size_t)row * 32 + lane] : 0.f;
        s = wave_sum(s);
        const float r1 = rsqrtf(s * (1.f / 2048.f) + EPS);
        float m = lane < 32 ? SSQM[(size_t)row * 32 + lane] : 0.f;
        m += __shfl_xor(m, 1); m += __shfl_xor(m, 2);
        const float ddh = lane < 32 ? ((const float*)(p.ws + WS_DD))[(size_t)row * 8 + (lane >> 2)] : 1.f;
        const float idd = 1.f / ddh;
        const float rh = rsqrtf(m * (1.f / 256.f) * idd * idd + EPS) * idd;
        u32x4 raws[8];
#pragma unroll
        for (int it = 0; it < 8; ++it) raws[it] = *(const u32x4*)(MIX + (size_t)row * MIXW + it * 512 + lane * 8);
#pragma unroll
        for (int it = 0; it < 8; ++it) {
            const int col = it * 512 + lane * 8;
            const u32x4 raw = raws[it];
            float scale; const float* wp;
            if (it < 4) { scale = r1; wp = w1 + col; }
            else { const int head = (it - 4) * 2 + (lane >> 5); scale = __shfl(rh, head * 4); wp = w2 + col - 2048; }
            const f32x4 wa = *(const f32x4*)wp, wb = *(const f32x4*)(wp + 4);
            u32x4 o;
            o[0] = pack2(bf_lo(raw[0]) * scale * wa[0], bf_hi(raw[0]) * scale * wa[1]); o[1] = pack2(bf_lo(raw[1]) * scale * wa[2], bf_hi(raw[1]) * scale * wa[3]);
            o[2] = pack2(bf_lo(raw[2]) * scale * wb[0], bf_hi(raw[2]) * scale * wb[1]); o[3] = pack2(bf_lo(raw[3]) * scale * wb[2], bf_hi(raw[3]) * scale * wb[3]);
            *(u32x4*)(MIX + (size_t)row * MIXW + col) = o;
        }
    }
    const bf16_t* U = (const bf16_t*)(p.ws + WS_U);
    for (int i = opaque_bid() * 512 + tid; i < 132 * 3 * 320; i += gridDim.x * 512) {
        const int cgp = i % 320, j = (i / 320) % 3, q = i / 960;
        int row; float* dst;
        if (q < 4) { row = q * 2048 + 2045 + j; dst = p.out + O_P_SSDCONV + (size_t)(q * 3 + j) * 2560 + cgp * 8; }
        else { row = ROW_SAMPLE + (q - 4) * 8 + 5 + j; dst = p.out + O_S_SSDCONV + (size_t)((q - 4) * 3 + j) * 2560 + cgp * 8; }
        const u32x4 raw = *(const u32x4*)(U + (size_t)row * N1P + UC_XBC + cgp * 8);
        *(f32x4*)dst = (f32x4){bf_lo(raw[0]), bf_hi(raw[0]), bf_lo(raw[1]), bf_hi(raw[1])};
        *(f32x4*)(dst + 4) = (f32x4){bf_lo(raw[2]), bf_hi(raw[2]), bf_lo(raw[3]), bf_hi(raw[3])};
    }
}

__device__ __forceinline__ void unpack8(const u32x4 raw, float (&x)[8]) {
#pragma unroll
    for (int i = 0; i < 4; ++i) { x[2 * i] = bf_lo(raw[i]); x[2 * i + 1] = bf_hi(raw[i]); }
}
__device__ __forceinline__ void phase_act(const Params& p) {
    const bf16_t* UP = (const bf16_t*)(p.ws + WS_UP); bf16_t* ACT = (bf16_t*)(p.ws + WS_ACT);
    const float* cw = p.in[23]; const float* cb = p.in[24]; const float* fst = p.in[7];
    constexpr int CGN = DFF / 8, TOTAL = (NVALID / 8) * CGN;
    const int tid = opaque_tid();
    for (int idx = opaque_bid() * 512 + tid; idx < TOTAL; idx += gridDim.x * 512) {
        const int rb = idx / CGN, cgp = idx % CGN, row0 = rb * 8, c0 = cgp * 8;
        float g2[8], g1[8], v2[8], v1[8];
        int prow = -1; bool from_state = false; int sb = 0, pb = -1;
        if (row0 < ROW_SAMPLE) { const int b = row0 >> 11, t0 = row0 & 2047; prow = t0 > 0 ? row0 - 2 : ROW_META + b * 16 + 14; if (t0 == 2040) pb = b; }
        else if (row0 < ROW_META) { from_state = true; sb = (row0 - ROW_SAMPLE) >> 3; }
        else { if ((row0 - ROW_META) & 15) prow = row0 - 2; }
        if (from_state) {
            const float* s0 = fst + (size_t)(sb * 2) * N3;
#pragma unroll
            for (int i = 0; i < 8; ++i) { g2[i] = s0[c0 + i]; g1[i] = s0[N3 + c0 + i]; v2[i] = s0[DFF + c0 + i]; v1[i] = s0[N3 + DFF + c0 + i]; }
        } else if (prow >= 0) {
            unpack8(*(const u32x4*)(UP + (size_t)prow * N3 + c0), g2); unpack8(*(const u32x4*)(UP + (size_t)(prow + 1) * N3 + c0), g1);
            unpack8(*(const u32x4*)(UP + (size_t)prow * N3 + DFF + c0), v2); unpack8(*(const u32x4*)(UP + (size_t)(prow + 1) * N3 + DFF + c0), v1);
        } else {
#pragma unroll
            for (int i = 0; i < 8; ++i) { g2[i] = 0.f; g1[i] = 0.f; v2[i] = 0.f; v1[i] = 0.f; }
        }
        float wg[3][8], wv[3][8], bg[8], bv[8];
#pragma unroll
        for (int j = 0; j < 3; ++j)
#pragma unroll
            for (int i = 0; i < 8; ++i) { wg[j][i] = cw[j * N3 + c0 + i]; wv[j][i] = cw[j * N3 + DFF + c0 + i]; }
#pragma unroll
        for (int i = 0; i < 8; ++i) { bg[i] = cb[c0 + i]; bv[i] = cb[DFF + c0 + i]; }
        u32x4 rg[8], rv[8];
#pragma unroll
        for (int r = 0; r < 8; ++r) { rg[r] = __builtin_nontemporal_load((const u32x4*)(UP + (size_t)(row0 + r) * N3 + c0)); rv[r] = __builtin_nontemporal_load((const u32x4*)(UP + (size_t)(row0 + r) * N3 + DFF + c0)); }
#pragma unroll
        for (int r = 0; r < 8; ++r) {
            float gx[8], vx[8];
            unpack8(rg[r], gx); unpack8(rv[r], vx);
            float o[8];
#pragma unroll
            for (int i = 0; i < 8; ++i) {
                const float yg = bg[i] + wg[0][i] * g2[i] + wg[1][i] * g1[i] + wg[2][i] * gx[i];
                const float yv = bv[i] + wv[0][i] * v2[i] + wv[1][i] * v1[i] + wv[2][i] * vx[i];
                o[i] = silu_f(yg) * yv;
                g2[i] = g1[i]; g1[i] = gx[i]; v2[i] = v1[i]; v1[i] = vx[i];
            }
            u32x4 ov; ov[0] = pack2(o[0], o[1]); ov[1] = pack2(o[2], o[3]); ov[2] = pack2(o[4], o[5]); ov[3] = pack2(o[6], o[7]);
            *(u32x4*)(ACT + (size_t)(row0 + r) * DFF + c0) = ov;
        }
        if (from_state || pb >= 0) {
            float* dst = from_state ? p.out + O_S_FFN + (size_t)(sb * 2) * N3 : p.out + O_P_FFN + (size_t)(pb * 2) * N3;
            *(f32x4*)(dst + c0) = (f32x4){g2[0], g2[1], g2[2], g2[3]}; *(f32x4*)(dst + c0 + 4) = (f32x4){g2[4], g2[5], g2[6], g2[7]};
            *(f32x4*)(dst + N3 + c0) = (f32x4){g1[0], g1[1], g1[2], g1[3]}; *(f32x4*)(dst + N3 + c0 + 4) = (f32x4){g1[4], g1[5], g1[6], g1[7]};
            *(f32x4*)(dst + DFF + c0) = (f32x4){v2[0], v2[1], v2[2], v2[3]}; *(f32x4*)(dst + DFF + c0 + 4) = (f32x4){v2[4], v2[5], v2[6], v2[7]};
            *(f32x4*)(dst + N3 + DFF + c0) = (f32x4){v1[0], v1[1], v1[2], v1[3]}; *(f32x4*)(dst + N3 + DFF + c0 + 4) = (f32x4){v1[4], v1[5], v1[6], v1[7]};
        }
    }
}

__device__ __forceinline__ void phase_final(const Params& p) {
    const int tid = opaque_tid(), wid = tid >> 6, lane = tid & 63;
    const float* SS3 = (const float*)(p.ws + WS_SS3); const float* nw = p.in[26];
    for (int row = opaque_bid() * 8 + wid; row < NOUTROWS; row += gridDim.x * 8) {
        const float r = rsqrtf(SS3[row] * (1.f / 2048.f) + EPS);
        float* rp = p.out + (size_t)row * DM;
        f32x4 v[8];
#pragma unroll
        for (int it = 0; it < 8; ++it) v[it] = __builtin_nontemporal_load((const f32x4*)(rp + it * 256 + lane * 4));
#pragma unroll
        for (int it = 0; it < 8; ++it) {
            const int col = it * 256 + lane * 4;
            const f32x4 w = *(const f32x4*)(nw + col);
            __builtin_nontemporal_store(v[it] * r * w, (f32x4*)(rp + col));
        }
    }
}

__global__ void __launch_bounds__(512, 2) hymba_fwd(Params p0) {
    extern __shared__ __attribute__((aligned(16))) unsigned char smem[];
    cg::grid_group grid = cg::this_grid();
#ifndef DUP_PHASE
#define DUP_PHASE -1
#endif
    for (int phx = p0.ph_lo; phx < p0.ph_hi + (DUP_PHASE >= 0 ? 1 : 0); ++phx) {
        const int ph = (DUP_PHASE >= 0 && phx > DUP_PHASE) ? phx - 1 : phx;
        Params p = p0;
        { size_t z = 0; asm volatile("" : "+s"(z)); p.ws = p0.ws + z; p.out = p0.out + z; }
        switch (ph) {
        case 0: if (PH_MASK & 1) phase_prep(p, smem); break;
        case 1: if (PH_MASK & 2) { pg8::Gemm g{(const bf16_t*)(p.ws + WS_XN), (const bf16_t*)(p.ws + WS_WIN), MP, N1P, 2048}; pg8::StaticOrder S; S.init(MP, N1P, gridDim.x, opaque_bid());
                  Epi1 E{(bf16_t*)(p.ws + WS_U), (float*)(p.ws + WS_SF)}; pg8::gemm_phase((LAS unsigned char*)smem, g, S, E);
                  convert_in_tail(p, smem, (MP / 256) * (N1P / 256), T_IN, T_IN + T_OUT + T_UP); } break;
        case 2: if (PH_MASK & 4) phase_scan(p, smem); break;
        case 3: if (PH_MASK & 8) phase_mixnorm(p); break;
        case 4: if (PH_MASK & 16) { pg8::Gemm g{(const bf16_t*)(p.ws + WS_MIX), (const bf16_t*)(p.ws + WS_WOUT), MP, 2048, 4096}; pg8::StaticOrder S; S.init(MP, 2048, gridDim.x, opaque_bid());
                  Epi2 E{p}; pg8::gemm_phase((LAS unsigned char*)smem, g, S, E); } break;
        case 5: if (PH_MASK & 32) { pg8::Gemm g{(const bf16_t*)(p.ws + WS_A2), (const bf16_t*)(p.ws + WS_WUP), MP, N3, 2048}; pg8::StaticOrder S; S.init(MP, N3, gridDim.x, opaque_bid());
                  Epi3 E{(bf16_t*)(p.ws + WS_UP), (const float*)(p.ws + WS_SS2)}; pg8::gemm_phase((LAS unsigned char*)smem, g, S, E);
                  convert_in_tail(p, smem, (MP / 256) * (N3 / 256), T_IN + T_OUT + T_UP, T_ALL); } break;
        case 6: if (PH_MASK & 64) phase_act(p); break;
        case 7: if (PH_MASK & 128) { pg8::Gemm g{(const bf16_t*)(p.ws + WS_ACT), (const bf16_t*)(p.ws + WS_WDOWN), MP, 2048, DFF}; pg8::StaticOrder S; S.init(MP, 2048, gridDim.x, opaque_bid());
                  Epi4 E{(const float*)(p.ws + WS_H1), p.out, (float*)(p.ws + WS_SS3)}; pg8::gemm_phase((LAS unsigned char*)smem, g, S, E); } break;
        default: if (PH_MASK & 256) phase_final(p); break;
        }
        if (phx + 1 < p0.ph_hi + (DUP_PHASE >= 0 ? 1 : 0)) grid.sync();
    }
}

extern "C" void kernel_launch(void* const* d_in, const int* in_sizes, int n_in, void* d_out, int out_size, void* d_ws, size_t ws_size, hipStream_t stream) {
    static int grid_blocks = 0;
    if (grid_blocks == 0) {
        if (n_in != 27 || (size_t)out_size != O_END || ws_size < WS_END) {
            fprintf(stderr, "kernel_launch: unexpected shapes: n_in %d out %d ws %zu (need %zu)\n", n_in, out_size, ws_size, (size_t)WS_END); grid_blocks = -1; return; }
        int dev = 0, cus = 0, per_cu = 0;
        (void)hipGetDevice(&dev);
        (void)hipDeviceGetAttribute(&cus, hipDeviceAttributeMultiprocessorCount, dev);
        (void)hipFuncSetAttribute((const void*)hymba_fwd, hipFuncAttributeMaxDynamicSharedMemorySize, LDS_BYTES);
        (void)hipOccupancyMaxActiveBlocksPerMultiprocessor(&per_cu, (const void*)hymba_fwd, 512, LDS_BYTES);
        if (per_cu < 1) { fprintf(stderr, "kernel_launch: occupancy query says %d blocks per CU\n", per_cu); per_cu = 1; }
        grid_blocks = cus;
    }
    if (grid_blocks < 0) return;
    Params p{};
    for (int i = 0; i < 27; ++i) p.in[i] = (const float*)d_in[i];
    p.out = (float*)d_out; p.ws = (unsigned char*)d_ws; p.ph_lo = 0; p.ph_hi = NPHASE;
    void* args[] = {&p};
    hipError_t e = hipLaunchCooperativeKernel((const void*)hymba_fwd, dim3(grid_blocks), dim3(512), args, LDS_BYTES, stream);
    if (e != hipSuccess) fprintf(stderr, "cooperative launch failed: %s (grid %d)\n", hipGetErrorString(e), grid_blocks);
}
```

```cpp
#include <hip/hip_runtime.h>
#include <hip/hip_cooperative_groups.h>
#include <cstdio>
namespace cg = cooperative_groups;

#define LAS __attribute__((address_space(3)))
typedef unsigned short bf16_t;
typedef short bf16x8 __attribute__((ext_vector_type(8)));
typedef float f32x4 __attribute__((ext_vector_type(4)));
typedef unsigned u32x4 __attribute__((ext_vector_type(4)));
typedef unsigned u32x2 __attribute__((ext_vector_type(2)));

constexpr int DM = 2048, MP = 9472, NVALID = 9280, NOUTROWS = 9216;
constexpr int N1P = 11008, N3 = 11264, DFF = 5632, MIXW = 4096;
constexpr int ROW_SAMPLE = 8192, ROW_META = 9216;
constexpr float EPS = 1e-6f;
constexpr int UC_Z = 0, UC_XBC = 2048, UC_Q = 4640, UC_K = 5664, UC_V = 6688, UC_O = 8752;
constexpr size_t WS_WIN = 0;
constexpr size_t WS_WOUT = WS_WIN + (size_t)N1P * 2048 * 2;
constexpr size_t WS_WUP = WS_WOUT + (size_t)2048 * 4096 * 2;
constexpr size_t WS_WDOWN = WS_WUP + (size_t)N3 * 2048 * 2;
constexpr size_t WS_XN = WS_WDOWN + (size_t)2048 * DFF * 2;
constexpr size_t WS_MIX = WS_XN + (size_t)MP * 2048 * 2;
constexpr size_t WS_ACT = WS_XN;
constexpr size_t WS_U = WS_MIX + (size_t)MP * MIXW * 2;
constexpr size_t WS_UP = WS_U;
constexpr size_t WS_H1 = WS_U + (size_t)MP * N3 * 2;
constexpr size_t WS_A2 = WS_H1 + (size_t)MP * 2048 * 4;
constexpr size_t WS_SF = WS_A2 + (size_t)MP * 2048 * 2;
constexpr size_t WS_SSQ = WS_SF + (size_t)MP * 64 * 4;
constexpr size_t WS_SSQM = WS_SSQ + (size_t)MP * 32 * 4;
constexpr size_t WS_SS2 = WS_SSQM + (size_t)MP * 32 * 4;
constexpr size_t WS_SS3 = WS_SS2 + (size_t)MP * 4;
constexpr size_t WS_DD = WS_SS3 + (size_t)MP * 4;
constexpr size_t WS_END = WS_DD + (size_t)MP * 8 * 4;
constexpr size_t O_Y = 0;
constexpr size_t O_P_SSDCONV = 18874368, O_P_SSD = 18905088, O_P_MLC = 19953664, O_P_MLN = 21002240, O_P_MLM = 21006336, O_P_FFN = 21006368;
constexpr size_t O_S_SSDCONV = 21096480, O_S_SSD = 22079520, O_S_MLC = 55633952, O_S_MLN = 89188384, O_S_MLM = 89319456, O_S_FFN = 89320480;
constexpr size_t O_END = 92204064;
constexpr int LDS_BYTES = 147456;
constexpr int NPHASE = 9;
#ifndef CHL_SSD
#define CHL_SSD 128
#endif
#ifndef CHL_ML
#define CHL_ML 128
#endif
#ifndef PH_MASK
#define PH_MASK 0x1ff
#endif

struct Params {
    const float* in[27];
    float* out;
    unsigned char* ws;
    int ph_lo, ph_hi;
};

__device__ __forceinline__ unsigned pack2(float lo, float hi) { unsigned r; asm("v_cvt_pk_bf16_f32 %0, %1, %2" : "=v"(r) : "v"(lo), "v"(hi)); return r; }
__device__ __forceinline__ float bf_lo(unsigned u) { return __uint_as_float(u << 16); }
__device__ __forceinline__ float bf_hi(unsigned u) { return __uint_as_float(u & 0xffff0000u); }
__device__ __forceinline__ float bf2f(bf16_t h) { return __uint_as_float((unsigned)h << 16); }
__device__ __forceinline__ float sigm_f(float x) { const float d = 1.f + __expf(fminf(-x, 80.f)); float r = __builtin_amdgcn_rcpf(d); return r * (2.f - d * r); }
__device__ __forceinline__ float silu_f(float x) { return x * sigm_f(x); }
__device__ __forceinline__ float softplus_f(float x) { return x > 20.f ? x : log1pf(__expf(x)); }
__device__ __forceinline__ float logsig_f(float x) { return fminf(x, 0.f) - log1pf(__expf(-fabsf(x))); }
__device__ __forceinline__ int opaque_tid() { int t = threadIdx.x; asm volatile("" : "+v"(t)); return t; }
__device__ __forceinline__ int opaque_bid() { int t = blockIdx.x; asm volatile("" : "+s"(t)); return t; }
__device__ __forceinline__ int row_of(int b, int pos) { return pos < 16 ? ROW_META + b * 16 + pos : b * 2048 + pos - 16; }
__device__ __forceinline__ float wave_sum(float v) {
    v += __shfl_xor(v, 32); v += __shfl_xor(v, 16); v += __shfl_xor(v, 8); v += __shfl_xor(v, 4); v += __shfl_xor(v, 2); v += __shfl_xor(v, 1); return v;
}
__device__ __forceinline__ const float* resid_row(const Params& p, int row) {
    if (row < ROW_SAMPLE) return p.in[0] + (size_t)row * DM;
    if (row < ROW_META) return p.in[1] + (size_t)(row - ROW_SAMPLE) * DM;
    if (row < NVALID) return p.in[8] + (size_t)((row - ROW_META) & 15) * DM;
    return nullptr;
}

namespace pg8 {
constexpr int BM = 256, BK = 64, HALF = 128, HTB = HALF * BK * 2, STAGE_BYTES = 8 * HTB, NXCD = 8, WGM = 8;
__device__ __forceinline__ int lds_byte(int r, int c) { const int st = (r >> 4) * 2 + (c >> 5), rr = r & 15, cc = c & 31, ob = rr * 64 + cc * 2; return st * 1024 + (ob ^ (((ob >> 9) & 1) << 5)); }
__device__ __forceinline__ void stage_rc(int b, int& R, int& C) { const int st = b / 1024, sb = b % 1024, swz = sb ^ (((sb >> 9) & 1) << 5); R = (st >> 1) * 16 + swz / 64; C = (st & 1) * 32 + (swz % 64) / 2; }
__device__ __forceinline__ int perm32(int rho) { const int n = rho >> 4, i = rho & 15; return 8 * (i >> 2) + 4 * n + (i & 3); }
struct Unit { int pm, pn; };
struct Gemm { const bf16_t* A; const bf16_t* Bt; int M, N, K; };
struct StaticOrder {
    int nM, nN, nwg, G, c;
    __device__ void init(int M, int N, int G_, int c_) { nM = M / BM; nN = N / BM; nwg = nM * nN; G = G_; c = c_; }
    __device__ bool next(int i, Unit& u) const {
        const long L = (long)i * G + c; if (L >= nwg) return false;
        int wgid = (int)L; { const int q = nwg / NXCD, r = nwg % NXCD, xcd = wgid % NXCD, off = wgid / NXCD; wgid = (xcd < r ? xcd * (q + 1) : r * (q + 1) + (xcd - r) * q) + off; }
        const int nig = WGM * nN, gid = wgid / nig, fm = gid * WGM, gsz = (nM - fm) < WGM ? (nM - fm) : WGM;
        u.pm = fm + ((wgid % nig) % gsz); u.pn = (wgid % nig) / gsz; return true;
    }
};

template <class Epi>
__device__ __forceinline__ void gemm_phase(LAS unsigned char* lds, const Gemm g, const StaticOrder& S, const Epi& E) {
    const int tid = opaque_tid(), wid = __builtin_amdgcn_readfirstlane(tid >> 6), lane = tid & 63, wr = wid >> 2, wc = wid & 3, fr = lane & 15, fq = lane >> 4;
    const int K = g.K, nt = K / BK;
    unsigned voffA[2], voffB[2];
#pragma unroll
    for (int i = 0; i < 2; ++i) { int R, C; stage_rc(tid * 16 + i * 8192, R, C); const int Rb = ((R & ~31) + perm32(R & 31));
        voffA[i] = (unsigned)(R * K + C) * 2u; voffB[i] = (unsigned)(Rb * K + C) * 2u; }
    const size_t kstep = (size_t)(BK * 2);
    const size_t hstep = (size_t)HALF * K * 2;
    const size_t tstep = 2 * hstep;
    const unsigned ldsw = (unsigned)wid * 1024u;
    const int aoff = lds_byte(wr * 64 + fr, fq * 8), boff = lds_byte(wc * 32 + fr, fq * 8);
#define PG8_SA(b, h) (((b) * 2 + (h)) * HTB)
#define PG8_SB(b, h) ((4 + (b) * 2 + (h)) * HTB)
#define PG8_STAGE(bufoff, gbase, voff) do { _Pragma("unroll") for (int _i = 0; _i < 2; ++_i) \
        __builtin_amdgcn_global_load_lds((const unsigned*)((const char*)(gbase) + (voff)[_i]), (LAS unsigned*)(lds + (bufoff) + ldsw + _i * 8192), 16, 0, 0); } while (0)
#define PG8_LDA(dst, b, h) do { _Pragma("unroll") for (int m = 0; m < 4; ++m) _Pragma("unroll") for (int k = 0; k < 2; ++k) dst[m][k] = *(const LAS bf16x8*)(lds + PG8_SA(b, h) + aoff + m * 2048 + k * 1024); } while (0)
#define PG8_LDB(dst, b, h) do { _Pragma("unroll") for (int n = 0; n < 2; ++n) _Pragma("unroll") for (int k = 0; k < 2; ++k) dst[n][k] = *(const LAS bf16x8*)(lds + PG8_SB(b, h) + boff + n * 2048 + k * 1024); } while (0)
#define PG8_MMA(ai, bj, At, Bt) do { __builtin_amdgcn_s_setprio(1); _Pragma("unroll") for (int m = 0; m < 4; ++m) _Pragma("unroll") for (int n = 0; n < 2; ++n) _Pragma("unroll") for (int k = 0; k < 2; ++k) \
        acc[ai][bj][m][n] = __builtin_amdgcn_mfma_f32_16x16x32_bf16(Bt[n][k], At[m][k], acc[ai][bj][m][n], 0, 0, 0); __builtin_amdgcn_s_setprio(0); } while (0)
#define PG8_WAIT_V(n) asm volatile("s_waitcnt vmcnt(" #n ")" ::: "memory")
#define PG8_WAIT_L(n) asm volatile("s_waitcnt lgkmcnt(" #n ")" ::: "memory")
#define PG8_BAR __builtin_amdgcn_s_barrier()
#define PG8_SCHED __builtin_amdgcn_sched_barrier(0)
    Unit cur, nxt; int ui = 0;
    if (!S.next(0, cur)) return;
    f32x4 acc[2][2][4][2];
#pragma unroll
    for (int a = 0; a < 2; ++a)
#pragma unroll
        for (int b = 0; b < 2; ++b)
#pragma unroll
            for (int m = 0; m < 4; ++m)
#pragma unroll
                for (int n = 0; n < 2; ++n) acc[a][b][m][n] = (f32x4){0.f, 0.f, 0.f, 0.f};
    bf16x8 At[4][2], B0[2][2], B1[2][2];
    const char* cA = (const char*)g.A + (size_t)cur.pm * tstep; const char* cB = (const char*)g.Bt + (size_t)cur.pn * tstep;
    PG8_STAGE(PG8_SB(0, 0), cB, voffB); PG8_STAGE(PG8_SA(0, 0), cA, voffA); PG8_STAGE(PG8_SB(0, 1), cB + hstep, voffB); PG8_STAGE(PG8_SA(0, 1), cA + hstep, voffA);
    if (wr == 1) PG8_BAR;
    PG8_WAIT_V(4); PG8_BAR;
    PG8_STAGE(PG8_SB(1, 0), cB + kstep, voffB); PG8_STAGE(PG8_SA(1, 0), cA + kstep, voffA); PG8_STAGE(PG8_SB(1, 1), cB + hstep + kstep, voffB);
    PG8_WAIT_V(6); PG8_BAR;
    for (;;) {
        const bool has_next = S.next(ui + 1, nxt);
        const char* nA = has_next ? (const char*)g.A + (size_t)nxt.pm * tstep : cA; const char* nB = has_next ? (const char*)g.Bt + (size_t)nxt.pn * tstep : cB;
        for (int t = 0; t < nt; t += 2) {
            const bool last = (t == nt - 2);
            const char* a1 = cA + (size_t)(t + 1) * kstep;
            const char* a2 = last ? nA : cA + (size_t)(t + 2) * kstep; const char* b2 = last ? nB : cB + (size_t)(t + 2) * kstep;
            const char* a3 = a2 + kstep; const char* b3 = b2 + kstep;
            PG8_LDB(B0, 0, 0); PG8_SCHED; PG8_LDA(At, 0, 0); PG8_STAGE(PG8_SA(1, 1), a1 + hstep, voffA);
            PG8_WAIT_L(8); PG8_BAR; PG8_WAIT_L(0); PG8_MMA(0, 0, At, B0); PG8_BAR; PG8_SCHED;
            PG8_LDB(B1, 0, 1); PG8_STAGE(PG8_SB(0, 0), b2, voffB);
            PG8_BAR; PG8_WAIT_L(0); PG8_MMA(0, 1, At, B1); PG8_BAR;
            PG8_LDA(At, 0, 1); PG8_STAGE(PG8_SA(0, 0), a2, voffA);
            PG8_BAR; PG8_WAIT_L(0); PG8_MMA(1, 0, At, B0); PG8_BAR; PG8_SCHED;
            PG8_STAGE(PG8_SB(0, 1), b2 + hstep, voffB);
            PG8_WAIT_V(6); PG8_BAR; PG8_MMA(1, 1, At, B1); PG8_BAR;
            PG8_LDB(B0, 1, 0); PG8_SCHED; PG8_LDA(At, 1, 0); PG8_STAGE(PG8_SA(0, 1), a2 + hstep, voffA);
            PG8_WAIT_L(8); PG8_BAR; PG8_WAIT_L(0); PG8_MMA(0, 0, At, B0); PG8_BAR; PG8_SCHED;
            PG8_LDB(B1, 1, 1); PG8_STAGE(PG8_SB(1, 0), b3, voffB);
            PG8_BAR; PG8_WAIT_L(0); PG8_MMA(0, 1, At, B1); PG8_BAR;
            PG8_LDA(At, 1, 1); PG8_STAGE(PG8_SA(1, 0), a3, voffA);
            PG8_BAR; PG8_WAIT_L(0); PG8_MMA(1, 0, At, B0); PG8_BAR; PG8_SCHED;
            PG8_STAGE(PG8_SB(1, 1), b3 + hstep, voffB);
            PG8_WAIT_V(6); PG8_BAR; PG8_MMA(1, 1, At, B1); PG8_BAR;
        }
        { Unit eu = cur; asm volatile("" : "+s"(eu.pm), "+s"(eu.pn)); E(acc, eu, wr, wc, fr, fq); }
        if (!has_next) break;
#pragma unroll
        for (int a = 0; a < 2; ++a)
#pragma unroll
            for (int b = 0; b < 2; ++b)
#pragma unroll
                for (int m = 0; m < 4; ++m)
#pragma unroll
                    for (int n = 0; n < 2; ++n) acc[a][b][m][n] = (f32x4){0.f, 0.f, 0.f, 0.f};
        cur = nxt; cA = nA; cB = nB; ++ui;
    }
    PG8_WAIT_V(0);
    if (wr == 0) PG8_BAR;
    PG8_BAR;
#undef PG8_SA
#undef PG8_SB
#undef PG8_STAGE
#undef PG8_LDA
#undef PG8_LDB
#undef PG8_MMA
#undef PG8_WAIT_V
#undef PG8_WAIT_L
#undef PG8_BAR
#undef PG8_SCHED
}
}

typedef f32x4 AccT[2][2][4][2];
struct Epi1 {
    bf16_t* U; float* sf;
    __device__ __forceinline__ void operator()(const AccT& acc, const pg8::Unit& u, int wr, int wc, int fr, int fq) const {
        const int row0 = u.pm * 256 + wr * 64 + fr, col0 = u.pn * 256 + wc * 32 + 8 * fq;
        const bool side_dt = (u.pn == 18 && wc == 0), side_if = (u.pn == 34 && wc == 1);
#pragma unroll
        for (int ai = 0; ai < 2; ++ai)
#pragma unroll
            for (int m = 0; m < 4; ++m) {
                const int row = row0 + ai * 128 + m * 16;
                bf16_t* rowp = U + (size_t)row * N1P + col0;
#pragma unroll
                for (int bj = 0; bj < 2; ++bj) {
                    const f32x4 v0 = acc[ai][bj][m][0], v1 = acc[ai][bj][m][1];
                    u32x4 o; o[0] = pack2(v0[0], v0[1]); o[1] = pack2(v0[2], v0[3]); o[2] = pack2(v1[0], v1[1]); o[3] = pack2(v1[2], v1[3]);
                    *(u32x4*)(rowp + bj * 128) = o;
                }
                if (side_dt || side_if) {
                    float* sp = sf + (size_t)row * 64 + (side_if ? 32 : 0) + 8 * fq;
                    *(f32x4*)sp = acc[ai][0][m][0]; *(f32x4*)(sp + 4) = acc[ai][0][m][1];
                }
            }
    }
};
struct Epi2 {
    Params p;
    __device__ __forceinline__ void operator()(const AccT& acc, const pg8::Unit& u, int wr, int wc, int fr, int fq) const {
        float* H1 = (float*)(p.ws + WS_H1); bf16_t* A2 = (bf16_t*)(p.ws + WS_A2); float* SS2 = (float*)(p.ws + WS_SS2);
        const float* nw = p.in[21];
        const int row0 = u.pm * 256 + wr * 64 + fr, col0 = u.pn * 256 + wc * 32 + 8 * fq;
        f32x4 w[2][2];
#pragma unroll
        for (int bj = 0; bj < 2; ++bj) { w[bj][0] = *(const f32x4*)(nw + col0 + bj * 128); w[bj][1] = *(const f32x4*)(nw + col0 + bj * 128 + 4); }
#pragma unroll
        for (int ai = 0; ai < 2; ++ai)
#pragma unroll
            for (int m = 0; m < 4; ++m) {
                const int row = row0 + ai * 128 + m * 16;
                const float* rp = resid_row(p, row);
                float ss = 0.f;
#pragma unroll
                for (int bj = 0; bj < 2; ++bj) {
                    f32x4 v0 = acc[ai][bj][m][0], v1 = acc[ai][bj][m][1];
                    if (rp) { v0 += __builtin_nontemporal_load((const f32x4*)(rp + col0 + bj * 128)); v1 += __builtin_nontemporal_load((const f32x4*)(rp + col0 + bj * 128 + 4)); }
                    *(f32x4*)(H1 + (size_t)row * DM + col0 + bj * 128) = v0; *(f32x4*)(H1 + (size_t)row * DM + col0 + bj * 128 + 4) = v1;
                    ss += v0[0] * v0[0] + v0[1] * v0[1] + v0[2] * v0[2] + v0[3] * v0[3] + v1[0] * v1[0] + v1[1] * v1[1] + v1[2] * v1[2] + v1[3] * v1[3];
                    const f32x4 a0 = v0 * w[bj][0], a1 = v1 * w[bj][1];
                    u32x4 o; o[0] = pack2(a0[0], a0[1]); o[1] = pack2(a0[2], a0[3]); o[2] = pack2(a1[0], a1[1]); o[3] = pack2(a1[2], a1[3]);
                    *(u32x4*)(A2 + (size_t)row * DM + col0 + bj * 128) = o;
                }
                ss += __shfl_xor(ss, 16); ss += __shfl_xor(ss, 32);
                if (fq == 0) atomicAdd(SS2 + row, ss);
            }
    }
};
struct Epi3 {
    bf16_t* UP; const float* SS2;
    __device__ __forceinline__ void operator()(const AccT& acc, const pg8::Unit& u, int wr, int wc, int fr, int fq) const {
        const int row0 = u.pm * 256 + wr * 64 + fr, col0 = u.pn * 256 + wc * 32 + 8 * fq;
#pragma unroll
        for (int ai = 0; ai < 2; ++ai)
#pragma unroll
            for (int m = 0; m < 4; ++m) {
                const int row = row0 + ai * 128 + m * 16;
                const float r2 = rsqrtf(SS2[row] * (1.f / 2048.f) + EPS);
                bf16_t* rowp = UP + (size_t)row * N3 + col0;
#pragma unroll
                for (int bj = 0; bj < 2; ++bj) {
                    const f32x4 v0 = acc[ai][bj][m][0] * r2, v1 = acc[ai][bj][m][1] * r2;
                    u32x4 o; o[0] = pack2(v0[0], v0[1]); o[1] = pack2(v0[2], v0[3]); o[2] = pack2(v1[0], v1[1]); o[3] = pack2(v1[2], v1[3]);
                    *(u32x4*)(rowp + bj * 128) = o;
                }
            }
    }
};
struct Epi4 {
    const float* H1; float* out; float* SS3;
    __device__ __forceinline__ void operator()(const AccT& acc, const pg8::Unit& u, int wr, int wc, int fr, int fq) const {
        const int row0 = u.pm * 256 + wr * 64 + fr, col0 = u.pn * 256 + wc * 32 + 8 * fq;
#pragma unroll
        for (int ai = 0; ai < 2; ++ai)
#pragma unroll
            for (int m = 0; m < 4; ++m) {
                const int row = row0 + ai * 128 + m * 16;
                if (row < NOUTROWS) {
                    float ss = 0.f;
#pragma unroll
                    for (int bj = 0; bj < 2; ++bj) {
                        const f32x4 v0 = acc[ai][bj][m][0] + __builtin_nontemporal_load((const f32x4*)(H1 + (size_t)row * DM + col0 + bj * 128));
                        const f32x4 v1 = acc[ai][bj][m][1] + __builtin_nontemporal_load((const f32x4*)(H1 + (size_t)row * DM + col0 + bj * 128 + 4));
                        *(f32x4*)(out + (size_t)row * DM + col0 + bj * 128) = v0; *(f32x4*)(out + (size_t)row * DM + col0 + bj * 128 + 4) = v1;
                        ss += v0[0] * v0[0] + v0[1] * v0[1] + v0[2] * v0[2] + v0[3] * v0[3] + v1[0] * v1[0] + v1[1] * v1[1] + v1[2] * v1[2] + v1[3] * v1[3];
                    }
                    ss += __shfl_xor(ss, 16); ss += __shfl_xor(ss, 32);
                    if (fq == 0) atomicAdd(SS3 + row, ss);
                }
            }
    }
};

constexpr int T_IN = 32 * 43, T_OUT = 64 * 8, T_UP = 32 * 44, T_DOWN = 88 * 8, T_ALL = T_IN + T_OUT + T_UP + T_DOWN;
struct TileRef { const float* W; bf16_t* WT; int K, N, kt, nt; };
__device__ __forceinline__ TileRef tile_ref(const Params& p, int t) {
    TileRef r;
    if (t < T_IN) { r.W = p.in[10]; r.WT = (bf16_t*)(p.ws + WS_WIN); r.K = 2048; r.N = 10800; r.kt = t % 32; r.nt = t / 32; }
    else if (t < T_IN + T_OUT) { const int q = t - T_IN; r.W = p.in[20]; r.WT = (bf16_t*)(p.ws + WS_WOUT); r.K = 4096; r.N = 2048; r.kt = q % 64; r.nt = q / 64; }
    else if (t < T_IN + T_OUT + T_UP) { const int q = t - T_IN - T_OUT; r.W = p.in[22]; r.WT = (bf16_t*)(p.ws + WS_WUP); r.K = 2048; r.N = N3; r.kt = q % 32; r.nt = q / 32; }
    else { const int q = t - T_IN - T_OUT - T_UP; r.W = p.in[25]; r.WT = (bf16_t*)(p.ws + WS_WDOWN); r.K = DFF; r.N = 2048; r.kt = q % 88; r.nt = q / 88; }
    return r;
}
__device__ __forceinline__ void tile_load(const TileRef& r, f32x4 (&v)[8], int tid) {
    const int nc = (tid & 63) * 4, n = r.nt * 256 + nc;
#pragma unroll
    for (int i = 0; i < 8; ++i) {
        const int kr = (tid >> 6) + 8 * i;
        v[i] = (f32x4){0.f, 0.f, 0.f, 0.f};
        if (n < r.N) v[i] = __builtin_nontemporal_load((const f32x4*)(r.W + (size_t)(r.kt * 64 + kr) * r.N + n));
    }
}
__device__ __forceinline__ void tile_lds_write(const f32x4 (&v)[8], int tid, unsigned char* smem) {
    float* tile = (float*)smem;
    const int nc = (tid & 63) * 4;
#pragma unroll
    for (int i = 0; i < 8; ++i) {
        const int kr = (tid >> 6) + 8 * i;
        tile[kr * 257 + nc] = v[i][0]; tile[kr * 257 + nc + 1] = v[i][1]; tile[kr * 257 + nc + 2] = v[i][2]; tile[kr * 257 + nc + 3] = v[i][3];
    }
}
__device__ __forceinline__ void tile_store(const TileRef& r, int tid, unsigned char* smem) {
    const float* tile = (const float*)smem;
    const int kc = (tid & 7) * 8;
#pragma unroll
    for (int q = 0; q < 4; ++q) {
        const int nr = (tid >> 3) + 64 * q;
        u32x4 o;
        o[0] = pack2(tile[(kc + 0) * 257 + nr], tile[(kc + 1) * 257 + nr]); o[1] = pack2(tile[(kc + 2) * 257 + nr], tile[(kc + 3) * 257 + nr]);
        o[2] = pack2(tile[(kc + 4) * 257 + nr], tile[(kc + 5) * 257 + nr]); o[3] = pack2(tile[(kc + 6) * 257 + nr], tile[(kc + 7) * 257 + nr]);
        *(u32x4*)(r.WT + (size_t)(r.nt * 256 + nr) * r.K + r.kt * 64 + kc) = o;
    }
}
__device__ __forceinline__ void convert_tiles(const Params& p, unsigned char* smem, int t_begin, int t_end, int worker, int nworkers) {
    const int tid = opaque_tid();
    int t = t_begin + worker;
    f32x4 v[8];
    TileRef cur{};
    if (t < t_end) { cur = tile_ref(p, t); tile_load(cur, v, tid); }
    while (t < t_end) {
        tile_lds_write(v, tid, smem);
        __syncthreads();
        const int tn = t + nworkers;
        TileRef nxt{};
        if (tn < t_end) { nxt = tile_ref(p, tn); tile_load(nxt, v, tid); }
        tile_store(cur, tid, smem);
        __syncthreads();
        cur = nxt; t = tn;
    }
}
__device__ __forceinline__ void convert_in_tail(const Params& p, unsigned char* smem, int n_units, int t_begin, int t_end) {
    const int G = gridDim.x, rem = n_units % G, bid = opaque_bid();
    if (rem == 0) convert_tiles(p, smem, t_begin, t_end, bid, G);
    else if (bid >= rem) convert_tiles(p, smem, t_begin, t_end, bid - rem, G - rem);
}
__device__ __forceinline__ void phase_prep(const Params& p, unsigned char* smem) {
    const int tid = opaque_tid(), wid = tid >> 6, lane = tid & 63;
    { float* SS2 = (float*)(p.ws + WS_SS2); for (int i = opaque_bid() * 512 + tid; i < 2 * MP; i += gridDim.x * 512) SS2[i] = 0.f; }
    {
        bf16_t* XN = (bf16_t*)(p.ws + WS_XN); const float* nw = p.in[9];
        for (int row = opaque_bid() * 8 + wid; row < MP; row += gridDim.x * 8) {
            const float* src = resid_row(p, row);
            f32x4 v[8];
            float ss = 0.f;
#pragma unroll
            for (int it = 0; it < 4; ++it) {
                const int col = it * 512 + lane * 8;
                if (src) { v[2 * it] = __builtin_nontemporal_load((const f32x4*)(src + col)); v[2 * it + 1] = __builtin_nontemporal_load((const f32x4*)(src + col + 4)); }
                else { v[2 * it] = (f32x4){0.f, 0.f, 0.f, 0.f}; v[2 * it + 1] = (f32x4){0.f, 0.f, 0.f, 0.f}; }
#pragma unroll
                for (int j = 0; j < 4; ++j) ss += v[2 * it][j] * v[2 * it][j] + v[2 * it + 1][j] * v[2 * it + 1][j];
            }
            ss = wave_sum(ss);
            const float r = rsqrtf(ss * (1.f / 2048.f) + EPS);
#pragma unroll
            for (int it = 0; it < 4; ++it) {
                const int col = it * 512 + lane * 8;
                const f32x4 w0 = *(const f32x4*)(nw + col), w1 = *(const f32x4*)(nw + col + 4);
                const f32x4 a = v[2 * it] * r * w0, c = v[2 * it + 1] * r * w1;
                u32x4 o; o[0] = pack2(a[0], a[1]); o[1] = pack2(a[2], a[3]); o[2] = pack2(c[0], c[1]); o[3] = pack2(c[2], c[3]);
                *(u32x4*)(XN + (size_t)row * DM + col) = o;
            }
        }
    }
    convert_tiles(p, smem, 0, T_IN, opaque_bid(), gridDim.x);
}

constexpr int RS = 272;
constexpr int L_QS = 0, L_KS = 34816, L_KT = 69632, L_VT = 104448, L_ST = 121856, L_SC = 139264;

template <bool ML>
__device__ __forceinline__ void load_block(const Params& p, float (&val)[8][4], int b, int p0, int Lv, int rb, int cg, int colbase, int chbase, float mlscale) {
    const bf16_t* U = (const bf16_t*)(p.ws + WS_U);
    const int t0 = rb * 8;
    if (t0 >= Lv) {
#pragma unroll
        for (int r = 0; r < 8; ++r)
#pragma unroll
            for (int i = 0; i < 4; ++i) val[r][i] = 0.f;
        return;
    }
    if (ML) {
#pragma unroll
        for (int r = 0; r < 8; ++r) {
            const int row = row_of(b, p0 + t0 + r);
            const u32x2 raw = *(const u32x2*)(U + (size_t)row * N1P + colbase + cg * 4);
            val[r][0] = bf_lo(raw[0]) * mlscale; val[r][1] = bf_hi(raw[0]) * mlscale; val[r][2] = bf_lo(raw[1]) * mlscale; val[r][3] = bf_hi(raw[1]) * mlscale;
        }
    } else {
        u32x2 raw[11];
#pragma unroll
        for (int rr = 0; rr < 11; ++rr) {
            const int pos = p0 + t0 - 3 + rr;
            if (pos >= 0) raw[rr] = *(const u32x2*)(U + (size_t)row_of(b, pos) * N1P + colbase + cg * 4);
            else raw[rr] = (u32x2){0u, 0u};
        }
        const float* cw = p.in[11]; const float* cb = p.in[12];
        const int ch = chbase + cg * 4;
        f32x4 w[4];
#pragma unroll
        for (int j = 0; j < 4; ++j) w[j] = *(const f32x4*)(cw + j * 2560 + ch);
        const f32x4 bi = *(const f32x4*)(cb + ch);
#pragma unroll
        for (int i = 0; i < 4; ++i) {
            float x[11];
#pragma unroll
            for (int rr = 0; rr < 11; ++rr) x[rr] = (i & 1) ? bf_hi(raw[rr][i >> 1]) : bf_lo(raw[rr][i >> 1]);
#pragma unroll
            for (int r = 0; r < 8; ++r) val[r][i] = silu_f(bi[i] + w[0][i] * x[r] + w[1][i] * x[r + 1] + w[2][i] * x[r + 2] + w[3][i] * x[r + 3]);
        }
    }
}
__device__ __forceinline__ void store_rows(unsigned char* base, const float (&val)[8][4], int rb, int cg) {
#pragma unroll
    for (int r = 0; r < 8; ++r) *(u32x2*)(base + (rb * 8 + r) * RS + cg * 8) = (u32x2){pack2(val[r][0], val[r][1]), pack2(val[r][2], val[r][3])};
}
__device__ __forceinline__ void store_cols(unsigned char* base, const float (&val)[8][4], int rb, int cg, const float* scale) {
    float s[8];
#pragma unroll
    for (int r = 0; r < 8; ++r) s[r] = scale ? scale[rb * 8 + r] : 1.f;
#pragma unroll
    for (int i = 0; i < 4; ++i) {
        const int row = cg * 4 + i;
        u32x4 o; o[0] = pack2(val[0][i] * s[0], val[1][i] * s[1]); o[1] = pack2(val[2][i] * s[2], val[3][i] * s[3]);
        o[2] = pack2(val[4][i] * s[4], val[5][i] * s[5]); o[3] = pack2(val[6][i] * s[6], val[7][i] * s[7]);
        *(u32x4*)(base + row * RS + ((rb ^ ((row >> 3) & 7)) << 4)) = o;
    }
}

template <bool ML>
__device__ __forceinline__ void prompt_scan(const Params& p, unsigned char* smem, int job) {
    const int tid = opaque_tid(), wid = __builtin_amdgcn_readfirstlane(tid >> 6), lane = tid & 63, fr = lane & 15, fq = lane >> 4;
    int b, h, vq = 0;
    if (ML) { b = job >> 5; h = (job >> 2) & 7; vq = job & 3; } else { b = job >> 5; h = job & 31; }
    const int g = h >> 4;
    const bf16_t* U = (const bf16_t*)(p.ws + WS_U);
    const float* SF = (const float*)(p.ws + WS_SF);
    bf16_t* MIX = (bf16_t*)(p.ws + WS_MIX);
    float* scb = (float*)(smem + L_SC);
    float *qn = scb + 1600, *nvec = scb + 1728, *mpp = scb + 1856;
    const int qcol = ML ? UC_Q + h * 128 : UC_XBC + 2304 + g * 128;
    const int kcol = ML ? UC_K + h * 128 : UC_XBC + 2048 + g * 128;
    const int vcol = ML ? UC_V + h * 256 + vq * 64 : UC_XBC + h * 64;
    const int gcol = ML ? UC_O + h * 256 + vq * 64 : UC_Z + h * 64;
    const int mixcol = ML ? 2048 + h * 256 + vq * 64 : h * 64;
    float A_h = 0.f, D_h = 0.f, dtb = 0.f, ib = 0.f, fb = 0.f;
    if (ML) { ib = p.in[17][h]; fb = p.in[18][h]; } else { A_h = -__expf(p.in[14][h]); D_h = p.in[15][h]; dtb = p.in[13][h]; }
    f32x4 st[4];
#pragma unroll
    for (int i = 0; i < 4; ++i) st[i] = (f32x4){0.f, 0.f, 0.f, 0.f};
    for (int i = tid; i < 64 * RS / 16; i += 512) *(u32x4*)(smem + L_ST + i * 16) = (u32x4){0u, 0u, 0u, 0u};
    if (tid < 128) nvec[tid] = 0.f;
    if (tid == 0) mpp[0] = 0.f;
    constexpr int CHLs = ML ? CHL_ML : CHL_SSD;
    float sraw[4] = {0.f, 0.f, 0.f, 0.f};
    auto scal_load = [&](int cc) {
        const int p0 = cc == 0 ? 0 : 16 + (cc - 1) * CHLs, Lv = cc == 0 ? 16 : CHLs;
        const int t0 = 2 * lane, t1 = t0 + 1;
        if (!ML) {
            if (t0 < Lv) sraw[0] = SF[(size_t)row_of(b, p0 + t0) * 64 + h];
            if (t1 < Lv) sraw[1] = SF[(size_t)row_of(b, p0 + t1) * 64 + h];
        } else {
            if (t0 < Lv) { const size_t r = (size_t)row_of(b, p0 + t0) * 64; sraw[0] = SF[r + 32 + h]; sraw[2] = SF[r + 40 + h]; }
            if (t1 < Lv) { const size_t r = (size_t)row_of(b, p0 + t1) * 64; sraw[1] = SF[r + 32 + h]; sraw[3] = SF[r + 40 + h]; }
        }
    };
    auto scalars = [&](int cc) {
        const int Lv = cc == 0 ? 16 : CHLs;
        float* sc = scb + (cc & 1) * 800;
        float *rowv = sc, *colv = sc + 128, *colm = sc + 256, *ev = sc + 384, *scv = sc + 512, *dden = sc + 640, *misc = sc + 768;
        const int t0 = 2 * lane, t1 = t0 + 1;
        if (!ML) {
            float d0 = 0.f, d1 = 0.f;
            if (t0 < Lv) d0 = softplus_f(sraw[0] + dtb);
            if (t1 < Lv) d1 = softplus_f(sraw[1] + dtb);
            const float a0 = d0 * A_h, a1 = d1 * A_h;
            float inc = a0 + a1;
#pragma unroll
            for (int o = 1; o < 64; o <<= 1) { const float y = __shfl_up(inc, o); if (lane >= o) inc += y; }
            const float c1 = inc, c0 = inc - a1, cl = __shfl(inc, 63);
            rowv[t0] = c0; rowv[t1] = c1; colv[t0] = -c0; colv[t1] = -c1; colm[t0] = d0; colm[t1] = d1;
            ev[t0] = __expf(c0); ev[t1] = __expf(c1); scv[t0] = __expf(cl - c0) * d0; scv[t1] = __expf(cl - c1) * d1;
            if (lane == 0) misc[0] = __expf(cl);
        } else {
            float i0 = -INFINITY, i1 = -INFINITY, f0 = 0.f, f1 = 0.f;
            if (t0 < Lv) { i0 = sraw[0] + ib; f0 = logsig_f(sraw[2] + fb); }
            if (t1 < Lv) { i1 = sraw[1] + ib; f1 = logsig_f(sraw[3] + fb); }
            float inc = f0 + f1;
#pragma unroll
            for (int o = 1; o < 64; o <<= 1) { const float y = __shfl_up(inc, o); if (lane >= o) inc += y; }
            const float F1 = inc, F0 = inc - f1;
            const float g0 = i0 - F0, g1 = i1 - F1;
            float mx = fmaxf(g0, g1);
#pragma unroll
            for (int o = 1; o < 64; o <<= 1) { const float y = __shfl_up(mx, o); if (lane >= o) mx = fmaxf(mx, y); }
            float ex = __shfl_up(mx, 1); if (lane == 0) ex = -INFINITY;
            const float mp = mpp[0];
            const float M0 = fmaxf(fmaxf(ex, g0), mp), M1 = fmaxf(mx, mp);
            const float Ml = __shfl(M1, 63), Fl = __shfl(F1, 63);
            rowv[t0] = -M0; rowv[t1] = -M1; colv[t0] = g0; colv[t1] = g1; colm[t0] = 1.f; colm[t1] = 1.f;
            ev[t0] = __expf(mp - M0); ev[t1] = __expf(mp - M1); dden[t0] = __expf(-(F0 + M0)); dden[t1] = __expf(-(F1 + M1));
            scv[t0] = __expf(g0 - Ml); scv[t1] = __expf(g1 - Ml);
            if (lane == 0) { misc[0] = __expf(mp - Ml); mpp[0] = Fl + Ml; }
        }
    };
    __syncthreads();
    if (wid == 0) { scal_load(0); scalars(0); }
    __syncthreads();
    constexpr int CHL = ML ? CHL_ML : CHL_SSD, NCH = 1 + 2048 / CHL;
    const int tid_outer = tid;
    for (int c = 0; c < NCH; ++c) {
        int tid = tid_outer; asm volatile("" : "+v"(tid));
        const int lane = tid & 63, fr = lane & 15, fq = lane >> 4;
        const int p0 = c == 0 ? 0 : 16 + (c - 1) * CHL, Lv = c == 0 ? 16 : CHL;
        float* sc = scb + (c & 1) * 800;
        float *rowv = sc, *colv = sc + 128, *colm = sc + 256, *ev = sc + 384, *scv = sc + 512, *dden = sc + 640, *misc = sc + 768;
        if (wid == 0 && c + 1 < NCH) scal_load(c + 1);
        {
            float val[8][4];
            load_block<ML>(p, val, b, p0, Lv, tid >> 5, tid & 31, qcol, 2304 + g * 128, 1.f);
            store_rows(smem + L_QS, val, tid >> 5, tid & 31);
            __builtin_amdgcn_sched_barrier(0);
            load_block<ML>(p, val, b, p0, Lv, tid >> 5, tid & 31, kcol, 2048 + g * 128, 0.08838834764831845f);
            store_rows(smem + L_KS, val, tid >> 5, tid & 31);
            store_cols(smem + L_KT, val, tid >> 5, tid & 31, scv);
            __builtin_amdgcn_sched_barrier(0);
            if (tid < 256) {
                load_block<ML>(p, val, b, p0, Lv, tid >> 4, tid & 15, vcol, h * 64, 1.f);
                store_cols(smem + L_VT, val, tid >> 4, tid & 15, nullptr);
            }
        }
        __syncthreads();
        const int t = 16 * wid + fr;
        const bool valid = t < Lv;
        const int row = row_of(b, p0 + (valid ? t : 0));
        u32x2 gate[4];
#pragma unroll
        for (int vb = 0; vb < 4; ++vb) gate[vb] = *(const u32x2*)(U + (size_t)row * N1P + gcol + 16 * vb + 4 * fq);
        if (ML) {
            const int tt = tid >> 2, part = tid & 3;
            float s = 0.f;
#pragma unroll
            for (int cc = 0; cc < 4; ++cc) {
                const u32x4 raw = *(const u32x4*)(smem + L_QS + tt * RS + (part * 4 + cc) * 16);
                const f32x4 n0 = *(const f32x4*)(nvec + (part * 4 + cc) * 8), n1 = *(const f32x4*)(nvec + (part * 4 + cc) * 8 + 4);
                s += bf_lo(raw[0]) * n0[0] + bf_hi(raw[0]) * n0[1] + bf_lo(raw[1]) * n0[2] + bf_hi(raw[1]) * n0[3]
                   + bf_lo(raw[2]) * n1[0] + bf_hi(raw[2]) * n1[1] + bf_lo(raw[3]) * n1[2] + bf_hi(raw[3]) * n1[3];
            }
            s += __shfl_xor(s, 1); s += __shfl_xor(s, 2);
            if (part == 0) qn[tt] = s;
        }
        bf16x8 qf[4];
#pragma unroll
        for (int kk = 0; kk < 4; ++kk) qf[kk] = *(const bf16x8*)(smem + L_QS + t * RS + (kk * 32 + fq * 8) * 2);
        const float rv = rowv[t];
        float rowsum = 0.f;
        u32x2 pk[8];
#pragma unroll
        for (int sb = 0; sb < 8; ++sb) {
            pk[sb] = (u32x2){0u, 0u};
            if (sb <= wid) {
                f32x4 acc = {0.f, 0.f, 0.f, 0.f};
#pragma unroll
                for (int kk = 0; kk < 4; ++kk) {
                    const bf16x8 kf = *(const bf16x8*)(smem + L_KS + (16 * sb + fr) * RS + (kk * 32 + fq * 8) * 2);
                    acc = __builtin_amdgcn_mfma_f32_16x16x32_bf16(kf, qf[kk], acc, 0, 0, 0);
                }
                const f32x4 cv = *(const f32x4*)(colv + 16 * sb + 4 * fq), cm = *(const f32x4*)(colm + 16 * sb + 4 * fq);
                float pv[4];
#pragma unroll
                for (int j = 0; j < 4; ++j) {
                    const int s = 16 * sb + 4 * fq + j;
                    const float w = (s <= t) ? __expf(rv + cv[j]) * cm[j] : 0.f;
                    pv[j] = acc[j] * w; rowsum += pv[j];
                }
                pk[sb] = (u32x2){pack2(pv[0], pv[1]), pack2(pv[2], pv[3])};
            }
        }
        if (wid == 0 && c + 1 < NCH) scalars(c + 1);
        __syncthreads();
#pragma unroll
        for (int sb = 0; sb < 8; ++sb) *(u32x2*)(smem + L_KS + t * RS + (16 * sb + 4 * fq) * 2) = pk[sb];
        rowsum += __shfl_xor(rowsum, 16); rowsum += __shfl_xor(rowsum, 32);
        if (ML) {
            const int d = tid >> 2, part = tid & 3;
            float s = 0.f;
#pragma unroll
            for (int cc = 0; cc < 4; ++cc) {
                const u32x4 raw = *(const u32x4*)(smem + L_KT + d * RS + (part * 4 + cc) * 16);
                s += bf_lo(raw[0]) + bf_hi(raw[0]) + bf_lo(raw[1]) + bf_hi(raw[1]) + bf_lo(raw[2]) + bf_hi(raw[2]) + bf_lo(raw[3]) + bf_hi(raw[3]);
            }
            s += __shfl_xor(s, 1); s += __shfl_xor(s, 2);
            if (part == 0) nvec[d] = misc[0] * nvec[d] + s;
        }
        __syncthreads();
        bf16x8 pf[4];
#pragma unroll
        for (int kk = 0; kk < 4; ++kk) pf[kk] = *(const bf16x8*)(smem + L_KS + t * RS + (kk * 32 + fq * 8) * 2);
        const float et = ev[t];
        float ddv = 1.f;
        if (ML) ddv = fmaxf(fabsf(rowsum + et * qn[t]), dden[t]);
        float ss = 0.f;
#pragma unroll
        for (int vb = 0; vb < 4; ++vb) {
            f32x4 acc = {0.f, 0.f, 0.f, 0.f};
            const int vrow = 16 * vb + fr;
#pragma unroll
            for (int kk = 0; kk < 4; ++kk) {
                const bf16x8 sf = *(const bf16x8*)(smem + L_ST + vrow * RS + (kk * 32 + fq * 8) * 2);
                acc = __builtin_amdgcn_mfma_f32_16x16x32_bf16(sf, qf[kk], acc, 0, 0, 0);
            }
            acc *= et;
#pragma unroll
            for (int kk = 0; kk < 4; ++kk) {
                const bf16x8 vf = *(const bf16x8*)(smem + L_VT + vrow * RS + (((kk * 4 + fq) ^ ((vrow >> 3) & 7)) << 4));
                acc = __builtin_amdgcn_mfma_f32_16x16x32_bf16(vf, pf[kk], acc, 0, 0, 0);
            }
            const float gz[4] = {bf_lo(gate[vb][0]), bf_hi(gate[vb][0]), bf_lo(gate[vb][1]), bf_hi(gate[vb][1])};
            float o[4];
#pragma unroll
            for (int j = 0; j < 4; ++j) {
                if (ML) { const float hv = acc[j]; ss += hv * hv; o[j] = hv * sigm_f(gz[j]); }
                else {
                    const int v = 16 * vb + 4 * fq + j;
                    const float xv = bf2f(*(const bf16_t*)(smem + L_VT + v * RS + (((t >> 3) ^ ((v >> 3) & 7)) << 4) + (t & 7) * 2));
                    const float y = (acc[j] + D_h * xv) * silu_f(gz[j]); ss += y * y; o[j] = y;
                }
            }
            if (valid) *(u32x2*)(MIX + (size_t)row * MIXW + mixcol + 16 * vb + 4 * fq) = (u32x2){pack2(o[0], o[1]), pack2(o[2], o[3])};
        }
        ss += __shfl_xor(ss, 16); ss += __shfl_xor(ss, 32);
        if (valid && fq == 0) {
            if (ML) { ((float*)(p.ws + WS_SSQM))[(size_t)row * 32 + h * 4 + vq] = ss; if (vq == 0) ((float*)(p.ws + WS_DD))[(size_t)row * 8 + h] = ddv; }
            else ((float*)(p.ws + WS_SSQ))[(size_t)row * 32 + h] = ss;
        }
        const float dec = misc[0];
#pragma unroll
        for (int vb = 0; vb < 4; ++vb) st[vb] *= dec;
#pragma unroll
        for (int kk = 0; kk < 4; ++kk) {
            const int drow = 16 * wid + fr;
            const bf16x8 kf = *(const bf16x8*)(smem + L_KT + drow * RS + (((kk * 4 + fq) ^ ((drow >> 3) & 7)) << 4));
#pragma unroll
            for (int vb = 0; vb < 4; ++vb) {
                const int vrow = 16 * vb + fr;
                const bf16x8 vf = *(const bf16x8*)(smem + L_VT + vrow * RS + (((kk * 4 + fq) ^ ((vrow >> 3) & 7)) << 4));
                st[vb] = __builtin_amdgcn_mfma_f32_16x16x32_bf16(kf, vf, st[vb], 0, 0, 0);
            }
        }
        __syncthreads();
#pragma unroll
        for (int vb = 0; vb < 4; ++vb)
            *(u32x2*)(smem + L_ST + (16 * vb + fr) * RS + (16 * wid + 4 * fq) * 2) = (u32x2){pack2(st[vb][0], st[vb][1]), pack2(st[vb][2], st[vb][3])};
    }
#pragma unroll
    for (int vb = 0; vb < 4; ++vb) {
        const int v = 16 * vb + fr, d0 = 16 * wid + 4 * fq;
        if (!ML) *(f32x4*)(p.out + O_P_SSD + ((size_t)(b * 32 + h) * 64 + v) * 128 + d0) = st[vb];
        else {
#pragma unroll
            for (int j = 0; j < 4; ++j) p.out[O_P_MLC + ((size_t)(b * 8 + h) * 128 + d0 + j) * 256 + vq * 64 + v] = st[vb][j];
        }
    }
    if (ML && vq == 0) {
        if (tid < 128) p.out[O_P_MLN + (size_t)(b * 8 + h) * 128 + tid] = nvec[tid];
        if (tid == 0) p.out[O_P_MLM + b * 8 + h] = mpp[0];
    }
    __syncthreads();
}

__device__ __forceinline__ void sample_ssd(const Params& p, unsigned char* smem, int job) {
    const int tid = opaque_tid(), wid = tid >> 6, lane = tid & 63;
    const int b = job >> 1, g = job & 1, rowb = ROW_SAMPLE + b * 8;
    const bf16_t* U = (const bf16_t*)(p.ws + WS_U);
    const float* SF = (const float*)(p.ws + WS_SF);
    bf16_t* MIX = (bf16_t*)(p.ws + WS_MIX);
    float* Bc = (float*)smem; float* Cc = Bc + 1024; float* xall = Cc + 1024; float* G = xall + 8192; float* dts = G + 64; float* ssqp = dts + 128;
    const float* sconv = p.in[2]; const float* cw = p.in[11]; const float* cb = p.in[12];
#pragma unroll
    for (int q = 0; q < 3; ++q) {
        int ch; float* dst; int dstride = 0;
        if (q < 2) { ch = g * 1024 + tid + q * 512; dst = xall + tid + q * 512; dstride = 1024; }
        else { if (tid >= 256) break; const int which = tid >> 7, n = tid & 127; ch = 2048 + which * 256 + g * 128 + n; dst = (which ? Cc : Bc) + n; dstride = 128; }
        float xm3 = sconv[(size_t)(b * 3 + 0) * 2560 + ch], xm2 = sconv[(size_t)(b * 3 + 1) * 2560 + ch], xm1 = sconv[(size_t)(b * 3 + 2) * 2560 + ch];
        const float w0 = cw[ch], w1 = cw[2560 + ch], w2 = cw[5120 + ch], w3 = cw[7680 + ch], bb = cb[ch];
#pragma unroll
        for (int t = 0; t < 8; ++t) {
            const float x = bf2f(U[(size_t)(rowb + t) * N1P + UC_XBC + ch]);
            dst[t * dstride] = silu_f(bb + w0 * xm3 + w1 * xm2 + w2 * xm1 + w3 * x);
            xm3 = xm2; xm2 = xm1; xm1 = x;
        }
    }
    if (tid < 128) { const int hh = tid >> 3, t = tid & 7; dts[tid] = softplus_f(SF[(size_t)(rowb + t) * 64 + g * 16 + hh] + p.in[13][g * 16 + hh]); }
    __syncthreads();
    {
        const int pair = tid >> 3, part = tid & 7, t = pair >> 3, s = pair & 7;
        float sum = 0.f;
#pragma unroll
        for (int i = 0; i < 4; ++i) {
            const f32x4 c4 = *(const f32x4*)(Cc + t * 128 + part * 16 + i * 4), b4 = *(const f32x4*)(Bc + s * 128 + part * 16 + i * 4);
            sum += c4[0] * b4[0] + c4[1] * b4[1] + c4[2] * b4[2] + c4[3] * b4[3];
        }
        sum += __shfl_xor(sum, 1); sum += __shfl_xor(sum, 2); sum += __shfl_xor(sum, 4);
        if (part == 0) G[pair] = sum;
    }
    __syncthreads();
    const int pp = tid >> 3, nq = tid & 7;
    f32x4 snext[4];
#pragma unroll
    for (int i = 0; i < 4; ++i) snext[i] = __builtin_nontemporal_load((const f32x4*)(p.in[3] + ((size_t)(b * 32 + g * 16) * 64 + pp) * 128 + nq * 4 + 32 * i));
    for (int hh = 0; hh < 16; ++hh) {
        const int h = g * 16 + hh;
        const float A_h = -__expf(p.in[14][h]), D_h = p.in[15][h];
        float dtv[8], cum[8];
        { float run = 0.f;
#pragma unroll
          for (int t = 0; t < 8; ++t) { dtv[t] = dts[hh * 8 + t]; run += dtv[t] * A_h; cum[t] = run; } }
        const size_t soff = ((size_t)(b * 32 + h) * 64 + pp) * 128 + nq * 4;
        f32x4 s0[4];
#pragma unroll
        for (int i = 0; i < 4; ++i) s0[i] = snext[i];
        if (hh + 1 < 16) {
#pragma unroll
            for (int i = 0; i < 4; ++i) snext[i] = __builtin_nontemporal_load((const f32x4*)(p.in[3] + soff + 64 * 128 + 32 * i));
        }
        float cs[8];
#pragma unroll
        for (int t = 0; t < 8; ++t) {
            float sum = 0.f;
#pragma unroll
            for (int i = 0; i < 4; ++i) { const f32x4 c4 = *(const f32x4*)(Cc + t * 128 + nq * 4 + 32 * i); sum += c4[0] * s0[i][0] + c4[1] * s0[i][1] + c4[2] * s0[i][2] + c4[3] * s0[i][3]; }
            sum += __shfl_xor(sum, 1); sum += __shfl_xor(sum, 2); sum += __shfl_xor(sum, 4);
            cs[t] = sum;
        }
        float ycs = 0.f, ct = 0.f;
#pragma unroll
        for (int t = 0; t < 8; ++t) { ycs = (nq == t) ? cs[t] : ycs; ct = (nq == t) ? cum[t] : ct; }
        float y = __expf(ct) * ycs, xt = 0.f;
#pragma unroll
        for (int s = 0; s < 8; ++s) {
            const float xs = xall[s * 1024 + hh * 64 + pp];
            const float term = (s <= nq) ? G[nq * 8 + s] * __expf(ct - cum[s]) * dtv[s] * xs : 0.f;
            y += term; xt = (s == nq) ? xs : xt;
        }
        y += D_h * xt;
        const float z = bf2f(U[(size_t)(rowb + nq) * N1P + UC_Z + h * 64 + pp]);
        y *= silu_f(z);
        { const unsigned pk = pack2(y, 0.f); MIX[(size_t)(rowb + nq) * MIXW + h * 64 + pp] = (bf16_t)(pk & 0xffffu); }
        float sq = y * y; sq += __shfl_xor(sq, 8); sq += __shfl_xor(sq, 16); sq += __shfl_xor(sq, 32);
        if (lane < 8) ssqp[(hh * 8 + wid) * 8 + lane] = sq;
        const float cl = cum[7], dec = __expf(cl);
        float xw[8];
#pragma unroll
        for (int s = 0; s < 8; ++s) xw[s] = __expf(cl - cum[s]) * dtv[s] * xall[s * 1024 + hh * 64 + pp];
#pragma unroll
        for (int i = 0; i < 4; ++i) {
            f32x4 acc = s0[i] * dec;
#pragma unroll
            for (int s = 0; s < 8; ++s) acc += xw[s] * *(const f32x4*)(Bc + s * 128 + nq * 4 + 32 * i);
            __builtin_nontemporal_store(acc, (f32x4*)(p.out + O_S_SSD + soff + 32 * i));
        }
    }
    __syncthreads();
    if (tid < 128) {
        const int hh = tid >> 3, t = tid & 7; float tot = 0.f;
#pragma unroll
        for (int w = 0; w < 8; ++w) tot += ssqp[(hh * 8 + w) * 8 + t];
        ((float*)(p.ws + WS_SSQ))[(size_t)(rowb + t) * 32 + g * 16 + hh] = tot;
    }
    __syncthreads();
}

__device__ __forceinline__ void sample_ml(const Params& p, unsigned char* smem, int job) {
    const int tid = opaque_tid(), wid = __builtin_amdgcn_readfirstlane(tid >> 6), lane = tid & 63;
    const int b = job >> 3, h = job & 7, rowb = ROW_SAMPLE + b * 8;
    const bf16_t* U = (const bf16_t*)(p.ws + WS_U);
    const float* SF = (const float*)(p.ws + WS_SF);
    bf16_t* MIX = (bf16_t*)(p.ws + WS_MIX);
    float* qs = (float*)smem; float* ks = qs + 1024; float* vs = qs + 2048; float* QK = qs + 4096; float* sig = qs + 4160; float* slf = qs + 4168;
    float* qnv = qs + 4176; float* n0v = qs + 4192; float* red = qs + 4352;
    {
        const int t = tid >> 6, c = tid & 63;
        const size_t r = (size_t)(rowb + t) * N1P;
        const unsigned qq = *(const unsigned*)(U + r + UC_Q + h * 128 + 2 * c), kk = *(const unsigned*)(U + r + UC_K + h * 128 + 2 * c);
        const u32x2 vv = *(const u32x2*)(U + r + UC_V + h * 256 + 4 * c);
        qs[t * 128 + 2 * c] = bf_lo(qq); qs[t * 128 + 2 * c + 1] = bf_hi(qq);
        ks[t * 128 + 2 * c] = bf_lo(kk) * 0.08838834764831845f; ks[t * 128 + 2 * c + 1] = bf_hi(kk) * 0.08838834764831845f;
        *(f32x4*)(vs + t * 256 + 4 * c) = (f32x4){bf_lo(vv[0]), bf_hi(vv[0]), bf_lo(vv[1]), bf_hi(vv[1])};
        if (tid < 8) { sig[tid] = SF[(size_t)(rowb + tid) * 64 + 32 + h] + p.in[17][h]; slf[tid] = logsig_f(SF[(size_t)(rowb + tid) * 64 + 40 + h] + p.in[18][h]); }
        if (tid >= 128 && tid < 256) n0v[tid - 128] = p.in[5][(size_t)(b * 8 + h) * 128 + tid - 128];
    }
    const int v4 = lane, dg = wid;
    const size_t coff = ((size_t)(b * 8 + h) * 128 + dg * 16) * 256 + v4 * 4;
    f32x4 c0[16];
#pragma unroll
    for (int i = 0; i < 16; ++i) c0[i] = __builtin_nontemporal_load((const f32x4*)(p.in[4] + coff + (size_t)i * 256));
    const float mp = p.in[6][b * 8 + h];
    __syncthreads();
    float F[8], gg[8], M[8];
    { float run = 0.f, pm = -INFINITY;
#pragma unroll
      for (int t = 0; t < 8; ++t) { run += slf[t]; F[t] = run; gg[t] = sig[t] - run; pm = fmaxf(pm, gg[t]); M[t] = fmaxf(pm, mp); } }
    const float Ml = M[7], dec = __expf(mp - Ml), m_new = F[7] + Ml;
    {
        const int pair = tid >> 3, part = tid & 7, t = pair >> 3, s = pair & 7;
        float sum = 0.f;
#pragma unroll
        for (int i = 0; i < 4; ++i) {
            const f32x4 a4 = *(const f32x4*)(qs + t * 128 + part * 16 + i * 4), b4 = *(const f32x4*)(ks + s * 128 + part * 16 + i * 4);
            sum += a4[0] * b4[0] + a4[1] * b4[1] + a4[2] * b4[2] + a4[3] * b4[3];
        }
        sum += __shfl_xor(sum, 1); sum += __shfl_xor(sum, 2); sum += __shfl_xor(sum, 4);
        if (part == 0) QK[pair] = sum;
        float qd = qs[wid * 128 + 2 * lane] * n0v[2 * lane] + qs[wid * 128 + 2 * lane + 1] * n0v[2 * lane + 1];
        qd = wave_sum(qd);
        if (lane == 0) qnv[wid] = qd;
    }
#pragma unroll
    for (int t = 0; t < 8; ++t) {
        f32x4 acc = {0.f, 0.f, 0.f, 0.f};
#pragma unroll
        for (int i4 = 0; i4 < 4; ++i4) {
            const f32x4 q4 = *(const f32x4*)(qs + t * 128 + dg * 16 + i4 * 4);
            acc += q4[0] * c0[i4 * 4] + q4[1] * c0[i4 * 4 + 1] + q4[2] * c0[i4 * 4 + 2] + q4[3] * c0[i4 * 4 + 3];
        }
        *(f32x4*)(red + (dg * 8 + t) * 256 + v4 * 4) = acc;
    }
    __syncthreads();
    f32x4 vv[8];
    float scs[8];
#pragma unroll
    for (int s = 0; s < 8; ++s) { vv[s] = *(const f32x4*)(vs + s * 256 + v4 * 4); scs[s] = __expf(gg[s] - Ml); }
#pragma unroll
    for (int i = 0; i < 16; ++i) {
        const int d = dg * 16 + i;
        f32x4 cn = c0[i] * dec;
#pragma unroll
        for (int s = 0; s < 8; ++s) cn += (scs[s] * ks[s * 128 + d]) * vv[s];
        __builtin_nontemporal_store(cn, (f32x4*)(p.out + O_S_MLC + coff + (size_t)i * 256));
    }
    if (tid < 128) {
        float nn = dec * n0v[tid];
#pragma unroll
        for (int s = 0; s < 8; ++s) nn += scs[s] * ks[s * 128 + tid];
        p.out[O_S_MLN + (size_t)(b * 8 + h) * 128 + tid] = nn;
    }
    if (tid == 0) p.out[O_S_MLM + b * 8 + h] = m_new;
    {
        const int t = wid;
        float Mt = 0.f, Ft = 0.f;
#pragma unroll
        for (int q = 0; q < 8; ++q) { Mt = (t == q) ? M[q] : Mt; Ft = (t == q) ? F[q] : Ft; }
        f32x4 numc = {0.f, 0.f, 0.f, 0.f};
#pragma unroll
        for (int q = 0; q < 8; ++q) numc += *(const f32x4*)(red + (q * 8 + t) * 256 + lane * 4);
        const float et = __expf(mp - Mt);
        float den = et * qnv[t];
        f32x4 intra = {0.f, 0.f, 0.f, 0.f};
#pragma unroll
        for (int s = 0; s < 8; ++s) {
            if (s <= t) { const float w = __expf(gg[s] - Mt) * QK[t * 8 + s]; den += w; intra += w * vv[s]; }
        }
        const float dd = fmaxf(fabsf(den), __expf(-(Ft + Mt)));
        const f32x4 hv = (et * numc + intra) * (1.f / dd);
        float ss = hv[0] * hv[0] + hv[1] * hv[1] + hv[2] * hv[2] + hv[3] * hv[3];
        ss = wave_sum(ss);
        const u32x2 og = *(const u32x2*)(U + (size_t)(rowb + t) * N1P + UC_O + h * 256 + lane * 4);
        *(u32x2*)(MIX + (size_t)(rowb + t) * MIXW + 2048 + h * 256 + lane * 4) =
            (u32x2){pack2(hv[0] * sigm_f(bf_lo(og[0])), hv[1] * sigm_f(bf_hi(og[0]))), pack2(hv[2] * sigm_f(bf_lo(og[1])), hv[3] * sigm_f(bf_hi(og[1])))};
        if (lane < 4) ((float*)(p.ws + WS_SSQM))[(size_t)(rowb + t) * 32 + h * 4 + lane] = lane == 0 ? ss : 0.f;
        if (lane == 0) ((float*)(p.ws + WS_DD))[(size_t)(rowb + t) * 8 + h] = 1.f;
    }
    __syncthreads();
}

__device__ __forceinline__ void phase_scan(const Params& p, unsigned char* smem) {
#ifndef SC_MASK
#define SC_MASK 15
#endif
    for (int j = opaque_bid(); j < 256; j += gridDim.x) { if (j < 128) { if (SC_MASK & 1) prompt_scan<false>(p, smem, j); } else { if (SC_MASK & 2) prompt_scan<true>(p, smem, j - 128); } }
    if (SC_MASK & 4) for (int j = opaque_bid(); j < 256; j += gridDim.x) sample_ssd(p, smem, j);
    if (SC_MASK & 8) for (int j = opaque_bid(); j < 1024; j += gridDim.x) sample_ml(p, smem, j);
}

__device__ __forceinline__ void phase_mixnorm(const Params& p) {
    const int tid = opaque_tid(), wid = tid >> 6, lane = tid & 63;
    bf16_t* MIX = (bf16_t*)(p.ws + WS_MIX);
    const float* SSQ = (const float*)(p.ws + WS_SSQ); const float* SSQM = (const float*)(p.ws + WS_SSQM);
    const float* w1 = p.in[16]; const float* w2 = p.in[19];
    for (int row = opaque_bid() * 8 + wid; row < NVALID; row += gridDim.x * 8) {
        float s = lane < 32 ? SSQ[(size_t)row * 32 + lane] : 0.f;
        s = wave_sum(s);
        const float r1 = rsqrtf(s * (1.f / 2048.f) + EPS);
        float m = lane < 32 ? SSQM[(size_t)row * 32 + lane] : 0.f;
        m += __shfl_xor(m, 1); m += __shfl_xor(m, 2);
        const float ddh = lane < 32 ? ((const float*)(p.ws + WS_DD))[(size_t)row * 8 + (lane >> 2)] : 1.f;
        const float idd = 1.f / ddh;
        const float rh = rsqrtf(m * (1.f / 256.f) * idd * idd + EPS) * idd;
        u32x4 raws[8];
#pragma unroll
        for (int it = 0; it < 8; ++it) raws[it] = *(const u32x4*)(MIX + (size_t)row * MIXW + it * 512 + lane * 8);
#pragma unroll
        for (int it = 0; it < 8; ++it) {
            const int col = it * 512 + lane * 8;
            const u32x4 raw = raws[it];
            float scale; const float* wp;
            if (it < 4) { scale = r1; wp = w1 + col; }
            else { const int head = (it - 4) * 2 + (lane >> 5); scale = __shfl(rh, head * 4); wp = w2 + col - 2048; }
            const f32x4 wa = *(const f32x4*)wp, wb = *(const f32x4*)(wp + 4);
            u32x4 o;
            o[0] = pack2(bf_lo(raw[0]) * scale * wa[0], bf_hi(raw[0]) * scale * wa[1]); o[1] = pack2(bf_lo(raw[1]) * scale * wa[2], bf_hi(raw[1]) * scale * wa[3]);
            o[2] = pack2(bf_lo(raw[2]) * scale * wb[0], bf_hi(raw[2]) * scale * wb[1]); o[3] = pack2(bf_lo(raw[3]) * scale * wb[2], bf_hi(raw[3]) * scale * wb[3]);
            *(u32x4*)(MIX + (size_t)row * MIXW + col) = o;
        }
    }
    const bf16_t* U = (const bf16_t*)(p.ws + WS_U);
    for (int i = opaque_bid() * 512 + tid; i < 132 * 3 * 320; i += gridDim.x * 512) {
        const int cgp = i % 320, j = (i / 320) % 3, q = i / 960;
        int row; float* dst;
        if (q < 4) { row = q * 2048 + 2045 + j; dst = p.out + O_P_SSDCONV + (size_t)(q * 3 + j) * 2560 + cgp * 8; }
        else { row = ROW_SAMPLE + (q - 4) * 8 + 5 + j; dst = p.out + O_S_SSDCONV + (size_t)((q - 4) * 3 + j) * 2560 + cgp * 8; }
        const u32x4 raw = *(const u32x4*)(U + (size_t)row * N1P + UC_XBC + cgp * 8);
        *(f32x4*)dst = (f32x4){bf_lo(raw[0]), bf_hi(raw[0]), bf_lo(raw[1]), bf_hi(raw[1])};
        *(f32x4*)(dst + 4) = (f32x4){bf_lo(raw[2]), bf_hi(raw[2]), bf_lo(raw[3]), bf_hi(raw[3])};
    }
}

__device__ __forceinline__ void unpack8(const u32x4 raw, float (&x)[8]) {
#pragma unroll
    for (int i = 0; i < 4; ++i) { x[2 * i] = bf_lo(raw[i]); x[2 * i + 1] = bf_hi(raw[i]); }
}
__device__ __forceinline__ void phase_act(const Params& p) {
    const bf16_t* UP = (const bf16_t*)(p.ws + WS_UP); bf16_t* ACT = (bf16_t*)(p.ws + WS_ACT);
    const float* cw = p.in[23]; const float* cb = p.in[24]; const float* fst = p.in[7];
    constexpr int CGN = DFF / 8, TOTAL = (NVALID / 8) * CGN;
    const int tid = opaque_tid();
    for (int idx = opaque_bid() * 512 + tid; idx < TOTAL; idx += gridDim.x * 512) {
        const int rb = idx / CGN, cgp = idx % CGN, row0 = rb * 8, c0 = cgp * 8;
        float g2[8], g1[8], v2[8], v1[8];
        int prow = -1; bool from_state = false; int sb = 0, pb = -1;
        if (row0 < ROW_SAMPLE) { const int b = row0 >> 11, t0 = row0 & 2047; prow = t0 > 0 ? row0 - 2 : ROW_META + b * 16 + 14; if (t0 == 2040) pb = b; }
        else if (row0 < ROW_META) { from_state = true; sb = (row0 - ROW_SAMPLE) >> 3; }
        else { if ((row0 - ROW_META) & 15) prow = row0 - 2; }
        if (from_state) {
            const float* s0 = fst + (size_t)(sb * 2) * N3;
#pragma unroll
            for (int i = 0; i < 8; ++i) { g2[i] = s0[c0 + i]; g1[i] = s0[N3 + c0 + i]; v2[i] = s0[DFF + c0 + i]; v1[i] = s0[N3 + DFF + c0 + i]; }
        } else if (prow >= 0) {
            unpack8(*(const u32x4*)(UP + (size_t)prow * N3 + c0), g2); unpack8(*(const u32x4*)(UP + (size_t)(prow + 1) * N3 + c0), g1);
            unpack8(*(const u32x4*)(UP + (size_t)prow * N3 + DFF + c0), v2); unpack8(*(const u32x4*)(UP + (size_t)(prow + 1) * N3 + DFF + c0), v1);
        } else {
#pragma unroll
            for (int i = 0; i < 8; ++i) { g2[i] = 0.f; g1[i] = 0.f; v2[i] = 0.f; v1[i] = 0.f; }
        }
        float wg[3][8], wv[3][8], bg[8], bv[8];
#pragma unroll
        for (int j = 0; j < 3; ++j)
#pragma unroll
            for (int i = 0; i < 8; ++i) { wg[j][i] = cw[j * N3 + c0 + i]; wv[j][i] = cw[j * N3 + DFF + c0 + i]; }
#pragma unroll
        for (int i = 0; i < 8; ++i) { bg[i] = cb[c0 + i]; bv[i] = cb[DFF + c0 + i]; }
        u32x4 rg[8], rv[8];
#pragma unroll
        for (int r = 0; r < 8; ++r) { rg[r] = __builtin_nontemporal_load((const u32x4*)(UP + (size_t)(row0 + r) * N3 + c0)); rv[r] = __builtin_nontemporal_load((const u32x4*)(UP + (size_t)(row0 + r) * N3 + DFF + c0)); }
#pragma unroll
        for (int r = 0; r < 8; ++r) {
            float gx[8], vx[8];
            unpack8(rg[r], gx); unpack8(rv[r], vx);
            float o[8];
#pragma unroll
            for (int i = 0; i < 8; ++i) {
                const float yg = bg[i] + wg[0][i] * g2[i] + wg[1][i] * g1[i] + wg[2][i] * gx[i];
                const float yv = bv[i] + wv[0][i] * v2[i] + wv[1][i] * v1[i] + wv[2][i] * vx[i];
                o[i] = silu_f(yg) * yv;
                g2[i] = g1[i]; g1[i] = gx[i]; v2[i] = v1[i]; v1[i] = vx[i];
            }
            u32x4 ov; ov[0] = pack2(o[0], o[1]); ov[1] = pack2(o[2], o[3]); ov[2] = pack2(o[4], o[5]); ov[3] = pack2(o[6], o[7]);
            *(u32x4*)(ACT + (size_t)(row0 + r) * DFF + c0) = ov;
        }
        if (from_state || pb >= 0) {
            float* dst = from_state ? p.out + O_S_FFN + (size_t)(sb * 2) * N3 : p.out + O_P_FFN + (size_t)(pb * 2) * N3;
            *(f32x4*)(dst + c0) = (f32x4){g2[0], g2[1], g2[2], g2[3]}; *(f32x4*)(dst + c0 + 4) = (f32x4){g2[4], g2[5], g2[6], g2[7]};
            *(f32x4*)(dst + N3 + c0) = (f32x4){g1[0], g1[1], g1[2], g1[3]}; *(f32x4*)(dst + N3 + c0 + 4) = (f32x4){g1[4], g1[5], g1[6], g1[7]};
            *(f32x4*)(dst + DFF + c0) = (f32x4){v2[0], v2[1], v2[2], v2[3]}; *(f32x4*)(dst + DFF + c0 + 4) = (f32x4){v2[4], v2[5], v2[6], v2[7]};
            *(f32x4*)(dst + N3 + DFF + c0) = (f32x4){v1[0], v1[1], v1[2], v1[3]}; *(f32x4*)(dst + N3 + DFF + c0 + 4) = (f32x4){v1[4], v1[5], v1[6], v1[7]};
        }
    }
}

__device__ __forceinline__ void phase_final(const Params& p) {
    const int tid = opaque_tid(), wid = tid >> 6, lane = tid & 63;
    const float* SS3 = (const float*)(p.ws + WS_SS3); const float* nw = p.in[26];
    for (int row = opaque_bid() * 8 + wid; row < NOUTROWS; row += gridDim.x * 8) {
        const float r = rsqrtf(SS3[row] * (1.f / 2048.f) + EPS);
        float* rp = p.out + (size_t)row * DM;
        f32x4 v[8];
#pragma unroll
        for (int it = 0; it < 8; ++it) v[it] = __builtin_nontemporal_load((const f32x4*)(rp + it * 256 + lane * 4));
#pragma unroll
        for (int it = 0; it < 8; ++it) {
            const int col = it * 256 + lane * 4;
            const f32x4 w = *(const f32x4*)(nw + col);
            __builtin_nontemporal_store(v[it] * r * w, (f32x4*)(rp + col));
        }
    }
}

__global__ void __launch_bounds__(512, 2) hymba_fwd(Params p0) {
    extern __shared__ __attribute__((aligned(16))) unsigned char smem[];
    cg::grid_group grid = cg::this_grid();
#ifndef DUP_PHASE
#define DUP_PHASE -1
#endif
    for (int phx = p0.ph_lo; phx < p0.ph_hi + (DUP_PHASE >= 0 ? 1 : 0); ++phx) {
        const int ph = (DUP_PHASE >= 0 && phx > DUP_PHASE) ? phx - 1 : phx;
        Params p = p0;
        { size_t z = 0; asm volatile("" : "+s"(z)); p.ws = p0.ws + z; p.out = p0.out + z; }
        switch (ph) {
        case 0: if (PH_MASK & 1) phase_prep(p, smem); break;
        case 1: if (PH_MASK & 2) { pg8::Gemm g{(const bf16_t*)(p.ws + WS_XN), (const bf16_t*)(p.ws + WS_WIN), MP, N1P, 2048}; pg8::StaticOrder S; S.init(MP, N1P, gridDim.x, opaque_bid());
                  Epi1 E{(bf16_t*)(p.ws + WS_U), (float*)(p.ws + WS_SF)}; pg8::gemm_phase((LAS unsigned char*)smem, g, S, E);
                  convert_in_tail(p, smem, (MP / 256) * (N1P / 256), T_IN, T_IN + T_OUT); } break;
        case 2: if (PH_MASK & 4) phase_scan(p, smem); break;
        case 3: if (PH_MASK & 8) phase_mixnorm(p); break;
        case 4: if (PH_MASK & 16) { pg8::Gemm g{(const bf16_t*)(p.ws + WS_MIX), (const bf16_t*)(p.ws + WS_WOUT), MP, 2048, 4096}; pg8::StaticOrder S; S.init(MP, 2048, gridDim.x, opaque_bid());
                  Epi2 E{p}; pg8::gemm_phase((LAS unsigned char*)smem, g, S, E);
                  convert_in_tail(p, smem, (MP / 256) * (2048 / 256), T_IN + T_OUT, T_IN + T_OUT + T_UP); } break;
        case 5: if (PH_MASK & 32) { pg8::Gemm g{(const bf16_t*)(p.ws + WS_A2), (const bf16_t*)(p.ws + WS_WUP), MP, N3, 2048}; pg8::StaticOrder S; S.init(MP, N3, gridDim.x, opaque_bid());
                  Epi3 E{(bf16_t*)(p.ws + WS_UP), (const float*)(p.ws + WS_SS2)}; pg8::gemm_phase((LAS unsigned char*)smem, g, S, E);
                  convert_in_tail(p, smem, (MP / 256) * (N3 / 256), T_IN + T_OUT + T_UP, T_ALL); } break;
        case 6: if (PH_MASK & 64) phase_act(p); break;
        case 7: if (PH_MASK & 128) { pg8::Gemm g{(const bf16_t*)(p.ws + WS_ACT), (const bf16_t*)(p.ws + WS_WDOWN), MP, 2048, DFF}; pg8::StaticOrder S; S.init(MP, 2048, gridDim.x, opaque_bid());
                  Epi4 E{(const float*)(p.ws + WS_H1), p.out, (float*)(p.ws + WS_SS3)}; pg8::gemm_phase((LAS unsigned char*)smem, g, S, E); } break;
        default: if (PH_MASK & 256) phase_final(p); break;
        }
        if (phx + 1 < p0.ph_hi + (DUP_PHASE >= 0 ? 1 : 0)) grid.sync();
    }
}

extern "C" void kernel_launch(void* const* d_in, const int* in_sizes, int n_in, void* d_out, int out_size, void* d_ws, size_t ws_size, hipStream_t stream) {
    static int grid_blocks = 0;
    if (grid_blocks == 0) {
        if (n_in != 27 || (size_t)out_size != O_END || ws_size < WS_END) {
            fprintf(stderr, "kernel_launch: unexpected shapes: n_in %d out %d ws %zu (need %zu)\n", n_in, out_size, ws_size, (size_t)WS_END); grid_blocks = -1; return; }
        int dev = 0, cus = 0, per_cu = 0;
        (void)hipGetDevice(&dev);
        (void)hipDeviceGetAttribute(&cus, hipDeviceAttributeMultiprocessorCount, dev);
        (void)hipFuncSetAttribute((const void*)hymba_fwd, hipFuncAttributeMaxDynamicSharedMemorySize, LDS_BYTES);
        (void)hipOccupancyMaxActiveBlocksPerMultiprocessor(&per_cu, (const void*)hymba_fwd, 512, LDS_BYTES);
        if (per_cu < 1) { fprintf(stderr, "kernel_launch: occupancy query says %d blocks per CU\n", per_cu); per_cu = 1; }
        grid_blocks = cus;
    }
    if (grid_blocks < 0) return;
    Params p{};
    for (int i = 0; i < 27; ++i) p.in[i] = (const float*)d_in[i];
    p.out = (float*)d_out; p.ws = (unsigned char*)d_ws; p.ph_lo = 0; p.ph_hi = NPHASE;
    void* args[] = {&p};
    hipError_t e = hipLaunchCooperativeKernel((const void*)hymba_fwd, dim3(grid_blocks), dim3(512), args, LDS_BYTES, stream);
    if (e != hipSuccess) fprintf(stderr, "cooperative launch failed: %s (grid %d)\n", hipGetErrorString(e), grid_blocks);
}
```
